# Optimizing an MI355X kernel written in HIP

```python
import math
import jax, jax.numpy as jnp
from jax import lax
import numpy as np

D_MODEL = 2048
BATCH = 8
SEQ = 2048
DEPTH = 1

MIX_WIDTH = D_MODEL
HG_DK = 128
HG_DV = 128
HG_HEADS = (MIX_WIDTH // 2) // HG_DV
HG_KEY = HG_HEADS * HG_DK
HG_VAL = HG_HEADS * HG_DV
HG_CHUNK = 64
SWA_HEAD_DIM = 64
SWA_HEADS = (MIX_WIDTH // 2) // SWA_HEAD_DIM
SWA_KV_HEADS = SWA_HEADS // 8
SWA_GROUP = SWA_HEADS // SWA_KV_HEADS
SWA_WIDTH = SWA_HEADS * SWA_HEAD_DIM
SWA_KV_WIDTH = SWA_KV_HEADS * SWA_HEAD_DIM
WINDOW = 128
IN_SPLITS = (HG_KEY, HG_KEY, HG_VAL, HG_VAL, SWA_WIDTH, SWA_KV_WIDTH, SWA_KV_WIDTH)
IN_COLS = sum(IN_SPLITS)
IN_OFFSETS = [int(o) for o in np.cumsum(IN_SPLITS)[:-1]]
ATTN_COLS = SWA_WIDTH + 2 * SWA_KV_WIDTH
N_EXPERTS = 32
TOP_K = 4
D_FF = D_MODEL
SWIGLU_LIMIT = 7.0
SWIGLU_ALPHA = 1.702
MOE_BLOCK = 128
DEEPNORM_ALPHA = (2.0 * DEPTH) ** 0.25
DEEPNORM_BETA = (8.0 * DEPTH) ** -0.25
NORM_EPS = 1e-5

kernel_name = "hgrn2_swa_sink_moe_deepnorm"


def layer_norm(x, w, b):
    xf = x.astype(jnp.float32)
    mu = jnp.mean(xf, axis=-1, keepdims=True)
    var = jnp.mean(jnp.square(xf - mu), axis=-1, keepdims=True)
    y = (xf - mu) * lax.rsqrt(var + NORM_EPS) * w.astype(jnp.float32) + b.astype(jnp.float32)
    return y.astype(x.dtype)


def rms_norm(x, w):
    xf = x.astype(jnp.float32)
    y = xf * lax.rsqrt(jnp.mean(xf * xf, axis=-1, keepdims=True) + NORM_EPS) * w.astype(jnp.float32)
    return y.astype(x.dtype)


def hgrn2_chunk_scan(q, k, v, log_f):
    bsz, seq, n_heads, dk = q.shape
    dv = v.shape[-1]
    nc = seq // HG_CHUNK

    def to_chunks(t):
        return t.reshape(bsz, nc, HG_CHUNK, n_heads, t.shape[-1]).transpose(1, 0, 3, 2, 4)

    causal = jnp.tril(jnp.ones((HG_CHUNK, HG_CHUNK), dtype=bool))

    def step(state, inp):
        qc, kc, vc, gc = inp
        b = jnp.cumsum(gc, axis=2)
        o_inter = jnp.einsum('bhtk,bhkv->bhtv', qc * jnp.exp(b), state)
        diff = b[:, :, :, None, :] - b[:, :, None, :, :]
        decay = jnp.exp(jnp.where(causal[:, :, None], diff, -jnp.inf))
        scores = jnp.einsum('bhtk,bhsk,bhtsk->bhts', qc, kc, decay)
        o_intra = jnp.einsum('bhts,bhsv->bhtv', scores, vc)
        b_last = b[:, :, -1:, :]
        new_state = jnp.exp(b_last[:, :, 0, :, None]) * state + jnp.einsum(
            'bhsk,bhsv->bhkv', kc * jnp.exp(b_last - b), vc)
        return new_state, o_inter + o_intra

    state0 = jnp.zeros((bsz, n_heads, dk, dv), jnp.float32)
    _, outs = lax.scan(step, state0, (to_chunks(q), to_chunks(k), to_chunks(v), to_chunks(log_f)))
    return outs.transpose(1, 0, 3, 2, 4).reshape(bsz, seq, n_heads, dv)


def hgrn2_mixer(hq, hf, hi, hg, lower_bound, norm_w):
    bsz, seq, _ = hq.shape
    f32 = jnp.float32
    q = jax.nn.silu(hq.astype(f32))
    forget = lower_bound + (1.0 - lower_bound) * jax.nn.sigmoid(hf.astype(f32))
    log_f = jnp.log(forget)
    k = 1.0 - forget
    v = hi.astype(f32)

    def heads(t, d):
        return t.reshape(bsz, seq, HG_HEADS, d)

    o = hgrn2_chunk_scan(heads(q, HG_DK), heads(k, HG_DK), heads(v, HG_DV), heads(log_f, HG_DK))
    o = rms_norm(o, norm_w) * jax.nn.silu(heads(hg.astype(f32), HG_DV))
    return o.reshape(bsz, seq, HG_VAL).astype(hq.dtype)


def swa_sink_mixer(aq, ak, av, sinks, norm_w):
    bsz, seq, _ = aq.shape
    nb = seq // WINDOW
    q = aq.reshape(bsz, nb, WINDOW, SWA_KV_HEADS, SWA_GROUP, SWA_HEAD_DIM)

    def band(t):
        t = t.reshape(bsz, seq, SWA_KV_HEADS, SWA_HEAD_DIM)
        t = jnp.concatenate([jnp.zeros_like(t[:, :WINDOW]), t], axis=1)
        t = t.reshape(bsz, nb + 1, WINDOW, SWA_KV_HEADS, SWA_HEAD_DIM)
        return jnp.concatenate([t[:, :-1], t[:, 1:]], axis=2)

    k = band(ak)
    v = band(av)
    scores = jnp.einsum('bnqhgd,bnkhd->bnhgqk', q, k).astype(jnp.float32) * (SWA_HEAD_DIM ** -0.5)
    q_pos = jnp.arange(nb)[:, None, None] * WINDOW + jnp.arange(WINDOW)[None, :, None]
    k_pos = jnp.arange(nb)[:, None, None] * WINDOW - WINDOW + jnp.arange(2 * WINDOW)[None, None, :]
    allowed = (k_pos <= q_pos) & (k_pos > q_pos - WINDOW) & (k_pos >= 0)
    scores = jnp.where(allowed[None, :, None, None], scores, -jnp.inf)
    sink = jnp.broadcast_to(
        sinks.astype(jnp.float32).reshape(1, 1, SWA_KV_HEADS, SWA_GROUP, 1, 1),
        scores.shape[:-1] + (1,))
    probs = jax.nn.softmax(jnp.concatenate([scores, sink], axis=-1), axis=-1)[..., :-1]
    o = jnp.einsum('bnhgqk,bnkhd->bnqhgd', probs.astype(av.dtype), v).reshape(bsz, seq, SWA_WIDTH)
    return rms_norm(o, norm_w)


def clamped_swiglu(g, u):
    g = jnp.minimum(g, SWIGLU_LIMIT)
    u = jnp.clip(u, -SWIGLU_LIMIT, SWIGLU_LIMIT)
    return g * jax.nn.sigmoid(SWIGLU_ALPHA * g) * (u + 1.0)


def moe_ffn(x2, w_router, b_router, w_gate, b_gate, w_up, b_up, w_down, b_down):
    n_tok, d = x2.shape
    logits = (x2 @ w_router + b_router).astype(jnp.float32)
    top_vals, top_idx = lax.top_k(logits, TOP_K)
    gates = jax.nn.softmax(top_vals, axis=-1)
    n_assign = n_tok * TOP_K
    eid = top_idx.reshape(n_assign).astype(jnp.int32)
    tok = jnp.repeat(jnp.arange(n_tok, dtype=jnp.int32), TOP_K)
    gw = gates.reshape(n_assign)
    order = jnp.argsort(eid)
    eid_s, tok_s, gw_s = eid[order], tok[order], gw[order]
    counts = jnp.zeros((N_EXPERTS,), jnp.int32).at[eid].add(1)
    starts = jnp.cumsum(counts) - counts
    padded = (counts + MOE_BLOCK - 1) // MOE_BLOCK * MOE_BLOCK
    pad_ends = jnp.cumsum(padded)
    pad_starts = pad_ends - padded
    dest = pad_starts[eid_s] + (jnp.arange(n_assign, dtype=jnp.int32) - starts[eid_s])
    n_blocks = -(-n_assign // MOE_BLOCK) + N_EXPERTS
    n_rows = n_blocks * MOE_BLOCK
    row_tok = jnp.full((n_rows,), n_tok, jnp.int32).at[dest].set(tok_s)
    row_gate = jnp.zeros((n_rows,), x2.dtype).at[dest].set(gw_s.astype(x2.dtype))
    block_start = jnp.arange(n_blocks, dtype=jnp.int32) * MOE_BLOCK
    block_expert = jnp.minimum(jnp.searchsorted(pad_ends, block_start, side='right'), N_EXPERTS - 1)
    x_pad = jnp.concatenate([x2, jnp.zeros((1, d), x2.dtype)], axis=0)
    xb = x_pad[row_tok].reshape(n_blocks, MOE_BLOCK, d)

    def expert_block(args):
        xblk, e = args
        hg = xblk @ w_gate[e] + b_gate[e]
        hu = xblk @ w_up[e] + b_up[e]
        return clamped_swiglu(hg, hu) @ w_down[e] + b_down[e]

    yb = lax.map(expert_block, (xb, block_expert)).reshape(n_rows, d)
    y = jax.ops.segment_sum(yb * row_gate[:, None], row_tok, num_segments=n_tok + 1)
    return y[:n_tok]


def setup_inputs(seed: int = 0) -> dict:
    key = jax.random.key(seed)
    ks = jax.random.split(key, 24)
    f32 = jnp.float32

    def nrm(k, shape, scale):
        return jax.random.normal(k, shape, f32) * scale

    return {
        "x": nrm(ks[0], (BATCH, SEQ, D_MODEL), 1.0),
        "ln_emb_w": 1.0 + nrm(ks[1], (D_MODEL,), 0.02),
        "ln_emb_b": nrm(ks[2], (D_MODEL,), 0.02),
        "w_in": nrm(ks[3], (DEPTH, D_MODEL, IN_COLS), D_MODEL ** -0.5),
        "b_qkv": nrm(ks[4], (DEPTH, ATTN_COLS), 0.02),
        "lb_logits": nrm(ks[5], (DEPTH + 1, HG_KEY), 0.5),
        "hg_norm_w": 1.0 + nrm(ks[6], (DEPTH, HG_DV), 0.02),
        "attn_sinks": nrm(ks[7], (DEPTH, SWA_HEADS), 0.5),
        "attn_norm_w": 1.0 + nrm(ks[8], (DEPTH, SWA_WIDTH), 0.02),
        "w_out": nrm(ks[9], (DEPTH, MIX_WIDTH, D_MODEL), MIX_WIDTH ** -0.5 * DEEPNORM_BETA),
        "b_out": nrm(ks[10], (DEPTH, D_MODEL), 0.02),
        "ln1_w": 1.0 + nrm(ks[11], (DEPTH, D_MODEL), 0.02),
        "ln1_b": nrm(ks[12], (DEPTH, D_MODEL), 0.02),
        "w_router": nrm(ks[13], (DEPTH, D_MODEL, N_EXPERTS), D_MODEL ** -0.5),
        "b_router": nrm(ks[14], (DEPTH, N_EXPERTS), 0.01),
        "w_gate": nrm(ks[15], (DEPTH, N_EXPERTS, D_MODEL, D_FF), D_MODEL ** -0.5),
        "b_gate": nrm(ks[16], (DEPTH, N_EXPERTS, D_FF), 0.02),
        "w_up": nrm(ks[17], (DEPTH, N_EXPERTS, D_MODEL, D_FF), D_MODEL ** -0.5),
        "b_up": nrm(ks[18], (DEPTH, N_EXPERTS, D_FF), 0.02),
        "w_down": nrm(ks[19], (DEPTH, N_EXPERTS, D_FF, D_MODEL), D_FF ** -0.5 * DEEPNORM_BETA),
        "b_down": nrm(ks[20], (DEPTH, N_EXPERTS, D_MODEL), 0.02),
        "ln2_w": 1.0 + nrm(ks[21], (DEPTH, D_MODEL), 0.02),
        "ln2_b": nrm(ks[22], (DEPTH, D_MODEL), 0.02),
    }


def reference(x, ln_emb_w, ln_emb_b, w_in, b_qkv, lb_logits, hg_norm_w, attn_sinks, attn_norm_w,
              w_out, b_out, ln1_w, ln1_b, w_router, b_router, w_gate, b_gate, w_up, b_up,
              w_down, b_down, ln2_w, ln2_b):
    bsz, seq, d = x.shape
    lower_bounds = jnp.cumsum(jax.nn.softmax(lb_logits.astype(jnp.float32), axis=0), axis=0)
    h = layer_norm(x, ln_emb_w, ln_emb_b)
    for l in range(DEPTH):
        proj = jnp.einsum('bsd,dc->bsc', h, w_in[l])
        hq, hf, hi, hg, aq, ak, av = jnp.split(proj, IN_OFFSETS, axis=-1)
        bq, bk, bv = jnp.split(b_qkv[l], [SWA_WIDTH, SWA_WIDTH + SWA_KV_WIDTH])
        y_hg = hgrn2_mixer(hq, hf, hi, hg, lower_bounds[l], hg_norm_w[l])
        y_sw = swa_sink_mixer(aq + bq, ak + bk, av + bv, attn_sinks[l], attn_norm_w[l])
        mix = jnp.concatenate([y_hg, y_sw.astype(h.dtype)], axis=-1) @ w_out[l] + b_out[l]
        h = layer_norm(DEEPNORM_ALPHA * h + mix, ln1_w[l], ln1_b[l])
        ffn = moe_ffn(h.reshape(bsz * seq, d), w_router[l], b_router[l], w_gate[l], b_gate[l],
                      w_up[l], b_up[l], w_down[l], b_down[l]).reshape(bsz, seq, d)
        h = layer_norm(DEEPNORM_ALPHA * h + ffn, ln2_w[l], ln2_b[l])
    return h
```

```cpp
#include <hip/hip_runtime.h>
#include <cstdio>
#include <cstdint>

namespace {
constexpr int D = 2048, NB = 8, L = 2048, T = NB * L;
constexpr int INC = 5376;
constexpr int HGH = 8, DK = 128, DV = 128;
constexpr int AH = 16, KVH = 2, HD = 64, WIN = 128;
constexpr int NE = 32, TOPK = 4, FF = 2048;
constexpr int NA = T * TOPK;
constexpr float ALPHA = 1.189207115002721f;
constexpr float EPS = 1e-5f;
constexpr int C_HQ = 0, C_HF = 1024, C_HI = 2048, C_HG = 3072, C_AQ = 4096, C_AK = 5120, C_AV = 5248;

__device__ __forceinline__ float wave_sum(float v) {
#pragma unroll
    for (int o = 1; o < 64; o <<= 1) v += __shfl_xor(v, o);
    return v;
}
__device__ __forceinline__ float sigmoidf_(float x) { return 1.f / (1.f + __expf(-x)); }

__global__ void __launch_bounds__(256) ln_kernel(const float* __restrict__ in, const float* __restrict__ res, float alpha,
                                                  const float* __restrict__ w, const float* __restrict__ b, float* __restrict__ out) {
    __shared__ float red[8];
    const int row = blockIdx.x, tid = threadIdx.x;
    const float4* ip = (const float4*)(in + (size_t)row * D);
    float4 v[2];
#pragma unroll
    for (int j = 0; j < 2; ++j) {
        v[j] = ip[tid + 256 * j];
        if (res) { float4 r = ((const float4*)(res + (size_t)row * D))[tid + 256 * j]; v[j].x += alpha * r.x; v[j].y += alpha * r.y; v[j].z += alpha * r.z; v[j].w += alpha * r.w; }
    }
    float s = (v[0].x + v[0].y) + (v[0].z + v[0].w) + (v[1].x + v[1].y) + (v[1].z + v[1].w);
    s = wave_sum(s);
    if ((tid & 63) == 0) red[tid >> 6] = s;
    __syncthreads();
    const float mean = (red[0] + red[1] + red[2] + red[3]) * (1.f / D);
    float q = 0.f;
#pragma unroll
    for (int j = 0; j < 2; ++j) { v[j].x -= mean; v[j].y -= mean; v[j].z -= mean; v[j].w -= mean; q += v[j].x * v[j].x + v[j].y * v[j].y + v[j].z * v[j].z + v[j].w * v[j].w; }
    q = wave_sum(q);
    if ((tid & 63) == 0) red[4 + (tid >> 6)] = q;
    __syncthreads();
    const float rstd = rsqrtf((red[4] + red[5] + red[6] + red[7]) * (1.f / D) + EPS);
#pragma unroll
    for (int j = 0; j < 2; ++j) {
        const float4 ww = ((const float4*)w)[tid + 256 * j], bb = ((const float4*)b)[tid + 256 * j];
        float4 o; o.x = v[j].x * rstd * ww.x + bb.x; o.y = v[j].y * rstd * ww.y + bb.y; o.z = v[j].z * rstd * ww.z + bb.z; o.w = v[j].w * rstd * ww.w + bb.w;
        ((float4*)(out + (size_t)row * D))[tid + 256 * j] = o;
    }
}

struct MoePlan { const int* tile_e; const int* tile_row0; const int* tile_nrows; const int* ntiles; const int* row_tok; };
template <int MODE, int EPI>
__global__ void __launch_bounds__(256) gemm_f32(const float* __restrict__ A, int lda, const float* __restrict__ Bw, size_t bstride,
                                                const float* __restrict__ bias, size_t biasstride, float* C, int ldc, int M, int N, int K, MoePlan P) {
    __shared__ float As[8][128 + 4];
    __shared__ float Bs[8][128];
    const int tid = threadIdx.x;
    const int n0 = blockIdx.x * 128;
    int row0, nrows, e = 0;
    if (MODE == 0) { row0 = blockIdx.y * 128; nrows = M - row0 < 128 ? M - row0 : 128; }
    else { if ((int)blockIdx.y >= P.ntiles[0]) return; e = P.tile_e[blockIdx.y]; row0 = P.tile_row0[blockIdx.y]; nrows = P.tile_nrows[blockIdx.y]; }
    const float* Bp = Bw + (size_t)e * bstride;
    const float* bp = bias ? bias + (size_t)e * biasstride : nullptr;
    const int ar = tid >> 1, ak = (tid & 1) * 4;
    const float* arow;
    {
        int r = ar < nrows ? ar : 0;
        size_t grow;
        if (MODE == 1) grow = (size_t)P.row_tok[row0 + r]; else grow = (size_t)(row0 + r);
        arow = A + grow * lda;
    }
    const int bk = tid >> 5, bn = (tid & 31) * 4;
    const int ty = tid >> 4, tx = tid & 15;
    float acc[8][8];
#pragma unroll
    for (int i = 0; i < 8; ++i)
#pragma unroll
        for (int j = 0; j < 8; ++j) acc[i][j] = 0.f;
    for (int k0 = 0; k0 < K; k0 += 8) {
        const float4 av = *(const float4*)(arow + k0 + ak);
        const float4 bv = *(const float4*)(Bp + (size_t)(k0 + bk) * N + n0 + bn);
        __syncthreads();
        As[ak + 0][ar] = av.x; As[ak + 1][ar] = av.y; As[ak + 2][ar] = av.z; As[ak + 3][ar] = av.w;
        *(float4*)&Bs[bk][bn] = bv;
        __syncthreads();
#pragma unroll
        for (int k = 0; k < 8; ++k) {
            float a[8], b[8];
            const float4 a0 = *(const float4*)&As[k][ty * 8], a1 = *(const float4*)&As[k][ty * 8 + 4];
            const float4 b0 = *(const float4*)&Bs[k][tx * 8], b1 = *(const float4*)&Bs[k][tx * 8 + 4];
            a[0] = a0.x; a[1] = a0.y; a[2] = a0.z; a[3] = a0.w; a[4] = a1.x; a[5] = a1.y; a[6] = a1.z; a[7] = a1.w;
            b[0] = b0.x; b[1] = b0.y; b[2] = b0.z; b[3] = b0.w; b[4] = b1.x; b[5] = b1.y; b[6] = b1.z; b[7] = b1.w;
#pragma unroll
            for (int i = 0; i < 8; ++i)
#pragma unroll
                for (int j = 0; j < 8; ++j) acc[i][j] = fmaf(a[i], b[j], acc[i][j]);
        }
    }
#pragma unroll
    for (int i = 0; i < 8; ++i) {
        const int r = ty * 8 + i;
        if (r >= nrows) continue;
        float* crow = C + (size_t)(row0 + r) * ldc + n0 + tx * 8;
#pragma unroll
        for (int j = 0; j < 8; ++j) {
            float v = acc[i][j] + (bp ? bp[n0 + tx * 8 + j] : 0.f);
            if (EPI == 1) {
                float g = crow[j];
                g = fminf(g, 7.f);
                const float u = fminf(fmaxf(v, -7.f), 7.f);
                v = g * sigmoidf_(1.702f * g) * (u + 1.f);
            }
            crow[j] = v;
        }
    }
}

constexpr int HG_TT = 16;
__global__ void __launch_bounds__(256) hgrn_direct(const float* __restrict__ proj, const float* __restrict__ lb_logits, float* __restrict__ o_raw) {
    __shared__ float fS[HG_TT][128], kS[HG_TT][128], qS[HG_TT][128], vS[HG_TT][32];
    const int tid = threadIdx.x, kg = tid & 7, col = tid >> 3;
    const int vq = blockIdx.x & 3, h = (blockIdx.x >> 2) & 7, b = blockIdx.x >> 5;
    float S[16];
#pragma unroll
    for (int i = 0; i < 16; ++i) S[i] = 0.f;
    for (int t0 = 0; t0 < L; t0 += HG_TT) {
        __syncthreads();
        for (int i = tid; i < HG_TT * 128; i += 256) {
            const int tt = i >> 7, k = i & 127;
            const size_t row = (size_t)(b * L + t0 + tt) * INC;
            const float hq = proj[row + C_HQ + h * 128 + k], hf = proj[row + C_HF + h * 128 + k];
            const float l0 = lb_logits[h * 128 + k], l1 = lb_logits[1024 + h * 128 + k];
            const float mx = fmaxf(l0, l1);
            const float e0 = __expf(l0 - mx), e1 = __expf(l1 - mx);
            const float lb = e0 / (e0 + e1);
            const float f = lb + (1.f - lb) * sigmoidf_(hf);
            fS[tt][k] = f; kS[tt][k] = 1.f - f; qS[tt][k] = hq * sigmoidf_(hq);
        }
        for (int i = tid; i < HG_TT * 32; i += 256) {
            const int tt = i >> 5, c = i & 31;
            vS[tt][c] = proj[(size_t)(b * L + t0 + tt) * INC + C_HI + h * 128 + vq * 32 + c];
        }
        __syncthreads();
        for (int tt = 0; tt < HG_TT; ++tt) {
            const float v = vS[tt][col];
            float o = 0.f;
#pragma unroll
            for (int i = 0; i < 16; ++i) {
                const int k = kg * 16 + i;
                S[i] = fS[tt][k] * S[i] + kS[tt][k] * v;
                o += S[i] * qS[tt][k];
            }
            o += __shfl_xor(o, 1); o += __shfl_xor(o, 2); o += __shfl_xor(o, 4);
            if (kg == 0) o_raw[(size_t)(b * L + t0 + tt) * 1024 + h * 128 + vq * 32 + col] = o;
        }
    }
}
__global__ void __launch_bounds__(256) hgrn_post(const float* __restrict__ o_raw, const float* __restrict__ proj, const float* __restrict__ nw, float* __restrict__ ymix) {
    const int tid = threadIdx.x, lane = tid & 63, w = tid >> 6;
    const int hh = blockIdx.x * 4 + w;
    const int tok = hh >> 3, h = hh & 7;
    const float a0 = o_raw[(size_t)tok * 1024 + h * 128 + lane], a1 = o_raw[(size_t)tok * 1024 + h * 128 + 64 + lane];
    const float ms = wave_sum(a0 * a0 + a1 * a1) * (1.f / 128.f);
    const float r = rsqrtf(ms + EPS);
    const float g0 = proj[(size_t)tok * INC + C_HG + h * 128 + lane], g1 = proj[(size_t)tok * INC + C_HG + h * 128 + 64 + lane];
    ymix[(size_t)tok * D + h * 128 + lane] = a0 * r * nw[lane] * (g0 * sigmoidf_(g0));
    ymix[(size_t)tok * D + h * 128 + 64 + lane] = a1 * r * nw[64 + lane] * (g1 * sigmoidf_(g1));
}

constexpr int ATT_ROWS = 64 + WIN - 1;
constexpr int ATT_LD = 65;
__global__ void __launch_bounds__(256) attn_direct(const float* __restrict__ proj, const float* __restrict__ b_qkv, const float* __restrict__ sinks, float* __restrict__ o_raw) {
    extern __shared__ float sm[];
    float* Ks = sm; float* Vs = sm + ATT_ROWS * ATT_LD;
    const int tid = threadIdx.x;
    const int hg = blockIdx.x & 3, qt = (blockIdx.x >> 2) & 31, b = blockIdx.x >> 7;
    const int kvh = hg >> 1;
    const int t0 = qt * 64;
    for (int i = tid; i < ATT_ROWS * 64; i += 256) {
        const int r = i >> 6, d = i & 63;
        const int pos = t0 - (WIN - 1) + r;
        float kv = 0.f, vv = 0.f;
        if (pos >= 0) {
            const size_t row = (size_t)(b * L + pos) * INC;
            kv = proj[row + C_AK + kvh * 64 + d] + b_qkv[1024 + kvh * 64 + d];
            vv = proj[row + C_AV + kvh * 64 + d] + b_qkv[1152 + kvh * 64 + d];
        }
        Ks[r * ATT_LD + d] = kv; Vs[r * ATT_LD + d] = vv;
    }
    __syncthreads();
    const int qi = tid & 63, hl = tid >> 6;
    const int head = hg * 4 + hl;
    const int qpos = t0 + qi;
    float q[64], acc[64];
    {
        const size_t row = (size_t)(b * L + qpos) * INC;
#pragma unroll
        for (int d = 0; d < 64; ++d) { q[d] = (proj[row + C_AQ + head * 64 + d] + b_qkv[head * 64 + d]) * 0.125f; acc[d] = 0.f; }
    }
    float m = sinks[head], l = 1.f;
    for (int j = 0; j < WIN; ++j) {
        const int r = qi + j;
        const int kpos = qpos - (WIN - 1) + j;
        if (kpos < 0) continue;
        float s = 0.f;
#pragma unroll
        for (int d = 0; d < 64; ++d) s = fmaf(q[d], Ks[r * ATT_LD + d], s);
        const float mn = fmaxf(m, s);
        const float sc = __expf(m - mn), p = __expf(s - mn);
        l = l * sc + p;
#pragma unroll
        for (int d = 0; d < 64; ++d) acc[d] = acc[d] * sc + p * Vs[r * ATT_LD + d];
        m = mn;
    }
    const float inv = 1.f / l;
    float* op = o_raw + (size_t)(b * L + qpos) * 1024 + head * 64;
#pragma unroll
    for (int d = 0; d < 64; ++d) op[d] = acc[d] * inv;
}
__global__ void __launch_bounds__(256) attn_post(const float* __restrict__ o_raw, const float* __restrict__ nw, float* __restrict__ ymix) {
    __shared__ float red[4];
    const int tok = blockIdx.x, tid = threadIdx.x;
    const float4 v = ((const float4*)(o_raw + (size_t)tok * 1024))[tid];
    float s = wave_sum(v.x * v.x + v.y * v.y + v.z * v.z + v.w * v.w);
    if ((tid & 63) == 0) red[tid >> 6] = s;
    __syncthreads();
    const float r = rsqrtf((red[0] + red[1] + red[2] + red[3]) * (1.f / 1024.f) + EPS);
    const float4 w = ((const float4*)nw)[tid];
    float4 o; o.x = v.x * r * w.x; o.y = v.y * r * w.y; o.z = v.z * r * w.z; o.w = v.w * r * w.w;
    ((float4*)(ymix + (size_t)tok * D + 1024))[tid] = o;
}

__global__ void __launch_bounds__(256) router_kernel(const float* __restrict__ h1, const float* __restrict__ wr, const float* __restrict__ br,
                                                     int* __restrict__ cnt, int* __restrict__ tok_e, int* __restrict__ tok_pos, float* __restrict__ tok_gate) {
    const int tid = threadIdx.x, lane = tid & 63, w = tid >> 6;
    const int tok = blockIdx.x * 4 + w;
    const int e = lane & 31, half = lane >> 5;
    const float* hp = h1 + (size_t)tok * D + half * 1024;
    const float* wp = wr + (size_t)half * 1024 * NE + e;
    float s = 0.f;
    for (int k = 0; k < 1024; ++k) s = fmaf(hp[k], wp[(size_t)k * NE], s);
    s += __shfl_xor(s, 32);
    s += br[e];
    float val = s; int te[4]; float tv[4];
#pragma unroll
    for (int r = 0; r < 4; ++r) {
        float bv = val; int bi = e;
#pragma unroll
        for (int o = 1; o < 32; o <<= 1) {
            const float ov = __shfl_xor(bv, o); const int oi = __shfl_xor(bi, o);
            if (ov > bv || (ov == bv && oi < bi)) { bv = ov; bi = oi; }
        }
        te[r] = bi; tv[r] = bv;
        if (e == bi) val = -INFINITY;
    }
    const float mx = tv[0];
    float p[4], ps = 0.f;
#pragma unroll
    for (int r = 0; r < 4; ++r) { p[r] = __expf(tv[r] - mx); ps += p[r]; }
    if (lane < 4) {
        int ee = te[0]; float g = p[0];
        if (lane == 1) { ee = te[1]; g = p[1]; } else if (lane == 2) { ee = te[2]; g = p[2]; } else if (lane == 3) { ee = te[3]; g = p[3]; }
        const int pos = atomicAdd(&cnt[ee], 1);
        tok_e[tok * 4 + lane] = ee; tok_pos[tok * 4 + lane] = pos; tok_gate[tok * 4 + lane] = g / ps;
    }
}
__global__ void plan_kernel(const int* __restrict__ cnt, int* __restrict__ offs, int* tile_e, int* tile_row0, int* tile_nrows, int* ntiles) {
    if (threadIdx.x == 0) {
        int o = 0, nt = 0;
        for (int e = 0; e < NE; ++e) {
            offs[e] = o;
            const int c = cnt[e];
            for (int r = 0; r < c; r += 128) { tile_e[nt] = e; tile_row0[nt] = o + r; tile_nrows[nt] = (c - r) < 128 ? (c - r) : 128; ++nt; }
            o += c;
        }
        ntiles[0] = nt;
    }
}
__global__ void __launch_bounds__(256) scatter_kernel(const int* __restrict__ tok_e, const int* __restrict__ tok_pos, const int* __restrict__ offs, int* __restrict__ row_tok) {
    const int i = blockIdx.x * 256 + threadIdx.x;
    if (i < NA) row_tok[offs[tok_e[i]] + tok_pos[i]] = i >> 2;
}
__global__ void __launch_bounds__(256) combine_kernel(const float* __restrict__ Y, const float* __restrict__ h1, const int* __restrict__ tok_e, const int* __restrict__ tok_pos,
                                                      const float* __restrict__ tok_gate, const int* __restrict__ offs, const float* __restrict__ w, const float* __restrict__ b, float* __restrict__ out) {
    __shared__ float red[8];
    const int tok = blockIdx.x, tid = threadIdx.x;
    float4 v[2];
#pragma unroll
    for (int j = 0; j < 2; ++j) { const float4 r = ((const float4*)(h1 + (size_t)tok * D))[tid + 256 * j]; v[j].x = ALPHA * r.x; v[j].y = ALPHA * r.y; v[j].z = ALPHA * r.z; v[j].w = ALPHA * r.w; }
#pragma unroll
    for (int k = 0; k < 4; ++k) {
        const int row = offs[tok_e[tok * 4 + k]] + tok_pos[tok * 4 + k];
        const float g = tok_gate[tok * 4 + k];
#pragma unroll
        for (int j = 0; j < 2; ++j) { const float4 y = ((const float4*)(Y + (size_t)row * D))[tid + 256 * j]; v[j].x += g * y.x; v[j].y += g * y.y; v[j].z += g * y.z; v[j].w += g * y.w; }
    }
    float s = (v[0].x + v[0].y) + (v[0].z + v[0].w) + (v[1].x + v[1].y) + (v[1].z + v[1].w);
    s = wave_sum(s);
    if ((tid & 63) == 0) red[tid >> 6] = s;
    __syncthreads();
    const float mean = (red[0] + red[1] + red[2] + red[3]) * (1.f / D);
    float q = 0.f;
#pragma unroll
    for (int j = 0; j < 2; ++j) { v[j].x -= mean; v[j].y -= mean; v[j].z -= mean; v[j].w -= mean; q += v[j].x * v[j].x + v[j].y * v[j].y + v[j].z * v[j].z + v[j].w * v[j].w; }
    q = wave_sum(q);
    if ((tid & 63) == 0) red[4 + (tid >> 6)] = q;
    __syncthreads();
    const float rstd = rsqrtf((red[4] + red[5] + red[6] + red[7]) * (1.f / D) + EPS);
#pragma unroll
    for (int j = 0; j < 2; ++j) {
        const float4 ww = ((const float4*)w)[tid + 256 * j], bb = ((const float4*)b)[tid + 256 * j];
        float4 o; o.x = v[j].x * rstd * ww.x + bb.x; o.y = v[j].y * rstd * ww.y + bb.y; o.z = v[j].z * rstd * ww.z + bb.z; o.w = v[j].w * rstd * ww.w + bb.w;
        ((float4*)(out + (size_t)tok * D))[tid + 256 * j] = o;
    }
}
}

extern "C" void kernel_launch(void* const* d_in, const int* in_sizes, int n_in, void* d_out, int out_size, void* d_ws, size_t ws_size, hipStream_t stream) {
    const float* x = (const float*)d_in[0];
    const float* ln_emb_w = (const float*)d_in[1]; const float* ln_emb_b = (const float*)d_in[2];
    const float* w_in = (const float*)d_in[3]; const float* b_qkv = (const float*)d_in[4];
    const float* lb_logits = (const float*)d_in[5]; const float* hg_norm_w = (const float*)d_in[6];
    const float* attn_sinks = (const float*)d_in[7]; const float* attn_norm_w = (const float*)d_in[8];
    const float* w_out = (const float*)d_in[9]; const float* b_out = (const float*)d_in[10];
    const float* ln1_w = (const float*)d_in[11]; const float* ln1_b = (const float*)d_in[12];
    const float* w_router = (const float*)d_in[13]; const float* b_router = (const float*)d_in[14];
    const float* w_gate = (const float*)d_in[15]; const float* b_gate = (const float*)d_in[16];
    const float* w_up = (const float*)d_in[17]; const float* b_up = (const float*)d_in[18];
    const float* w_down = (const float*)d_in[19]; const float* b_down = (const float*)d_in[20];
    const float* ln2_w = (const float*)d_in[21]; const float* ln2_b = (const float*)d_in[22];
    float* out = (float*)d_out;

    char* ws = (char*)d_ws;
    size_t off = 0;
    auto carve = [&](size_t bytes) { char* p = ws + off; off += (bytes + 255) & ~(size_t)255; return p; };
    int* ctl = (int*)carve(4096);
    int* cnt = ctl, *offs = ctl + 64, *ntiles = ctl + 128;
    int* tile_e = (int*)carve(1024 * 4); int* tile_row0 = (int*)carve(1024 * 4); int* tile_nrows = (int*)carve(1024 * 4);
    int* tok_e = (int*)carve((size_t)NA * 4); int* tok_pos = (int*)carve((size_t)NA * 4); float* tok_gate = (float*)carve((size_t)NA * 4);
    int* row_tok = (int*)carve((size_t)NA * 4);
    float* h0 = (float*)carve((size_t)T * D * 4);
    float* proj = (float*)carve((size_t)T * INC * 4);
    float* o_hg = (float*)carve((size_t)T * 1024 * 4);
    float* o_sw = (float*)carve((size_t)T * 1024 * 4);
    float* ymix = (float*)carve((size_t)T * D * 4);
    float* mix = (float*)carve((size_t)T * D * 4);
    float* h1 = (float*)carve((size_t)T * D * 4);
    float* G = (float*)carve((size_t)NA * FF * 4);
    float* Y = (float*)carve((size_t)NA * D * 4);
    if (off > ws_size) { fprintf(stderr, "ws too small: need %zu have %zu\n", off, ws_size); return; }

    hipMemsetAsync(ctl, 0, 4096, stream);
    ln_kernel<<<T, 256, 0, stream>>>(x, nullptr, 0.f, ln_emb_w, ln_emb_b, h0);
    MoePlan P0{nullptr, nullptr, nullptr, nullptr, nullptr};
    gemm_f32<0, 0><<<dim3(INC / 128, T / 128), 256, 0, stream>>>(h0, D, w_in, 0, nullptr, 0, proj, INC, T, INC, D, P0);
    hgrn_direct<<<NB * HGH * 4, 256, 0, stream>>>(proj, lb_logits, o_hg);
    hgrn_post<<<T * HGH / 4, 256, 0, stream>>>(o_hg, proj, hg_norm_w, ymix);
    static bool attr_set = false;
    const int att_lds = 2 * ATT_ROWS * ATT_LD * 4;
    if (!attr_set) { hipFuncSetAttribute((const void*)attn_direct, hipFuncAttributeMaxDynamicSharedMemorySize, att_lds); attr_set = true; }
    attn_direct<<<NB * 32 * 4, 256, att_lds, stream>>>(proj, b_qkv, attn_sinks, o_sw);
    attn_post<<<T, 256, 0, stream>>>(o_sw, attn_norm_w, ymix);
    gemm_f32<0, 0><<<dim3(D / 128, T / 128), 256, 0, stream>>>(ymix, D, w_out, 0, b_out, 0, mix, D, T, D, D, P0);
    ln_kernel<<<T, 256, 0, stream>>>(mix, h0, ALPHA, ln1_w, ln1_b, h1);
    router_kernel<<<T / 4, 256, 0, stream>>>(h1, w_router, b_router, cnt, tok_e, tok_pos, tok_gate);
    plan_kernel<<<1, 64, 0, stream>>>(cnt, offs, tile_e, tile_row0, tile_nrows, ntiles);
    scatter_kernel<<<NA / 256, 256, 0, stream>>>(tok_e, tok_pos, offs, row_tok);
    MoePlan P{tile_e, tile_row0, tile_nrows, ntiles, row_tok};
    const int max_tiles = NA / 128 + NE;
    gemm_f32<1, 0><<<dim3(FF / 128, max_tiles), 256, 0, stream>>>(h1, D, w_gate, (size_t)D * FF, b_gate, FF, G, FF, NA, FF, D, P);
    gemm_f32<1, 1><<<dim3(FF / 128, max_tiles), 256, 0, stream>>>(h1, D, w_up, (size_t)D * FF, b_up, FF, G, FF, NA, FF, D, P);
    gemm_f32<2, 0><<<dim3(D / 128, max_tiles), 256, 0, stream>>>(G, FF, w_down, (size_t)FF * D, b_down, D, Y, D, NA, D, FF, P);
    combine_kernel<<<T, 256, 0, stream>>>(Y, h1, tok_e, tok_pos, tok_gate, offs, ln2_w, ln2_b, out);
}
```

```cpp
#include <hip/hip_runtime.h>
#include <cstdio>
#include <cstdint>

#ifndef MK_PER_PHASE
#define MK_PER_PHASE 0
#endif

#define LAS __attribute__((address_space(3)))
#define GAS __attribute__((address_space(1)))
typedef unsigned short bf16_t;
typedef short bf16x8 __attribute__((ext_vector_type(8)));
typedef float f32x4 __attribute__((ext_vector_type(4)));
typedef float f32x2 __attribute__((ext_vector_type(2)));
typedef unsigned u32x4 __attribute__((ext_vector_type(4)));
typedef unsigned u32x2 __attribute__((ext_vector_type(2)));
typedef GAS unsigned gu32;

namespace {
constexpr int D = 2048, NB = 8, L = 2048, T = NB * L;
constexpr int INC = 5376;
constexpr int NE = 32, FF = 2048, NA = T * 4;
constexpr int LISTCAP = T;
constexpr int MAXROWS = NA + NE * 256;
constexpr float ALPHA = 1.189207115002721f;
constexpr float EPS = 1e-5f;
constexpr int NWAVES = 8, NTHR = 512;
constexpr int NPHASE = 8;

constexpr size_t MiB = 1u << 20;
constexpr size_t WS_CTL = 0, CTL_ZERO_BYTES = 1 * MiB;
constexpr size_t WS_LB = 1 * MiB;
constexpr size_t WS_STATS0 = WS_LB + 4096;
constexpr size_t WS_LIST = 2 * MiB;
constexpr size_t WS_TOKE = 4 * MiB, WS_TOKP = WS_TOKE + (size_t)NA * 4, WS_TOKG = WS_TOKP + (size_t)NA * 4;
constexpr size_t WS_WIN = 8 * MiB;
constexpr size_t WS_WOUT = 30 * MiB;
constexpr size_t WS_WGU = 40 * MiB;
constexpr size_t WS_WD = 552 * MiB;
constexpr size_t WS_H1 = 808 * MiB;
constexpr size_t WS_Z = 872 * MiB;
constexpr size_t WS_HACT = 1000 * MiB;
constexpr size_t WS_EARLY = 1288 * MiB;
constexpr size_t WS_H0 = WS_EARLY;
constexpr size_t WS_QH = WS_H0 + 64 * MiB, WS_KH = WS_QH + 32 * MiB, WS_VH = WS_KH + 32 * MiB, WS_OG = WS_VH + 32 * MiB, WS_AQ = WS_OG + 32 * MiB;
constexpr size_t WS_GH = WS_AQ + 32 * MiB;
constexpr size_t WS_AK = WS_GH + 64 * MiB, WS_AV = WS_AK + 4 * MiB;
constexpr size_t WS_YMIX = WS_AV + 4 * MiB;
constexpr size_t WS_Y = WS_EARLY;
constexpr size_t WS_END = WS_YMIX + 64 * MiB;
static_assert(WS_Y + (size_t)MAXROWS * 4096 <= WS_END + 0 * MiB || true, "");
static_assert(WS_END <= 2048 * MiB, "d_ws map");
constexpr int CW_CNT = 64;
constexpr int CW_BAR = 4096;

constexpr int RING_BYTES = 131072;
constexpr int LDSCTL_OFF = RING_BYTES;
constexpr int LDS_BYTES = 147456;
constexpr int LC_BAR = 0, LC_PTS = 64, LC_CNT = 256, LC_TILEE = 512, LC_MISC = 2048;

#define RLX_AGENT __ATOMIC_RELAXED, __HIP_MEMORY_SCOPE_AGENT
__device__ __forceinline__ unsigned f2bf(float f) { unsigned u = __builtin_bit_cast(unsigned, f); return (u + 0x7fffu + ((u >> 16) & 1u)) >> 16; }
__device__ __forceinline__ unsigned pk2(float lo, float hi) { return f2bf(lo) | (f2bf(hi) << 16); }
__device__ __forceinline__ float bf2f(unsigned short b) { return __builtin_bit_cast(float, (unsigned)b << 16); }
__device__ __forceinline__ float bflo(unsigned w) { return __builtin_bit_cast(float, w << 16); }
__device__ __forceinline__ float bfhi(unsigned w) { return __builtin_bit_cast(float, w & 0xffff0000u); }
__device__ __forceinline__ unsigned cvt_pk_bf16(float lo, float hi) { unsigned r; asm volatile("v_cvt_pk_bf16_f32 %0, %1, %2" : "=v"(r) : "v"(lo), "v"(hi)); return r; }
__device__ __forceinline__ float wave_sum(float v) {
#pragma unroll
    for (int o = 1; o < 64; o <<= 1) v += __shfl_xor(v, o);
    return v;
}
__device__ __forceinline__ float sigm(float x) { return __builtin_amdgcn_rcpf(1.f + __expf(-x)); }

#define XB_TMO      128
#define XB_XCNT(j)  (256  + 64 * (j))
#define XB_XSUB(j)  (1280 + 64 * (j))
#define XB_XGEN(j)  (2304 + 64 * (j))
#define XB_TOP      3328
#define XB_TOPGEN   3392
#define XCD_BAR_WORDS 3456
#define XB_SPIN_CAP (1u << 18)
__device__ __forceinline__ unsigned xb_ld(unsigned* p)              { return __hip_atomic_load(p, __ATOMIC_RELAXED, __HIP_MEMORY_SCOPE_AGENT); }
__device__ __forceinline__ unsigned xb_add(unsigned* p, unsigned v) { return __hip_atomic_fetch_add(p, v, __ATOMIC_RELAXED, __HIP_MEMORY_SCOPE_AGENT); }
__device__ __forceinline__ unsigned xb_xcc_id() { return (unsigned)__builtin_amdgcn_s_getreg((3 << 11) | 20) & 0xFu; }
#define XB_SPIN(cond, bar) do { unsigned _sp = 0; while (cond) { __builtin_amdgcn_s_sleep(1); \
    if ((++_sp & 255u) == 0u) { if (xb_ld(&(bar)[XB_TMO])) break; if (_sp > XB_SPIN_CAP) { atomicAdd(&(bar)[XB_TMO], 1u); break; } } } } while (0)
struct XcdBarrier { unsigned* bar; unsigned x; volatile LAS unsigned* st; };
__device__ __forceinline__ XcdBarrier xcd_barrier_post(unsigned* bar, volatile LAS unsigned* st) {
    XcdBarrier b; b.bar = bar; b.x = xb_xcc_id(); b.st = st;
    if (threadIdx.x == 0) (void)xb_add(&bar[XB_XCNT(b.x)], 1u);
    return b;
}
__device__ __forceinline__ void xcd_barrier_complete(unsigned* bar, unsigned x, unsigned& nloc, unsigned& nx) {
    const unsigned G = gridDim.x * gridDim.y * gridDim.z;
    unsigned sum, cnt, mine, sp = 0u;
    for (;;) {
        sum = 0u; cnt = 0u; mine = 0u;
#pragma unroll
        for (unsigned j = 0; j < 16; ++j) { const unsigned c = xb_ld(&bar[XB_XCNT(j)]); sum += c; cnt += (c > 0u) ? 1u : 0u; mine = (j == x) ? c : mine; }
        if (sum == G) break;
        __builtin_amdgcn_s_sleep(1);
        if ((++sp & 255u) == 0u) { if (xb_ld(&bar[XB_TMO])) break; if (sp > XB_SPIN_CAP) { atomicAdd(&bar[XB_TMO], 1u); break; } }
    }
    nloc = mine > 0u ? mine : 1u; nx = cnt > 0u ? cnt : 1u;
}
__device__ __forceinline__ void xcd_barrier(const XcdBarrier& b) {
    asm volatile("s_waitcnt vmcnt(0)" ::: "memory");
    __syncthreads();
    if (threadIdx.x == 0) {
        unsigned* bar = b.bar;
        __builtin_amdgcn_s_waitcnt(0);
        unsigned nloc = b.st[0], nx = b.st[1];
        if (nloc == 0u) { xcd_barrier_complete(bar, b.x, nloc, nx); b.st[0] = nloc; b.st[1] = nx; }
        const unsigned old = xb_add(&bar[XB_XSUB(b.x)], 1u);
        const unsigned gen = old / nloc;
        if (old + 1u == (gen + 1u) * nloc) {
            __builtin_amdgcn_fence(__ATOMIC_RELEASE, "agent");
            asm volatile("s_waitcnt vmcnt(0)" ::: "memory");
            const unsigned og = xb_add(&bar[XB_TOP], 1u);
            const unsigned tg = og / nx;
            if (og + 1u == (tg + 1u) * nx) xb_add(&bar[XB_TOPGEN], 1u);
            else XB_SPIN(xb_ld(&bar[XB_TOPGEN]) == tg, bar);
            __builtin_amdgcn_fence(__ATOMIC_ACQUIRE, "agent");
            xb_add(&bar[XB_XGEN(b.x)], 1u);
            asm volatile("s_waitcnt vmcnt(0)" ::: "memory");
        } else {
            XB_SPIN(xb_ld(&bar[XB_XGEN(b.x)]) == gen, bar);
            __builtin_amdgcn_fence(__ATOMIC_ACQUIRE, "agent");
            asm volatile("s_waitcnt vmcnt(0)" ::: "memory");
        }
    }
    __syncthreads();
}

constexpr int BM = 256, BK = 64, HALF = 128, HTB = HALF * BK * 2, NXCD = 8, WGM = 8;
constexpr int KD = 2048, NT = KD / BK;
__device__ __forceinline__ int lds_byte(int r, int c) { const int st = (r >> 4) * 2 + (c >> 5), rr = r & 15, cc = c & 31, ob = rr * 64 + cc * 2; return st * 1024 + (ob ^ (((ob >> 9) & 1) << 5)); }
__device__ __forceinline__ void stage_rc(int b, int& R, int& C) { const int st = b / 1024, sb = b % 1024, swz = sb ^ (((sb >> 9) & 1) << 5); R = (st >> 1) * 16 + swz / 64; C = (st & 1) * 32 + (swz % 64) / 2; }
__device__ __forceinline__ int perm32(int rho) { const int n = rho >> 4, i = rho & 15; return 8 * (i >> 2) + 4 * n + (i & 3); }

struct GU { const char* A; const char* B; int pm, pn, e, mtl; };

__device__ __forceinline__ bool order_next(int i, int G, int c, int nM, int nN, int& pm, int& pn) {
    const int nwg = nM * nN; const long Lx = (long)i * G + c; if (Lx >= nwg) return false;
    int wgid = (int)Lx; { const int q = nwg / NXCD, r = nwg % NXCD, xcd = wgid % NXCD, off = wgid / NXCD; wgid = (xcd < r ? xcd * (q + 1) : r * (q + 1) + (xcd - r) * q) + off; }
    const int nig = WGM * nN, gid = wgid / nig, fm = gid * WGM, gsz = (nM - fm) < WGM ? (nM - fm) : WGM;
    pm = fm + ((wgid % nig) % gsz); pn = (wgid % nig) / gsz; return true;
}

template <class Epi, class Sched>
__device__ __forceinline__ void gemm_phase(LAS unsigned char* lds, const Sched& S, const Epi& E) {
    const int tid = threadIdx.x, wid = __builtin_amdgcn_readfirstlane(tid >> 6), lane = tid & 63, wr = wid >> 2, wc = wid & 3, fr = lane & 15, fq = lane >> 4;
    constexpr int K = KD, nt = NT;
    int Rr[2], Cc[2]; unsigned voffB[2];
#pragma unroll
    for (int i = 0; i < 2; ++i) { stage_rc(tid * 16 + i * 8192, Rr[i], Cc[i]); const int Rb = Epi::PERM ? ((Rr[i] & ~31) + perm32(Rr[i] & 31)) : Rr[i]; voffB[i] = (unsigned)(Rb * K + Cc[i]) * 2u; }
    const size_t kstep = (size_t)(BK * 2);
    const size_t hstep = (size_t)HALF * K * 2;
    const unsigned ldsw = (unsigned)wid * 1024u;
    const int aoff = lds_byte(wr * 64 + fr, fq * 8), boff = lds_byte(wc * 32 + fr, fq * 8);
#define PG8_SA(b, h) (((b) * 2 + (h)) * HTB)
#define PG8_SB(b, h) ((4 + (b) * 2 + (h)) * HTB)
#define PG8_STAGE(bufoff, gbase, voff) do { _Pragma("unroll") for (int _i = 0; _i < 2; ++_i) \
        __builtin_amdgcn_global_load_lds((const unsigned*)((const char*)(gbase) + (voff)[_i]), (LAS unsigned*)(lds + (bufoff) + ldsw + _i * 8192), 16, 0, 0); } while (0)
#define PG8_LDA(dst, b, h) do { _Pragma("unroll") for (int m = 0; m < 4; ++m) _Pragma("unroll") for (int k = 0; k < 2; ++k) dst[m][k] = *(const LAS bf16x8*)(lds + PG8_SA(b, h) + aoff + m * 2048 + k * 1024); } while (0)
#define PG8_LDB(dst, b, h) do { _Pragma("unroll") for (int n = 0; n < 2; ++n) _Pragma("unroll") for (int k = 0; k < 2; ++k) dst[n][k] = *(const LAS bf16x8*)(lds + PG8_SB(b, h) + boff + n * 2048 + k * 1024); } while (0)
#define PG8_MMA(ai, bj, At, Bt) do { __builtin_amdgcn_s_setprio(1); _Pragma("unroll") for (int m = 0; m < 4; ++m) _Pragma("unroll") for (int n = 0; n < 2; ++n) _Pragma("unroll") for (int k = 0; k < 2; ++k) \
        acc[ai][bj][m][n] = __builtin_amdgcn_mfma_f32_16x16x32_bf16(Bt[n][k], At[m][k], acc[ai][bj][m][n], 0, 0, 0); __builtin_amdgcn_s_setprio(0); } while (0)
#define PG8_WAIT_V(n) asm volatile("s_waitcnt vmcnt(" #n ")" ::: "memory")
#define PG8_WAIT_L(n) asm volatile("s_waitcnt lgkmcnt(" #n ")" ::: "memory")
#define PG8_BAR __builtin_amdgcn_s_barrier()
#define PG8_SCHED __builtin_amdgcn_sched_barrier(0)
    GU cur, nxt; int ui = 0;
    if (!S.next(0, cur)) return;
    f32x4 acc[2][2][4][2];
#pragma unroll
    for (int a = 0; a < 2; ++a)
#pragma unroll
        for (int b = 0; b < 2; ++b)
#pragma unroll
            for (int m = 0; m < 4; ++m)
#pragma unroll
                for (int n = 0; n < 2; ++n) acc[a][b][m][n] = (f32x4){0.f, 0.f, 0.f, 0.f};
    bf16x8 At[4][2], B0[2][2], B1[2][2];
    unsigned oc0[2], oc1[2], on0[2], on1[2];
    S.a_off(cur, Rr, Cc, oc0, oc1);
    const char* cA = cur.A; const char* cB = cur.B;
    PG8_STAGE(PG8_SB(0, 0), cB, voffB); PG8_STAGE(PG8_SB(0, 1), cB + hstep, voffB); PG8_STAGE(PG8_SA(0, 0), cA, oc0); PG8_STAGE(PG8_SA(0, 1), cA, oc1);
    if (wr == 1) PG8_BAR;
    PG8_WAIT_V(2); PG8_BAR;
    PG8_STAGE(PG8_SB(1, 0), cB + kstep, voffB); PG8_STAGE(PG8_SA(1, 0), cA + kstep, oc0); PG8_STAGE(PG8_SB(1, 1), cB + hstep + kstep, voffB);
    PG8_WAIT_V(6); PG8_BAR;
    for (;;) {
        const bool has_next = S.next(ui + 1, nxt);
        const char* nA = has_next ? nxt.A : cA; const char* nB = has_next ? nxt.B : cB;
        for (int t = 0; t < nt; t += 2) {
            const bool last = (t == nt - 2);
            const char* a1 = cA + (size_t)(t + 1) * kstep;
            const char* a2 = last ? nA : cA + (size_t)(t + 2) * kstep; const char* b2 = last ? nB : cB + (size_t)(t + 2) * kstep;
            const char* a3 = a2 + kstep; const char* b3 = b2 + kstep;
            unsigned o20[2], o21[2];
            if (last) {
                if (has_next) S.a_off(nxt, Rr, Cc, on0, on1); else { on0[0] = oc0[0]; on0[1] = oc0[1]; on1[0] = oc1[0]; on1[1] = oc1[1]; }
                o20[0] = on0[0]; o20[1] = on0[1]; o21[0] = on1[0]; o21[1] = on1[1];
            } else { o20[0] = oc0[0]; o20[1] = oc0[1]; o21[0] = oc1[0]; o21[1] = oc1[1]; }
            PG8_LDB(B0, 0, 0); PG8_LDB(B1, 0, 1); PG8_SCHED; PG8_LDA(At, 0, 0); PG8_STAGE(PG8_SA(1, 1), a1, oc1);
            PG8_WAIT_V(8); PG8_WAIT_L(0); PG8_BAR; PG8_MMA(0, 0, At, B0); PG8_MMA(0, 1, At, B1); PG8_BAR; PG8_SCHED;
            PG8_LDA(At, 0, 1); PG8_STAGE(PG8_SB(0, 0), b2, voffB); PG8_STAGE(PG8_SB(0, 1), b2 + hstep, voffB); PG8_STAGE(PG8_SA(0, 0), a2, o20);
            PG8_WAIT_V(8); PG8_WAIT_L(0); PG8_BAR; PG8_MMA(1, 0, At, B0); PG8_MMA(1, 1, At, B1); PG8_BAR; PG8_SCHED;
            PG8_LDB(B0, 1, 0); PG8_LDB(B1, 1, 1); PG8_SCHED; PG8_LDA(At, 1, 0); PG8_STAGE(PG8_SA(0, 1), a2, o21);
            PG8_WAIT_V(8); PG8_WAIT_L(0); PG8_BAR; PG8_MMA(0, 0, At, B0); PG8_MMA(0, 1, At, B1); PG8_BAR; PG8_SCHED;
            PG8_LDA(At, 1, 1); PG8_STAGE(PG8_SB(1, 0), b3, voffB); PG8_STAGE(PG8_SB(1, 1), b3 + hstep, voffB); PG8_STAGE(PG8_SA(1, 0), a3, o20);
            PG8_WAIT_V(8); PG8_WAIT_L(0); PG8_BAR; PG8_MMA(1, 0, At, B0); PG8_MMA(1, 1, At, B1); PG8_BAR; PG8_SCHED;
        }
        if (wr == 0) PG8_BAR;
        E(acc, cur, wr, wc, fr, fq);
        if (!has_next) break;
#pragma unroll
        for (int a = 0; a < 2; ++a)
#pragma unroll
            for (int b = 0; b < 2; ++b)
#pragma unroll
                for (int m = 0; m < 4; ++m)
#pragma unroll
                    for (int n = 0; n < 2; ++n) acc[a][b][m][n] = (f32x4){0.f, 0.f, 0.f, 0.f};
        cur = nxt; cA = nA; cB = nB; ++ui;
        oc0[0] = on0[0]; oc0[1] = on0[1]; oc1[0] = on1[0]; oc1[1] = on1[1];
        if (wr == 1) PG8_BAR;
    }
    PG8_WAIT_V(0);
    PG8_BAR;
#undef PG8_SA
#undef PG8_SB
#undef PG8_STAGE
#undef PG8_LDA
#undef PG8_LDB
#undef PG8_MMA
#undef PG8_WAIT_V
#undef PG8_WAIT_L
#undef PG8_BAR
#undef PG8_SCHED
}

struct SchedDense {
    const bf16_t* A; const bf16_t* Bt; int nM, nN, G, c;
    __device__ __forceinline__ bool next(int i, GU& u) const {
        int pm, pn; if (!order_next(i, G, c, nM, nN, pm, pn)) return false;
        u.pm = pm; u.pn = pn; u.e = 0; u.mtl = pm; u.A = (const char*)A; u.B = (const char*)Bt + (size_t)pn * (256 * KD * 2); return true;
    }
    __device__ __forceinline__ void a_off(const GU& u, const int (&R)[2], const int (&C)[2], unsigned (&o0)[2], unsigned (&o1)[2]) const {
#pragma unroll
        for (int i = 0; i < 2; ++i) { o0[i] = (unsigned)((u.pm * 256 + R[i]) * KD + C[i]) * 2u; o1[i] = (unsigned)((u.pm * 256 + 128 + R[i]) * KD + C[i]) * 2u; }
    }
};
struct SchedMoe {
    const bf16_t* A; const bf16_t* Bt; size_t bstride_e;
    const int* list; const LAS int* pts; const LAS int* cntl; const LAS unsigned char* tileE;
    int nM, nN, G, c; bool gather;
    __device__ __forceinline__ bool next(int i, GU& u) const {
        int pm, pn; if (!order_next(i, G, c, nM, nN, pm, pn)) return false;
        const int e = __builtin_amdgcn_readfirstlane((int)tileE[pm]);
        u.pm = pm; u.pn = pn; u.e = e; u.mtl = pm - __builtin_amdgcn_readfirstlane(pts[e]);
        u.A = (const char*)A; u.B = (const char*)Bt + (size_t)e * bstride_e + (size_t)pn * (256 * KD * 2); return true;
    }
    __device__ __forceinline__ void a_off(const GU& u, const int (&R)[2], const int (&C)[2], unsigned (&o0)[2], unsigned (&o1)[2]) const {
        if (gather) {
            const int ce = __builtin_amdgcn_readfirstlane(cntl[u.e]);
            const int* lp = list + (size_t)u.e * LISTCAP;
#pragma unroll
            for (int i = 0; i < 2; ++i) {
                int i0 = u.mtl * 256 + R[i], i1 = i0 + 128;
                i0 = i0 < ce ? i0 : 0; i1 = i1 < ce ? i1 : 0;
                const int t0 = lp[i0], t1 = lp[i1];
                o0[i] = (unsigned)(t0 * KD + C[i]) * 2u; o1[i] = (unsigned)(t1 * KD + C[i]) * 2u;
            }
        } else {
#pragma unroll
            for (int i = 0; i < 2; ++i) { o0[i] = (unsigned)((u.pm * 256 + R[i]) * KD + C[i]) * 2u; o1[i] = (unsigned)((u.pm * 256 + 128 + R[i]) * KD + C[i]) * 2u; }
        }
    }
};

__device__ __forceinline__ u32x4 pack8(const f32x4& a, const f32x4& b) { u32x4 w; w.x = cvt_pk_bf16(a[0], a[1]); w.y = cvt_pk_bf16(a[2], a[3]); w.z = cvt_pk_bf16(b[0], b[1]); w.w = cvt_pk_bf16(b[2], b[3]); return w; }

struct EpiInProj {
    static constexpr bool PERM = true;
    bf16_t *QH, *KH, *VH, *OG, *AQ, *AK, *AV; float* GH; const float* lb; const float* bqkv;
    __device__ __forceinline__ void operator()(const f32x4 (&acc)[2][2][4][2], const GU& u, int wr, int wc, int fr, int fq) const {
        const int row0 = u.pm * BM + wr * 64 + fr;
        const int type = u.pn >> 2;
        const int cw = wc * 32 + 8 * fq;
#pragma unroll
        for (int bj = 0; bj < 2; ++bj) {
            const int col = (u.pn & 3) * 256 + bj * HALF + cw;
            if (type == 0 || type == 3) {
                bf16_t* O = (type == 0 ? QH : OG);
#pragma unroll
                for (int ai = 0; ai < 2; ++ai)
#pragma unroll
                    for (int m = 0; m < 4; ++m) { f32x4 v0 = acc[ai][bj][m][0], v1 = acc[ai][bj][m][1];
#pragma unroll
                        for (int j = 0; j < 4; ++j) { v0[j] = v0[j] * sigm(v0[j]); v1[j] = v1[j] * sigm(v1[j]); }
                        *(u32x4*)(O + (size_t)(row0 + ai * HALF + m * 16) * 1024 + col) = pack8(v0, v1); }
            } else if (type == 1) {
                const f32x4 l0 = *(const f32x4*)(lb + col), l1 = *(const f32x4*)(lb + col + 4);
#pragma unroll
                for (int ai = 0; ai < 2; ++ai)
#pragma unroll
                    for (int m = 0; m < 4; ++m) { f32x4 v0 = acc[ai][bj][m][0], v1 = acc[ai][bj][m][1], g0, g1;
#pragma unroll
                        for (int j = 0; j < 4; ++j) { const float s0 = sigm(v0[j]), s1 = sigm(v1[j]);
                            const float f0 = l0[j] + (1.f - l0[j]) * s0, f1 = l1[j] + (1.f - l1[j]) * s1;
                            g0[j] = __logf(f0); g1[j] = __logf(f1); v0[j] = 1.f - f0; v1[j] = 1.f - f1; }
                        const size_t o = (size_t)(row0 + ai * HALF + m * 16) * 1024 + col;
                        *(u32x4*)(KH + o) = pack8(v0, v1); *(f32x4*)(GH + o) = g0; *(f32x4*)(GH + o + 4) = g1; }
            } else if (type == 2) {
#pragma unroll
                for (int ai = 0; ai < 2; ++ai)
#pragma unroll
                    for (int m = 0; m < 4; ++m) *(u32x4*)(VH + (size_t)(row0 + ai * HALF + m * 16) * 1024 + col) = pack8(acc[ai][bj][m][0], acc[ai][bj][m][1]);
            } else if (type == 4) {
                const f32x4 b0 = *(const f32x4*)(bqkv + col), b1 = *(const f32x4*)(bqkv + col + 4);
#pragma unroll
                for (int ai = 0; ai < 2; ++ai)
#pragma unroll
                    for (int m = 0; m < 4; ++m) { const f32x4 v0 = (acc[ai][bj][m][0] + b0) * 0.125f, v1 = (acc[ai][bj][m][1] + b1) * 0.125f;
                        *(u32x4*)(AQ + (size_t)(row0 + ai * HALF + m * 16) * 1024 + col) = pack8(v0, v1); }
            } else {
                bf16_t* O = bj == 0 ? AK : AV;
                const f32x4 b0 = *(const f32x4*)(bqkv + 1024 + bj * 128 + cw), b1 = *(const f32x4*)(bqkv + 1024 + bj * 128 + cw + 4);
#pragma unroll
                for (int ai = 0; ai < 2; ++ai)
#pragma unroll
                    for (int m = 0; m < 4; ++m) *(u32x4*)(O + (size_t)(row0 + ai * HALF + m * 16) * 128 + cw) = pack8(acc[ai][bj][m][0] + b0, acc[ai][bj][m][1] + b1);
            }
        }
    }
};
struct EpiOutProj {
    static constexpr bool PERM = false;
    float* Z; const float* x; const float* stats; const float* lnw; const float* lnb; const float* bo;
    __device__ __forceinline__ void operator()(const f32x4 (&acc)[2][2][4][2], const GU& u, int wr, int wc, int fr, int fq) const {
        const int row0 = u.pm * BM + wr * 64 + fr, col0 = u.pn * BM + wc * 32 + 4 * fq;
#pragma unroll
        for (int ai = 0; ai < 2; ++ai)
#pragma unroll
            for (int m = 0; m < 4; ++m) {
                const int row = row0 + ai * HALF + m * 16;
                const f32x2 st = *(const f32x2*)(stats + 2 * row);
#pragma unroll
                for (int bj = 0; bj < 2; ++bj)
#pragma unroll
                    for (int n = 0; n < 2; ++n) {
                        const int col = col0 + bj * HALF + n * 16;
                        const f32x4 xv = *(const f32x4*)(x + (size_t)row * D + col), w4 = *(const f32x4*)(lnw + col), b4 = *(const f32x4*)(lnb + col), o4 = *(const f32x4*)(bo + col);
                        f32x4 z;
#pragma unroll
                        for (int j = 0; j < 4; ++j) z[j] = ALPHA * ((xv[j] - st.x) * st.y * w4[j] + b4[j]) + acc[ai][bj][m][n][j] + o4[j];
                        *(f32x4*)(Z + (size_t)row * D + col) = z;
                    }
            }
    }
};
struct EpiMoe1 {
    static constexpr bool PERM = true;
    bf16_t* H; const float* bg; const float* bu;
    __device__ __forceinline__ void operator()(const f32x4 (&acc)[2][2][4][2], const GU& u, int wr, int wc, int fr, int fq) const {
        const int row0 = u.pm * BM + wr * 64 + fr, hc = u.pn * 128 + wc * 32 + 8 * fq;
        const float* bgp = bg + (size_t)u.e * FF + hc; const float* bup = bu + (size_t)u.e * FF + hc;
        const f32x4 g0b = *(const f32x4*)bgp, g1b = *(const f32x4*)(bgp + 4), u0b = *(const f32x4*)bup, u1b = *(const f32x4*)(bup + 4);
#pragma unroll
        for (int ai = 0; ai < 2; ++ai)
#pragma unroll
            for (int m = 0; m < 4; ++m) {
                f32x4 a0 = acc[ai][0][m][0] + g0b, a1 = acc[ai][0][m][1] + g1b, c0 = acc[ai][1][m][0] + u0b, c1 = acc[ai][1][m][1] + u1b;
#pragma unroll
                for (int j = 0; j < 4; ++j) {
                    const float gg0 = fminf(a0[j], 7.f), gg1 = fminf(a1[j], 7.f);
                    const float uu0 = fminf(fmaxf(c0[j], -7.f), 7.f), uu1 = fminf(fmaxf(c1[j], -7.f), 7.f);
                    a0[j] = gg0 * sigm(1.702f * gg0) * (uu0 + 1.f); a1[j] = gg1 * sigm(1.702f * gg1) * (uu1 + 1.f);
                }
                *(u32x4*)(H + (size_t)(row0 + ai * HALF + m * 16) * FF + hc) = pack8(a0, a1);
            }
    }
};
struct EpiMoe2 {
    static constexpr bool PERM = true;
    bf16_t* Y; const float* bd;
    __device__ __forceinline__ void operator()(const f32x4 (&acc)[2][2][4][2], const GU& u, int wr, int wc, int fr, int fq) const {
        const int row0 = u.pm * BM + wr * 64 + fr, col0 = u.pn * BM + wc * 32 + 8 * fq;
        const float* bp = bd + (size_t)u.e * D + col0;
#pragma unroll
        for (int bj = 0; bj < 2; ++bj) {
            const f32x4 b0 = *(const f32x4*)(bp + bj * HALF), b1 = *(const f32x4*)(bp + bj * HALF + 4);
#pragma unroll
            for (int ai = 0; ai < 2; ++ai)
#pragma unroll
                for (int m = 0; m < 4; ++m) *(u32x4*)(Y + (size_t)(row0 + ai * HALF + m * 16) * D + col0 + bj * HALF) = pack8(acc[ai][bj][m][0] + b0, acc[ai][bj][m][1] + b1);
        }
    }
};

struct Args { const float* in[23]; float* out; unsigned char* ws; int ph_lo, ph_hi; };
struct Frame { LAS unsigned char* lds; int tid, lane, wave, G, vcu; unsigned char* ws; };

__device__ __forceinline__ void p0_transpose_item(const float* W, int N, int k0, int n0, bf16_t* WT_row0  , LAS float* scr, int lane) {
#pragma unroll 8
    for (int i = 0; i < 32; ++i) { const int kk = 2 * i + (lane >> 5); scr[kk * 33 + (lane & 31)] = W[(size_t)(k0 + kk) * N + n0 + (lane & 31)]; }
    asm volatile("s_waitcnt lgkmcnt(0)" ::: "memory");
    const int c = lane & 7;
#pragma unroll
    for (int j = 0; j < 4; ++j) { const int n = (lane >> 3) + 8 * j; const LAS float* s = scr + (8 * c) * 33 + n;
        u32x4 o; o.x = pk2(s[0 * 33], s[1 * 33]); o.y = pk2(s[2 * 33], s[3 * 33]); o.z = pk2(s[4 * 33], s[5 * 33]); o.w = pk2(s[6 * 33], s[7 * 33]);
        *(GAS u32x4*)(WT_row0 + (size_t)n * KD + k0 + 8 * c) = o; }
    asm volatile("s_waitcnt lgkmcnt(0)" ::: "memory");
}

__device__ __forceinline__ void p0_prologue(Frame& F, const Args& a) {
    LAS float* scr = (LAS float*)(F.lds + F.wave * 16384);
    const int gw = F.vcu * NWAVES + F.wave, NGW = F.G * NWAVES;
    unsigned char* ws = F.ws;
    if (gw < 16) { const int i = gw * 64 + F.lane; const float* lbl = a.in[5]; const float l0 = lbl[i], l1 = lbl[1024 + i]; const float mx = fmaxf(l0, l1); const float e0 = __expf(l0 - mx), e1 = __expf(l1 - mx);
        ((float*)(ws + WS_LB))[i] = e0 / (e0 + e1); }
    {
        const float* x = a.in[0]; const float* w = a.in[1]; const float* b = a.in[2];
        bf16_t* H0 = (bf16_t*)(ws + WS_H0); float* st = (float*)(ws + WS_STATS0);
        for (int m = gw; m < T; m += NGW) {
            const GAS f32x4* xr = (const GAS f32x4*)(x + (size_t)m * D) + F.lane;
            f32x4 v[8]; float s = 0.f;
#pragma unroll
            for (int j = 0; j < 8; ++j) { v[j] = xr[64 * j]; s += (v[j][0] + v[j][1]) + (v[j][2] + v[j][3]); }
            const float mean = wave_sum(s) * (1.f / D); float s2 = 0.f;
#pragma unroll
            for (int j = 0; j < 8; ++j) { v[j] = v[j] - mean; s2 += (v[j][0] * v[j][0] + v[j][1] * v[j][1]) + (v[j][2] * v[j][2] + v[j][3] * v[j][3]); }
            const float rstd = rsqrtf(wave_sum(s2) * (1.f / D) + EPS);
            if (F.lane == 0) { st[2 * m] = mean; st[2 * m + 1] = rstd; }
            GAS u32x2* o8 = (GAS u32x2*)(H0 + (size_t)m * D) + F.lane;
#pragma unroll
            for (int j = 0; j < 8; ++j) { const f32x4 ww = *((const f32x4*)w + F.lane + 64 * j), bb = *((const f32x4*)b + F.lane + 64 * j);
                u32x2 o; o.x = pk2(v[j][0] * rstd * ww[0] + bb[0], v[j][1] * rstd * ww[1] + bb[1]); o.y = pk2(v[j][2] * rstd * ww[2] + bb[2], v[j][3] * rstd * ww[3] + bb[3]); o8[64 * j] = o; }
        }
    }
    constexpr int I_IN = 32 * (INC / 32), I_OUT = 32 * 64, I_E = 32 * 64;
    constexpr int NITEMS = I_IN + I_OUT + NE * 3 * I_E;
    for (int it = gw; it < NITEMS; it += NGW) {
        int r = it;
        if (r < I_IN) { const int nb = INC / 32, kb = r / nb, n0 = 32 * (r % nb); p0_transpose_item(a.in[3], INC, 64 * kb, n0, (bf16_t*)(ws + WS_WIN) + (size_t)n0 * KD, scr, F.lane); continue; } r -= I_IN;
        if (r < I_OUT) { const int kb = r / 64, n0 = 32 * (r % 64); p0_transpose_item(a.in[9], D, 64 * kb, n0, (bf16_t*)(ws + WS_WOUT) + (size_t)n0 * KD, scr, F.lane); continue; } r -= I_OUT;
        const int e = r / (3 * I_E), q = r % (3 * I_E), which = q / I_E, r2 = q % I_E, kb = r2 / 64, n0 = 32 * (r2 % 64);
        if (which < 2) {
            const float* W = a.in[which == 0 ? 15 : 17] + (size_t)e * D * FF;
            bf16_t* dst = (bf16_t*)(ws + WS_WGU) + ((size_t)e * 4096 + (size_t)(n0 >> 7) * 256 + which * 128 + (n0 & 127)) * KD;
            p0_transpose_item(W, FF, 64 * kb, n0, dst, scr, F.lane);
        } else {
            const float* W = a.in[19] + (size_t)e * FF * D;
            bf16_t* dst = (bf16_t*)(ws + WS_WD) + ((size_t)e * 2048 + n0) * KD;
            p0_transpose_item(W, D, 64 * kb, n0, dst, scr, F.lane);
        }
    }
}

constexpr int HG_TT = 16;
__device__ __forceinline__ void hgrn_unit(Frame& F, const Args& a, int b, int h) {
    LAS float* fS = (LAS float*)F.lds; LAS float* kS = fS + HG_TT * 128; LAS float* qS = kS + HG_TT * 128; LAS float* vS = qS + HG_TT * 128; LAS float* oS = vS + HG_TT * 128;
    const bf16_t* QH = (const bf16_t*)(F.ws + WS_QH); const bf16_t* KH = (const bf16_t*)(F.ws + WS_KH); const bf16_t* VH = (const bf16_t*)(F.ws + WS_VH); const bf16_t* OG = (const bf16_t*)(F.ws + WS_OG);
    const float* GH = (const float*)(F.ws + WS_GH);
    bf16_t* YM = (bf16_t*)(F.ws + WS_YMIX);
    const int tid = F.tid, kg = tid & 3, col = tid >> 2;
    float S[32];
#pragma unroll
    for (int i = 0; i < 32; ++i) S[i] = 0.f;
    for (int t0 = 0; t0 < L; t0 += HG_TT) {
        __syncthreads();
        for (int i = tid; i < HG_TT * 128; i += NTHR) {
            const int tt = i >> 7, k = i & 127; const size_t o = (size_t)(b * L + t0 + tt) * 1024 + h * 128 + k;
            fS[i] = __expf(GH[o]); kS[i] = bf2f(KH[o]); qS[i] = bf2f(QH[o]); vS[i] = bf2f(VH[o]);
        }
        __syncthreads();
        for (int tt = 0; tt < HG_TT; ++tt) {
            const float v = vS[tt * 128 + col];
            float o = 0.f;
#pragma unroll
            for (int i = 0; i < 32; ++i) { const int k = kg * 32 + i; S[i] = fS[tt * 128 + k] * S[i] + kS[tt * 128 + k] * v; o += S[i] * qS[tt * 128 + k]; }
            o += __shfl_xor(o, 1); o += __shfl_xor(o, 2);
            if (kg == 0) oS[tt * 128 + col] = o;
        }
        __syncthreads();
#pragma unroll
        for (int q = 0; q < 2; ++q) {
            const int tt = F.wave * 2 + q;
            const float a0 = oS[tt * 128 + F.lane], a1 = oS[tt * 128 + 64 + F.lane];
            const float r = rsqrtf(wave_sum(a0 * a0 + a1 * a1) * (1.f / 128.f) + EPS);
            const size_t o = (size_t)(b * L + t0 + tt) * 1024 + h * 128;
            const float* nw = a.in[6];
            const float g0 = bf2f(OG[o + F.lane]), g1 = bf2f(OG[o + 64 + F.lane]);
            YM[(size_t)(b * L + t0 + tt) * D + h * 128 + F.lane] = (bf16_t)f2bf(a0 * r * nw[F.lane] * g0);
            YM[(size_t)(b * L + t0 + tt) * D + h * 128 + 64 + F.lane] = (bf16_t)f2bf(a1 * r * nw[64 + F.lane] * g1);
        }
    }
}
constexpr int AT_Q = 32, AT_ROWS = AT_Q + 127, AT_LD = 66;
__device__ __forceinline__ void attn_unit(Frame& F, const Args& a, int b, int qt) {
    LAS unsigned short* Ks = (LAS unsigned short*)F.lds;
    LAS unsigned short* Vs = Ks + 2 * AT_ROWS * AT_LD;
    LAS float* ssq = (LAS float*)(Vs + 2 * AT_ROWS * AT_LD);
    const bf16_t* AQ = (const bf16_t*)(F.ws + WS_AQ); const bf16_t* AK = (const bf16_t*)(F.ws + WS_AK); const bf16_t* AV = (const bf16_t*)(F.ws + WS_AV);
    bf16_t* YM = (bf16_t*)(F.ws + WS_YMIX);
    const int tid = F.tid, t0 = qt * AT_Q;
    __syncthreads();
    for (int i = tid; i < 2 * AT_ROWS * 32; i += NTHR) {
        const int dw = i & 31, r = (i >> 5) % AT_ROWS, kvh = (i >> 5) / AT_ROWS;
        const int pos = t0 - 127 + r;
        unsigned kv = 0u, vv = 0u;
        if (pos >= 0) { const size_t o = (size_t)(b * L + pos) * 128 + kvh * 64 + dw * 2; kv = *(const unsigned*)(AK + o); vv = *(const unsigned*)(AV + o); }
        *(LAS unsigned*)(Ks + (kvh * AT_ROWS + r) * AT_LD + dw * 2) = kv; *(LAS unsigned*)(Vs + (kvh * AT_ROWS + r) * AT_LD + dw * 2) = vv;
    }
    __syncthreads();
    const int qi = tid & 31, head = tid >> 5, kvh = head >> 3;
    const int qpos = t0 + qi;
    float q[64], acc[64];
    { const u32x4* qp = (const u32x4*)(AQ + (size_t)(b * L + qpos) * 1024 + head * 64);
#pragma unroll
      for (int c = 0; c < 8; ++c) { const u32x4 w = qp[c];
#pragma unroll
          for (int j = 0; j < 4; ++j) { q[c * 8 + 2 * j] = bflo(w[j]); q[c * 8 + 2 * j + 1] = bfhi(w[j]); } }
#pragma unroll
      for (int d = 0; d < 64; ++d) acc[d] = 0.f; }
    float m = a.in[7][head], l = 1.f;
    for (int j = 0; j < 128; ++j) {
        const int r = qi + j, kpos = qpos - 127 + j;
        if (kpos < 0) continue;
        const LAS unsigned* kr = (const LAS unsigned*)(Ks + (kvh * AT_ROWS + r) * AT_LD);
        float s = 0.f;
#pragma unroll
        for (int d = 0; d < 32; ++d) { const unsigned w = kr[d]; s = fmaf(q[2 * d], bflo(w), s); s = fmaf(q[2 * d + 1], bfhi(w), s); }
        const float mn = fmaxf(m, s); const float sc = __expf(m - mn), p = __expf(s - mn);
        l = l * sc + p;
        const LAS unsigned* vr = (const LAS unsigned*)(Vs + (kvh * AT_ROWS + r) * AT_LD);
#pragma unroll
        for (int d = 0; d < 32; ++d) { const unsigned w = vr[d]; acc[2 * d] = acc[2 * d] * sc + p * bflo(w); acc[2 * d + 1] = acc[2 * d + 1] * sc + p * bfhi(w); }
        m = mn;
    }
    const float inv = 1.f / l; float ss = 0.f;
#pragma unroll
    for (int d = 0; d < 64; ++d) { acc[d] *= inv; ss += acc[d] * acc[d]; }
    ssq[qi * 16 + head] = ss;
    __syncthreads();
    float tot = 0.f;
#pragma unroll
    for (int hh = 0; hh < 16; ++hh) tot += ssq[qi * 16 + hh];
    const float rr = rsqrtf(tot * (1.f / 1024.f) + EPS);
    const float* nw = a.in[8] + head * 64;
    u32x4* op = (u32x4*)(YM + (size_t)(b * L + qpos) * D + 1024 + head * 64);
#pragma unroll
    for (int c = 0; c < 8; ++c) { u32x4 w;
#pragma unroll
        for (int j = 0; j < 4; ++j) w[j] = pk2(acc[c * 8 + 2 * j] * rr * nw[c * 8 + 2 * j], acc[c * 8 + 2 * j + 1] * rr * nw[c * 8 + 2 * j + 1]);
        op[c] = w; }
}

__device__ __forceinline__ void p4_ln_router(Frame& F, const Args& a) {
    LAS float* hrow = (LAS float*)(F.lds + F.wave * 8192);
    const float* Z = (const float*)(F.ws + WS_Z); bf16_t* H1 = (bf16_t*)(F.ws + WS_H1);
    const float* w = a.in[11]; const float* b = a.in[12]; const float* wr = a.in[13]; const float* br = a.in[14];
    int* cnt = (int*)(F.ws + WS_CTL) + CW_CNT; int* list = (int*)(F.ws + WS_LIST);
    int* tok_e = (int*)(F.ws + WS_TOKE); int* tok_p = (int*)(F.ws + WS_TOKP); float* tok_g = (float*)(F.ws + WS_TOKG);
    const int gw = F.vcu * NWAVES + F.wave, NGW = F.G * NWAVES, lane = F.lane;
    for (int m = gw; m < T; m += NGW) {
        const GAS f32x4* zr = (const GAS f32x4*)(Z + (size_t)m * D) + lane;
        f32x4 v[8]; float s = 0.f;
#pragma unroll
        for (int j = 0; j < 8; ++j) { v[j] = zr[64 * j]; s += (v[j][0] + v[j][1]) + (v[j][2] + v[j][3]); }
        const float mean = wave_sum(s) * (1.f / D); float s2 = 0.f;
#pragma unroll
        for (int j = 0; j < 8; ++j) { v[j] = v[j] - mean; s2 += (v[j][0] * v[j][0] + v[j][1] * v[j][1]) + (v[j][2] * v[j][2] + v[j][3] * v[j][3]); }
        const float rstd = rsqrtf(wave_sum(s2) * (1.f / D) + EPS);
        GAS u32x2* o8 = (GAS u32x2*)(H1 + (size_t)m * D) + lane;
#pragma unroll
        for (int j = 0; j < 8; ++j) { const f32x4 ww = *((const f32x4*)w + lane + 64 * j), bb = *((const f32x4*)b + lane + 64 * j);
            f32x4 hv; hv[0] = v[j][0] * rstd * ww[0] + bb[0]; hv[1] = v[j][1] * rstd * ww[1] + bb[1]; hv[2] = v[j][2] * rstd * ww[2] + bb[2]; hv[3] = v[j][3] * rstd * ww[3] + bb[3];
            u32x2 o; o.x = pk2(hv[0], hv[1]); o.y = pk2(hv[2], hv[3]); o8[64 * j] = o;
            *((LAS f32x4*)hrow + lane + 64 * j) = hv; }
        asm volatile("s_waitcnt lgkmcnt(0)" ::: "memory");
        const int e = lane & 31, half = lane >> 5;
        const LAS float* hp = hrow + half * 1024; const float* wp = wr + (size_t)half * 1024 * NE + e;
        float sA = 0.f, sB = 0.f;
        for (int k = 0; k < 1024; k += 2) { sA = fmaf(hp[k], wp[(size_t)k * NE], sA); sB = fmaf(hp[k + 1], wp[(size_t)(k + 1) * NE], sB); }
        float sl = sA + sB; sl += __shfl_xor(sl, 32); sl += br[e];
        float val = sl; int te[4]; float tv[4];
#pragma unroll
        for (int r = 0; r < 4; ++r) {
            float bv = val; int bi = e;
#pragma unroll
            for (int o = 1; o < 32; o <<= 1) { const float ov = __shfl_xor(bv, o); const int oi = __shfl_xor(bi, o); if (ov > bv || (ov == bv && oi < bi)) { bv = ov; bi = oi; } }
            te[r] = bi; tv[r] = bv; if (e == bi) val = -INFINITY;
        }
        float p[4], ps = 0.f;
#pragma unroll
        for (int r = 0; r < 4; ++r) { p[r] = __expf(tv[r] - tv[0]); ps += p[r]; }
        if (lane < 4) {
            int ee = te[0]; float g = p[0];
            if (lane == 1) { ee = te[1]; g = p[1]; } else if (lane == 2) { ee = te[2]; g = p[2]; } else if (lane == 3) { ee = te[3]; g = p[3]; }
            const int pos = atomicAdd(&cnt[ee], 1);
            list[(size_t)ee * LISTCAP + pos] = m;
            tok_e[m * 4 + lane] = ee; tok_p[m * 4 + lane] = pos; tok_g[m * 4 + lane] = g / ps;
        }
        asm volatile("s_waitcnt lgkmcnt(0)" ::: "memory");
    }
}
__device__ __forceinline__ int moe_tables(Frame& F) {
    LAS int* pts = (LAS int*)(F.lds + LDSCTL_OFF + LC_PTS); LAS int* cl = (LAS int*)(F.lds + LDSCTL_OFF + LC_CNT); LAS unsigned char* tileE = (LAS unsigned char*)(F.lds + LDSCTL_OFF + LC_TILEE);
    const int* cnt = (const int*)(F.ws + WS_CTL) + CW_CNT;
    __syncthreads();
    if (F.tid < 64) {
        const int e = F.tid & 31; const int c = __hip_atomic_load(cnt + e, RLX_AGENT); const int tl = (c + 255) >> 8;
        int incl = tl;
#pragma unroll
        for (int o = 1; o < 32; o <<= 1) { const int v = __shfl_up(incl, o, 32); if (e >= o) incl += v; }
        if (F.tid < 32) { cl[e] = c; pts[e] = incl - tl; if (e == 31) pts[32] = incl; }
    }
    __syncthreads();
    const int nmt = pts[32];
    for (int t = F.tid; t < nmt; t += NTHR) { int e = 0;
        for (int j = 0; j < 32; ++j) if (t >= pts[j + 1]) e = j + 1;
        tileE[t] = (unsigned char)e; }
    __syncthreads();
    return __builtin_amdgcn_readfirstlane(nmt);
}
__device__ __forceinline__ void p7_combine(Frame& F, const Args& a) {
    const LAS int* pts = (const LAS int*)(F.lds + LDSCTL_OFF + LC_PTS);
    const bf16_t* H1 = (const bf16_t*)(F.ws + WS_H1); const bf16_t* Y = (const bf16_t*)(F.ws + WS_Y);
    const int* tok_e = (const int*)(F.ws + WS_TOKE); const int* tok_p = (const int*)(F.ws + WS_TOKP); const float* tok_g = (const float*)(F.ws + WS_TOKG);
    const float* w = a.in[21]; const float* b = a.in[22]; float* out = a.out;
    const int gw = F.vcu * NWAVES + F.wave, NGW = F.G * NWAVES, lane = F.lane;
    for (int m = gw; m < T; m += NGW) {
        f32x4 v[8];
        { const GAS u32x2* hr = (const GAS u32x2*)(H1 + (size_t)m * D) + lane;
#pragma unroll
          for (int j = 0; j < 8; ++j) { const u32x2 hw = hr[64 * j]; v[j][0] = ALPHA * bflo(hw.x); v[j][1] = ALPHA * bfhi(hw.x); v[j][2] = ALPHA * bflo(hw.y); v[j][3] = ALPHA * bfhi(hw.y); } }
#pragma unroll
        for (int k = 0; k < 4; ++k) {
            const int e = tok_e[m * 4 + k]; const int row = pts[e] * 256 + tok_p[m * 4 + k]; const float g = tok_g[m * 4 + k];
            const GAS u32x2* yr = (const GAS u32x2*)(Y + (size_t)row * D) + lane;
#pragma unroll
            for (int j = 0; j < 8; ++j) { const u32x2 yw = yr[64 * j]; v[j][0] += g * bflo(yw.x); v[j][1] += g * bfhi(yw.x); v[j][2] += g * bflo(yw.y); v[j][3] += g * bfhi(yw.y); }
        }
        float s = 0.f;
#pragma unroll
        for (int j = 0; j < 8; ++j) s += (v[j][0] + v[j][1]) + (v[j][2] + v[j][3]);
        const float mean = wave_sum(s) * (1.f / D); float s2 = 0.f;
#pragma unroll
        for (int j = 0; j < 8; ++j) { v[j] = v[j] - mean; s2 += (v[j][0] * v[j][0] + v[j][1] * v[j][1]) + (v[j][2] * v[j][2] + v[j][3] * v[j][3]); }
        const float rstd = rsqrtf(wave_sum(s2) * (1.f / D) + EPS);
        GAS f32x4* orow = (GAS f32x4*)(out + (size_t)m * D) + lane;
#pragma unroll
        for (int j = 0; j < 8; ++j) { const f32x4 ww = *((const f32x4*)w + lane + 64 * j), bb = *((const f32x4*)b + lane + 64 * j);
            f32x4 o; o[0] = v[j][0] * rstd * ww[0] + bb[0]; o[1] = v[j][1] * rstd * ww[1] + bb[1]; o[2] = v[j][2] * rstd * ww[2] + bb[2]; o[3] = v[j][3] * rstd * ww[3] + bb[3]; orow[64 * j] = o; }
    }
}

__global__ void __launch_bounds__(NTHR, 2) mk_fwd(Args args) {
    extern __shared__ __attribute__((aligned(16))) unsigned char lds_raw[];
    Frame F;
    F.lds = (LAS unsigned char*)lds_raw;
    F.tid = threadIdx.x; F.lane = F.tid & 63; F.wave = __builtin_amdgcn_readfirstlane(F.tid >> 6);
    F.G = gridDim.x; { const int bx = blockIdx.x; F.vcu = (F.G % 8 == 0) ? (bx % 8) * (F.G / 8) + bx / 8 : bx; }
    F.ws = args.ws;
    unsigned char* ws = args.ws;
    for (int u = F.tid; u < (LDS_BYTES - LDSCTL_OFF) / 4; u += NTHR) ((LAS unsigned*)(F.lds + LDSCTL_OFF))[u] = 0u;
    __syncthreads();
    XcdBarrier bar; bar.bar = (unsigned*)(ws + WS_CTL) + CW_BAR; bar.x = 0; bar.st = nullptr;
#if !MK_PER_PHASE
    bar = xcd_barrier_post((unsigned*)(ws + WS_CTL) + CW_BAR, (volatile LAS unsigned*)(F.lds + LDSCTL_OFF + LC_BAR));
#endif
    const int lo = args.ph_lo, hi = args.ph_hi;
#define IN(k) (lo <= (k) && (k) < hi)
#define SEAM(k) do { if (IN(k) && IN((k) + 1)) xcd_barrier(bar); } while (0)

    if (IN(0)) { p0_prologue(F, args); } SEAM(0);

    if (IN(1)) {
        SchedDense S{(const bf16_t*)(ws + WS_H0), (const bf16_t*)(ws + WS_WIN), T / 256, INC / 256, F.G, (int)blockIdx.x};
        EpiInProj E{(bf16_t*)(ws + WS_QH), (bf16_t*)(ws + WS_KH), (bf16_t*)(ws + WS_VH), (bf16_t*)(ws + WS_OG), (bf16_t*)(ws + WS_AQ), (bf16_t*)(ws + WS_AK), (bf16_t*)(ws + WS_AV),
                    (float*)(ws + WS_GH), (const float*)(ws + WS_LB), args.in[4]};
        gemm_phase<EpiInProj, SchedDense>(F.lds, S, E);
    } SEAM(1);

    if (IN(2)) {
        for (int u = blockIdx.x; u < 64 + NB * (L / AT_Q); u += F.G) {
            if (u < 64) hgrn_unit(F, args, u >> 3, u & 7);
            else { const int v = u - 64; attn_unit(F, args, v / (L / AT_Q), v % (L / AT_Q)); }
        }
    } SEAM(2);

    if (IN(3)) {
        SchedDense S{(const bf16_t*)(ws + WS_YMIX), (const bf16_t*)(ws + WS_WOUT), T / 256, D / 256, F.G, (int)blockIdx.x};
        EpiOutProj E{(float*)(ws + WS_Z), args.in[0], (const float*)(ws + WS_STATS0), args.in[1], args.in[2], args.in[10]};
        gemm_phase<EpiOutProj, SchedDense>(F.lds, S, E);
    } SEAM(3);

    if (IN(4)) { p4_ln_router(F, args); } SEAM(4);

    if (IN(5)) {
        const int nmt = moe_tables(F);
        SchedMoe S{(const bf16_t*)(ws + WS_H1), (const bf16_t*)(ws + WS_WGU), (size_t)4096 * KD * 2, (const int*)(ws + WS_LIST),
                   (const LAS int*)(F.lds + LDSCTL_OFF + LC_PTS), (const LAS int*)(F.lds + LDSCTL_OFF + LC_CNT), (const LAS unsigned char*)(F.lds + LDSCTL_OFF + LC_TILEE), nmt, 16, F.G, (int)blockIdx.x, true};
        EpiMoe1 E{(bf16_t*)(ws + WS_HACT), args.in[16], args.in[18]};
        gemm_phase<EpiMoe1, SchedMoe>(F.lds, S, E);
    } SEAM(5);

    if (IN(6)) {
        const int nmt = moe_tables(F);
        SchedMoe S{(const bf16_t*)(ws + WS_HACT), (const bf16_t*)(ws + WS_WD), (size_t)2048 * KD * 2, (const int*)(ws + WS_LIST),
                   (const LAS int*)(F.lds + LDSCTL_OFF + LC_PTS), (const LAS int*)(F.lds + LDSCTL_OFF + LC_CNT), (const LAS unsigned char*)(F.lds + LDSCTL_OFF + LC_TILEE), nmt, 8, F.G, (int)blockIdx.x, false};
        EpiMoe2 E{(bf16_t*)(ws + WS_Y), args.in[20]};
        gemm_phase<EpiMoe2, SchedMoe>(F.lds, S, E);
    } SEAM(6);

    if (IN(7)) { (void)moe_tables(F); p7_combine(F, args); }
#undef IN
#undef SEAM
}
}

extern "C" void kernel_launch(void* const* d_in, const int* in_sizes, int n_in, void* d_out, int out_size, void* d_ws, size_t ws_size, hipStream_t stream) {
    static int grid = 0;
    if (grid == 0) {
        if (n_in != 23 || out_size != T * D || ws_size < WS_END) { fprintf(stderr, "kernel_launch: unexpected shapes (n_in %d out %d ws %zu need %zu)\n", n_in, out_size, ws_size, (size_t)WS_END); grid = -1; return; }
        int dev = 0, cus = 0, per_cu = 0;
        if (hipGetDevice(&dev) != hipSuccess || hipDeviceGetAttribute(&cus, hipDeviceAttributeMultiprocessorCount, dev) != hipSuccess) { grid = -1; return; }
        if (hipFuncSetAttribute((const void*)mk_fwd, hipFuncAttributeMaxDynamicSharedMemorySize, LDS_BYTES) != hipSuccess) { fprintf(stderr, "kernel_launch: hipFuncSetAttribute failed\n"); grid = -1; return; }
        if (hipOccupancyMaxActiveBlocksPerMultiprocessor(&per_cu, (const void*)mk_fwd, NTHR, LDS_BYTES) != hipSuccess || per_cu < 1) { fprintf(stderr, "kernel_launch: occupancy query says %d\n", per_cu); }
        (void)hipGetLastError();
        grid = cus;
    }
    if (grid < 0) return;
    if (hipMemsetAsync((char*)d_ws + WS_CTL, 0, CTL_ZERO_BYTES, stream) != hipSuccess) return;
    Args a{};
    for (int i = 0; i < 23; ++i) a.in[i] = (const float*)d_in[i];
    a.out = (float*)d_out; a.ws = (unsigned char*)d_ws;
#if MK_PER_PHASE
    for (int p = 0; p < NPHASE; ++p) { a.ph_lo = p; a.ph_hi = p + 1; hipLaunchKernelGGL(mk_fwd, dim3(grid), dim3(NTHR), LDS_BYTES, stream, a); }
#else
    a.ph_lo = 0; a.ph_hi = NPHASE; hipLaunchKernelGGL(mk_fwd, dim3(grid), dim3(NTHR), LDS_BYTES, stream, a);
#endif
}
```

```cpp
#include <hip/hip_runtime.h>
#include <cstdio>
#include <cstdint>

#ifndef MK_PER_PHASE
#define MK_PER_PHASE 0
#endif

#define LAS __attribute__((address_space(3)))
#define GAS __attribute__((address_space(1)))
typedef unsigned short bf16_t;
typedef short bf16x8 __attribute__((ext_vector_type(8)));
typedef float f32x4 __attribute__((ext_vector_type(4)));
typedef float f32x2 __attribute__((ext_vector_type(2)));
typedef unsigned u32x4 __attribute__((ext_vector_type(4)));
typedef unsigned u32x2 __attribute__((ext_vector_type(2)));
typedef GAS unsigned gu32;

namespace {
constexpr int D = 2048, NB = 8, L = 2048, T = NB * L;
constexpr int INC = 5376;
constexpr int NE = 32, FF = 2048, NA = T * 4;
constexpr int LISTCAP = T;
constexpr int MAXROWS = NA + NE * 256;
constexpr float ALPHA = 1.189207115002721f;
constexpr float EPS = 1e-5f;
constexpr int NWAVES = 8, NTHR = 512;
constexpr int NPHASE = 8;
constexpr int REP2H = 1, REP2A = 1;
constexpr int REP0 = 1, REP1 = 1, REP2 = 1, REP3 = 1, REP5 = 1, REP6 = 1, REP7 = 1;

constexpr size_t MiB = 1u << 20;
constexpr size_t WS_CTL = 0, CTL_ZERO_BYTES = 1 * MiB;
constexpr size_t WS_LB = 1 * MiB;
constexpr size_t WS_STATS0 = WS_LB + 4096;
constexpr size_t WS_LIST = 2 * MiB;
constexpr size_t WS_TOKE = 4 * MiB, WS_TOKP = WS_TOKE + (size_t)NA * 4, WS_TOKG = WS_TOKP + (size_t)NA * 4;
constexpr size_t WS_WIN = 8 * MiB;
constexpr size_t WS_WOUT = 30 * MiB;
constexpr size_t WS_WGU = 40 * MiB;
constexpr size_t WS_WD = 552 * MiB;
constexpr size_t WS_H1 = 808 * MiB;
constexpr size_t WS_Z = 872 * MiB;
constexpr size_t WS_HACT = 1000 * MiB;
constexpr size_t WS_EARLY = 1288 * MiB;
constexpr size_t WS_H0 = WS_EARLY;
constexpr size_t WS_QH = WS_H0 + 64 * MiB, WS_KH = WS_QH + 32 * MiB, WS_VH = WS_KH + 32 * MiB, WS_OG = WS_VH + 32 * MiB, WS_AQ = WS_OG + 32 * MiB;
constexpr size_t WS_GH = WS_AQ + 32 * MiB;
constexpr size_t WS_AK = WS_GH + 64 * MiB, WS_AV = WS_AK + 4 * MiB;
constexpr size_t WS_YMIX = WS_AV + 4 * MiB;
constexpr size_t WS_H1Q = WS_KH;
constexpr size_t WS_Y = WS_EARLY;
constexpr size_t WS_END = WS_YMIX + 64 * MiB;
static_assert(WS_Y + (size_t)MAXROWS * 4096 <= WS_END + 0 * MiB || true, "");
static_assert(WS_END <= 2048 * MiB, "d_ws map");
constexpr int CW_CNT = 64;
constexpr int CW_BAR = 4096;

constexpr int RING_BYTES = 131072;
constexpr int LDSCTL_OFF = RING_BYTES;
constexpr int LDS_BYTES = 147456;
constexpr int LC_BAR = 0, LC_PTS = 64, LC_CNT = 256, LC_TILEE = 512, LC_MISC = 2048;

#define RLX_AGENT __ATOMIC_RELAXED, __HIP_MEMORY_SCOPE_AGENT
__device__ __forceinline__ unsigned f2bf(float f) { unsigned u = __builtin_bit_cast(unsigned, f); return (u + 0x7fffu + ((u >> 16) & 1u)) >> 16; }
__device__ __forceinline__ unsigned pk2(float lo, float hi) { return f2bf(lo) | (f2bf(hi) << 16); }
__device__ __forceinline__ float bf2f(unsigned short b) { return __builtin_bit_cast(float, (unsigned)b << 16); }
__device__ __forceinline__ float bflo(unsigned w) { return __builtin_bit_cast(float, w << 16); }
__device__ __forceinline__ float bfhi(unsigned w) { return __builtin_bit_cast(float, w & 0xffff0000u); }
typedef __bf16 bf16x2_t __attribute__((ext_vector_type(2)));
__device__ __forceinline__ unsigned cvt_pk_bf16_c(float lo, float hi) { f32x2 v = {lo, hi}; bf16x2_t b = __builtin_convertvector(v, bf16x2_t); return __builtin_bit_cast(unsigned, b); }
__device__ __forceinline__ unsigned cvt_pk_bf16(float lo, float hi) { unsigned r; asm volatile("v_cvt_pk_bf16_f32 %0, %1, %2" : "=v"(r) : "v"(lo), "v"(hi)); return r; }
__device__ __forceinline__ float wave_sum(float v) {
#pragma unroll
    for (int o = 1; o < 64; o <<= 1) v += __shfl_xor(v, o);
    return v;
}
__device__ __forceinline__ float sigm(float x) { return __builtin_amdgcn_rcpf(1.f + __expf(-x)); }

#define XB_TMO      128
#define XB_XCNT(j)  (256  + 64 * (j))
#define XB_XSUB(j)  (1280 + 64 * (j))
#define XB_XGEN(j)  (2304 + 64 * (j))
#define XB_TOP      3328
#define XB_TOPGEN   3392
#define XCD_BAR_WORDS 3456
#define XB_SPIN_CAP (1u << 18)
__device__ __forceinline__ unsigned xb_ld(unsigned* p)              { return __hip_atomic_load(p, __ATOMIC_RELAXED, __HIP_MEMORY_SCOPE_AGENT); }
__device__ __forceinline__ unsigned xb_add(unsigned* p, unsigned v) { return __hip_atomic_fetch_add(p, v, __ATOMIC_RELAXED, __HIP_MEMORY_SCOPE_AGENT); }
__device__ __forceinline__ unsigned xb_xcc_id() { return (unsigned)__builtin_amdgcn_s_getreg((3 << 11) | 20) & 0xFu; }
#define XB_SPIN(cond, bar) do { unsigned _sp = 0; while (cond) { __builtin_amdgcn_s_sleep(1); \
    if ((++_sp & 255u) == 0u) { if (xb_ld(&(bar)[XB_TMO])) break; if (_sp > XB_SPIN_CAP) { atomicAdd(&(bar)[XB_TMO], 1u); break; } } } } while (0)
struct XcdBarrier { unsigned* bar; unsigned x; volatile LAS unsigned* st; };
__device__ __forceinline__ XcdBarrier xcd_barrier_post(unsigned* bar, volatile LAS unsigned* st) {
    XcdBarrier b; b.bar = bar; b.x = xb_xcc_id(); b.st = st;
    if (threadIdx.x == 0) (void)xb_add(&bar[XB_XCNT(b.x)], 1u);
    return b;
}
__device__ __forceinline__ void xcd_barrier_complete(unsigned* bar, unsigned x, unsigned& nloc, unsigned& nx) {
    const unsigned G = gridDim.x * gridDim.y * gridDim.z;
    unsigned sum, cnt, mine, sp = 0u;
    for (;;) {
        sum = 0u; cnt = 0u; mine = 0u;
#pragma unroll
        for (unsigned j = 0; j < 16; ++j) { const unsigned c = xb_ld(&bar[XB_XCNT(j)]); sum += c; cnt += (c > 0u) ? 1u : 0u; mine = (j == x) ? c : mine; }
        if (sum == G) break;
        __builtin_amdgcn_s_sleep(1);
        if ((++sp & 255u) == 0u) { if (xb_ld(&bar[XB_TMO])) break; if (sp > XB_SPIN_CAP) { atomicAdd(&bar[XB_TMO], 1u); break; } }
    }
    nloc = mine > 0u ? mine : 1u; nx = cnt > 0u ? cnt : 1u;
}
__device__ __forceinline__ void xcd_barrier(const XcdBarrier& b) {
    asm volatile("s_waitcnt vmcnt(0)" ::: "memory");
    __syncthreads();
    if (threadIdx.x == 0) {
        unsigned* bar = b.bar;
        __builtin_amdgcn_s_waitcnt(0);
        unsigned nloc = b.st[0], nx = b.st[1];
        if (nloc == 0u) { xcd_barrier_complete(bar, b.x, nloc, nx); b.st[0] = nloc; b.st[1] = nx; }
        const unsigned old = xb_add(&bar[XB_XSUB(b.x)], 1u);
        const unsigned gen = old / nloc;
        if (old + 1u == (gen + 1u) * nloc) {
            __builtin_amdgcn_fence(__ATOMIC_RELEASE, "agent");
            asm volatile("s_waitcnt vmcnt(0)" ::: "memory");
            const unsigned og = xb_add(&bar[XB_TOP], 1u);
            const unsigned tg = og / nx;
            if (og + 1u == (tg + 1u) * nx) xb_add(&bar[XB_TOPGEN], 1u);
            else XB_SPIN(xb_ld(&bar[XB_TOPGEN]) == tg, bar);
            __builtin_amdgcn_fence(__ATOMIC_ACQUIRE, "agent");
            xb_add(&bar[XB_XGEN(b.x)], 1u);
            asm volatile("s_waitcnt vmcnt(0)" ::: "memory");
        } else {
            XB_SPIN(xb_ld(&bar[XB_XGEN(b.x)]) == gen, bar);
            __builtin_amdgcn_fence(__ATOMIC_ACQUIRE, "agent");
            asm volatile("s_waitcnt vmcnt(0)" ::: "memory");
        }
    }
    __syncthreads();
}

constexpr int BM = 256, BK = 64, HALF = 128, HTB = HALF * BK * 2, NXCD = 8, WGM = 8;
constexpr int KD = 2048, NT = KD / BK;
__device__ __forceinline__ int lds_byte(int r, int c) { const int st = (r >> 4) * 2 + (c >> 5), rr = r & 15, cc = c & 31, ob = rr * 64 + cc * 2; return st * 1024 + (ob ^ (((ob >> 9) & 1) << 5)); }
__device__ __forceinline__ void stage_rc(int b, int& R, int& C) { const int st = b / 1024, sb = b % 1024, swz = sb ^ (((sb >> 9) & 1) << 5); R = (st >> 1) * 16 + swz / 64; C = (st & 1) * 32 + (swz % 64) / 2; }
__device__ __forceinline__ int perm32(int rho) { const int n = rho >> 4, i = rho & 15; return 8 * (i >> 2) + 4 * n + (i & 3); }

struct GU { const char* A; const char* B; int pm, pn, e, mtl; };

__device__ __forceinline__ bool order_next(int i, int G, int c, int nM, int nN, int& pm, int& pn) {
    const int nwg = nM * nN; const long Lx = (long)i * G + c; if (Lx >= nwg) return false;
    int wgid = (int)Lx; { const int q = nwg / NXCD, r = nwg % NXCD, xcd = wgid % NXCD, off = wgid / NXCD; wgid = (xcd < r ? xcd * (q + 1) : r * (q + 1) + (xcd - r) * q) + off; }
    const int nig = WGM * nN, gid = wgid / nig, fm = gid * WGM, gsz = (nM - fm) < WGM ? (nM - fm) : WGM;
    pm = fm + ((wgid % nig) % gsz); pn = (wgid % nig) / gsz; return true;
}

typedef int v8i_t __attribute__((ext_vector_type(8)));
template <class Epi, class Sched, bool F8 = false>
__device__ __forceinline__ void gemm_phase(LAS unsigned char* lds, const Sched& S, const Epi& E) {
    const int tid = threadIdx.x, wid = __builtin_amdgcn_readfirstlane(tid >> 6), lane = tid & 63, wr = wid >> 2, wc = wid & 3, fr = lane & 15, fq = lane >> 4;
    constexpr int ROWB = F8 ? KD : KD * 2;
    constexpr int nt = ROWB / 128;
    int Rr[2], Cc[2]; unsigned voffB[2];
#pragma unroll
    for (int i = 0; i < 2; ++i) { stage_rc(tid * 16 + i * 8192, Rr[i], Cc[i]); const int Rb = Epi::PERM ? ((Rr[i] & ~31) + perm32(Rr[i] & 31)) : Rr[i]; voffB[i] = (unsigned)(Rb * ROWB + Cc[i] * 2); }
    const size_t kstep = (size_t)128;
    const size_t hstep = (size_t)HALF * ROWB;
    const unsigned ldsw = (unsigned)wid * 1024u;
    const int aoff = F8 ? lds_byte(wr * 64 + fr, fq * 16) : lds_byte(wr * 64 + fr, fq * 8), boff = F8 ? lds_byte(wc * 32 + fr, fq * 16) : lds_byte(wc * 32 + fr, fq * 8);
#define PG8_SA(b, h) (((b) * 2 + (h)) * HTB)
#define PG8_SB(b, h) ((4 + (b) * 2 + (h)) * HTB)
#define PG8_STAGE(bufoff, gbase, voff) do { _Pragma("unroll") for (int _i = 0; _i < 2; ++_i) \
        __builtin_amdgcn_global_load_lds((const unsigned*)((const char*)(gbase) + (voff)[_i]), (LAS unsigned*)(lds + (bufoff) + ldsw + _i * 8192), 16, 0, 0); } while (0)
#define PG8_LDA(dst, b, h) do { _Pragma("unroll") for (int m = 0; m < 4; ++m) _Pragma("unroll") for (int k = 0; k < 2; ++k) dst[m].q[k] = *(const LAS u32x4*)(lds + PG8_SA(b, h) + aoff + m * 2048 + k * (F8 ? 16 : 1024)); } while (0)
#define PG8_LDB(dst, b, h) do { _Pragma("unroll") for (int n = 0; n < 2; ++n) _Pragma("unroll") for (int k = 0; k < 2; ++k) dst[n].q[k] = *(const LAS u32x4*)(lds + PG8_SB(b, h) + boff + n * 2048 + k * (F8 ? 16 : 1024)); } while (0)
#define PG8_MMA(ai, bj, At, Bt) do { __builtin_amdgcn_s_setprio(1); _Pragma("unroll") for (int m = 0; m < 4; ++m) _Pragma("unroll") for (int n = 0; n < 2; ++n) { \
        if constexpr (F8) { asm volatile("v_mfma_scale_f32_16x16x128_f8f6f4 %0, %1, %2, %0, %3, %3 op_sel_hi:[0,0,0]" : "+v"(acc[ai][bj][m][n]) : "v"(Bt[n].v), "v"(At[m].v), "v"(f8sc)); } \
        else { _Pragma("unroll") for (int k = 0; k < 2; ++k) acc[ai][bj][m][n] = __builtin_amdgcn_mfma_f32_16x16x32_bf16(__builtin_bit_cast(bf16x8, Bt[n].q[k]), __builtin_bit_cast(bf16x8, At[m].q[k]), acc[ai][bj][m][n], 0, 0, 0); } } \
        __builtin_amdgcn_s_setprio(0); } while (0)
#define PG8_WAIT_V(n) asm volatile("s_waitcnt vmcnt(" #n ")" ::: "memory")
#define PG8_WAIT_L(n) asm volatile("s_waitcnt lgkmcnt(" #n ")" ::: "memory")
#define PG8_BAR __builtin_amdgcn_s_barrier()
#define PG8_SCHED __builtin_amdgcn_sched_barrier(0)
    GU cur, nxt; int ui = 0;
    if (!S.next(0, cur)) return;
    f32x4 acc[2][2][4][2];
#pragma unroll
    for (int a = 0; a < 2; ++a)
#pragma unroll
        for (int b = 0; b < 2; ++b)
#pragma unroll
            for (int m = 0; m < 4; ++m)
#pragma unroll
                for (int n = 0; n < 2; ++n) acc[a][b][m][n] = (f32x4){0.f, 0.f, 0.f, 0.f};
    int f8sc = 0x7f7f7f7f; asm volatile("" : "+v"(f8sc));
    union Frag { v8i_t v; u32x4 q[2]; };
    Frag At[4], B0[2], B1[2];
    unsigned oc0[2], oc1[2], on0[2], on1[2];
    S.a_off(cur, Rr, Cc, oc0, oc1);
    const char* cA = cur.A; const char* cB = cur.B;
    PG8_STAGE(PG8_SB(0, 0), cB, voffB); PG8_STAGE(PG8_SB(0, 1), cB + hstep, voffB); PG8_STAGE(PG8_SA(0, 0), cA, oc0); PG8_STAGE(PG8_SA(0, 1), cA, oc1);
    if (wr == 1) PG8_BAR;
    PG8_WAIT_V(2); PG8_BAR;
    PG8_STAGE(PG8_SB(1, 0), cB + kstep, voffB); PG8_STAGE(PG8_SA(1, 0), cA + kstep, oc0); PG8_STAGE(PG8_SB(1, 1), cB + hstep + kstep, voffB);
    PG8_WAIT_V(6); PG8_BAR;
    for (;;) {
        const bool has_next = S.next(ui + 1, nxt);
        const char* nA = has_next ? nxt.A : cA; const char* nB = has_next ? nxt.B : cB;
        for (int t = 0; t < nt; t += 2) {
            const bool last = (t == nt - 2);
            const char* a1 = cA + (size_t)(t + 1) * kstep;
            const char* a2 = last ? nA : cA + (size_t)(t + 2) * kstep; const char* b2 = last ? nB : cB + (size_t)(t + 2) * kstep;
            const char* a3 = a2 + kstep; const char* b3 = b2 + kstep;
            unsigned o20[2], o21[2];
            if (last) {
                if (has_next) S.a_off(nxt, Rr, Cc, on0, on1); else { on0[0] = oc0[0]; on0[1] = oc0[1]; on1[0] = oc1[0]; on1[1] = oc1[1]; }
                o20[0] = on0[0]; o20[1] = on0[1]; o21[0] = on1[0]; o21[1] = on1[1];
            } else { o20[0] = oc0[0]; o20[1] = oc0[1]; o21[0] = oc1[0]; o21[1] = oc1[1]; }
            PG8_LDB(B0, 0, 0); PG8_LDB(B1, 0, 1); PG8_SCHED; PG8_LDA(At, 0, 0); PG8_STAGE(PG8_SA(1, 1), a1, oc1);
            PG8_WAIT_V(8); PG8_WAIT_L(0); PG8_BAR; PG8_MMA(0, 0, At, B0); PG8_MMA(0, 1, At, B1); PG8_BAR; PG8_SCHED;
            PG8_LDA(At, 0, 1); PG8_STAGE(PG8_SB(0, 0), b2, voffB); PG8_STAGE(PG8_SB(0, 1), b2 + hstep, voffB); PG8_STAGE(PG8_SA(0, 0), a2, o20);
            PG8_WAIT_V(8); PG8_WAIT_L(0); PG8_BAR; PG8_MMA(1, 0, At, B0); PG8_MMA(1, 1, At, B1); PG8_BAR; PG8_SCHED;
            PG8_LDB(B0, 1, 0); PG8_LDB(B1, 1, 1); PG8_SCHED; PG8_LDA(At, 1, 0); PG8_STAGE(PG8_SA(0, 1), a2, o21);
            PG8_WAIT_V(8); PG8_WAIT_L(0); PG8_BAR; PG8_MMA(0, 0, At, B0); PG8_MMA(0, 1, At, B1); PG8_BAR; PG8_SCHED;
            PG8_LDA(At, 1, 1); PG8_STAGE(PG8_SB(1, 0), b3, voffB); PG8_STAGE(PG8_SB(1, 1), b3 + hstep, voffB); PG8_STAGE(PG8_SA(1, 0), a3, o20);
            PG8_WAIT_V(8); PG8_WAIT_L(0); PG8_BAR; PG8_MMA(1, 0, At, B0); PG8_MMA(1, 1, At, B1); PG8_BAR; PG8_SCHED;
        }
        if (wr == 0) PG8_BAR;
        if constexpr (F8) asm volatile("s_nop 15\n\ts_nop 15" ::: "memory");
        E(acc, cur, wr, wc, fr, fq);
        if (!has_next) break;
#pragma unroll
        for (int a = 0; a < 2; ++a)
#pragma unroll
            for (int b = 0; b < 2; ++b)
#pragma unroll
                for (int m = 0; m < 4; ++m)
#pragma unroll
                    for (int n = 0; n < 2; ++n) acc[a][b][m][n] = (f32x4){0.f, 0.f, 0.f, 0.f};
        cur = nxt; cA = nA; cB = nB; ++ui;
        oc0[0] = on0[0]; oc0[1] = on0[1]; oc1[0] = on1[0]; oc1[1] = on1[1];
        if (wr == 1) PG8_BAR;
    }
    PG8_WAIT_V(0);
    PG8_BAR;
#undef PG8_SA
#undef PG8_SB
#undef PG8_STAGE
#undef PG8_LDA
#undef PG8_LDB
#undef PG8_MMA
#undef PG8_WAIT_V
#undef PG8_WAIT_L
#undef PG8_BAR
#undef PG8_SCHED
}

struct SchedDense {
    const bf16_t* A; const bf16_t* Bt; int nM, nN, G, c;
    __device__ __forceinline__ bool next(int i, GU& u) const {
        int pm, pn; if (!order_next(i, G, c, nM, nN, pm, pn)) return false;
        u.pm = pm; u.pn = pn; u.e = 0; u.mtl = pm; u.A = (const char*)A; u.B = (const char*)Bt + (size_t)pn * (256 * KD * 2); return true;
    }
    __device__ __forceinline__ void a_off(const GU& u, const int (&R)[2], const int (&C)[2], unsigned (&o0)[2], unsigned (&o1)[2]) const {
#pragma unroll
        for (int i = 0; i < 2; ++i) { o0[i] = (unsigned)((u.pm * 256 + R[i]) * KD + C[i]) * 2u; o1[i] = (unsigned)((u.pm * 256 + 128 + R[i]) * KD + C[i]) * 2u; }
    }
};
template <int ROWB>
struct SchedMoe {
    const void* A; const void* Bt; size_t bstride_e;
    const int* list; const LAS int* pts; const LAS int* cntl; const LAS unsigned char* tileE;
    int nM, nN, G, c; bool gather;
    __device__ __forceinline__ bool next(int i, GU& u) const {
        int pm, pn; if (!order_next(i, G, c, nM, nN, pm, pn)) return false;
        const int e = __builtin_amdgcn_readfirstlane((int)tileE[pm]);
        u.pm = pm; u.pn = pn; u.e = e; u.mtl = pm - __builtin_amdgcn_readfirstlane(pts[e]);
        u.A = (const char*)A; u.B = (const char*)Bt + (size_t)e * bstride_e + (size_t)pn * (256 * ROWB); return true;
    }
    __device__ __forceinline__ void a_off(const GU& u, const int (&R)[2], const int (&C)[2], unsigned (&o0)[2], unsigned (&o1)[2]) const {
        if (gather) {
            const int ce = __builtin_amdgcn_readfirstlane(cntl[u.e]);
            const int* lp = list + (size_t)u.e * LISTCAP;
#pragma unroll
            for (int i = 0; i < 2; ++i) {
                int i0 = u.mtl * 256 + R[i], i1 = i0 + 128;
                i0 = i0 < ce ? i0 : 0; i1 = i1 < ce ? i1 : 0;
                const int t0 = lp[i0], t1 = lp[i1];
                o0[i] = (unsigned)(t0 * ROWB + C[i] * 2); o1[i] = (unsigned)(t1 * ROWB + C[i] * 2);
            }
        } else {
#pragma unroll
            for (int i = 0; i < 2; ++i) { o0[i] = (unsigned)((u.pm * 256 + R[i]) * ROWB + C[i] * 2); o1[i] = (unsigned)((u.pm * 256 + 128 + R[i]) * ROWB + C[i] * 2); }
        }
    }
};

__device__ __forceinline__ u32x4 pack8(const f32x4& a, const f32x4& b) { u32x4 w; w.x = cvt_pk_bf16(a[0], a[1]); w.y = cvt_pk_bf16(a[2], a[3]); w.z = cvt_pk_bf16(b[0], b[1]); w.w = cvt_pk_bf16(b[2], b[3]); return w; }

struct EpiInProj {
    static constexpr bool PERM = true;
    bf16_t *QH, *KH, *VH, *OG, *AQ, *AK, *AV; float* GH; const float* lb; const float* bqkv;
    __device__ __forceinline__ void operator()(const f32x4 (&acc)[2][2][4][2], const GU& u, int wr, int wc, int fr, int fq) const {
        const int row0 = u.pm * BM + wr * 64 + fr;
        const int type = u.pn >> 2;
        const int cw = wc * 32 + 8 * fq;
#pragma unroll
        for (int bj = 0; bj < 2; ++bj) {
            const int col = (u.pn & 3) * 256 + bj * HALF + cw;
            if (type == 0 || type == 3) {
                bf16_t* O = (type == 0 ? QH : OG);
#pragma unroll
                for (int ai = 0; ai < 2; ++ai)
#pragma unroll
                    for (int m = 0; m < 4; ++m) { f32x4 v0 = acc[ai][bj][m][0], v1 = acc[ai][bj][m][1];
#pragma unroll
                        for (int j = 0; j < 4; ++j) { v0[j] = v0[j] * sigm(v0[j]); v1[j] = v1[j] * sigm(v1[j]); }
                        *(u32x4*)(O + (size_t)(row0 + ai * HALF + m * 16) * 1024 + col) = pack8(v0, v1); }
            } else if (type == 1) {
                const f32x4 l0 = *(const f32x4*)(lb + col), l1 = *(const f32x4*)(lb + col + 4);
#pragma unroll
                for (int ai = 0; ai < 2; ++ai)
#pragma unroll
                    for (int m = 0; m < 4; ++m) { f32x4 v0 = acc[ai][bj][m][0], v1 = acc[ai][bj][m][1], g0, g1;
#pragma unroll
                        for (int j = 0; j < 4; ++j) { const float s0 = sigm(v0[j]), s1 = sigm(v1[j]);
                            const float f0 = l0[j] + (1.f - l0[j]) * s0, f1 = l1[j] + (1.f - l1[j]) * s1;
                            g0[j] = __log2f(f0); g1[j] = __log2f(f1); }
                        const size_t o = (size_t)(row0 + ai * HALF + m * 16) * 1024 + col;
                        *(f32x4*)(GH + o) = g0; *(f32x4*)(GH + o + 4) = g1; }
            } else if (type == 2) {
#pragma unroll
                for (int ai = 0; ai < 2; ++ai)
#pragma unroll
                    for (int m = 0; m < 4; ++m) *(u32x4*)(VH + (size_t)(row0 + ai * HALF + m * 16) * 1024 + col) = pack8(acc[ai][bj][m][0], acc[ai][bj][m][1]);
            } else if (type == 4) {
                const f32x4 b0 = *(const f32x4*)(bqkv + col), b1 = *(const f32x4*)(bqkv + col + 4);
#pragma unroll
                for (int ai = 0; ai < 2; ++ai)
#pragma unroll
                    for (int m = 0; m < 4; ++m) { const f32x4 v0 = (acc[ai][bj][m][0] + b0) * 0.125f, v1 = (acc[ai][bj][m][1] + b1) * 0.125f;
                        *(u32x4*)(AQ + (size_t)(row0 + ai * HALF + m * 16) * 1024 + col) = pack8(v0, v1); }
            } else {
                bf16_t* O = bj == 0 ? AK : AV;
                const f32x4 b0 = *(const f32x4*)(bqkv + 1024 + bj * 128 + cw), b1 = *(const f32x4*)(bqkv + 1024 + bj * 128 + cw + 4);
#pragma unroll
                for (int ai = 0; ai < 2; ++ai)
#pragma unroll
                    for (int m = 0; m < 4; ++m) *(u32x4*)(O + (size_t)(row0 + ai * HALF + m * 16) * 128 + cw) = pack8(acc[ai][bj][m][0] + b0, acc[ai][bj][m][1] + b1);
            }
        }
    }
};
struct EpiOutProj {
    static constexpr bool PERM = false;
    float* Z; const float* x; const float* stats; const float* lnw; const float* lnb; const float* bo;
    __device__ __forceinline__ void operator()(const f32x4 (&acc)[2][2][4][2], const GU& u, int wr, int wc, int fr, int fq) const {
        const int row0 = u.pm * BM + wr * 64 + fr, col0 = u.pn * BM + wc * 32 + 4 * fq;
#pragma unroll
        for (int ai = 0; ai < 2; ++ai)
#pragma unroll
            for (int m = 0; m < 4; ++m) {
                const int row = row0 + ai * HALF + m * 16;
                const f32x2 st = *(const f32x2*)(stats + 2 * row);
#pragma unroll
                for (int bj = 0; bj < 2; ++bj)
#pragma unroll
                    for (int n = 0; n < 2; ++n) {
                        const int col = col0 + bj * HALF + n * 16;
                        const f32x4 xv = *(const f32x4*)(x + (size_t)row * D + col), w4 = *(const f32x4*)(lnw + col), b4 = *(const f32x4*)(lnb + col), o4 = *(const f32x4*)(bo + col);
                        f32x4 z;
#pragma unroll
                        for (int j = 0; j < 4; ++j) z[j] = ALPHA * ((xv[j] - st.x) * st.y * w4[j] + b4[j]) + acc[ai][bj][m][n][j] + o4[j];
                        *(f32x4*)(Z + (size_t)row * D + col) = z;
                    }
            }
    }
};
struct EpiMoe1 {
    static constexpr bool PERM = true;
    bf16_t* H; const float* bg; const float* bu;
    __device__ __forceinline__ void operator()(const f32x4 (&acc)[2][2][4][2], const GU& u, int wr, int wc, int fr, int fq) const {
        const int row0 = u.pm * BM + wr * 64 + fr, hc = u.pn * 128 + wc * 32 + 8 * fq;
        const float* bgp = bg + (size_t)u.e * FF + hc; const float* bup = bu + (size_t)u.e * FF + hc;
        const f32x4 g0b = *(const f32x4*)bgp, g1b = *(const f32x4*)(bgp + 4), u0b = *(const f32x4*)bup, u1b = *(const f32x4*)(bup + 4);
#pragma unroll
        for (int ai = 0; ai < 2; ++ai)
#pragma unroll
            for (int m = 0; m < 4; ++m) {
                f32x4 a0 = acc[ai][0][m][0] + g0b, a1 = acc[ai][0][m][1] + g1b, c0 = acc[ai][1][m][0] + u0b, c1 = acc[ai][1][m][1] + u1b;
#pragma unroll
                for (int j = 0; j < 4; ++j) {
                    const float gg0 = fminf(a0[j], 7.f), gg1 = fminf(a1[j], 7.f);
                    const float uu0 = fminf(fmaxf(c0[j], -7.f), 7.f), uu1 = fminf(fmaxf(c1[j], -7.f), 7.f);
                    a0[j] = gg0 * sigm(1.702f * gg0) * (uu0 + 1.f); a1[j] = gg1 * sigm(1.702f * gg1) * (uu1 + 1.f);
                }
                *(u32x4*)(H + (size_t)(row0 + ai * HALF + m * 16) * FF + hc) = pack8(a0, a1);
            }
    }
};
__device__ __forceinline__ unsigned pk4_fp8(float a, float b, float c, float d) {
    a = fminf(fmaxf(a, -448.f), 448.f); b = fminf(fmaxf(b, -448.f), 448.f); c = fminf(fmaxf(c, -448.f), 448.f); d = fminf(fmaxf(d, -448.f), 448.f);
    int w = __builtin_amdgcn_cvt_pk_fp8_f32(a, b, 0, false); w = __builtin_amdgcn_cvt_pk_fp8_f32(c, d, w, true); return (unsigned)w;
}
constexpr float SC_H1 = 32.f, SC_WGU = 2048.f, SC_HACT = 8.f, SC_WD = 4096.f;
struct EpiMoe1F8 {
    static constexpr bool PERM = true;
    unsigned char* H; const float* bg; const float* bu;
    __device__ __forceinline__ void operator()(const f32x4 (&acc)[2][2][4][2], const GU& u, int wr, int wc, int fr, int fq) const {
        const int row0 = u.pm * BM + wr * 64 + fr, hc = u.pn * 128 + wc * 32 + 8 * fq;
        const float* bgp = bg + (size_t)u.e * FF + hc; const float* bup = bu + (size_t)u.e * FF + hc;
        const f32x4 g0b = *(const f32x4*)bgp, g1b = *(const f32x4*)(bgp + 4), u0b = *(const f32x4*)bup, u1b = *(const f32x4*)(bup + 4);
        constexpr float IS = 1.f / (SC_H1 * SC_WGU);
#pragma unroll
        for (int ai = 0; ai < 2; ++ai)
#pragma unroll
            for (int m = 0; m < 4; ++m) {
                f32x4 a0 = acc[ai][0][m][0] * IS + g0b, a1 = acc[ai][0][m][1] * IS + g1b, c0 = acc[ai][1][m][0] * IS + u0b, c1 = acc[ai][1][m][1] * IS + u1b;
#pragma unroll
                for (int j = 0; j < 4; ++j) {
                    const float gg0 = fminf(a0[j], 7.f), gg1 = fminf(a1[j], 7.f);
                    const float uu0 = fminf(fmaxf(c0[j], -7.f), 7.f), uu1 = fminf(fmaxf(c1[j], -7.f), 7.f);
                    a0[j] = SC_HACT * gg0 * sigm(1.702f * gg0) * (uu0 + 1.f); a1[j] = SC_HACT * gg1 * sigm(1.702f * gg1) * (uu1 + 1.f);
                }
                u32x2 o; o.x = pk4_fp8(a0[0], a0[1], a0[2], a0[3]); o.y = pk4_fp8(a1[0], a1[1], a1[2], a1[3]);
                *(u32x2*)(H + (size_t)(row0 + ai * HALF + m * 16) * FF + hc) = o;
            }
    }
};
struct EpiMoe2F8 {
    static constexpr bool PERM = true;
    bf16_t* Y; const float* bd;
    __device__ __forceinline__ void operator()(const f32x4 (&acc)[2][2][4][2], const GU& u, int wr, int wc, int fr, int fq) const {
        const int row0 = u.pm * BM + wr * 64 + fr, col0 = u.pn * BM + wc * 32 + 8 * fq;
        const float* bp = bd + (size_t)u.e * D + col0;
        constexpr float IS = 1.f / (SC_HACT * SC_WD);
#pragma unroll
        for (int bj = 0; bj < 2; ++bj) {
            const f32x4 b0 = *(const f32x4*)(bp + bj * HALF), b1 = *(const f32x4*)(bp + bj * HALF + 4);
#pragma unroll
            for (int ai = 0; ai < 2; ++ai)
#pragma unroll
                for (int m = 0; m < 4; ++m) *(u32x4*)(Y + (size_t)(row0 + ai * HALF + m * 16) * D + col0 + bj * HALF) = pack8(acc[ai][bj][m][0] * IS + b0, acc[ai][bj][m][1] * IS + b1);
        }
    }
};
struct EpiMoe2 {
    static constexpr bool PERM = true;
    bf16_t* Y; const float* bd;
    __device__ __forceinline__ void operator()(const f32x4 (&acc)[2][2][4][2], const GU& u, int wr, int wc, int fr, int fq) const {
        const int row0 = u.pm * BM + wr * 64 + fr, col0 = u.pn * BM + wc * 32 + 8 * fq;
        const float* bp = bd + (size_t)u.e * D + col0;
#pragma unroll
        for (int bj = 0; bj < 2; ++bj) {
            const f32x4 b0 = *(const f32x4*)(bp + bj * HALF), b1 = *(const f32x4*)(bp + bj * HALF + 4);
#pragma unroll
            for (int ai = 0; ai < 2; ++ai)
#pragma unroll
                for (int m = 0; m < 4; ++m) *(u32x4*)(Y + (size_t)(row0 + ai * HALF + m * 16) * D + col0 + bj * HALF) = pack8(acc[ai][bj][m][0] + b0, acc[ai][bj][m][1] + b1);
        }
    }
};

struct Args { const float* in[23]; float* out; unsigned char* ws; int ph_lo, ph_hi; };
struct Frame { LAS unsigned char* lds; int tid, lane, wave, G, vcu; unsigned char* ws; };

__device__ __forceinline__ void p0_transpose_item(const float* W, int N, int k0, int n0, bf16_t* WT_row0  , LAS float* scr, int lane) {
#pragma unroll 8
    for (int i = 0; i < 32; ++i) { const int kk = 2 * i + (lane >> 5); scr[kk * 33 + (lane & 31)] = W[(size_t)(k0 + kk) * N + n0 + (lane & 31)]; }
    asm volatile("s_waitcnt lgkmcnt(0)" ::: "memory");
    const int c = lane & 7;
#pragma unroll
    for (int j = 0; j < 4; ++j) { const int n = (lane >> 3) + 8 * j; const LAS float* s = scr + (8 * c) * 33 + n;
        u32x4 o; o.x = pk2(s[0 * 33], s[1 * 33]); o.y = pk2(s[2 * 33], s[3 * 33]); o.z = pk2(s[4 * 33], s[5 * 33]); o.w = pk2(s[6 * 33], s[7 * 33]);
        *(GAS u32x4*)(WT_row0 + (size_t)n * KD + k0 + 8 * c) = o; }
    asm volatile("s_waitcnt lgkmcnt(0)" ::: "memory");
}

__device__ __forceinline__ void p0_transpose_item_f8(const float* W, int N, int k0, int n0, unsigned char* WT_row0, float sc, LAS float* scr, int lane) {
#pragma unroll 8
    for (int i = 0; i < 32; ++i) { const int kk = 2 * i + (lane >> 5); scr[kk * 33 + (lane & 31)] = W[(size_t)(k0 + kk) * N + n0 + (lane & 31)]; }
    asm volatile("s_waitcnt lgkmcnt(0)" ::: "memory");
    const int c = lane & 3;
#pragma unroll
    for (int j = 0; j < 2; ++j) { const int n = (lane >> 2) + 16 * j; const LAS float* sp = scr + (16 * c) * 33 + n;
        u32x4 o;
        o.x = pk4_fp8(sp[0 * 33] * sc, sp[1 * 33] * sc, sp[2 * 33] * sc, sp[3 * 33] * sc); o.y = pk4_fp8(sp[4 * 33] * sc, sp[5 * 33] * sc, sp[6 * 33] * sc, sp[7 * 33] * sc);
        o.z = pk4_fp8(sp[8 * 33] * sc, sp[9 * 33] * sc, sp[10 * 33] * sc, sp[11 * 33] * sc); o.w = pk4_fp8(sp[12 * 33] * sc, sp[13 * 33] * sc, sp[14 * 33] * sc, sp[15 * 33] * sc);
        *(GAS u32x4*)(WT_row0 + (size_t)n * KD + k0 + 16 * c) = o; }
    asm volatile("s_waitcnt lgkmcnt(0)" ::: "memory");
}
__device__ __forceinline__ void p0_prologue(Frame& F, const Args& a) {
    LAS float* scr = (LAS float*)(F.lds + F.wave * 16384);
    const int gw = F.vcu * NWAVES + F.wave, NGW = F.G * NWAVES;
    unsigned char* ws = F.ws;
    if (gw < 16) { const int i = gw * 64 + F.lane; const float* lbl = a.in[5]; const float l0 = lbl[i], l1 = lbl[1024 + i]; const float mx = fmaxf(l0, l1); const float e0 = __expf(l0 - mx), e1 = __expf(l1 - mx);
        ((float*)(ws + WS_LB))[i] = e0 / (e0 + e1); }
    {
        const float* x = a.in[0]; const float* w = a.in[1]; const float* b = a.in[2];
        bf16_t* H0 = (bf16_t*)(ws + WS_H0); float* st = (float*)(ws + WS_STATS0);
        for (int m = gw; m < T; m += NGW) {
            const GAS f32x4* xr = (const GAS f32x4*)(x + (size_t)m * D) + F.lane;
            f32x4 v[8]; float s = 0.f;
#pragma unroll
            for (int j = 0; j < 8; ++j) { v[j] = xr[64 * j]; s += (v[j][0] + v[j][1]) + (v[j][2] + v[j][3]); }
            const float mean = wave_sum(s) * (1.f / D); float s2 = 0.f;
#pragma unroll
            for (int j = 0; j < 8; ++j) { v[j] = v[j] - mean; s2 += (v[j][0] * v[j][0] + v[j][1] * v[j][1]) + (v[j][2] * v[j][2] + v[j][3] * v[j][3]); }
            const float rstd = rsqrtf(wave_sum(s2) * (1.f / D) + EPS);
            if (F.lane == 0) { st[2 * m] = mean; st[2 * m + 1] = rstd; }
            GAS u32x2* o8 = (GAS u32x2*)(H0 + (size_t)m * D) + F.lane;
#pragma unroll
            for (int j = 0; j < 8; ++j) { const f32x4 ww = *((const f32x4*)w + F.lane + 64 * j), bb = *((const f32x4*)b + F.lane + 64 * j);
                u32x2 o; o.x = pk2(v[j][0] * rstd * ww[0] + bb[0], v[j][1] * rstd * ww[1] + bb[1]); o.y = pk2(v[j][2] * rstd * ww[2] + bb[2], v[j][3] * rstd * ww[3] + bb[3]); o8[64 * j] = o; }
        }
    }
    constexpr int I_IN = 32 * (INC / 32), I_OUT = 32 * 64, I_E = 32 * 64;
    constexpr int NITEMS = I_IN + I_OUT + NE * 3 * I_E;
    for (int it = gw; it < NITEMS; it += NGW) {
        int r = it;
        if (r < I_IN) { const int nb = INC / 32, kb = r / nb, n0 = 32 * (r % nb); p0_transpose_item(a.in[3], INC, 64 * kb, n0, (bf16_t*)(ws + WS_WIN) + (size_t)n0 * KD, scr, F.lane); continue; } r -= I_IN;
        if (r < I_OUT) { const int kb = r / 64, n0 = 32 * (r % 64); p0_transpose_item(a.in[9], D, 64 * kb, n0, (bf16_t*)(ws + WS_WOUT) + (size_t)n0 * KD, scr, F.lane); continue; } r -= I_OUT;
        const int e = r / (3 * I_E), q = r % (3 * I_E), which = q / I_E, r2 = q % I_E, kb = r2 / 64, n0 = 32 * (r2 % 64);
        if (which < 2) {
            const float* W = a.in[which == 0 ? 15 : 17] + (size_t)e * D * FF;
            unsigned char* dst = (unsigned char*)(ws + WS_WGU) + ((size_t)e * 4096 + (size_t)(n0 >> 7) * 256 + which * 128 + (n0 & 127)) * KD;
            p0_transpose_item_f8(W, FF, 64 * kb, n0, dst, SC_WGU, scr, F.lane);
        } else {
            const float* W = a.in[19] + (size_t)e * FF * D;
            unsigned char* dst = (unsigned char*)(ws + WS_WD) + ((size_t)e * 2048 + n0) * KD;
            p0_transpose_item_f8(W, D, 64 * kb, n0, dst, SC_WD, scr, F.lane);
        }
    }
}

constexpr int HG_TT = 16;
__device__ __forceinline__ void hgrn_unit(Frame& F, const Args& a, int b, int h) {
    LAS float* fS = (LAS float*)F.lds; LAS float* kS = fS + HG_TT * 128; LAS float* qS = kS + HG_TT * 128; LAS float* vS = qS + HG_TT * 128; LAS float* oS = vS + HG_TT * 128;
    const bf16_t* QH = (const bf16_t*)(F.ws + WS_QH); const bf16_t* KH = (const bf16_t*)(F.ws + WS_KH); const bf16_t* VH = (const bf16_t*)(F.ws + WS_VH); const bf16_t* OG = (const bf16_t*)(F.ws + WS_OG);
    const float* GH = (const float*)(F.ws + WS_GH);
    bf16_t* YM = (bf16_t*)(F.ws + WS_YMIX);
    const int tid = F.tid, kg = tid & 3, col = tid >> 2;
    float S[32];
#pragma unroll
    for (int i = 0; i < 32; ++i) S[i] = 0.f;
    for (int t0 = 0; t0 < L; t0 += HG_TT) {
        __syncthreads();
        for (int i = tid; i < HG_TT * 128; i += NTHR) {
            const int tt = i >> 7, k = i & 127; const size_t o = (size_t)(b * L + t0 + tt) * 1024 + h * 128 + k;
            fS[i] = __expf(GH[o]); kS[i] = bf2f(KH[o]); qS[i] = bf2f(QH[o]); vS[i] = bf2f(VH[o]);
        }
        __syncthreads();
        for (int tt = 0; tt < HG_TT; ++tt) {
            const float v = vS[tt * 128 + col];
            float o = 0.f;
#pragma unroll
            for (int i = 0; i < 32; ++i) { const int k = kg * 32 + i; S[i] = fS[tt * 128 + k] * S[i] + kS[tt * 128 + k] * v; o += S[i] * qS[tt * 128 + k]; }
            o += __shfl_xor(o, 1); o += __shfl_xor(o, 2);
            if (kg == 0) oS[tt * 128 + col] = o;
        }
        __syncthreads();
#pragma unroll
        for (int q = 0; q < 2; ++q) {
            const int tt = F.wave * 2 + q;
            const float a0 = oS[tt * 128 + F.lane], a1 = oS[tt * 128 + 64 + F.lane];
            const float r = rsqrtf(wave_sum(a0 * a0 + a1 * a1) * (1.f / 128.f) + EPS);
            const size_t o = (size_t)(b * L + t0 + tt) * 1024 + h * 128;
            const float* nw = a.in[6];
            const float g0 = bf2f(OG[o + F.lane]), g1 = bf2f(OG[o + 64 + F.lane]);
            YM[(size_t)(b * L + t0 + tt) * D + h * 128 + F.lane] = (bf16_t)f2bf(a0 * r * nw[F.lane] * g0);
            YM[(size_t)(b * L + t0 + tt) * D + h * 128 + 64 + F.lane] = (bf16_t)f2bf(a1 * r * nw[64 + F.lane] * g1);
        }
    }
}
constexpr int AT_Q = 32, AT_ROWS = AT_Q + 127, AT_LD = 66;
__device__ __forceinline__ void attn_unit(Frame& F, const Args& a, int b, int qt) {
    LAS unsigned short* Ks = (LAS unsigned short*)F.lds;
    LAS unsigned short* Vs = Ks + 2 * AT_ROWS * AT_LD;
    LAS float* ssq = (LAS float*)(Vs + 2 * AT_ROWS * AT_LD);
    const bf16_t* AQ = (const bf16_t*)(F.ws + WS_AQ); const bf16_t* AK = (const bf16_t*)(F.ws + WS_AK); const bf16_t* AV = (const bf16_t*)(F.ws + WS_AV);
    bf16_t* YM = (bf16_t*)(F.ws + WS_YMIX);
    const int tid = F.tid, t0 = qt * AT_Q;
    __syncthreads();
    for (int i = tid; i < 2 * AT_ROWS * 32; i += NTHR) {
        const int dw = i & 31, r = (i >> 5) % AT_ROWS, kvh = (i >> 5) / AT_ROWS;
        const int pos = t0 - 127 + r;
        unsigned kv = 0u, vv = 0u;
        if (pos >= 0) { const size_t o = (size_t)(b * L + pos) * 128 + kvh * 64 + dw * 2; kv = *(const unsigned*)(AK + o); vv = *(const unsigned*)(AV + o); }
        *(LAS unsigned*)(Ks + (kvh * AT_ROWS + r) * AT_LD + dw * 2) = kv; *(LAS unsigned*)(Vs + (kvh * AT_ROWS + r) * AT_LD + dw * 2) = vv;
    }
    __syncthreads();
    const int qi = tid & 31, head = tid >> 5, kvh = head >> 3;
    const int qpos = t0 + qi;
    float q[64], acc[64];
    { const u32x4* qp = (const u32x4*)(AQ + (size_t)(b * L + qpos) * 1024 + head * 64);
#pragma unroll
      for (int c = 0; c < 8; ++c) { const u32x4 w = qp[c];
#pragma unroll
          for (int j = 0; j < 4; ++j) { q[c * 8 + 2 * j] = bflo(w[j]); q[c * 8 + 2 * j + 1] = bfhi(w[j]); } }
#pragma unroll
      for (int d = 0; d < 64; ++d) acc[d] = 0.f; }
    float m = a.in[7][head], l = 1.f;
    for (int j = 0; j < 128; ++j) {
        const int r = qi + j, kpos = qpos - 127 + j;
        if (kpos < 0) continue;
        const LAS unsigned* kr = (const LAS unsigned*)(Ks + (kvh * AT_ROWS + r) * AT_LD);
        float s = 0.f;
#pragma unroll
        for (int d = 0; d < 32; ++d) { const unsigned w = kr[d]; s = fmaf(q[2 * d], bflo(w), s); s = fmaf(q[2 * d + 1], bfhi(w), s); }
        const float mn = fmaxf(m, s); const float sc = __expf(m - mn), p = __expf(s - mn);
        l = l * sc + p;
        const LAS unsigned* vr = (const LAS unsigned*)(Vs + (kvh * AT_ROWS + r) * AT_LD);
#pragma unroll
        for (int d = 0; d < 32; ++d) { const unsigned w = vr[d]; acc[2 * d] = acc[2 * d] * sc + p * bflo(w); acc[2 * d + 1] = acc[2 * d + 1] * sc + p * bfhi(w); }
        m = mn;
    }
    const float inv = 1.f / l; float ss = 0.f;
#pragma unroll
    for (int d = 0; d < 64; ++d) { acc[d] *= inv; ss += acc[d] * acc[d]; }
    ssq[qi * 16 + head] = ss;
    __syncthreads();
    float tot = 0.f;
#pragma unroll
    for (int hh = 0; hh < 16; ++hh) tot += ssq[qi * 16 + hh];
    const float rr = rsqrtf(tot * (1.f / 1024.f) + EPS);
    const float* nw = a.in[8] + head * 64;
    u32x4* op = (u32x4*)(YM + (size_t)(b * L + qpos) * D + 1024 + head * 64);
#pragma unroll
    for (int c = 0; c < 8; ++c) { u32x4 w;
#pragma unroll
        for (int j = 0; j < 4; ++j) w[j] = pk2(acc[c * 8 + 2 * j] * rr * nw[c * 8 + 2 * j], acc[c * 8 + 2 * j + 1] * rr * nw[c * 8 + 2 * j + 1]);
        op[c] = w; }
}

typedef float f32x16 __attribute__((ext_vector_type(16)));
typedef short s16x4 __attribute__((ext_vector_type(4)));
typedef short v4i16_t __attribute__((ext_vector_type(4)));
__device__ __forceinline__ s16x4 lds_tr16(const LAS unsigned char* p) { return __builtin_bit_cast(s16x4, __builtin_amdgcn_ds_read_tr16_b64_v4i16((LAS v4i16_t*)p)); }
__device__ __forceinline__ void attn_unit_mfma(Frame& F, const Args& a, int b, int qt) {
    LAS unsigned char* KS = F.lds;
    LAS unsigned char* VS = F.lds + 40960;
    LAS float* SSQ = (LAS float*)(F.lds + 81920);
    const bf16_t* AQ = (const bf16_t*)(F.ws + WS_AQ); const bf16_t* AK = (const bf16_t*)(F.ws + WS_AK); const bf16_t* AV = (const bf16_t*)(F.ws + WS_AV);
    bf16_t* YM = (bf16_t*)(F.ws + WS_YMIX);
    const int tid = F.tid, lane = F.lane, w = F.wave, r32 = lane & 31, hi = lane >> 5, t0 = qt * 32;
    __syncthreads();
#pragma unroll
    for (int p = 0; p < 5; ++p) {
        const int c = p * 512 + tid, row = c >> 4, ch = c & 15, kvh = ch >> 3, cr = ch & 7;
        const int pos = t0 - 128 + row;
        u32x4 kv = (u32x4){0u, 0u, 0u, 0u}, vv = (u32x4){0u, 0u, 0u, 0u};
        if (pos >= 0) { const size_t o = (size_t)(b * L + pos) * 128 + kvh * 64 + cr * 8; kv = *(const u32x4*)(AK + o); vv = *(const u32x4*)(AV + o); }
        *(LAS u32x4*)(KS + kvh * 20480 + row * 128 + ((cr ^ ((row >> 1) & 7)) << 4)) = kv;
        *(LAS u32x4*)(VS + kvh * 20480 + row * 128 + (((cr >> 2) ^ ((row >> 1) & 1)) << 6) + ((cr & 3) << 4)) = vv;
    }
    __syncthreads();
    const int kvh = w >> 2;
    const int ktmin = t0 < 128 ? (128 - t0) >> 5 : 0;
    const LAS unsigned char* Kb = KS + kvh * 20480;
    const LAS unsigned char* Vb = VS + kvh * 20480;
    unsigned OP[2][2][8];
    float ssq = 0.f;
#pragma unroll
    for (int hh = 0; hh < 2; ++hh) {
        const int head = 2 * w + hh;
        bf16x8 qf[4];
#pragma unroll
        for (int ks = 0; ks < 4; ++ks) qf[ks] = *(const bf16x8*)(AQ + (size_t)(b * L + t0 + r32) * 1024 + head * 64 + ks * 16 + hi * 8);
        f32x16 S[5];
#pragma unroll
        for (int kt = 0; kt < 5; ++kt) {
            const int row = kt * 32 + r32;
            f32x16 acc = (f32x16){0.f, 0.f, 0.f, 0.f, 0.f, 0.f, 0.f, 0.f, 0.f, 0.f, 0.f, 0.f, 0.f, 0.f, 0.f, 0.f};
#pragma unroll
            for (int ks = 0; ks < 4; ++ks) {
                const bf16x8 kf = *(const LAS bf16x8*)(Kb + row * 128 + (((2 * ks + hi) ^ ((row >> 1) & 7)) << 4));
                acc = __builtin_amdgcn_mfma_f32_32x32x16_bf16(kf, qf[ks], acc, 0, 0, 0);
            }
            S[kt] = acc;
        }
        const float sink = a.in[7][head];
        float m = sink;
#pragma unroll
        for (int kt = 0; kt < 5; ++kt)
#pragma unroll
            for (int r = 0; r < 16; ++r) {
                const int i = (r & 3) + 8 * (r >> 2) + 4 * hi;
                bool ok = kt >= ktmin;
                if (kt == 0) ok = ok && (i > r32);
                if (kt == 4) ok = ok && (i <= r32);
                const float v = ok ? S[kt][r] : -INFINITY;
                S[kt][r] = v; m = fmaxf(m, v);
            }
        m = fmaxf(m, __shfl_xor(m, 32));
        float l = 0.f;
#pragma unroll
        for (int kt = 0; kt < 5; ++kt)
#pragma unroll
            for (int r = 0; r < 16; ++r) { const float pv = __expf(S[kt][r] - m); S[kt][r] = pv; l += pv; }
        l += __shfl_xor(l, 32);
        l += __expf(sink - m);
        const float inv = 1.f / l;
#pragma unroll
        for (int dt = 0; dt < 2; ++dt) {
            f32x16 acc = (f32x16){0.f, 0.f, 0.f, 0.f, 0.f, 0.f, 0.f, 0.f, 0.f, 0.f, 0.f, 0.f, 0.f, 0.f, 0.f, 0.f};
            const int dcol = dt * 32 + 16 * ((lane >> 4) & 1) + 4 * (lane & 3);
            const int vlane = ((lane & 15) >> 2) * 128 + ((((dcol >> 5) ^ ((lane >> 3) & 1))) << 6) + (dcol & 31) * 2;
#pragma unroll
            for (int kt = 0; kt < 5; ++kt)
#pragma unroll
                for (int s2 = 0; s2 < 2; ++s2) {
                    const int rowb = kt * 32 + 16 * s2 + 4 * hi;
                    const s16x4 lo = lds_tr16(Vb + rowb * 128 + vlane), hi4 = lds_tr16(Vb + (rowb + 8) * 128 + vlane);
                    const bf16x8 vf = (bf16x8){lo[0], lo[1], lo[2], lo[3], hi4[0], hi4[1], hi4[2], hi4[3]};
                    u32x4 pw; pw.x = cvt_pk_bf16(S[kt][8 * s2 + 0], S[kt][8 * s2 + 1]); pw.y = cvt_pk_bf16(S[kt][8 * s2 + 2], S[kt][8 * s2 + 3]);
                    pw.z = cvt_pk_bf16(S[kt][8 * s2 + 4], S[kt][8 * s2 + 5]); pw.w = cvt_pk_bf16(S[kt][8 * s2 + 6], S[kt][8 * s2 + 7]);
                    acc = __builtin_amdgcn_mfma_f32_32x32x16_bf16(vf, __builtin_bit_cast(bf16x8, pw), acc, 0, 0, 0);
                }
#pragma unroll
            for (int r = 0; r < 16; ++r) { acc[r] *= inv; ssq += acc[r] * acc[r]; }
#pragma unroll
            for (int r = 0; r < 8; ++r) OP[hh][dt][r] = cvt_pk_bf16(acc[2 * r], acc[2 * r + 1]);
        }
    }
    ssq += __shfl_xor(ssq, 32);
    if (hi == 0) SSQ[w * 32 + r32] = ssq;
    __syncthreads();
    float tot = 0.f;
#pragma unroll
    for (int ww = 0; ww < 8; ++ww) tot += SSQ[ww * 32 + r32];
    const float rr = rsqrtf(tot * (1.f / 1024.f) + EPS);
    const float* nwp = a.in[8];
#pragma unroll
    for (int hh = 0; hh < 2; ++hh)
#pragma unroll
        for (int dt = 0; dt < 2; ++dt)
#pragma unroll
            for (int g4 = 0; g4 < 4; ++g4) {
                const int d = (2 * w + hh) * 64 + dt * 32 + 8 * g4 + 4 * hi;
                const f32x4 nw4 = *(const f32x4*)(nwp + d);
                const unsigned p0 = OP[hh][dt][2 * g4], p1 = OP[hh][dt][2 * g4 + 1];
                u32x2 o; o.x = pk2(bflo(p0) * rr * nw4[0], bfhi(p0) * rr * nw4[1]); o.y = pk2(bflo(p1) * rr * nw4[2], bfhi(p1) * rr * nw4[3]);
                *(u32x2*)(YM + (size_t)(b * L + t0 + r32) * D + 1024 + d) = o;
            }
}

constexpr int HL_QM = 0, HL_KM = 16384, HL_QS = 32768, HL_KE = 49152, HL_VT = 65536, HL_PL = 81920, HL_SEG = 90112, HL_DS = 94208, HL_SSQ = 94720;
__device__ __forceinline__ int trkey(int s) { return (s & 3) | (((s >> 3) & 1) << 2); }
__device__ __forceinline__ bf16x8 mk8(const s16x4& lo, const s16x4& hi) { return (bf16x8){lo[0], lo[1], lo[2], lo[3], hi[0], hi[1], hi[2], hi[3]}; }
__device__ __forceinline__ void hgrn_unit_mfma(Frame& F, const Args& a, int b, int h) {
    LAS unsigned char* lds = F.lds;
    const bf16_t* QH = (const bf16_t*)(F.ws + WS_QH); const bf16_t* VH = (const bf16_t*)(F.ws + WS_VH); const bf16_t* OG = (const bf16_t*)(F.ws + WS_OG);
    const float* GH = (const float*)(F.ws + WS_GH);
    bf16_t* YM = (bf16_t*)(F.ws + WS_YMIX);
    const int tid = F.tid, lane = F.lane, w = F.wave, r16 = lane & 15, g = lane >> 4, cp = lane;
    const size_t tokb = (size_t)b * L;
    const int hc = h * 128;
    f32x4 Sacc[8];
#pragma unroll
    for (int i = 0; i < 8; ++i) Sacc[i] = (f32x4){0.f, 0.f, 0.f, 0.f};
    f32x2 gpre[8]; unsigned qpre[8]; u32x4 vpre[2];
    const int vrow = tid >> 3, vc16 = tid & 7;
    const unsigned lo_g = 2u * (unsigned)cp, lo_v = (unsigned)(vrow * 1024 + vc16 * 8), lo_og = (unsigned)(r16 * 1024 + 4 * g), lo_ym = (unsigned)(r16 * 2048 + 4 * g);
    {
        const size_t rb = (tokb + 8 * w) * 1024 + hc;
        const float* gb = GH + rb; const bf16_t* qb = QH + rb; const bf16_t* vb = VH + tokb * 1024 + hc;
#pragma unroll
        for (int i = 0; i < 8; ++i) { gpre[i] = *(const f32x2*)(gb + i * 1024 + lo_g); qpre[i] = *(const unsigned*)(qb + i * 1024 + lo_g); }
        vpre[0] = *(const u32x4*)(vb + lo_v); vpre[1] = *(const u32x4*)(vb + 64 + lo_v);
    }
    const int keyl = ((lane & 15) >> 2) | ((g & 1) << 2);
    const int trrow = (8 * g + ((lane & 15) >> 2)) * 256 + 8 * (lane & 3);
    __syncthreads();
    for (int c = 0; c < L / 64; ++c) {
        int cc = c; asm volatile("" : "+s"(cc));
        const size_t tok0 = tokb + 64 * cc;
        { float run0 = 0.f, run1 = 0.f;
#pragma unroll
          for (int i = 0; i < 8; ++i) { run0 += gpre[i].x; run1 += gpre[i].y; }
          *(LAS f32x2*)(lds + HL_SEG + (w * 128 + 2 * cp) * 4) = (f32x2){run0, run1}; }
        { const int k0 = trkey(vrow);
          *(LAS u32x4*)(lds + HL_VT + vrow * 256 + ((((vc16 >> 1)) ^ k0) << 5) + (vc16 & 1) * 16) = vpre[0];
          *(LAS u32x4*)(lds + HL_VT + vrow * 256 + (((((vc16 + 8) >> 1)) ^ k0) << 5) + (vc16 & 1) * 16) = vpre[1]; }
        __syncthreads();
        float off0 = 0.f, off1 = 0.f, r0 = 0.f, r1 = 0.f, tot0 = 0.f, tot1 = 0.f;
#pragma unroll
        for (int sg = 0; sg < 8; ++sg) { const f32x2 sv = *(const LAS f32x2*)(lds + HL_SEG + (sg * 128 + 2 * cp) * 4);
            if (sg < w) { off0 += sv.x; off1 += sv.y; } if (sg < 4) { r0 += sv.x; r1 += sv.y; } tot0 += sv.x; tot1 += sv.y; }
        if (w == 0) *(LAS f32x2*)(lds + HL_DS + 2 * cp * 4) = (f32x2){__builtin_amdgcn_exp2f(tot0), __builtin_amdgcn_exp2f(tot1)};
#pragma unroll
        for (int i = 0; i < 8; ++i) {
            const int t = 8 * w + i, k = 2 * cp;
            off0 += gpre[i].x; off1 += gpre[i].y;
            const float b0 = off0, b1 = off1;
            const float q0 = bflo(qpre[i]), q1 = bfhi(qpre[i]);
            const float k0 = 1.f - __builtin_amdgcn_exp2f(gpre[i].x), k1 = 1.f - __builtin_amdgcn_exp2f(gpre[i].y);
            const float e30 = __builtin_amdgcn_exp2f(b0), e31 = __builtin_amdgcn_exp2f(b1);
            const float e10 = __builtin_amdgcn_exp2f(fminf(b0 - r0, 115.f)), e11 = __builtin_amdgcn_exp2f(fminf(b1 - r1, 115.f));
            const float e20 = __builtin_amdgcn_exp2f(fminf(r0 - b0, 115.f)), e21 = __builtin_amdgcn_exp2f(fminf(r1 - b1, 115.f));
            const float e40 = __builtin_amdgcn_exp2f(tot0 - b0), e41 = __builtin_amdgcn_exp2f(tot1 - b1);
            const int oqm = t * 256 + (((k >> 3) ^ (t & 15)) << 4) + (k & 7) * 2;
            *(LAS unsigned*)(lds + HL_QM + oqm) = cvt_pk_bf16_c(q0 * e10, q1 * e11);
            *(LAS unsigned*)(lds + HL_KM + oqm) = cvt_pk_bf16_c(k0 * e20, k1 * e21);
            *(LAS unsigned*)(lds + HL_QS + t * 256 + (((k >> 2) ^ ((t & 15) << 1)) << 3) + (k & 3) * 2) = cvt_pk_bf16_c(q0 * e30, q1 * e31);
            *(LAS unsigned*)(lds + HL_KE + t * 256 + (((k >> 4) ^ trkey(t)) << 5) + (k & 15) * 2) = cvt_pk_bf16_c(k0 * e40, k1 * e41);
        }
        if (c + 1 < L / 64) {
            const size_t rb = (tok0 + 64 + 8 * w) * 1024 + hc;
            const float* gb = GH + rb; const bf16_t* qb = QH + rb; const bf16_t* vb = VH + (tok0 + 64) * 1024 + hc;
#pragma unroll
            for (int i = 0; i < 8; ++i) { gpre[i] = *(const f32x2*)(gb + i * 1024 + lo_g); qpre[i] = *(const unsigned*)(qb + i * 1024 + lo_g); }
            vpre[0] = *(const u32x4*)(vb + lo_v); vpre[1] = *(const u32x4*)(vb + 64 + lo_v);
        }
        __syncthreads();
#pragma unroll
        for (int rep = 0; rep < 2; ++rep) {
            if (rep == 1 && w >= 4) break;
            const int idx = rep == 0 ? w : 8 + w;
            const int si = (0xd940e4 >> (2 * idx)) & 3, ti = (0x8fb9e4 >> (2 * idx)) & 3;
            f32x4 pacc = (f32x4){0.f, 0.f, 0.f, 0.f};
            if (idx < 10) {
#pragma unroll
                for (int ks = 0; ks < 4; ++ks) {
                    const int ofs = r16 * 256 + (((4 * ks + g) ^ r16) << 4);
                    const bf16x8 af = *(const LAS bf16x8*)(lds + HL_KM + si * 4096 + ofs);
                    const bf16x8 bfr = *(const LAS bf16x8*)(lds + HL_QM + ti * 4096 + ofs);
                    pacc = __builtin_amdgcn_mfma_f32_16x16x32_bf16(af, bfr, pacc, 0, 0, 0);
                }
                const bool offd = si != ti;
#pragma unroll
                for (int r = 0; r < 4; ++r) pacc[r] = (offd || (4 * g + r <= r16)) ? pacc[r] : 0.f;
            }
            asm volatile("s_nop 7\n\ts_nop 7" ::: "memory");
            const int t = 16 * ti + r16;
            u32x2 pw; pw.x = cvt_pk_bf16_c(pacc[0], pacc[1]); pw.y = cvt_pk_bf16_c(pacc[2], pacc[3]);
            *(LAS u32x2*)(lds + HL_PL + t * 128 + (((2 * si + (g >> 1)) ^ ((t >> 1) & 7)) << 4) + (g & 1) * 8) = pw;
        }
        __syncthreads();
        u32x2 ogp[4];
        { const bf16_t* ob = OG + tok0 * 1024 + hc + 16 * w;
#pragma unroll
          for (int ti = 0; ti < 4; ++ti) ogp[ti] = *(const u32x2*)(ob + ti * 16384 + lo_og); }
#define HG_SB() __builtin_amdgcn_sched_barrier(0)
#define HG_QSLD(dst, kp) do { _Pragma("unroll") for (int ti = 0; ti < 4; ++ti) { const int t_ = 16 * ti + r16; \
            const u32x2 lo_ = *(const LAS u32x2*)(lds + HL_QS + t_ * 256 + (((8 * (kp) + g) ^ (r16 << 1)) << 3)); \
            const u32x2 hi_ = *(const LAS u32x2*)(lds + HL_QS + t_ * 256 + (((8 * (kp) + 4 + g) ^ (r16 << 1)) << 3)); \
            dst[ti] = (u32x4){lo_.x, lo_.y, hi_.x, hi_.y}; } } while (0)
#define HG_KELD(dst, kt) do { _Pragma("unroll") for (int ks = 0; ks < 2; ++ks) { const LAS unsigned char* pb_ = lds + HL_KE + ks * 32 * 256 + trrow + (((kt) ^ keyl) << 5); \
            dst[ks] = mk8(lds_tr16(pb_), lds_tr16(pb_ + 4 * 256)); } } while (0)
#define HG_INTER(kp, qsv) do { u32x4 sw_; sw_.x = cvt_pk_bf16_c(Sacc[2 * (kp)][0], Sacc[2 * (kp)][1]); sw_.y = cvt_pk_bf16_c(Sacc[2 * (kp)][2], Sacc[2 * (kp)][3]); \
            sw_.z = cvt_pk_bf16_c(Sacc[2 * (kp) + 1][0], Sacc[2 * (kp) + 1][1]); sw_.w = cvt_pk_bf16_c(Sacc[2 * (kp) + 1][2], Sacc[2 * (kp) + 1][3]); \
            const bf16x8 sf_ = __builtin_bit_cast(bf16x8, sw_); \
            _Pragma("unroll") for (int ti = 0; ti < 4; ++ti) Oa[ti] = __builtin_amdgcn_mfma_f32_16x16x32_bf16(sf_, __builtin_bit_cast(bf16x8, qsv[ti]), Oa[ti], 0, 0, 0); } while (0)
#define HG_SUPD(kt, kev, dsv) do { f32x4 sa_ = Sacc[kt] * dsv; \
            sa_ = __builtin_amdgcn_mfma_f32_16x16x32_bf16(kev[0], vf[0], sa_, 0, 0, 0); sa_ = __builtin_amdgcn_mfma_f32_16x16x32_bf16(kev[1], vf[1], sa_, 0, 0, 0); Sacc[kt] = sa_; } while (0)
        bf16x8 vf[2];
        bf16x8 pf[6];
        u32x4 qsA[4], qsB[4];
#pragma unroll
        for (int ks = 0; ks < 2; ++ks) {
            const LAS unsigned char* pb = lds + HL_VT + ks * 32 * 256 + trrow + ((w ^ keyl) << 5);
            vf[ks] = mk8(lds_tr16(pb), lds_tr16(pb + 4 * 256));
        }
        {
            const int t0_ = r16, t1_ = 16 + r16, t2_ = 32 + r16, t3_ = 48 + r16;
            pf[0] = *(const LAS bf16x8*)(lds + HL_PL + t0_ * 128 + (((g) ^ ((t0_ >> 1) & 7)) << 4));
            pf[1] = *(const LAS bf16x8*)(lds + HL_PL + t1_ * 128 + (((g) ^ ((t1_ >> 1) & 7)) << 4));
            pf[2] = *(const LAS bf16x8*)(lds + HL_PL + t2_ * 128 + (((g) ^ ((t2_ >> 1) & 7)) << 4));
            pf[3] = *(const LAS bf16x8*)(lds + HL_PL + t2_ * 128 + (((4 + g) ^ ((t2_ >> 1) & 7)) << 4));
            pf[4] = *(const LAS bf16x8*)(lds + HL_PL + t3_ * 128 + (((g) ^ ((t3_ >> 1) & 7)) << 4));
            pf[5] = *(const LAS bf16x8*)(lds + HL_PL + t3_ * 128 + (((4 + g) ^ ((t3_ >> 1) & 7)) << 4));
        }
        HG_QSLD(qsA, 0);
        HG_SB();
        f32x4 Oa[4];
        const f32x4 z4 = (f32x4){0.f, 0.f, 0.f, 0.f};
        Oa[0] = __builtin_amdgcn_mfma_f32_16x16x32_bf16(vf[0], pf[0], z4, 0, 0, 0);
        Oa[1] = __builtin_amdgcn_mfma_f32_16x16x32_bf16(vf[0], pf[1], z4, 0, 0, 0);
        Oa[2] = __builtin_amdgcn_mfma_f32_16x16x32_bf16(vf[0], pf[2], z4, 0, 0, 0);
        Oa[3] = __builtin_amdgcn_mfma_f32_16x16x32_bf16(vf[0], pf[4], z4, 0, 0, 0);
        Oa[2] = __builtin_amdgcn_mfma_f32_16x16x32_bf16(vf[1], pf[3], Oa[2], 0, 0, 0);
        Oa[3] = __builtin_amdgcn_mfma_f32_16x16x32_bf16(vf[1], pf[5], Oa[3], 0, 0, 0);
        HG_SB();
        HG_QSLD(qsB, 1);
        HG_SB();
        HG_INTER(0, qsA);
        HG_SB();
        HG_QSLD(qsA, 2);
        HG_SB();
        HG_INTER(1, qsB);
        HG_SB();
        HG_QSLD(qsB, 3);
        HG_SB();
#define HG_DSLD(kt) (*(const LAS f32x4*)(lds + HL_DS + (16 * (kt) + 4 * g) * 4))
        bf16x8 keA[2], keB[2], keC[2], keD[2]; f32x4 dA, dB, dC, dD;
        HG_KELD(keA, 0); HG_KELD(keB, 1); dA = HG_DSLD(0); dB = HG_DSLD(1);
        HG_SB();
        HG_INTER(2, qsA);
        HG_SB();
        HG_KELD(keC, 2); HG_KELD(keD, 3); dC = HG_DSLD(2); dD = HG_DSLD(3);
        HG_SB();
        HG_INTER(3, qsB);
        HG_SB();
        HG_SUPD(0, keA, dA); HG_SUPD(1, keB, dB);
        HG_SB();
        HG_KELD(keA, 4); HG_KELD(keB, 5); dA = HG_DSLD(4); dB = HG_DSLD(5);
        HG_SB();
        HG_SUPD(2, keC, dC); HG_SUPD(3, keD, dD);
        HG_SB();
        HG_KELD(keC, 6); HG_KELD(keD, 7); dC = HG_DSLD(6); dD = HG_DSLD(7);
        HG_SB();
        HG_SUPD(4, keA, dA); HG_SUPD(5, keB, dB);
        HG_SB();
        HG_SUPD(6, keC, dC); HG_SUPD(7, keD, dD);
#undef HG_DSLD
#undef HG_SB
#undef HG_QSLD
#undef HG_KELD
#undef HG_INTER
#undef HG_SUPD
#pragma unroll
        for (int ti = 0; ti < 4; ++ti) {
            float sq = (Oa[ti][0] * Oa[ti][0] + Oa[ti][1] * Oa[ti][1]) + (Oa[ti][2] * Oa[ti][2] + Oa[ti][3] * Oa[ti][3]);
            sq += __shfl_xor(sq, 16); sq += __shfl_xor(sq, 32);
            if (g == 0) *(LAS float*)(lds + HL_SSQ + (w * 64 + 16 * ti + r16) * 4) = sq;
        }
        __syncthreads();
#pragma unroll
        for (int ti = 0; ti < 4; ++ti) {
            const int t = 16 * ti + r16;
            float tot = 0.f;
#pragma unroll
            for (int ww = 0; ww < 8; ++ww) tot += *(const LAS float*)(lds + HL_SSQ + (ww * 64 + t) * 4);
            const float rs = rsqrtf(tot * (1.f / 128.f) + EPS);
            const f32x4 nw4 = *(const f32x4*)(a.in[6] + 16 * w + 4 * g);
            u32x2 o; o.x = pk2(Oa[ti][0] * rs * nw4[0] * bflo(ogp[ti].x), Oa[ti][1] * rs * nw4[1] * bfhi(ogp[ti].x));
            o.y = pk2(Oa[ti][2] * rs * nw4[2] * bflo(ogp[ti].y), Oa[ti][3] * rs * nw4[3] * bfhi(ogp[ti].y));
            *(u32x2*)(YM + tok0 * D + hc + 16 * w + ti * 32768 + lo_ym) = o;
        }
    }
}

__device__ __forceinline__ void p4_ln_router(Frame& F, const Args& a) {
    LAS float* hrow = (LAS float*)(F.lds + F.wave * 8192);
    const float* Z = (const float*)(F.ws + WS_Z); bf16_t* H1 = (bf16_t*)(F.ws + WS_H1);
    const float* w = a.in[11]; const float* b = a.in[12]; const float* wr = a.in[13]; const float* br = a.in[14];
    int* cnt = (int*)(F.ws + WS_CTL) + CW_CNT; int* list = (int*)(F.ws + WS_LIST);
    int* tok_e = (int*)(F.ws + WS_TOKE); int* tok_p = (int*)(F.ws + WS_TOKP); float* tok_g = (float*)(F.ws + WS_TOKG);
    const int gw = F.vcu * NWAVES + F.wave, NGW = F.G * NWAVES, lane = F.lane;
    for (int m = gw; m < T; m += NGW) {
        const GAS f32x4* zr = (const GAS f32x4*)(Z + (size_t)m * D) + lane;
        f32x4 v[8]; float s = 0.f;
#pragma unroll
        for (int j = 0; j < 8; ++j) { v[j] = zr[64 * j]; s += (v[j][0] + v[j][1]) + (v[j][2] + v[j][3]); }
        const float mean = wave_sum(s) * (1.f / D); float s2 = 0.f;
#pragma unroll
        for (int j = 0; j < 8; ++j) { v[j] = v[j] - mean; s2 += (v[j][0] * v[j][0] + v[j][1] * v[j][1]) + (v[j][2] * v[j][2] + v[j][3] * v[j][3]); }
        const float rstd = rsqrtf(wave_sum(s2) * (1.f / D) + EPS);
        GAS u32x2* o8 = (GAS u32x2*)(H1 + (size_t)m * D) + lane;
#pragma unroll
        for (int j = 0; j < 8; ++j) { const f32x4 ww = *((const f32x4*)w + lane + 64 * j), bb = *((const f32x4*)b + lane + 64 * j);
            f32x4 hv; hv[0] = v[j][0] * rstd * ww[0] + bb[0]; hv[1] = v[j][1] * rstd * ww[1] + bb[1]; hv[2] = v[j][2] * rstd * ww[2] + bb[2]; hv[3] = v[j][3] * rstd * ww[3] + bb[3];
            u32x2 o; o.x = pk2(hv[0], hv[1]); o.y = pk2(hv[2], hv[3]); o8[64 * j] = o;
            *((GAS unsigned*)(F.ws + WS_H1Q + (size_t)m * D) + lane + 64 * j) = pk4_fp8(hv[0] * SC_H1, hv[1] * SC_H1, hv[2] * SC_H1, hv[3] * SC_H1);
            *((LAS f32x4*)hrow + lane + 64 * j) = hv; }
        asm volatile("s_waitcnt lgkmcnt(0)" ::: "memory");
        const int e = lane & 31, half = lane >> 5;
        const LAS float* hp = hrow + half * 1024; const float* wp = wr + (size_t)half * 1024 * NE + e;
        float sA = 0.f, sB = 0.f;
        for (int k = 0; k < 1024; k += 2) { sA = fmaf(hp[k], wp[(size_t)k * NE], sA); sB = fmaf(hp[k + 1], wp[(size_t)(k + 1) * NE], sB); }
        float sl = sA + sB; sl += __shfl_xor(sl, 32); sl += br[e];
        float val = sl; int te[4]; float tv[4];
#pragma unroll
        for (int r = 0; r < 4; ++r) {
            float bv = val; int bi = e;
#pragma unroll
            for (int o = 1; o < 32; o <<= 1) { const float ov = __shfl_xor(bv, o); const int oi = __shfl_xor(bi, o); if (ov > bv || (ov == bv && oi < bi)) { bv = ov; bi = oi; } }
            te[r] = bi; tv[r] = bv; if (e == bi) val = -INFINITY;
        }
        float p[4], ps = 0.f;
#pragma unroll
        for (int r = 0; r < 4; ++r) { p[r] = __expf(tv[r] - tv[0]); ps += p[r]; }
        if (lane < 4) {
            int ee = te[0]; float g = p[0];
            if (lane == 1) { ee = te[1]; g = p[1]; } else if (lane == 2) { ee = te[2]; g = p[2]; } else if (lane == 3) { ee = te[3]; g = p[3]; }
            const int pos = atomicAdd(&cnt[ee], 1);
            list[(size_t)ee * LISTCAP + pos] = m;
            tok_e[m * 4 + lane] = ee; tok_p[m * 4 + lane] = pos; tok_g[m * 4 + lane] = g / ps;
        }
        asm volatile("s_waitcnt lgkmcnt(0)" ::: "memory");
    }
}
__device__ __forceinline__ int moe_tables(Frame& F) {
    LAS int* pts = (LAS int*)(F.lds + LDSCTL_OFF + LC_PTS); LAS int* cl = (LAS int*)(F.lds + LDSCTL_OFF + LC_CNT); LAS unsigned char* tileE = (LAS unsigned char*)(F.lds + LDSCTL_OFF + LC_TILEE);
    const int* cnt = (const int*)(F.ws + WS_CTL) + CW_CNT;
    __syncthreads();
    if (F.tid < 64) {
        const int e = F.tid & 31; const int c = __hip_atomic_load(cnt + e, RLX_AGENT); const int tl = (c + 255) >> 8;
        int incl = tl;
#pragma unroll
        for (int o = 1; o < 32; o <<= 1) { const int v = __shfl_up(incl, o, 32); if (e >= o) incl += v; }
        if (F.tid < 32) { cl[e] = c; pts[e] = incl - tl; if (e == 31) pts[32] = incl; }
    }
    __syncthreads();
    const int nmt = pts[32];
    for (int t = F.tid; t < nmt; t += NTHR) { int e = 0;
        for (int j = 0; j < 32; ++j) if (t >= pts[j + 1]) e = j + 1;
        tileE[t] = (unsigned char)e; }
    __syncthreads();
    return __builtin_amdgcn_readfirstlane(nmt);
}
__device__ __forceinline__ void p7_combine(Frame& F, const Args& a) {
    const LAS int* pts = (const LAS int*)(F.lds + LDSCTL_OFF + LC_PTS);
    const bf16_t* H1 = (const bf16_t*)(F.ws + WS_H1); const bf16_t* Y = (const bf16_t*)(F.ws + WS_Y);
    const int* tok_e = (const int*)(F.ws + WS_TOKE); const int* tok_p = (const int*)(F.ws + WS_TOKP); const float* tok_g = (const float*)(F.ws + WS_TOKG);
    const float* w = a.in[21]; const float* b = a.in[22]; float* out = a.out;
    const int gw = F.vcu * NWAVES + F.wave, NGW = F.G * NWAVES, lane = F.lane;
    for (int m = gw; m < T; m += NGW) {
        f32x4 v[8];
        { const GAS u32x2* hr = (const GAS u32x2*)(H1 + (size_t)m * D) + lane;
#pragma unroll
          for (int j = 0; j < 8; ++j) { const u32x2 hw = hr[64 * j]; v[j][0] = ALPHA * bflo(hw.x); v[j][1] = ALPHA * bfhi(hw.x); v[j][2] = ALPHA * bflo(hw.y); v[j][3] = ALPHA * bfhi(hw.y); } }
#pragma unroll
        for (int k = 0; k < 4; ++k) {
            const int e = tok_e[m * 4 + k]; const int row = pts[e] * 256 + tok_p[m * 4 + k]; const float g = tok_g[m * 4 + k];
            const GAS u32x2* yr = (const GAS u32x2*)(Y + (size_t)row * D) + lane;
#pragma unroll
            for (int j = 0; j < 8; ++j) { const u32x2 yw = yr[64 * j]; v[j][0] += g * bflo(yw.x); v[j][1] += g * bfhi(yw.x); v[j][2] += g * bflo(yw.y); v[j][3] += g * bfhi(yw.y); }
        }
        float s = 0.f;
#pragma unroll
        for (int j = 0; j < 8; ++j) s += (v[j][0] + v[j][1]) + (v[j][2] + v[j][3]);
        const float mean = wave_sum(s) * (1.f / D); float s2 = 0.f;
#pragma unroll
        for (int j = 0; j < 8; ++j) { v[j] = v[j] - mean; s2 += (v[j][0] * v[j][0] + v[j][1] * v[j][1]) + (v[j][2] * v[j][2] + v[j][3] * v[j][3]); }
        const float rstd = rsqrtf(wave_sum(s2) * (1.f / D) + EPS);
        GAS f32x4* orow = (GAS f32x4*)(out + (size_t)m * D) + lane;
#pragma unroll
        for (int j = 0; j < 8; ++j) { const f32x4 ww = *((const f32x4*)w + lane + 64 * j), bb = *((const f32x4*)b + lane + 64 * j);
            f32x4 o; o[0] = v[j][0] * rstd * ww[0] + bb[0]; o[1] = v[j][1] * rstd * ww[1] + bb[1]; o[2] = v[j][2] * rstd * ww[2] + bb[2]; o[3] = v[j][3] * rstd * ww[3] + bb[3]; orow[64 * j] = o; }
    }
}

__global__ void __launch_bounds__(NTHR, 2) mk_fwd(Args args) {
    extern __shared__ __attribute__((aligned(16))) unsigned char lds_raw[];
    Frame F;
    F.lds = (LAS unsigned char*)lds_raw;
    F.tid = threadIdx.x; F.lane = F.tid & 63; F.wave = __builtin_amdgcn_readfirstlane(F.tid >> 6);
    F.G = gridDim.x; { const int bx = blockIdx.x; F.vcu = (F.G % 8 == 0) ? (bx % 8) * (F.G / 8) + bx / 8 : bx; }
    F.ws = args.ws;
    unsigned char* ws = args.ws;
    for (int u = F.tid; u < (LDS_BYTES - LDSCTL_OFF) / 4; u += NTHR) ((LAS unsigned*)(F.lds + LDSCTL_OFF))[u] = 0u;
    __syncthreads();
    XcdBarrier bar; bar.bar = (unsigned*)(ws + WS_CTL) + CW_BAR; bar.x = 0; bar.st = nullptr;
#if !MK_PER_PHASE
    bar = xcd_barrier_post((unsigned*)(ws + WS_CTL) + CW_BAR, (volatile LAS unsigned*)(F.lds + LDSCTL_OFF + LC_BAR));
#endif
    const int lo = args.ph_lo, hi = args.ph_hi;
#define IN(k) (lo <= (k) && (k) < hi)
#define REFRESH_IDS() do { int t_ = threadIdx.x; asm volatile("" : "+v"(t_)); F.tid = t_; F.lane = t_ & 63; F.wave = __builtin_amdgcn_readfirstlane(t_ >> 6); } while (0)
#define SEAM(k) do { if (IN(k) && IN((k) + 1)) xcd_barrier(bar); } while (0)

    if (IN(0)) { REFRESH_IDS(); for (int r = 0; r < REP0; ++r) { p0_prologue(F, args); if (r + 1 < REP0) xcd_barrier(bar); } } SEAM(0);

    if (IN(1)) { REFRESH_IDS();
        SchedDense S{(const bf16_t*)(ws + WS_H0), (const bf16_t*)(ws + WS_WIN), T / 256, INC / 256, F.G, (int)blockIdx.x};
        EpiInProj E{(bf16_t*)(ws + WS_QH), (bf16_t*)(ws + WS_KH), (bf16_t*)(ws + WS_VH), (bf16_t*)(ws + WS_OG), (bf16_t*)(ws + WS_AQ), (bf16_t*)(ws + WS_AK), (bf16_t*)(ws + WS_AV),
                    (float*)(ws + WS_GH), (const float*)(ws + WS_LB), args.in[4]};
        for (int r = 0; r < REP1; ++r) { gemm_phase<EpiInProj, SchedDense>(F.lds, S, E); if (r + 1 < REP1) xcd_barrier(bar); }
    } SEAM(1);

    if (IN(2)) { REFRESH_IDS();
        for (int r = 0; r < REP2; ++r) {
        const int nh = F.G > 64 ? 64 : F.G, na = F.G > 64 ? F.G - 64 : F.G, aid = F.G > 64 ? (int)blockIdx.x - 64 : (int)blockIdx.x;
        if ((int)blockIdx.x < nh) { for (int hu = blockIdx.x; hu < 64 * REP2H; hu += nh) hgrn_unit_mfma(F, args, (hu & 63) >> 3, hu & 7); }
        REFRESH_IDS();
        if (aid >= 0) { for (int v0 = aid; v0 < NB * (L / AT_Q) * REP2A; v0 += na) { const int v = v0 % (NB * (L / AT_Q)); attn_unit_mfma(F, args, v / (L / AT_Q), v % (L / AT_Q)); } }
        if (r + 1 < REP2) xcd_barrier(bar); }
    } SEAM(2);

    if (IN(3)) { REFRESH_IDS();
        SchedDense S{(const bf16_t*)(ws + WS_YMIX), (const bf16_t*)(ws + WS_WOUT), T / 256, D / 256, F.G, (int)blockIdx.x};
        EpiOutProj E{(float*)(ws + WS_Z), args.in[0], (const float*)(ws + WS_STATS0), args.in[1], args.in[2], args.in[10]};
        for (int r = 0; r < REP3; ++r) { gemm_phase<EpiOutProj, SchedDense>(F.lds, S, E); if (r + 1 < REP3) xcd_barrier(bar); }
    } SEAM(3);

    if (IN(4)) { REFRESH_IDS(); p4_ln_router(F, args); } SEAM(4);

    if (IN(5)) { REFRESH_IDS();
        const int nmt = moe_tables(F);
        SchedMoe<2048> S{(const void*)(ws + WS_H1Q), (const void*)(ws + WS_WGU), (size_t)4096 * KD, (const int*)(ws + WS_LIST),
                   (const LAS int*)(F.lds + LDSCTL_OFF + LC_PTS), (const LAS int*)(F.lds + LDSCTL_OFF + LC_CNT), (const LAS unsigned char*)(F.lds + LDSCTL_OFF + LC_TILEE), nmt, 16, F.G, (int)blockIdx.x, true};
        EpiMoe1F8 E{(unsigned char*)(ws + WS_HACT), args.in[16], args.in[18]};
        for (int r = 0; r < REP5; ++r) { gemm_phase<EpiMoe1F8, SchedMoe<2048>, true>(F.lds, S, E); if (r + 1 < REP5) xcd_barrier(bar); }
    } SEAM(5);

    if (IN(6)) { REFRESH_IDS();
        const int nmt = moe_tables(F);
        SchedMoe<2048> S{(const void*)(ws + WS_HACT), (const void*)(ws + WS_WD), (size_t)2048 * KD, (const int*)(ws + WS_LIST),
                   (const LAS int*)(F.lds + LDSCTL_OFF + LC_PTS), (const LAS int*)(F.lds + LDSCTL_OFF + LC_CNT), (const LAS unsigned char*)(F.lds + LDSCTL_OFF + LC_TILEE), nmt, 8, F.G, (int)blockIdx.x, false};
        EpiMoe2F8 E{(bf16_t*)(ws + WS_Y), args.in[20]};
        for (int r = 0; r < REP6; ++r) { gemm_phase<EpiMoe2F8, SchedMoe<2048>, true>(F.lds, S, E); if (r + 1 < REP6) xcd_barrier(bar); }
    } SEAM(6);

    if (IN(7)) { REFRESH_IDS(); (void)moe_tables(F); for (int r = 0; r < REP7; ++r) p7_combine(F, args); }
#undef IN
#undef SEAM
}
}

extern "C" void kernel_launch(void* const* d_in, const int* in_sizes, int n_in, void* d_out, int out_size, void* d_ws, size_t ws_size, hipStream_t stream) {
    static int grid = 0;
    if (grid == 0) {
        if (n_in != 23 || out_size != T * D || ws_size < WS_END) { fprintf(stderr, "kernel_launch: unexpected shapes (n_in %d out %d ws %zu need %zu)\n", n_in, out_size, ws_size, (size_t)WS_END); grid = -1; return; }
        int dev = 0, cus = 0, per_cu = 0;
        if (hipGetDevice(&dev) != hipSuccess || hipDeviceGetAttribute(&cus, hipDeviceAttributeMultiprocessorCount, dev) != hipSuccess) { grid = -1; return; }
        if (hipFuncSetAttribute((const void*)mk_fwd, hipFuncAttributeMaxDynamicSharedMemorySize, LDS_BYTES) != hipSuccess) { fprintf(stderr, "kernel_launch: hipFuncSetAttribute failed\n"); grid = -1; return; }
        if (hipOccupancyMaxActiveBlocksPerMultiprocessor(&per_cu, (const void*)mk_fwd, NTHR, LDS_BYTES) != hipSuccess || per_cu < 1) { fprintf(stderr, "kernel_launch: occupancy query says %d\n", per_cu); }
        (void)hipGetLastError();
        grid = cus;
    }
    if (grid < 0) return;
    if (hipMemsetAsync((char*)d_ws + WS_CTL, 0, CTL_ZERO_BYTES, stream) != hipSuccess) return;
    Args a{};
    for (int i = 0; i < 23; ++i) a.in[i] = (const float*)d_in[i];
    a.out = (float*)d_out; a.ws = (unsigned char*)d_ws;
#if MK_PER_PHASE
    for (int p = 0; p < NPHASE; ++p) { a.ph_lo = p; a.ph_hi = p + 1; hipLaunchKernelGGL(mk_fwd, dim3(grid), dim3(NTHR), LDS_BYTES, stream, a); }
#else
    a.ph_lo = 0; a.ph_hi = NPHASE; hipLaunchKernelGGL(mk_fwd, dim3(grid), dim3(NTHR), LDS_BYTES, stream, a);
#endif
}
```

```cpp
#include <hip/hip_runtime.h>
#include <cstdio>
#include <cstdint>

#ifndef MK_PER_PHASE
#define MK_PER_PHASE 0
#endif

#define LAS __attribute__((address_space(3)))
#define GAS __attribute__((address_space(1)))
typedef unsigned short bf16_t;
typedef short bf16x8 __attribute__((ext_vector_type(8)));
typedef float f32x4 __attribute__((ext_vector_type(4)));
typedef float f32x2 __attribute__((ext_vector_type(2)));
typedef unsigned u32x4 __attribute__((ext_vector_type(4)));
typedef unsigned u32x2 __attribute__((ext_vector_type(2)));
typedef GAS unsigned gu32;

namespace {
constexpr int D = 2048, NB = 8, L = 2048, T = NB * L;
constexpr int INC = 5376;
constexpr int NE = 32, FF = 2048, NA = T * 4;
constexpr int LISTCAP = T;
constexpr int MAXROWS = NA + NE * 256;
constexpr float ALPHA = 1.189207115002721f;
constexpr float EPS = 1e-5f;
constexpr int NWAVES = 8, NTHR = 512;
constexpr int NPHASE = 9;
constexpr int REP2H = 1, REP2A = 1;
constexpr int REP0 = 1, REP1 = 1, REP2 = 1, REP3 = 1, REP5 = 1, REP6 = 1, REP7 = 1;

constexpr size_t MiB = 1u << 20;
constexpr size_t WS_CTL = 0, CTL_ZERO_BYTES = 1 * MiB;
constexpr size_t WS_LB = 1 * MiB;
constexpr size_t WS_STATS0 = WS_LB + 4096;
constexpr size_t WS_LIST = 2 * MiB;
constexpr size_t WS_TOKE = 4 * MiB, WS_TOKP = WS_TOKE + (size_t)NA * 4, WS_TOKG = WS_TOKP + (size_t)NA * 4;
constexpr size_t WS_WRH = 5 * MiB, WS_WRL = WS_WRH + 131072;
constexpr size_t WS_WIN = 8 * MiB;
constexpr size_t WS_WOUT = 30 * MiB;
constexpr size_t WS_WGU = 40 * MiB;
constexpr size_t WS_WD = 552 * MiB;
constexpr size_t WS_H1 = 808 * MiB;
constexpr size_t WS_Z = 872 * MiB;
constexpr size_t WS_HACT = 1000 * MiB;
constexpr size_t WS_EARLY = 1288 * MiB;
constexpr size_t WS_H0 = WS_EARLY;
constexpr size_t WS_QH = WS_H0 + 64 * MiB, WS_KH = WS_QH + 32 * MiB, WS_VH = WS_KH + 32 * MiB, WS_OG = WS_VH + 32 * MiB, WS_AQ = WS_OG + 32 * MiB;
constexpr size_t WS_GH = WS_AQ + 32 * MiB;
constexpr size_t WS_AK = WS_GH + 64 * MiB, WS_AV = WS_AK + 4 * MiB;
constexpr size_t WS_YMIX = WS_AV + 4 * MiB;
constexpr size_t WS_H1Q = WS_KH;
constexpr size_t WS_Y = WS_EARLY;
constexpr size_t WS_END = WS_YMIX + 64 * MiB;
static_assert(WS_Y + (size_t)MAXROWS * 4096 <= WS_END + 0 * MiB || true, "");
static_assert(WS_END <= 2048 * MiB, "d_ws map");
constexpr int CW_CNT = 64;
constexpr int CW_CONV = 128, CW_P1DONE = 192, CW_HGDONE = 256;
constexpr int CW_BAR = 4096;

constexpr int RING_BYTES = 131072;
constexpr int CV_SCR = 17408;
constexpr int LDSCTL_OFF = 8 * CV_SCR;
constexpr int LDS_BYTES = 147456;
constexpr int LC_BAR = 0, LC_PTS = 64, LC_CNT = 256, LC_TILEE = 512, LC_MISC = 2048;

#define RLX_AGENT __ATOMIC_RELAXED, __HIP_MEMORY_SCOPE_AGENT
__device__ __forceinline__ unsigned f2bf(float f) { unsigned u = __builtin_bit_cast(unsigned, f); return (u + 0x7fffu + ((u >> 16) & 1u)) >> 16; }
__device__ __forceinline__ unsigned pk2(float lo, float hi) { return f2bf(lo) | (f2bf(hi) << 16); }
__device__ __forceinline__ float bf2f(unsigned short b) { return __builtin_bit_cast(float, (unsigned)b << 16); }
__device__ __forceinline__ float bflo(unsigned w) { return __builtin_bit_cast(float, w << 16); }
__device__ __forceinline__ float bfhi(unsigned w) { return __builtin_bit_cast(float, w & 0xffff0000u); }
typedef __bf16 bf16x2_t __attribute__((ext_vector_type(2)));
__device__ __forceinline__ unsigned cvt_pk_bf16_c(float lo, float hi) { f32x2 v = {lo, hi}; bf16x2_t b = __builtin_convertvector(v, bf16x2_t); return __builtin_bit_cast(unsigned, b); }
__device__ __forceinline__ unsigned cvt_pk_bf16(float lo, float hi) { unsigned r; asm volatile("v_cvt_pk_bf16_f32 %0, %1, %2" : "=v"(r) : "v"(lo), "v"(hi)); return r; }
__device__ __forceinline__ float wave_sum(float v) {
#pragma unroll
    for (int o = 1; o < 64; o <<= 1) v += __shfl_xor(v, o);
    return v;
}
__device__ __forceinline__ float sigm(float x) { return __builtin_amdgcn_rcpf(1.f + __expf(-x)); }

#define XB_TMO      128
#define XB_XCNT(j)  (256  + 64 * (j))
#define XB_XSUB(j)  (1280 + 64 * (j))
#define XB_XGEN(j)  (2304 + 64 * (j))
#define XB_TOP      3328
#define XB_TOPGEN   3392
#define XCD_BAR_WORDS 3456
#define XB_SPIN_CAP (1u << 18)
__device__ __forceinline__ unsigned xb_ld(unsigned* p)              { return __hip_atomic_load(p, __ATOMIC_RELAXED, __HIP_MEMORY_SCOPE_AGENT); }
__device__ __forceinline__ unsigned xb_add(unsigned* p, unsigned v) { return __hip_atomic_fetch_add(p, v, __ATOMIC_RELAXED, __HIP_MEMORY_SCOPE_AGENT); }
__device__ __forceinline__ unsigned xb_xcc_id() { return (unsigned)__builtin_amdgcn_s_getreg((3 << 11) | 20) & 0xFu; }
#define XB_SPIN(cond, bar) do { unsigned _sp = 0; while (cond) { __builtin_amdgcn_s_sleep(1); \
    if ((++_sp & 255u) == 0u) { if (xb_ld(&(bar)[XB_TMO])) break; if (_sp > XB_SPIN_CAP) { atomicAdd(&(bar)[XB_TMO], 1u); break; } } } } while (0)
struct XcdBarrier { unsigned* bar; unsigned x; volatile LAS unsigned* st; };
__device__ __forceinline__ XcdBarrier xcd_barrier_post(unsigned* bar, volatile LAS unsigned* st) {
    XcdBarrier b; b.bar = bar; b.x = xb_xcc_id(); b.st = st;
    if (threadIdx.x == 0) (void)xb_add(&bar[XB_XCNT(b.x)], 1u);
    return b;
}
__device__ __forceinline__ void xcd_barrier_complete(unsigned* bar, unsigned x, unsigned& nloc, unsigned& nx) {
    const unsigned G = gridDim.x * gridDim.y * gridDim.z;
    unsigned sum, cnt, mine, sp = 0u;
    for (;;) {
        sum = 0u; cnt = 0u; mine = 0u;
#pragma unroll
        for (unsigned j = 0; j < 16; ++j) { const unsigned c = xb_ld(&bar[XB_XCNT(j)]); sum += c; cnt += (c > 0u) ? 1u : 0u; mine = (j == x) ? c : mine; }
        if (sum == G) break;
        __builtin_amdgcn_s_sleep(1);
        if ((++sp & 255u) == 0u) { if (xb_ld(&bar[XB_TMO])) break; if (sp > XB_SPIN_CAP) { atomicAdd(&bar[XB_TMO], 1u); break; } }
    }
    nloc = mine > 0u ? mine : 1u; nx = cnt > 0u ? cnt : 1u;
}
__device__ __forceinline__ void xcd_barrier(const XcdBarrier& b) {
    asm volatile("s_waitcnt vmcnt(0)" ::: "memory");
    __syncthreads();
    if (threadIdx.x == 0) {
        unsigned* bar = b.bar;
        __builtin_amdgcn_s_waitcnt(0);
        unsigned nloc = b.st[0], nx = b.st[1];
        if (nloc == 0u) { xcd_barrier_complete(bar, b.x, nloc, nx); b.st[0] = nloc; b.st[1] = nx; }
        const unsigned old = xb_add(&bar[XB_XSUB(b.x)], 1u);
        const unsigned gen = old / nloc;
        if (old + 1u == (gen + 1u) * nloc) {
            __builtin_amdgcn_fence(__ATOMIC_RELEASE, "agent");
            asm volatile("s_waitcnt vmcnt(0)" ::: "memory");
            const unsigned og = xb_add(&bar[XB_TOP], 1u);
            const unsigned tg = og / nx;
            if (og + 1u == (tg + 1u) * nx) xb_add(&bar[XB_TOPGEN], 1u);
            else XB_SPIN(xb_ld(&bar[XB_TOPGEN]) == tg, bar);
            __builtin_amdgcn_fence(__ATOMIC_ACQUIRE, "agent");
            xb_add(&bar[XB_XGEN(b.x)], 1u);
            asm volatile("s_waitcnt vmcnt(0)" ::: "memory");
        } else {
            XB_SPIN(xb_ld(&bar[XB_XGEN(b.x)]) == gen, bar);
            __builtin_amdgcn_fence(__ATOMIC_ACQUIRE, "agent");
            asm volatile("s_waitcnt vmcnt(0)" ::: "memory");
        }
    }
    __syncthreads();
}

constexpr int BM = 256, BK = 64, HALF = 128, HTB = HALF * BK * 2, NXCD = 8, WGM = 8;
constexpr int KD = 2048, NT = KD / BK;
__device__ __forceinline__ int lds_byte(int r, int c) { const int st = (r >> 4) * 2 + (c >> 5), rr = r & 15, cc = c & 31, ob = rr * 64 + cc * 2; return st * 1024 + (ob ^ (((ob >> 9) & 1) << 5)); }
__device__ __forceinline__ void stage_rc(int b, int& R, int& C) { const int st = b / 1024, sb = b % 1024, swz = sb ^ (((sb >> 9) & 1) << 5); R = (st >> 1) * 16 + swz / 64; C = (st & 1) * 32 + (swz % 64) / 2; }
__device__ __forceinline__ int perm32(int rho) { const int n = rho >> 4, i = rho & 15; return 8 * (i >> 2) + 4 * n + (i & 3); }

struct GU { const char* A; const char* B; int pm, pn, e, mtl; };

__device__ __forceinline__ bool order_next(int i, int G, int c, int nM, int nN, int& pm, int& pn) {
    const int nwg = nM * nN; const long Lx = (long)i * G + c; if (Lx >= nwg) return false;
    int wgid = (int)Lx; { const int q = nwg / NXCD, r = nwg % NXCD, xcd = wgid % NXCD, off = wgid / NXCD; wgid = (xcd < r ? xcd * (q + 1) : r * (q + 1) + (xcd - r) * q) + off; }
    const int nig = WGM * nN, gid = wgid / nig, fm = gid * WGM, gsz = (nM - fm) < WGM ? (nM - fm) : WGM;
    pm = fm + ((wgid % nig) % gsz); pn = (wgid % nig) / gsz; return true;
}

typedef int v8i_t __attribute__((ext_vector_type(8)));
template <class Epi, class Sched, bool F8 = false>
__device__ __forceinline__ void gemm_phase(LAS unsigned char* lds, const Sched& S, const Epi& E) {
    const int tid = threadIdx.x, wid = __builtin_amdgcn_readfirstlane(tid >> 6), lane = tid & 63, wr = wid >> 2, wc = wid & 3, fr = lane & 15, fq = lane >> 4;
    constexpr int ROWB = F8 ? KD : KD * 2;
    constexpr int nt = ROWB / 128;
    int Rr[2], Cc[2]; unsigned voffB[2];
#pragma unroll
    for (int i = 0; i < 2; ++i) { stage_rc(tid * 16 + i * 8192, Rr[i], Cc[i]); const int Rb = Epi::PERM ? ((Rr[i] & ~31) + perm32(Rr[i] & 31)) : Rr[i]; voffB[i] = (unsigned)(Rb * ROWB + Cc[i] * 2); }
    const size_t kstep = (size_t)128;
    const size_t hstep = (size_t)HALF * ROWB;
    const unsigned ldsw = (unsigned)wid * 1024u;
    const int aoff = F8 ? lds_byte(wr * 64 + fr, fq * 16) : lds_byte(wr * 64 + fr, fq * 8), boff = F8 ? lds_byte(wc * 32 + fr, fq * 16) : lds_byte(wc * 32 + fr, fq * 8);
#define PG8_SA(b, h) (((b) * 2 + (h)) * HTB)
#define PG8_SB(b, h) ((4 + (b) * 2 + (h)) * HTB)
#define PG8_STAGE(bufoff, gbase, voff) do { _Pragma("unroll") for (int _i = 0; _i < 2; ++_i) \
        __builtin_amdgcn_global_load_lds((const unsigned*)((const char*)(gbase) + (voff)[_i]), (LAS unsigned*)(lds + (bufoff) + ldsw + _i * 8192), 16, 0, 0); } while (0)
#define PG8_LDA(dst, b, h) do { _Pragma("unroll") for (int m = 0; m < 4; ++m) _Pragma("unroll") for (int k = 0; k < 2; ++k) dst[m].q[k] = *(const LAS u32x4*)(lds + PG8_SA(b, h) + aoff + m * 2048 + k * (F8 ? 16 : 1024)); } while (0)
#define PG8_LDB(dst, b, h) do { _Pragma("unroll") for (int n = 0; n < 2; ++n) _Pragma("unroll") for (int k = 0; k < 2; ++k) dst[n].q[k] = *(const LAS u32x4*)(lds + PG8_SB(b, h) + boff + n * 2048 + k * (F8 ? 16 : 1024)); } while (0)
#define PG8_MMA(ai, bj, At, Bt) do { __builtin_amdgcn_s_setprio(1); _Pragma("unroll") for (int m = 0; m < 4; ++m) _Pragma("unroll") for (int n = 0; n < 2; ++n) { \
        if constexpr (F8) { asm volatile("v_mfma_scale_f32_16x16x128_f8f6f4 %0, %1, %2, %0, %3, %3 op_sel_hi:[0,0,0]" : "+v"(acc[ai][bj][m][n]) : "v"(Bt[n].v), "v"(At[m].v), "v"(f8sc)); } \
        else { _Pragma("unroll") for (int k = 0; k < 2; ++k) acc[ai][bj][m][n] = __builtin_amdgcn_mfma_f32_16x16x32_bf16(__builtin_bit_cast(bf16x8, Bt[n].q[k]), __builtin_bit_cast(bf16x8, At[m].q[k]), acc[ai][bj][m][n], 0, 0, 0); } } \
        __builtin_amdgcn_s_setprio(0); } while (0)
#define PG8_WAIT_V(n) asm volatile("s_waitcnt vmcnt(" #n ")" ::: "memory")
#define PG8_WAIT_L(n) asm volatile("s_waitcnt lgkmcnt(" #n ")" ::: "memory")
#define PG8_BAR __builtin_amdgcn_s_barrier()
#define PG8_SCHED __builtin_amdgcn_sched_barrier(0)
    GU cur, nxt; int ui = 0;
    if (!S.next(0, cur)) return;
    f32x4 acc[2][2][4][2];
#pragma unroll
    for (int a = 0; a < 2; ++a)
#pragma unroll
        for (int b = 0; b < 2; ++b)
#pragma unroll
            for (int m = 0; m < 4; ++m)
#pragma unroll
                for (int n = 0; n < 2; ++n) acc[a][b][m][n] = (f32x4){0.f, 0.f, 0.f, 0.f};
    int f8sc = 0x7f7f7f7f; asm volatile("" : "+v"(f8sc));
    union Frag { v8i_t v; u32x4 q[2]; };
    Frag At[4], B0[2], B1[2];
    unsigned oc0[2], oc1[2], on0[2], on1[2];
    S.a_off(cur, Rr, Cc, oc0, oc1);
    const char* cA = cur.A; const char* cB = cur.B;
    PG8_STAGE(PG8_SB(0, 0), cB, voffB); PG8_STAGE(PG8_SB(0, 1), cB + hstep, voffB); PG8_STAGE(PG8_SA(0, 0), cA, oc0); PG8_STAGE(PG8_SA(0, 1), cA, oc1);
    if (wr == 1) PG8_BAR;
    PG8_WAIT_V(2); PG8_BAR;
    PG8_STAGE(PG8_SB(1, 0), cB + kstep, voffB); PG8_STAGE(PG8_SA(1, 0), cA + kstep, oc0); PG8_STAGE(PG8_SB(1, 1), cB + hstep + kstep, voffB);
    PG8_WAIT_V(6); PG8_BAR;
    for (;;) {
        const bool has_next = S.next(ui + 1, nxt);
        const char* nA = has_next ? nxt.A : cA; const char* nB = has_next ? nxt.B : cB;
        for (int t = 0; t < nt; t += 2) {
            const bool last = (t == nt - 2);
            const char* a1 = cA + (size_t)(t + 1) * kstep;
            const char* a2 = last ? nA : cA + (size_t)(t + 2) * kstep; const char* b2 = last ? nB : cB + (size_t)(t + 2) * kstep;
            const char* a3 = a2 + kstep; const char* b3 = b2 + kstep;
            unsigned o20[2], o21[2];
            if (last) {
                if (has_next) S.a_off(nxt, Rr, Cc, on0, on1); else { on0[0] = oc0[0]; on0[1] = oc0[1]; on1[0] = oc1[0]; on1[1] = oc1[1]; }
                o20[0] = on0[0]; o20[1] = on0[1]; o21[0] = on1[0]; o21[1] = on1[1];
            } else { o20[0] = oc0[0]; o20[1] = oc0[1]; o21[0] = oc1[0]; o21[1] = oc1[1]; }
            PG8_LDB(B0, 0, 0); PG8_LDB(B1, 0, 1); PG8_SCHED; PG8_LDA(At, 0, 0); PG8_STAGE(PG8_SA(1, 1), a1, oc1);
            PG8_WAIT_V(8); PG8_WAIT_L(0); PG8_BAR; PG8_MMA(0, 0, At, B0); PG8_MMA(0, 1, At, B1); PG8_BAR; PG8_SCHED;
            PG8_LDA(At, 0, 1); PG8_STAGE(PG8_SB(0, 0), b2, voffB); PG8_STAGE(PG8_SB(0, 1), b2 + hstep, voffB); PG8_STAGE(PG8_SA(0, 0), a2, o20);
            PG8_WAIT_V(8); PG8_WAIT_L(0); PG8_BAR; PG8_MMA(1, 0, At, B0); PG8_MMA(1, 1, At, B1); PG8_BAR; PG8_SCHED;
            PG8_LDB(B0, 1, 0); PG8_LDB(B1, 1, 1); PG8_SCHED; PG8_LDA(At, 1, 0); PG8_STAGE(PG8_SA(0, 1), a2, o21);
            PG8_WAIT_V(8); PG8_WAIT_L(0); PG8_BAR; PG8_MMA(0, 0, At, B0); PG8_MMA(0, 1, At, B1); PG8_BAR; PG8_SCHED;
            PG8_LDA(At, 1, 1); PG8_STAGE(PG8_SB(1, 0), b3, voffB); PG8_STAGE(PG8_SB(1, 1), b3 + hstep, voffB); PG8_STAGE(PG8_SA(1, 0), a3, o20);
            PG8_WAIT_V(8); PG8_WAIT_L(0); PG8_BAR; PG8_MMA(1, 0, At, B0); PG8_MMA(1, 1, At, B1); PG8_BAR; PG8_SCHED;
        }
        if (wr == 0) PG8_BAR;
        if constexpr (F8) asm volatile("s_nop 15\n\ts_nop 15" ::: "memory");
        E(acc, cur, wr, wc, fr, fq);
        if (!has_next) break;
#pragma unroll
        for (int a = 0; a < 2; ++a)
#pragma unroll
            for (int b = 0; b < 2; ++b)
#pragma unroll
                for (int m = 0; m < 4; ++m)
#pragma unroll
                    for (int n = 0; n < 2; ++n) acc[a][b][m][n] = (f32x4){0.f, 0.f, 0.f, 0.f};
        cur = nxt; cA = nA; cB = nB; ++ui;
        oc0[0] = on0[0]; oc0[1] = on0[1]; oc1[0] = on1[0]; oc1[1] = on1[1];
        if (wr == 1) PG8_BAR;
    }
    PG8_WAIT_V(0);
    PG8_BAR;
#undef PG8_SA
#undef PG8_SB
#undef PG8_STAGE
#undef PG8_LDA
#undef PG8_LDB
#undef PG8_MMA
#undef PG8_WAIT_V
#undef PG8_WAIT_L
#undef PG8_BAR
#undef PG8_SCHED
}

struct SchedDense {
    const bf16_t* A; const bf16_t* Bt; int nM, nN, G, c;
    __device__ __forceinline__ bool next(int i, GU& u) const {
        int pm, pn; if (!order_next(i, G, c, nM, nN, pm, pn)) return false;
        u.pm = pm; u.pn = pn; u.e = 0; u.mtl = pm; u.A = (const char*)A; u.B = (const char*)Bt + (size_t)pn * (256 * KD * 2); return true;
    }
    __device__ __forceinline__ void a_off(const GU& u, const int (&R)[2], const int (&C)[2], unsigned (&o0)[2], unsigned (&o1)[2]) const {
#pragma unroll
        for (int i = 0; i < 2; ++i) { o0[i] = (unsigned)((u.pm * 256 + R[i]) * KD + C[i]) * 2u; o1[i] = (unsigned)((u.pm * 256 + 128 + R[i]) * KD + C[i]) * 2u; }
    }
};
template <int ROWB>
struct SchedMoe {
    const void* A; const void* Bt; size_t bstride_e;
    const int* list; const LAS int* pts; const LAS int* cntl; const LAS unsigned char* tileE;
    int nM, nN, G, c; bool gather;
    __device__ __forceinline__ bool next(int i, GU& u) const {
        int pm, pn; if (!order_next(i, G, c, nM, nN, pm, pn)) return false;
        const int e = __builtin_amdgcn_readfirstlane((int)tileE[pm]);
        u.pm = pm; u.pn = pn; u.e = e; u.mtl = pm - __builtin_amdgcn_readfirstlane(pts[e]);
        u.A = (const char*)A; u.B = (const char*)Bt + (size_t)e * bstride_e + (size_t)pn * (256 * ROWB); return true;
    }
    __device__ __forceinline__ void a_off(const GU& u, const int (&R)[2], const int (&C)[2], unsigned (&o0)[2], unsigned (&o1)[2]) const {
        if (gather) {
            const int ce = __builtin_amdgcn_readfirstlane(cntl[u.e]);
            const int* lp = list + (size_t)u.e * LISTCAP;
#pragma unroll
            for (int i = 0; i < 2; ++i) {
                int i0 = u.mtl * 256 + R[i], i1 = i0 + 128;
                i0 = i0 < ce ? i0 : 0; i1 = i1 < ce ? i1 : 0;
                const int t0 = lp[i0], t1 = lp[i1];
                o0[i] = (unsigned)(t0 * ROWB + C[i] * 2); o1[i] = (unsigned)(t1 * ROWB + C[i] * 2);
            }
        } else {
#pragma unroll
            for (int i = 0; i < 2; ++i) { o0[i] = (unsigned)((u.pm * 256 + R[i]) * ROWB + C[i] * 2); o1[i] = (unsigned)((u.pm * 256 + 128 + R[i]) * ROWB + C[i] * 2); }
        }
    }
};

__device__ __forceinline__ u32x4 pack8(const f32x4& a, const f32x4& b) { u32x4 w; w.x = cvt_pk_bf16(a[0], a[1]); w.y = cvt_pk_bf16(a[2], a[3]); w.z = cvt_pk_bf16(b[0], b[1]); w.w = cvt_pk_bf16(b[2], b[3]); return w; }

struct EpiInProj {
    static constexpr bool PERM = true;
    bf16_t *QH, *KH, *VH, *OG, *AQ, *AK, *AV; float* GH; const float* lb; const float* bqkv;
    __device__ __forceinline__ void operator()(const f32x4 (&acc)[2][2][4][2], const GU& u, int wr, int wc, int fr, int fq) const {
        const int row0 = u.pm * BM + wr * 64 + fr;
        const int type = u.pn >> 2;
        const int cw = wc * 32 + 8 * fq;
#pragma unroll
        for (int bj = 0; bj < 2; ++bj) {
            const int col = (u.pn & 3) * 256 + bj * HALF + cw;
            if (type == 0 || type == 3) {
                bf16_t* O = (type == 0 ? QH : OG);
#pragma unroll
                for (int ai = 0; ai < 2; ++ai)
#pragma unroll
                    for (int m = 0; m < 4; ++m) { f32x4 v0 = acc[ai][bj][m][0], v1 = acc[ai][bj][m][1];
#pragma unroll
                        for (int j = 0; j < 4; ++j) { v0[j] = v0[j] * sigm(v0[j]); v1[j] = v1[j] * sigm(v1[j]); }
                        *(u32x4*)(O + (size_t)(row0 + ai * HALF + m * 16) * 1024 + col) = pack8(v0, v1); }
            } else if (type == 1) {
                const f32x4 l0 = *(const f32x4*)(lb + col), l1 = *(const f32x4*)(lb + col + 4);
#pragma unroll
                for (int ai = 0; ai < 2; ++ai)
#pragma unroll
                    for (int m = 0; m < 4; ++m) { f32x4 v0 = acc[ai][bj][m][0], v1 = acc[ai][bj][m][1], g0, g1;
#pragma unroll
                        for (int j = 0; j < 4; ++j) { const float s0 = sigm(v0[j]), s1 = sigm(v1[j]);
                            const float f0 = l0[j] + (1.f - l0[j]) * s0, f1 = l1[j] + (1.f - l1[j]) * s1;
                            g0[j] = __log2f(f0); g1[j] = __log2f(f1); }
                        const size_t o = (size_t)(row0 + ai * HALF + m * 16) * 1024 + col;
                        *(f32x4*)(GH + o) = g0; *(f32x4*)(GH + o + 4) = g1; }
            } else if (type == 2) {
#pragma unroll
                for (int ai = 0; ai < 2; ++ai)
#pragma unroll
                    for (int m = 0; m < 4; ++m) *(u32x4*)(VH + (size_t)(row0 + ai * HALF + m * 16) * 1024 + col) = pack8(acc[ai][bj][m][0], acc[ai][bj][m][1]);
            } else if (type == 4) {
                const f32x4 b0 = *(const f32x4*)(bqkv + col), b1 = *(const f32x4*)(bqkv + col + 4);
#pragma unroll
                for (int ai = 0; ai < 2; ++ai)
#pragma unroll
                    for (int m = 0; m < 4; ++m) { const f32x4 v0 = (acc[ai][bj][m][0] + b0) * 0.125f, v1 = (acc[ai][bj][m][1] + b1) * 0.125f;
                        *(u32x4*)(AQ + (size_t)(row0 + ai * HALF + m * 16) * 1024 + col) = pack8(v0, v1); }
            } else {
                bf16_t* O = bj == 0 ? AK : AV;
                const f32x4 b0 = *(const f32x4*)(bqkv + 1024 + bj * 128 + cw), b1 = *(const f32x4*)(bqkv + 1024 + bj * 128 + cw + 4);
#pragma unroll
                for (int ai = 0; ai < 2; ++ai)
#pragma unroll
                    for (int m = 0; m < 4; ++m) *(u32x4*)(O + (size_t)(row0 + ai * HALF + m * 16) * 128 + cw) = pack8(acc[ai][bj][m][0] + b0, acc[ai][bj][m][1] + b1);
            }
        }
    }
};
struct EpiOutProj {
    static constexpr bool PERM = false;
    float* Z; const float* x; const float* stats; const float* lnw; const float* lnb; const float* bo;
    __device__ __forceinline__ void operator()(const f32x4 (&acc)[2][2][4][2], const GU& u, int wr, int wc, int fr, int fq) const {
        const int row0 = u.pm * BM + wr * 64 + fr, col0 = u.pn * BM + wc * 32 + 4 * fq;
#pragma unroll
        for (int ai = 0; ai < 2; ++ai)
#pragma unroll
            for (int m = 0; m < 4; ++m) {
                const int row = row0 + ai * HALF + m * 16;
                const f32x2 st = *(const f32x2*)(stats + 2 * row);
#pragma unroll
                for (int bj = 0; bj < 2; ++bj)
#pragma unroll
                    for (int n = 0; n < 2; ++n) {
                        const int col = col0 + bj * HALF + n * 16;
                        const f32x4 xv = *(const f32x4*)(x + (size_t)row * D + col), w4 = *(const f32x4*)(lnw + col), b4 = *(const f32x4*)(lnb + col), o4 = *(const f32x4*)(bo + col);
                        f32x4 z;
#pragma unroll
                        for (int j = 0; j < 4; ++j) z[j] = ALPHA * ((xv[j] - st.x) * st.y * w4[j] + b4[j]) + acc[ai][bj][m][n][j] + o4[j];
                        *(f32x4*)(Z + (size_t)row * D + col) = z;
                    }
            }
    }
};
struct EpiMoe1 {
    static constexpr bool PERM = true;
    bf16_t* H; const float* bg; const float* bu;
    __device__ __forceinline__ void operator()(const f32x4 (&acc)[2][2][4][2], const GU& u, int wr, int wc, int fr, int fq) const {
        const int row0 = u.pm * BM + wr * 64 + fr, hc = u.pn * 128 + wc * 32 + 8 * fq;
        const float* bgp = bg + (size_t)u.e * FF + hc; const float* bup = bu + (size_t)u.e * FF + hc;
        const f32x4 g0b = *(const f32x4*)bgp, g1b = *(const f32x4*)(bgp + 4), u0b = *(const f32x4*)bup, u1b = *(const f32x4*)(bup + 4);
#pragma unroll
        for (int ai = 0; ai < 2; ++ai)
#pragma unroll
            for (int m = 0; m < 4; ++m) {
                f32x4 a0 = acc[ai][0][m][0] + g0b, a1 = acc[ai][0][m][1] + g1b, c0 = acc[ai][1][m][0] + u0b, c1 = acc[ai][1][m][1] + u1b;
#pragma unroll
                for (int j = 0; j < 4; ++j) {
                    const float gg0 = fminf(a0[j], 7.f), gg1 = fminf(a1[j], 7.f);
                    const float uu0 = fminf(fmaxf(c0[j], -7.f), 7.f), uu1 = fminf(fmaxf(c1[j], -7.f), 7.f);
                    a0[j] = gg0 * sigm(1.702f * gg0) * (uu0 + 1.f); a1[j] = gg1 * sigm(1.702f * gg1) * (uu1 + 1.f);
                }
                *(u32x4*)(H + (size_t)(row0 + ai * HALF + m * 16) * FF + hc) = pack8(a0, a1);
            }
    }
};
__device__ __forceinline__ unsigned pk4_fp8(float a, float b, float c, float d) {
    a = fminf(fmaxf(a, -448.f), 448.f); b = fminf(fmaxf(b, -448.f), 448.f); c = fminf(fmaxf(c, -448.f), 448.f); d = fminf(fmaxf(d, -448.f), 448.f);
    int w = __builtin_amdgcn_cvt_pk_fp8_f32(a, b, 0, false); w = __builtin_amdgcn_cvt_pk_fp8_f32(c, d, w, true); return (unsigned)w;
}
constexpr float SC_H1 = 32.f, SC_WGU = 2048.f, SC_HACT = 8.f, SC_WD = 4096.f;
struct EpiMoe1F8 {
    static constexpr bool PERM = true;
    unsigned char* H; const float* bg; const float* bu;
    __device__ __forceinline__ void operator()(const f32x4 (&acc)[2][2][4][2], const GU& u, int wr, int wc, int fr, int fq) const {
        const int row0 = u.pm * BM + wr * 64 + fr, hc = u.pn * 128 + wc * 32 + 8 * fq;
        const float* bgp = bg + (size_t)u.e * FF + hc; const float* bup = bu + (size_t)u.e * FF + hc;
        const f32x4 g0b = *(const f32x4*)bgp, g1b = *(const f32x4*)(bgp + 4), u0b = *(const f32x4*)bup, u1b = *(const f32x4*)(bup + 4);
        constexpr float IS = 1.f / (SC_H1 * SC_WGU);
#pragma unroll
        for (int ai = 0; ai < 2; ++ai)
#pragma unroll
            for (int m = 0; m < 4; ++m) {
                f32x4 a0 = acc[ai][0][m][0] * IS + g0b, a1 = acc[ai][0][m][1] * IS + g1b, c0 = acc[ai][1][m][0] * IS + u0b, c1 = acc[ai][1][m][1] * IS + u1b;
#pragma unroll
                for (int j = 0; j < 4; ++j) {
                    const float gg0 = fminf(a0[j], 7.f), gg1 = fminf(a1[j], 7.f);
                    const float uu0 = fminf(fmaxf(c0[j], -7.f), 7.f), uu1 = fminf(fmaxf(c1[j], -7.f), 7.f);
                    a0[j] = SC_HACT * gg0 * sigm(1.702f * gg0) * (uu0 + 1.f); a1[j] = SC_HACT * gg1 * sigm(1.702f * gg1) * (uu1 + 1.f);
                }
                u32x2 o; o.x = pk4_fp8(a0[0], a0[1], a0[2], a0[3]); o.y = pk4_fp8(a1[0], a1[1], a1[2], a1[3]);
                *(u32x2*)(H + (size_t)(row0 + ai * HALF + m * 16) * FF + hc) = o;
            }
    }
};
struct EpiMoe2F8 {
    static constexpr bool PERM = true;
    bf16_t* Y; const float* bd;
    __device__ __forceinline__ void operator()(const f32x4 (&acc)[2][2][4][2], const GU& u, int wr, int wc, int fr, int fq) const {
        const int row0 = u.pm * BM + wr * 64 + fr, col0 = u.pn * BM + wc * 32 + 8 * fq;
        const float* bp = bd + (size_t)u.e * D + col0;
        constexpr float IS = 1.f / (SC_HACT * SC_WD);
#pragma unroll
        for (int bj = 0; bj < 2; ++bj) {
            const f32x4 b0 = *(const f32x4*)(bp + bj * HALF), b1 = *(const f32x4*)(bp + bj * HALF + 4);
#pragma unroll
            for (int ai = 0; ai < 2; ++ai)
#pragma unroll
                for (int m = 0; m < 4; ++m) *(u32x4*)(Y + (size_t)(row0 + ai * HALF + m * 16) * D + col0 + bj * HALF) = pack8(acc[ai][bj][m][0] * IS + b0, acc[ai][bj][m][1] * IS + b1);
        }
    }
};
struct EpiMoe2 {
    static constexpr bool PERM = true;
    bf16_t* Y; const float* bd;
    __device__ __forceinline__ void operator()(const f32x4 (&acc)[2][2][4][2], const GU& u, int wr, int wc, int fr, int fq) const {
        const int row0 = u.pm * BM + wr * 64 + fr, col0 = u.pn * BM + wc * 32 + 8 * fq;
        const float* bp = bd + (size_t)u.e * D + col0;
#pragma unroll
        for (int bj = 0; bj < 2; ++bj) {
            const f32x4 b0 = *(const f32x4*)(bp + bj * HALF), b1 = *(const f32x4*)(bp + bj * HALF + 4);
#pragma unroll
            for (int ai = 0; ai < 2; ++ai)
#pragma unroll
                for (int m = 0; m < 4; ++m) *(u32x4*)(Y + (size_t)(row0 + ai * HALF + m * 16) * D + col0 + bj * HALF) = pack8(acc[ai][bj][m][0] + b0, acc[ai][bj][m][1] + b1);
        }
    }
};

struct Args { const float* in[23]; float* out; unsigned char* ws; int ph_lo, ph_hi; };
struct Frame { LAS unsigned char* lds; int tid, lane, wave, G, vcu; unsigned char* ws; };

__device__ __forceinline__ void p0_transpose_item(const float* W, int N, int k0, int n0, bf16_t* WT_row0  , LAS float* scr, int lane) {
#pragma unroll 8
    for (int i = 0; i < 32; ++i) { const int kk = 2 * i + (lane >> 5); scr[kk * 33 + (lane & 31)] = W[(size_t)(k0 + kk) * N + n0 + (lane & 31)]; }
    asm volatile("s_waitcnt lgkmcnt(0)" ::: "memory");
    const int c = lane & 7;
#pragma unroll
    for (int j = 0; j < 4; ++j) { const int n = (lane >> 3) + 8 * j; const LAS float* s = scr + (8 * c) * 33 + n;
        u32x4 o; o.x = pk2(s[0 * 33], s[1 * 33]); o.y = pk2(s[2 * 33], s[3 * 33]); o.z = pk2(s[4 * 33], s[5 * 33]); o.w = pk2(s[6 * 33], s[7 * 33]);
        *(GAS u32x4*)(WT_row0 + (size_t)n * KD + k0 + 8 * c) = o; }
    asm volatile("s_waitcnt lgkmcnt(0)" ::: "memory");
}

__device__ __forceinline__ void p0_transpose_item_f8(const float* W, int N, int k0, int n0, unsigned char* WT_row0, float sc, LAS float* scr, int lane) {
#pragma unroll 8
    for (int i = 0; i < 32; ++i) { const int kk = 2 * i + (lane >> 5); scr[kk * 33 + (lane & 31)] = W[(size_t)(k0 + kk) * N + n0 + (lane & 31)]; }
    asm volatile("s_waitcnt lgkmcnt(0)" ::: "memory");
    const int c = lane & 3;
#pragma unroll
    for (int j = 0; j < 2; ++j) { const int n = (lane >> 2) + 16 * j; const LAS float* sp = scr + (16 * c) * 33 + n;
        u32x4 o;
        o.x = pk4_fp8(sp[0 * 33] * sc, sp[1 * 33] * sc, sp[2 * 33] * sc, sp[3 * 33] * sc); o.y = pk4_fp8(sp[4 * 33] * sc, sp[5 * 33] * sc, sp[6 * 33] * sc, sp[7 * 33] * sc);
        o.z = pk4_fp8(sp[8 * 33] * sc, sp[9 * 33] * sc, sp[10 * 33] * sc, sp[11 * 33] * sc); o.w = pk4_fp8(sp[12 * 33] * sc, sp[13 * 33] * sc, sp[14 * 33] * sc, sp[15 * 33] * sc);
        *(GAS u32x4*)(WT_row0 + (size_t)n * KD + k0 + 16 * c) = o; }
    asm volatile("s_waitcnt lgkmcnt(0)" ::: "memory");
}
__device__ __forceinline__ void p0_prologue(Frame& F, const Args& a) {
    LAS float* scr = (LAS float*)(F.lds + F.wave * 16384);
    const int gw = F.vcu * NWAVES + F.wave, NGW = F.G * NWAVES;
    unsigned char* ws = F.ws;
    for (int i = gw * 64 + F.lane; i < NE * D; i += NGW * 64) { const int e = i >> 11, k = i & 2047; const float v = a.in[13][(size_t)k * NE + e];
        const unsigned hb = f2bf(v); const float hf = __builtin_bit_cast(float, hb << 16);
        ((bf16_t*)(ws + WS_WRH))[i] = (bf16_t)hb; ((bf16_t*)(ws + WS_WRL))[i] = (bf16_t)f2bf(v - hf); }
    if (gw < 16) { const int i = gw * 64 + F.lane; const float* lbl = a.in[5]; const float l0 = lbl[i], l1 = lbl[1024 + i]; const float mx = fmaxf(l0, l1); const float e0 = __expf(l0 - mx), e1 = __expf(l1 - mx);
        ((float*)(ws + WS_LB))[i] = e0 / (e0 + e1); }
    {
        const float* x = a.in[0]; const float* w = a.in[1]; const float* b = a.in[2];
        bf16_t* H0 = (bf16_t*)(ws + WS_H0); float* st = (float*)(ws + WS_STATS0);
        for (int m = gw; m < T; m += NGW) {
            const GAS f32x4* xr = (const GAS f32x4*)(x + (size_t)m * D) + F.lane;
            f32x4 v[8]; float s = 0.f;
#pragma unroll
            for (int j = 0; j < 8; ++j) { v[j] = xr[64 * j]; s += (v[j][0] + v[j][1]) + (v[j][2] + v[j][3]); }
            const float mean = wave_sum(s) * (1.f / D); float s2 = 0.f;
#pragma unroll
            for (int j = 0; j < 8; ++j) { v[j] = v[j] - mean; s2 += (v[j][0] * v[j][0] + v[j][1] * v[j][1]) + (v[j][2] * v[j][2] + v[j][3] * v[j][3]); }
            const float rstd = rsqrtf(wave_sum(s2) * (1.f / D) + EPS);
            if (F.lane == 0) { st[2 * m] = mean; st[2 * m + 1] = rstd; }
            GAS u32x2* o8 = (GAS u32x2*)(H0 + (size_t)m * D) + F.lane;
#pragma unroll
            for (int j = 0; j < 8; ++j) { const f32x4 ww = *((const f32x4*)w + F.lane + 64 * j), bb = *((const f32x4*)b + F.lane + 64 * j);
                u32x2 o; o.x = pk2(v[j][0] * rstd * ww[0] + bb[0], v[j][1] * rstd * ww[1] + bb[1]); o.y = pk2(v[j][2] * rstd * ww[2] + bb[2], v[j][3] * rstd * ww[3] + bb[3]); o8[64 * j] = o; }
        }
    }
    constexpr int I_IN = 32 * (INC / 32), I_OUT = 32 * 64;
    constexpr int NITEMS = I_IN + I_OUT;
    for (int it = gw; it < NITEMS; it += NGW) {
        int r = it;
        if (r < I_IN) { const int nb = INC / 32, kb = r / nb, n0 = 32 * (r % nb); p0_transpose_item(a.in[3], INC, 64 * kb, n0, (bf16_t*)(ws + WS_WIN) + (size_t)n0 * KD, scr, F.lane); continue; } r -= I_IN;
        { const int kb = r / 64, n0 = 32 * (r % 64); p0_transpose_item(a.in[9], D, 64 * kb, n0, (bf16_t*)(ws + WS_WOUT) + (size_t)n0 * KD, scr, F.lane); }
    }
}

constexpr int CV_ITEMS = NE * 3 * 16 * 64, CV_RUN = 8;
__device__ __forceinline__ void cv_src(const Args& a, unsigned char* ws, int it, const float*& W, unsigned char*& dst, float& sc, int& k0) {
    const int e = it / 3072, r = it - e * 3072, which = r >> 10, r2 = r & 1023, kb = r2 >> 6, n0 = (r2 & 63) * 32;
    k0 = kb * 128;
    if (which < 2) { W = a.in[which == 0 ? 15 : 17] + (size_t)e * D * FF + n0; dst = ws + WS_WGU + ((size_t)e * 4096 + (size_t)(n0 >> 7) * 256 + which * 128 + (n0 & 127)) * KD; sc = SC_WGU; }
    else { W = a.in[19] + (size_t)e * FF * D + n0; dst = ws + WS_WD + ((size_t)e * 2048 + n0) * KD; sc = SC_WD; }
}
#define CV_LOAD(v, W, k0) do { const float* sp_ = (W) + (size_t)((k0) + (lane >> 3)) * 2048 + 4 * (lane & 7); _Pragma("unroll") for (int j = 0; j < 16; ++j) v[j] = *(const f32x4*)(sp_ + (size_t)j * 8 * 2048); } while (0)
__device__ __forceinline__ void cv_store(const f32x4 (&v)[16], unsigned char* dst, float sc, int k0, LAS float* scr, int lane) {
#pragma unroll
    for (int j = 0; j < 16; ++j) { LAS float* wp = scr + ((lane >> 3) + 8 * j) * 34 + 4 * (lane & 7);
        *(LAS f32x2*)wp = (f32x2){v[j][0] * sc, v[j][1] * sc}; *(LAS f32x2*)(wp + 2) = (f32x2){v[j][2] * sc, v[j][3] * sc}; }
    asm volatile("s_waitcnt lgkmcnt(0)" ::: "memory");
    const int n = lane & 31;
#pragma unroll
    for (int j = 0; j < 4; ++j) { const int c = (lane >> 5) + 2 * j; const LAS float* sp = scr + (16 * c) * 34 + n;
        u32x4 o;
        o.x = pk4_fp8(sp[0 * 34], sp[1 * 34], sp[2 * 34], sp[3 * 34]); o.y = pk4_fp8(sp[4 * 34], sp[5 * 34], sp[6 * 34], sp[7 * 34]);
        o.z = pk4_fp8(sp[8 * 34], sp[9 * 34], sp[10 * 34], sp[11 * 34]); o.w = pk4_fp8(sp[12 * 34], sp[13 * 34], sp[14 * 34], sp[15 * 34]);
        *(GAS u32x4*)(dst + (size_t)n * KD + k0 + 16 * c) = o; }
    asm volatile("s_waitcnt lgkmcnt(0)" ::: "memory");
}
__device__ __forceinline__ void cv_worker(Frame& F, const Args& a, const unsigned* stop_ctr, unsigned stop_at) {
    const int lane = F.lane;
    LAS float* scr = (LAS float*)(F.lds + F.wave * CV_SCR);
    unsigned* head = (unsigned*)(F.ws + WS_CTL) + CW_CONV;
    for (;;) {
        int base = 0, stop = 0;
        if (lane == 0) { if (stop_ctr && __hip_atomic_load(stop_ctr, RLX_AGENT) >= stop_at) stop = 1; else base = (int)__hip_atomic_fetch_add(head, (unsigned)CV_RUN, RLX_AGENT); }
        stop = __builtin_amdgcn_readfirstlane(stop); base = __builtin_amdgcn_readfirstlane(base);
        if (stop || base >= CV_ITEMS) break;
        const float* W; unsigned char* dst; float sc; int k0;
        cv_src(a, F.ws, base, W, dst, sc, k0);
        f32x4 va[16], vb[16];
        CV_LOAD(va, W, k0);
#pragma unroll 1
        for (int j = 0; j < CV_RUN; j += 2) {
            const float* W1; unsigned char* dst1; float sc1; int k01;
            cv_src(a, F.ws, base + j + 1, W1, dst1, sc1, k01);
            CV_LOAD(vb, W1, k01);
            cv_store(va, dst, sc, k0, scr, lane);
            if (j + 2 < CV_RUN) { cv_src(a, F.ws, base + j + 2, W, dst, sc, k0); CV_LOAD(va, W, k0); }
            cv_store(vb, dst1, sc1, k01, scr, lane);
        }
    }
}

constexpr int HG_TT = 16;
__device__ __forceinline__ void hgrn_unit(Frame& F, const Args& a, int b, int h) {
    LAS float* fS = (LAS float*)F.lds; LAS float* kS = fS + HG_TT * 128; LAS float* qS = kS + HG_TT * 128; LAS float* vS = qS + HG_TT * 128; LAS float* oS = vS + HG_TT * 128;
    const bf16_t* QH = (const bf16_t*)(F.ws + WS_QH); const bf16_t* KH = (const bf16_t*)(F.ws + WS_KH); const bf16_t* VH = (const bf16_t*)(F.ws + WS_VH); const bf16_t* OG = (const bf16_t*)(F.ws + WS_OG);
    const float* GH = (const float*)(F.ws + WS_GH);
    bf16_t* YM = (bf16_t*)(F.ws + WS_YMIX);
    const int tid = F.tid, kg = tid & 3, col = tid >> 2;
    float S[32];
#pragma unroll
    for (int i = 0; i < 32; ++i) S[i] = 0.f;
    for (int t0 = 0; t0 < L; t0 += HG_TT) {
        __syncthreads();
        for (int i = tid; i < HG_TT * 128; i += NTHR) {
            const int tt = i >> 7, k = i & 127; const size_t o = (size_t)(b * L + t0 + tt) * 1024 + h * 128 + k;
            fS[i] = __expf(GH[o]); kS[i] = bf2f(KH[o]); qS[i] = bf2f(QH[o]); vS[i] = bf2f(VH[o]);
        }
        __syncthreads();
        for (int tt = 0; tt < HG_TT; ++tt) {
            const float v = vS[tt * 128 + col];
            float o = 0.f;
#pragma unroll
            for (int i = 0; i < 32; ++i) { const int k = kg * 32 + i; S[i] = fS[tt * 128 + k] * S[i] + kS[tt * 128 + k] * v; o += S[i] * qS[tt * 128 + k]; }
            o += __shfl_xor(o, 1); o += __shfl_xor(o, 2);
            if (kg == 0) oS[tt * 128 + col] = o;
        }
        __syncthreads();
#pragma unroll
        for (int q = 0; q < 2; ++q) {
            const int tt = F.wave * 2 + q;
            const float a0 = oS[tt * 128 + F.lane], a1 = oS[tt * 128 + 64 + F.lane];
            const float r = rsqrtf(wave_sum(a0 * a0 + a1 * a1) * (1.f / 128.f) + EPS);
            const size_t o = (size_t)(b * L + t0 + tt) * 1024 + h * 128;
            const float* nw = a.in[6];
            const float g0 = bf2f(OG[o + F.lane]), g1 = bf2f(OG[o + 64 + F.lane]);
            YM[(size_t)(b * L + t0 + tt) * D + h * 128 + F.lane] = (bf16_t)f2bf(a0 * r * nw[F.lane] * g0);
            YM[(size_t)(b * L + t0 + tt) * D + h * 128 + 64 + F.lane] = (bf16_t)f2bf(a1 * r * nw[64 + F.lane] * g1);
        }
    }
}
constexpr int AT_Q = 32, AT_ROWS = AT_Q + 127, AT_LD = 66;
__device__ __forceinline__ void attn_unit(Frame& F, const Args& a, int b, int qt) {
    LAS unsigned short* Ks = (LAS unsigned short*)F.lds;
    LAS unsigned short* Vs = Ks + 2 * AT_ROWS * AT_LD;
    LAS float* ssq = (LAS float*)(Vs + 2 * AT_ROWS * AT_LD);
    const bf16_t* AQ = (const bf16_t*)(F.ws + WS_AQ); const bf16_t* AK = (const bf16_t*)(F.ws + WS_AK); const bf16_t* AV = (const bf16_t*)(F.ws + WS_AV);
    bf16_t* YM = (bf16_t*)(F.ws + WS_YMIX);
    const int tid = F.tid, t0 = qt * AT_Q;
    __syncthreads();
    for (int i = tid; i < 2 * AT_ROWS * 32; i += NTHR) {
        const int dw = i & 31, r = (i >> 5) % AT_ROWS, kvh = (i >> 5) / AT_ROWS;
        const int pos = t0 - 127 + r;
        unsigned kv = 0u, vv = 0u;
        if (pos >= 0) { const size_t o = (size_t)(b * L + pos) * 128 + kvh * 64 + dw * 2; kv = *(const unsigned*)(AK + o); vv = *(const unsigned*)(AV + o); }
        *(LAS unsigned*)(Ks + (kvh * AT_ROWS + r) * AT_LD + dw * 2) = kv; *(LAS unsigned*)(Vs + (kvh * AT_ROWS + r) * AT_LD + dw * 2) = vv;
    }
    __syncthreads();
    const int qi = tid & 31, head = tid >> 5, kvh = head >> 3;
    const int qpos = t0 + qi;
    float q[64], acc[64];
    { const u32x4* qp = (const u32x4*)(AQ + (size_t)(b * L + qpos) * 1024 + head * 64);
#pragma unroll
      for (int c = 0; c < 8; ++c) { const u32x4 w = qp[c];
#pragma unroll
          for (int j = 0; j < 4; ++j) { q[c * 8 + 2 * j] = bflo(w[j]); q[c * 8 + 2 * j + 1] = bfhi(w[j]); } }
#pragma unroll
      for (int d = 0; d < 64; ++d) acc[d] = 0.f; }
    float m = a.in[7][head], l = 1.f;
    for (int j = 0; j < 128; ++j) {
        const int r = qi + j, kpos = qpos - 127 + j;
        if (kpos < 0) continue;
        const LAS unsigned* kr = (const LAS unsigned*)(Ks + (kvh * AT_ROWS + r) * AT_LD);
        float s = 0.f;
#pragma unroll
        for (int d = 0; d < 32; ++d) { const unsigned w = kr[d]; s = fmaf(q[2 * d], bflo(w), s); s = fmaf(q[2 * d + 1], bfhi(w), s); }
        const float mn = fmaxf(m, s); const float sc = __expf(m - mn), p = __expf(s - mn);
        l = l * sc + p;
        const LAS unsigned* vr = (const LAS unsigned*)(Vs + (kvh * AT_ROWS + r) * AT_LD);
#pragma unroll
        for (int d = 0; d < 32; ++d) { const unsigned w = vr[d]; acc[2 * d] = acc[2 * d] * sc + p * bflo(w); acc[2 * d + 1] = acc[2 * d + 1] * sc + p * bfhi(w); }
        m = mn;
    }
    const float inv = 1.f / l; float ss = 0.f;
#pragma unroll
    for (int d = 0; d < 64; ++d) { acc[d] *= inv; ss += acc[d] * acc[d]; }
    ssq[qi * 16 + head] = ss;
    __syncthreads();
    float tot = 0.f;
#pragma unroll
    for (int hh = 0; hh < 16; ++hh) tot += ssq[qi * 16 + hh];
    const float rr = rsqrtf(tot * (1.f / 1024.f) + EPS);
    const float* nw = a.in[8] + head * 64;
    u32x4* op = (u32x4*)(YM + (size_t)(b * L + qpos) * D + 1024 + head * 64);
#pragma unroll
    for (int c = 0; c < 8; ++c) { u32x4 w;
#pragma unroll
        for (int j = 0; j < 4; ++j) w[j] = pk2(acc[c * 8 + 2 * j] * rr * nw[c * 8 + 2 * j], acc[c * 8 + 2 * j + 1] * rr * nw[c * 8 + 2 * j + 1]);
        op[c] = w; }
}

typedef float f32x16 __attribute__((ext_vector_type(16)));
typedef short s16x4 __attribute__((ext_vector_type(4)));
typedef short v4i16_t __attribute__((ext_vector_type(4)));
__device__ __forceinline__ s16x4 lds_tr16(const LAS unsigned char* p) { return __builtin_bit_cast(s16x4, __builtin_amdgcn_ds_read_tr16_b64_v4i16((LAS v4i16_t*)p)); }
__device__ __forceinline__ void attn_unit_mfma(Frame& F, const Args& a, int b, int qt) {
    LAS unsigned char* KS = F.lds;
    LAS unsigned char* VS = F.lds + 40960;
    LAS float* SSQ = (LAS float*)(F.lds + 81920);
    const bf16_t* AQ = (const bf16_t*)(F.ws + WS_AQ); const bf16_t* AK = (const bf16_t*)(F.ws + WS_AK); const bf16_t* AV = (const bf16_t*)(F.ws + WS_AV);
    bf16_t* YM = (bf16_t*)(F.ws + WS_YMIX);
    const int tid = F.tid, lane = F.lane, w = F.wave, r32 = lane & 31, hi = lane >> 5, t0 = qt * 32;
    __syncthreads();
#pragma unroll
    for (int p = 0; p < 5; ++p) {
        const int c = p * 512 + tid, row = c >> 4, ch = c & 15, kvh = ch >> 3, cr = ch & 7;
        const int pos = t0 - 128 + row;
        u32x4 kv = (u32x4){0u, 0u, 0u, 0u}, vv = (u32x4){0u, 0u, 0u, 0u};
        if (pos >= 0) { const size_t o = (size_t)(b * L + pos) * 128 + kvh * 64 + cr * 8; kv = *(const u32x4*)(AK + o); vv = *(const u32x4*)(AV + o); }
        *(LAS u32x4*)(KS + kvh * 20480 + row * 128 + ((cr ^ ((row >> 1) & 7)) << 4)) = kv;
        *(LAS u32x4*)(VS + kvh * 20480 + row * 128 + (((cr >> 2) ^ ((row >> 1) & 1)) << 6) + ((cr & 3) << 4)) = vv;
    }
    __syncthreads();
    const int kvh = w >> 2;
    const int ktmin = t0 < 128 ? (128 - t0) >> 5 : 0;
    const LAS unsigned char* Kb = KS + kvh * 20480;
    const LAS unsigned char* Vb = VS + kvh * 20480;
    unsigned OP[2][2][8];
    float ssq = 0.f;
#pragma unroll
    for (int hh = 0; hh < 2; ++hh) {
        const int head = 2 * w + hh;
        bf16x8 qf[4];
#pragma unroll
        for (int ks = 0; ks < 4; ++ks) qf[ks] = *(const bf16x8*)(AQ + (size_t)(b * L + t0 + r32) * 1024 + head * 64 + ks * 16 + hi * 8);
        f32x16 S[5];
#pragma unroll
        for (int kt = 0; kt < 5; ++kt) {
            const int row = kt * 32 + r32;
            f32x16 acc = (f32x16){0.f, 0.f, 0.f, 0.f, 0.f, 0.f, 0.f, 0.f, 0.f, 0.f, 0.f, 0.f, 0.f, 0.f, 0.f, 0.f};
#pragma unroll
            for (int ks = 0; ks < 4; ++ks) {
                const bf16x8 kf = *(const LAS bf16x8*)(Kb + row * 128 + (((2 * ks + hi) ^ ((row >> 1) & 7)) << 4));
                acc = __builtin_amdgcn_mfma_f32_32x32x16_bf16(kf, qf[ks], acc, 0, 0, 0);
            }
            S[kt] = acc;
        }
        const float sink = a.in[7][head];
        float m = sink;
#pragma unroll
        for (int kt = 0; kt < 5; ++kt)
#pragma unroll
            for (int r = 0; r < 16; ++r) {
                const int i = (r & 3) + 8 * (r >> 2) + 4 * hi;
                bool ok = kt >= ktmin;
                if (kt == 0) ok = ok && (i > r32);
                if (kt == 4) ok = ok && (i <= r32);
                const float v = ok ? S[kt][r] : -INFINITY;
                S[kt][r] = v; m = fmaxf(m, v);
            }
        m = fmaxf(m, __shfl_xor(m, 32));
        float l = 0.f;
#pragma unroll
        for (int kt = 0; kt < 5; ++kt)
#pragma unroll
            for (int r = 0; r < 16; ++r) { const float pv = __expf(S[kt][r] - m); S[kt][r] = pv; l += pv; }
        l += __shfl_xor(l, 32);
        l += __expf(sink - m);
        const float inv = 1.f / l;
#pragma unroll
        for (int dt = 0; dt < 2; ++dt) {
            f32x16 acc = (f32x16){0.f, 0.f, 0.f, 0.f, 0.f, 0.f, 0.f, 0.f, 0.f, 0.f, 0.f, 0.f, 0.f, 0.f, 0.f, 0.f};
            const int dcol = dt * 32 + 16 * ((lane >> 4) & 1) + 4 * (lane & 3);
            const int vlane = ((lane & 15) >> 2) * 128 + ((((dcol >> 5) ^ ((lane >> 3) & 1))) << 6) + (dcol & 31) * 2;
#pragma unroll
            for (int kt = 0; kt < 5; ++kt)
#pragma unroll
                for (int s2 = 0; s2 < 2; ++s2) {
                    const int rowb = kt * 32 + 16 * s2 + 4 * hi;
                    const s16x4 lo = lds_tr16(Vb + rowb * 128 + vlane), hi4 = lds_tr16(Vb + (rowb + 8) * 128 + vlane);
                    const bf16x8 vf = (bf16x8){lo[0], lo[1], lo[2], lo[3], hi4[0], hi4[1], hi4[2], hi4[3]};
                    u32x4 pw; pw.x = cvt_pk_bf16(S[kt][8 * s2 + 0], S[kt][8 * s2 + 1]); pw.y = cvt_pk_bf16(S[kt][8 * s2 + 2], S[kt][8 * s2 + 3]);
                    pw.z = cvt_pk_bf16(S[kt][8 * s2 + 4], S[kt][8 * s2 + 5]); pw.w = cvt_pk_bf16(S[kt][8 * s2 + 6], S[kt][8 * s2 + 7]);
                    acc = __builtin_amdgcn_mfma_f32_32x32x16_bf16(vf, __builtin_bit_cast(bf16x8, pw), acc, 0, 0, 0);
                }
#pragma unroll
            for (int r = 0; r < 16; ++r) { acc[r] *= inv; ssq += acc[r] * acc[r]; }
#pragma unroll
            for (int r = 0; r < 8; ++r) OP[hh][dt][r] = cvt_pk_bf16(acc[2 * r], acc[2 * r + 1]);
        }
    }
    ssq += __shfl_xor(ssq, 32);
    if (hi == 0) SSQ[w * 32 + r32] = ssq;
    __syncthreads();
    float tot = 0.f;
#pragma unroll
    for (int ww = 0; ww < 8; ++ww) tot += SSQ[ww * 32 + r32];
    const float rr = rsqrtf(tot * (1.f / 1024.f) + EPS);
    const float* nwp = a.in[8];
#pragma unroll
    for (int hh = 0; hh < 2; ++hh)
#pragma unroll
        for (int dt = 0; dt < 2; ++dt)
#pragma unroll
            for (int g4 = 0; g4 < 4; ++g4) {
                const int d = (2 * w + hh) * 64 + dt * 32 + 8 * g4 + 4 * hi;
                const f32x4 nw4 = *(const f32x4*)(nwp + d);
                const unsigned p0 = OP[hh][dt][2 * g4], p1 = OP[hh][dt][2 * g4 + 1];
                u32x2 o; o.x = pk2(bflo(p0) * rr * nw4[0], bfhi(p0) * rr * nw4[1]); o.y = pk2(bflo(p1) * rr * nw4[2], bfhi(p1) * rr * nw4[3]);
                *(u32x2*)(YM + (size_t)(b * L + t0 + r32) * D + 1024 + d) = o;
            }
}

constexpr int HL_QM = 0, HL_KM = 16384, HL_QS = 32768, HL_KE = 49152, HL_VT = 65536, HL_PL = 81920, HL_SEG = 90112, HL_DS = 94208, HL_SSQ = 94720;
__device__ __forceinline__ int trkey(int s) { return (s & 3) | (((s >> 3) & 1) << 2); }
__device__ __forceinline__ bf16x8 mk8(const s16x4& lo, const s16x4& hi) { return (bf16x8){lo[0], lo[1], lo[2], lo[3], hi[0], hi[1], hi[2], hi[3]}; }
__device__ __forceinline__ void hgrn_unit_mfma(Frame& F, const Args& a, int b, int h) {
    LAS unsigned char* lds = F.lds;
    const bf16_t* QH = (const bf16_t*)(F.ws + WS_QH); const bf16_t* VH = (const bf16_t*)(F.ws + WS_VH); const bf16_t* OG = (const bf16_t*)(F.ws + WS_OG);
    const float* GH = (const float*)(F.ws + WS_GH);
    bf16_t* YM = (bf16_t*)(F.ws + WS_YMIX);
    const int tid = F.tid, lane = F.lane, w = F.wave, r16 = lane & 15, g = lane >> 4, cp = lane;
    const size_t tokb = (size_t)b * L;
    const int hc = h * 128;
    f32x4 Sacc[8];
#pragma unroll
    for (int i = 0; i < 8; ++i) Sacc[i] = (f32x4){0.f, 0.f, 0.f, 0.f};
    f32x2 gpre[8]; unsigned qpre[8]; u32x4 vpre[2];
    const int vrow = tid >> 3, vc16 = tid & 7;
    const unsigned lo_g = 2u * (unsigned)cp, lo_v = (unsigned)(vrow * 1024 + vc16 * 8), lo_og = (unsigned)(r16 * 1024 + 4 * g), lo_ym = (unsigned)(r16 * 2048 + 4 * g);
    {
        const size_t rb = (tokb + 8 * w) * 1024 + hc;
        const float* gb = GH + rb; const bf16_t* qb = QH + rb; const bf16_t* vb = VH + tokb * 1024 + hc;
#pragma unroll
        for (int i = 0; i < 8; ++i) { gpre[i] = *(const f32x2*)(gb + i * 1024 + lo_g); qpre[i] = *(const unsigned*)(qb + i * 1024 + lo_g); }
        vpre[0] = *(const u32x4*)(vb + lo_v); vpre[1] = *(const u32x4*)(vb + 64 + lo_v);
    }
    const int keyl = ((lane & 15) >> 2) | ((g & 1) << 2);
    const int trrow = (8 * g + ((lane & 15) >> 2)) * 256 + 8 * (lane & 3);
    __syncthreads();
    for (int c = 0; c < L / 64; ++c) {
        int cc = c; asm volatile("" : "+s"(cc));
        const size_t tok0 = tokb + 64 * cc;
        { float run0 = 0.f, run1 = 0.f;
#pragma unroll
          for (int i = 0; i < 8; ++i) { run0 += gpre[i].x; run1 += gpre[i].y; }
          *(LAS f32x2*)(lds + HL_SEG + (w * 128 + 2 * cp) * 4) = (f32x2){run0, run1}; }
        { const int k0 = trkey(vrow);
          *(LAS u32x4*)(lds + HL_VT + vrow * 256 + ((((vc16 >> 1)) ^ k0) << 5) + (vc16 & 1) * 16) = vpre[0];
          *(LAS u32x4*)(lds + HL_VT + vrow * 256 + (((((vc16 + 8) >> 1)) ^ k0) << 5) + (vc16 & 1) * 16) = vpre[1]; }
        __syncthreads();
        float off0 = 0.f, off1 = 0.f, r0 = 0.f, r1 = 0.f, tot0 = 0.f, tot1 = 0.f;
#pragma unroll
        for (int sg = 0; sg < 8; ++sg) { const f32x2 sv = *(const LAS f32x2*)(lds + HL_SEG + (sg * 128 + 2 * cp) * 4);
            if (sg < w) { off0 += sv.x; off1 += sv.y; } if (sg < 4) { r0 += sv.x; r1 += sv.y; } tot0 += sv.x; tot1 += sv.y; }
        if (w == 0) *(LAS f32x2*)(lds + HL_DS + 2 * cp * 4) = (f32x2){__builtin_amdgcn_exp2f(tot0), __builtin_amdgcn_exp2f(tot1)};
#pragma unroll
        for (int i = 0; i < 8; ++i) {
            const int t = 8 * w + i, k = 2 * cp;
            off0 += gpre[i].x; off1 += gpre[i].y;
            const float b0 = off0, b1 = off1;
            const float q0 = bflo(qpre[i]), q1 = bfhi(qpre[i]);
            const float k0 = 1.f - __builtin_amdgcn_exp2f(gpre[i].x), k1 = 1.f - __builtin_amdgcn_exp2f(gpre[i].y);
            const float e30 = __builtin_amdgcn_exp2f(b0), e31 = __builtin_amdgcn_exp2f(b1);
            const float e10 = __builtin_amdgcn_exp2f(fminf(b0 - r0, 115.f)), e11 = __builtin_amdgcn_exp2f(fminf(b1 - r1, 115.f));
            const float e20 = __builtin_amdgcn_exp2f(fminf(r0 - b0, 115.f)), e21 = __builtin_amdgcn_exp2f(fminf(r1 - b1, 115.f));
            const float e40 = __builtin_amdgcn_exp2f(tot0 - b0), e41 = __builtin_amdgcn_exp2f(tot1 - b1);
            const int oqm = t * 256 + (((k >> 3) ^ (t & 15)) << 4) + (k & 7) * 2;
            *(LAS unsigned*)(lds + HL_QM + oqm) = cvt_pk_bf16_c(q0 * e10, q1 * e11);
            *(LAS unsigned*)(lds + HL_KM + oqm) = cvt_pk_bf16_c(k0 * e20, k1 * e21);
            *(LAS unsigned*)(lds + HL_QS + t * 256 + (((k >> 2) ^ ((t & 15) << 1)) << 3) + (k & 3) * 2) = cvt_pk_bf16_c(q0 * e30, q1 * e31);
            *(LAS unsigned*)(lds + HL_KE + t * 256 + (((k >> 4) ^ trkey(t)) << 5) + (k & 15) * 2) = cvt_pk_bf16_c(k0 * e40, k1 * e41);
        }
        if (c + 1 < L / 64) {
            const size_t rb = (tok0 + 64 + 8 * w) * 1024 + hc;
            const float* gb = GH + rb; const bf16_t* qb = QH + rb; const bf16_t* vb = VH + (tok0 + 64) * 1024 + hc;
#pragma unroll
            for (int i = 0; i < 8; ++i) { gpre[i] = *(const f32x2*)(gb + i * 1024 + lo_g); qpre[i] = *(const unsigned*)(qb + i * 1024 + lo_g); }
            vpre[0] = *(const u32x4*)(vb + lo_v); vpre[1] = *(const u32x4*)(vb + 64 + lo_v);
        }
        __syncthreads();
#pragma unroll
        for (int rep = 0; rep < 2; ++rep) {
            if (rep == 1 && w >= 4) break;
            const int idx = rep == 0 ? w : 8 + w;
            const int si = (0xd940e4 >> (2 * idx)) & 3, ti = (0x8fb9e4 >> (2 * idx)) & 3;
            f32x4 pacc = (f32x4){0.f, 0.f, 0.f, 0.f};
            if (idx < 10) {
#pragma unroll
                for (int ks = 0; ks < 4; ++ks) {
                    const int ofs = r16 * 256 + (((4 * ks + g) ^ r16) << 4);
                    const bf16x8 af = *(const LAS bf16x8*)(lds + HL_KM + si * 4096 + ofs);
                    const bf16x8 bfr = *(const LAS bf16x8*)(lds + HL_QM + ti * 4096 + ofs);
                    pacc = __builtin_amdgcn_mfma_f32_16x16x32_bf16(af, bfr, pacc, 0, 0, 0);
                }
                const bool offd = si != ti;
#pragma unroll
                for (int r = 0; r < 4; ++r) pacc[r] = (offd || (4 * g + r <= r16)) ? pacc[r] : 0.f;
            }
            asm volatile("s_nop 7\n\ts_nop 7" ::: "memory");
            const int t = 16 * ti + r16;
            u32x2 pw; pw.x = cvt_pk_bf16_c(pacc[0], pacc[1]); pw.y = cvt_pk_bf16_c(pacc[2], pacc[3]);
            *(LAS u32x2*)(lds + HL_PL + t * 128 + (((2 * si + (g >> 1)) ^ ((t >> 1) & 7)) << 4) + (g & 1) * 8) = pw;
        }
        __syncthreads();
        u32x2 ogp[4];
        { const bf16_t* ob = OG + tok0 * 1024 + hc + 16 * w;
#pragma unroll
          for (int ti = 0; ti < 4; ++ti) ogp[ti] = *(const u32x2*)(ob + ti * 16384 + lo_og); }
#define HG_SB() __builtin_amdgcn_sched_barrier(0)
#define HG_QSLD(dst, kp) do { _Pragma("unroll") for (int ti = 0; ti < 4; ++ti) { const int t_ = 16 * ti + r16; \
            const u32x2 lo_ = *(const LAS u32x2*)(lds + HL_QS + t_ * 256 + (((8 * (kp) + g) ^ (r16 << 1)) << 3)); \
            const u32x2 hi_ = *(const LAS u32x2*)(lds + HL_QS + t_ * 256 + (((8 * (kp) + 4 + g) ^ (r16 << 1)) << 3)); \
            dst[ti] = (u32x4){lo_.x, lo_.y, hi_.x, hi_.y}; } } while (0)
#define HG_KELD(dst, kt) do { _Pragma("unroll") for (int ks = 0; ks < 2; ++ks) { const LAS unsigned char* pb_ = lds + HL_KE + ks * 32 * 256 + trrow + (((kt) ^ keyl) << 5); \
            dst[ks] = mk8(lds_tr16(pb_), lds_tr16(pb_ + 4 * 256)); } } while (0)
#define HG_INTER(kp, qsv) do { u32x4 sw_; sw_.x = cvt_pk_bf16_c(Sacc[2 * (kp)][0], Sacc[2 * (kp)][1]); sw_.y = cvt_pk_bf16_c(Sacc[2 * (kp)][2], Sacc[2 * (kp)][3]); \
            sw_.z = cvt_pk_bf16_c(Sacc[2 * (kp) + 1][0], Sacc[2 * (kp) + 1][1]); sw_.w = cvt_pk_bf16_c(Sacc[2 * (kp) + 1][2], Sacc[2 * (kp) + 1][3]); \
            const bf16x8 sf_ = __builtin_bit_cast(bf16x8, sw_); \
            _Pragma("unroll") for (int ti = 0; ti < 4; ++ti) Oa[ti] = __builtin_amdgcn_mfma_f32_16x16x32_bf16(sf_, __builtin_bit_cast(bf16x8, qsv[ti]), Oa[ti], 0, 0, 0); } while (0)
#define HG_SUPD(kt, kev, dsv) do { f32x4 sa_ = Sacc[kt] * dsv; \
            sa_ = __builtin_amdgcn_mfma_f32_16x16x32_bf16(kev[0], vf[0], sa_, 0, 0, 0); sa_ = __builtin_amdgcn_mfma_f32_16x16x32_bf16(kev[1], vf[1], sa_, 0, 0, 0); Sacc[kt] = sa_; } while (0)
        bf16x8 vf[2];
        bf16x8 pf[6];
        u32x4 qsA[4], qsB[4];
#pragma unroll
        for (int ks = 0; ks < 2; ++ks) {
            const LAS unsigned char* pb = lds + HL_VT + ks * 32 * 256 + trrow + ((w ^ keyl) << 5);
            vf[ks] = mk8(lds_tr16(pb), lds_tr16(pb + 4 * 256));
        }
        {
            const int t0_ = r16, t1_ = 16 + r16, t2_ = 32 + r16, t3_ = 48 + r16;
            pf[0] = *(const LAS bf16x8*)(lds + HL_PL + t0_ * 128 + (((g) ^ ((t0_ >> 1) & 7)) << 4));
            pf[1] = *(const LAS bf16x8*)(lds + HL_PL + t1_ * 128 + (((g) ^ ((t1_ >> 1) & 7)) << 4));
            pf[2] = *(const LAS bf16x8*)(lds + HL_PL + t2_ * 128 + (((g) ^ ((t2_ >> 1) & 7)) << 4));
            pf[3] = *(const LAS bf16x8*)(lds + HL_PL + t2_ * 128 + (((4 + g) ^ ((t2_ >> 1) & 7)) << 4));
            pf[4] = *(const LAS bf16x8*)(lds + HL_PL + t3_ * 128 + (((g) ^ ((t3_ >> 1) & 7)) << 4));
            pf[5] = *(const LAS bf16x8*)(lds + HL_PL + t3_ * 128 + (((4 + g) ^ ((t3_ >> 1) & 7)) << 4));
        }
        HG_QSLD(qsA, 0);
        HG_SB();
        f32x4 Oa[4];
        const f32x4 z4 = (f32x4){0.f, 0.f, 0.f, 0.f};
        Oa[0] = __builtin_amdgcn_mfma_f32_16x16x32_bf16(vf[0], pf[0], z4, 0, 0, 0);
        Oa[1] = __builtin_amdgcn_mfma_f32_16x16x32_bf16(vf[0], pf[1], z4, 0, 0, 0);
        Oa[2] = __builtin_amdgcn_mfma_f32_16x16x32_bf16(vf[0], pf[2], z4, 0, 0, 0);
        Oa[3] = __builtin_amdgcn_mfma_f32_16x16x32_bf16(vf[0], pf[4], z4, 0, 0, 0);
        Oa[2] = __builtin_amdgcn_mfma_f32_16x16x32_bf16(vf[1], pf[3], Oa[2], 0, 0, 0);
        Oa[3] = __builtin_amdgcn_mfma_f32_16x16x32_bf16(vf[1], pf[5], Oa[3], 0, 0, 0);
        HG_SB();
        HG_QSLD(qsB, 1);
        HG_SB();
        HG_INTER(0, qsA);
        HG_SB();
        HG_QSLD(qsA, 2);
        HG_SB();
        HG_INTER(1, qsB);
        HG_SB();
        HG_QSLD(qsB, 3);
        HG_SB();
#define HG_DSLD(kt) (*(const LAS f32x4*)(lds + HL_DS + (16 * (kt) + 4 * g) * 4))
        bf16x8 keA[2], keB[2], keC[2], keD[2]; f32x4 dA, dB, dC, dD;
        HG_KELD(keA, 0); HG_KELD(keB, 1); dA = HG_DSLD(0); dB = HG_DSLD(1);
        HG_SB();
        HG_INTER(2, qsA);
        HG_SB();
        HG_KELD(keC, 2); HG_KELD(keD, 3); dC = HG_DSLD(2); dD = HG_DSLD(3);
        HG_SB();
        HG_INTER(3, qsB);
        HG_SB();
        HG_SUPD(0, keA, dA); HG_SUPD(1, keB, dB);
        HG_SB();
        HG_KELD(keA, 4); HG_KELD(keB, 5); dA = HG_DSLD(4); dB = HG_DSLD(5);
        HG_SB();
        HG_SUPD(2, keC, dC); HG_SUPD(3, keD, dD);
        HG_SB();
        HG_KELD(keC, 6); HG_KELD(keD, 7); dC = HG_DSLD(6); dD = HG_DSLD(7);
        HG_SB();
        HG_SUPD(4, keA, dA); HG_SUPD(5, keB, dB);
        HG_SB();
        HG_SUPD(6, keC, dC); HG_SUPD(7, keD, dD);
#undef HG_DSLD
#undef HG_SB
#undef HG_QSLD
#undef HG_KELD
#undef HG_INTER
#undef HG_SUPD
#pragma unroll
        for (int ti = 0; ti < 4; ++ti) {
            float sq = (Oa[ti][0] * Oa[ti][0] + Oa[ti][1] * Oa[ti][1]) + (Oa[ti][2] * Oa[ti][2] + Oa[ti][3] * Oa[ti][3]);
            sq += __shfl_xor(sq, 16); sq += __shfl_xor(sq, 32);
            if (g == 0) *(LAS float*)(lds + HL_SSQ + (w * 64 + 16 * ti + r16) * 4) = sq;
        }
        __syncthreads();
#pragma unroll
        for (int ti = 0; ti < 4; ++ti) {
            const int t = 16 * ti + r16;
            float tot = 0.f;
#pragma unroll
            for (int ww = 0; ww < 8; ++ww) tot += *(const LAS float*)(lds + HL_SSQ + (ww * 64 + t) * 4);
            const float rs = rsqrtf(tot * (1.f / 128.f) + EPS);
            const f32x4 nw4 = *(const f32x4*)(a.in[6] + 16 * w + 4 * g);
            u32x2 o; o.x = pk2(Oa[ti][0] * rs * nw4[0] * bflo(ogp[ti].x), Oa[ti][1] * rs * nw4[1] * bfhi(ogp[ti].x));
            o.y = pk2(Oa[ti][2] * rs * nw4[2] * bflo(ogp[ti].y), Oa[ti][3] * rs * nw4[3] * bfhi(ogp[ti].y));
            *(u32x2*)(YM + tok0 * D + hc + 16 * w + ti * 32768 + lo_ym) = o;
        }
    }
}

constexpr int P4_HI = 0, P4_LO = 65536, P4_PL = 131072;
__device__ __forceinline__ void p4_ln_router(Frame& F, const Args& a) {
    LAS unsigned char* lds = F.lds;
    const float* Z = (const float*)(F.ws + WS_Z); bf16_t* H1 = (bf16_t*)(F.ws + WS_H1);
    const float* w = a.in[11]; const float* b = a.in[12]; const float* br = a.in[14];
    int* cnt = (int*)(F.ws + WS_CTL) + CW_CNT; int* list = (int*)(F.ws + WS_LIST);
    int* tok_e = (int*)(F.ws + WS_TOKE); int* tok_p = (int*)(F.ws + WS_TOKP); float* tok_g = (float*)(F.ws + WS_TOKG);
    const int lane = F.lane, wv = F.wave, r16 = lane & 15, g = lane >> 4, nh = wv & 1, q = wv >> 1;
    bf16x8 wh[16], wl[16];
    { const bf16_t* ph = (const bf16_t*)(F.ws + WS_WRH) + (size_t)(16 * nh + r16) * D + 512 * q + 8 * g; const bf16_t* pl = (const bf16_t*)(F.ws + WS_WRL) + (size_t)(16 * nh + r16) * D + 512 * q + 8 * g;
#pragma unroll
      for (int ks = 0; ks < 16; ++ks) { wh[ks] = *(const bf16x8*)(ph + 32 * ks); wl[ks] = *(const bf16x8*)(pl + 32 * ks); } }
    const int ntile = T / 16;
    for (int tile = F.vcu; tile < ntile; tile += F.G) {
        __syncthreads();
#pragma unroll 1
        for (int th = 0; th < 2; ++th) {
            const int tl = 2 * wv + th, m = tile * 16 + tl;
            const GAS f32x4* zr = (const GAS f32x4*)(Z + (size_t)m * D) + lane;
            f32x4 v[8]; float s = 0.f;
#pragma unroll
            for (int j = 0; j < 8; ++j) { v[j] = zr[64 * j]; s += (v[j][0] + v[j][1]) + (v[j][2] + v[j][3]); }
            const float mean = wave_sum(s) * (1.f / D); float s2 = 0.f;
#pragma unroll
            for (int j = 0; j < 8; ++j) { v[j] = v[j] - mean; s2 += (v[j][0] * v[j][0] + v[j][1] * v[j][1]) + (v[j][2] * v[j][2] + v[j][3] * v[j][3]); }
            const float rstd = rsqrtf(wave_sum(s2) * (1.f / D) + EPS);
            GAS u32x2* o8 = (GAS u32x2*)(H1 + (size_t)m * D) + lane;
#pragma unroll
            for (int j = 0; j < 8; ++j) { const f32x4 ww = *((const f32x4*)w + lane + 64 * j), bb = *((const f32x4*)b + lane + 64 * j);
                f32x4 hv; hv[0] = v[j][0] * rstd * ww[0] + bb[0]; hv[1] = v[j][1] * rstd * ww[1] + bb[1]; hv[2] = v[j][2] * rstd * ww[2] + bb[2]; hv[3] = v[j][3] * rstd * ww[3] + bb[3];
                const unsigned h01 = pk2(hv[0], hv[1]), h23 = pk2(hv[2], hv[3]);
                u32x2 o; o.x = h01; o.y = h23; o8[64 * j] = o;
                *((GAS unsigned*)(F.ws + WS_H1Q + (size_t)m * D) + lane + 64 * j) = pk4_fp8(hv[0] * SC_H1, hv[1] * SC_H1, hv[2] * SC_H1, hv[3] * SC_H1);
                u32x2 lo; lo.x = pk2(hv[0] - bflo(h01), hv[1] - bfhi(h01)); lo.y = pk2(hv[2] - bflo(h23), hv[3] - bfhi(h23));
                const int off = tl * 4096 + ((((lane >> 1) + 32 * j) ^ tl) << 4) + (lane & 1) * 8;
                *(LAS u32x2*)(lds + P4_HI + off) = o; *(LAS u32x2*)(lds + P4_LO + off) = lo; }
        }
        __syncthreads();
        f32x4 acc = (f32x4){0.f, 0.f, 0.f, 0.f};
#pragma unroll
        for (int ks = 0; ks < 16; ++ks) {
            const int off = r16 * 4096 + (((64 * q + 4 * ks + g) ^ r16) << 4);
            const bf16x8 th = *(const LAS bf16x8*)(lds + P4_HI + off), tl8 = *(const LAS bf16x8*)(lds + P4_LO + off);
            acc = __builtin_amdgcn_mfma_f32_16x16x32_bf16(wh[ks], th, acc, 0, 0, 0);
            acc = __builtin_amdgcn_mfma_f32_16x16x32_bf16(wh[ks], tl8, acc, 0, 0, 0);
            acc = __builtin_amdgcn_mfma_f32_16x16x32_bf16(wl[ks], th, acc, 0, 0, 0);
        }
        *(LAS f32x4*)(lds + P4_PL + ((q * 16 + r16) * 32 + 16 * nh + 4 * g) * 4) = acc;
        __syncthreads();
        {
            const int e = lane & 31, th = lane >> 5, tl = 2 * wv + th, m = tile * 16 + tl;
            float sl = br[e];
#pragma unroll
            for (int qq = 0; qq < 4; ++qq) sl += *(const LAS float*)(lds + P4_PL + ((qq * 16 + tl) * 32 + e) * 4);
            float val = sl; int te[4]; float tv[4];
#pragma unroll
            for (int r = 0; r < 4; ++r) {
                float bv = val; int bi = e;
#pragma unroll
                for (int o = 1; o < 32; o <<= 1) { const float ov = __shfl_xor(bv, o); const int oi = __shfl_xor(bi, o); if (ov > bv || (ov == bv && oi < bi)) { bv = ov; bi = oi; } }
                te[r] = bi; tv[r] = bv; if (e == bi) val = -INFINITY;
            }
            float p[4], ps = 0.f;
#pragma unroll
            for (int r = 0; r < 4; ++r) { p[r] = __expf(tv[r] - tv[0]); ps += p[r]; }
            if (e < 4) {
                int ee = te[0]; float gg = p[0];
                if (e == 1) { ee = te[1]; gg = p[1]; } else if (e == 2) { ee = te[2]; gg = p[2]; } else if (e == 3) { ee = te[3]; gg = p[3]; }
                const int pos = atomicAdd(&cnt[ee], 1);
                list[(size_t)ee * LISTCAP + pos] = m;
                tok_e[m * 4 + e] = ee; tok_p[m * 4 + e] = pos; tok_g[m * 4 + e] = gg / ps;
            }
        }
    }
}
__device__ __forceinline__ int moe_tables(Frame& F) {
    LAS int* pts = (LAS int*)(F.lds + LDSCTL_OFF + LC_PTS); LAS int* cl = (LAS int*)(F.lds + LDSCTL_OFF + LC_CNT); LAS unsigned char* tileE = (LAS unsigned char*)(F.lds + LDSCTL_OFF + LC_TILEE);
    const int* cnt = (const int*)(F.ws + WS_CTL) + CW_CNT;
    __syncthreads();
    if (F.tid < 64) {
        const int e = F.tid & 31; const int c = __hip_atomic_load(cnt + e, RLX_AGENT); const int tl = (c + 255) >> 8;
        int incl = tl;
#pragma unroll
        for (int o = 1; o < 32; o <<= 1) { const int v = __shfl_up(incl, o, 32); if (e >= o) incl += v; }
        if (F.tid < 32) { cl[e] = c; pts[e] = incl - tl; if (e == 31) pts[32] = incl; }
    }
    __syncthreads();
    const int nmt = pts[32];
    for (int t = F.tid; t < nmt; t += NTHR) { int e = 0;
        for (int j = 0; j < 32; ++j) if (t >= pts[j + 1]) e = j + 1;
        tileE[t] = (unsigned char)e; }
    __syncthreads();
    return __builtin_amdgcn_readfirstlane(nmt);
}
__device__ __forceinline__ void p7_combine(Frame& F, const Args& a) {
    const LAS int* pts = (const LAS int*)(F.lds + LDSCTL_OFF + LC_PTS);
    const bf16_t* H1 = (const bf16_t*)(F.ws + WS_H1); const bf16_t* Y = (const bf16_t*)(F.ws + WS_Y);
    const int* tok_e = (const int*)(F.ws + WS_TOKE); const int* tok_p = (const int*)(F.ws + WS_TOKP); const float* tok_g = (const float*)(F.ws + WS_TOKG);
    const float* w = a.in[21]; const float* b = a.in[22]; float* out = a.out;
    const int gw = F.vcu * NWAVES + F.wave, NGW = F.G * NWAVES, lane = F.lane;
    for (int m = gw; m < T; m += NGW) {
        f32x4 v[8];
        { const GAS u32x2* hr = (const GAS u32x2*)(H1 + (size_t)m * D) + lane;
#pragma unroll
          for (int j = 0; j < 8; ++j) { const u32x2 hw = hr[64 * j]; v[j][0] = ALPHA * bflo(hw.x); v[j][1] = ALPHA * bfhi(hw.x); v[j][2] = ALPHA * bflo(hw.y); v[j][3] = ALPHA * bfhi(hw.y); } }
#pragma unroll
        for (int k = 0; k < 4; ++k) {
            const int e = tok_e[m * 4 + k]; const int row = pts[e] * 256 + tok_p[m * 4 + k]; const float g = tok_g[m * 4 + k];
            const GAS u32x2* yr = (const GAS u32x2*)(Y + (size_t)row * D) + lane;
#pragma unroll
            for (int j = 0; j < 8; ++j) { const u32x2 yw = yr[64 * j]; v[j][0] += g * bflo(yw.x); v[j][1] += g * bfhi(yw.x); v[j][2] += g * bflo(yw.y); v[j][3] += g * bfhi(yw.y); }
        }
        float s = 0.f;
#pragma unroll
        for (int j = 0; j < 8; ++j) s += (v[j][0] + v[j][1]) + (v[j][2] + v[j][3]);
        const float mean = wave_sum(s) * (1.f / D); float s2 = 0.f;
#pragma unroll
        for (int j = 0; j < 8; ++j) { v[j] = v[j] - mean; s2 += (v[j][0] * v[j][0] + v[j][1] * v[j][1]) + (v[j][2] * v[j][2] + v[j][3] * v[j][3]); }
        const float rstd = rsqrtf(wave_sum(s2) * (1.f / D) + EPS);
        GAS f32x4* orow = (GAS f32x4*)(out + (size_t)m * D) + lane;
#pragma unroll
        for (int j = 0; j < 8; ++j) { const f32x4 ww = *((const f32x4*)w + lane + 64 * j), bb = *((const f32x4*)b + lane + 64 * j);
            f32x4 o; o[0] = v[j][0] * rstd * ww[0] + bb[0]; o[1] = v[j][1] * rstd * ww[1] + bb[1]; o[2] = v[j][2] * rstd * ww[2] + bb[2]; o[3] = v[j][3] * rstd * ww[3] + bb[3]; orow[64 * j] = o; }
    }
}

__global__ void __launch_bounds__(NTHR, 2) mk_fwd(Args args) {
    extern __shared__ __attribute__((aligned(16))) unsigned char lds_raw[];
    Frame F;
    F.lds = (LAS unsigned char*)lds_raw;
    F.tid = threadIdx.x; F.lane = F.tid & 63; F.wave = __builtin_amdgcn_readfirstlane(F.tid >> 6);
    F.G = gridDim.x; { const int bx = blockIdx.x; F.vcu = (F.G % 8 == 0) ? (bx % 8) * (F.G / 8) + bx / 8 : bx; }
    F.ws = args.ws;
    unsigned char* ws = args.ws;
    for (int u = F.tid; u < (LDS_BYTES - LDSCTL_OFF) / 4; u += NTHR) ((LAS unsigned*)(F.lds + LDSCTL_OFF))[u] = 0u;
    __syncthreads();
    XcdBarrier bar; bar.bar = (unsigned*)(ws + WS_CTL) + CW_BAR; bar.x = 0; bar.st = nullptr;
#if !MK_PER_PHASE
    bar = xcd_barrier_post((unsigned*)(ws + WS_CTL) + CW_BAR, (volatile LAS unsigned*)(F.lds + LDSCTL_OFF + LC_BAR));
#endif
    const int lo = args.ph_lo, hi = args.ph_hi;
#define IN(k) (lo <= (k) && (k) < hi)
#define REFRESH_IDS() do { int t_ = threadIdx.x; asm volatile("" : "+v"(t_)); F.tid = t_; F.lane = t_ & 63; F.wave = __builtin_amdgcn_readfirstlane(t_ >> 6); } while (0)
#define SEAM(k) do { if (IN(k) && IN((k) + 1)) xcd_barrier(bar); } while (0)

    if (IN(0)) { REFRESH_IDS(); for (int r = 0; r < REP0; ++r) { p0_prologue(F, args); if (r + 1 < REP0) xcd_barrier(bar); } } SEAM(0);

    if (IN(1)) { REFRESH_IDS();
        const int Gg = F.G >= 64 ? F.G - F.G / 8 : F.G;
        SchedDense S{(const bf16_t*)(ws + WS_H0), (const bf16_t*)(ws + WS_WIN), T / 256, INC / 256, Gg, (int)blockIdx.x};
        EpiInProj E{(bf16_t*)(ws + WS_QH), (bf16_t*)(ws + WS_KH), (bf16_t*)(ws + WS_VH), (bf16_t*)(ws + WS_OG), (bf16_t*)(ws + WS_AQ), (bf16_t*)(ws + WS_AK), (bf16_t*)(ws + WS_AV),
                    (float*)(ws + WS_GH), (const float*)(ws + WS_LB), args.in[4]};
        if ((int)blockIdx.x < Gg) {
            for (int r = 0; r < REP1; ++r) { gemm_phase<EpiInProj, SchedDense>(F.lds, S, E); if (r + 1 < REP1) xcd_barrier(bar); }
            if (threadIdx.x == 0) __hip_atomic_fetch_add((unsigned*)(ws + WS_CTL) + CW_P1DONE, 1u, RLX_AGENT);
        } else {
            cv_worker(F, args, (const unsigned*)(ws + WS_CTL) + CW_P1DONE, 0u);
        }
    } SEAM(1);

    if (IN(2)) { REFRESH_IDS();
        for (int r = 0; r < REP2; ++r) {
        const int nh = F.G > 64 ? 64 : F.G, na = F.G > 64 ? F.G - 64 : F.G, aid = F.G > 64 ? (int)blockIdx.x - 64 : (int)blockIdx.x;
        if ((int)blockIdx.x < nh) { for (int hu = blockIdx.x; hu < 64 * REP2H; hu += nh) { hgrn_unit_mfma(F, args, (hu & 63) >> 3, hu & 7);
                if (threadIdx.x == 0) __hip_atomic_fetch_add((unsigned*)(ws + WS_CTL) + CW_HGDONE, 1u, RLX_AGENT); } }
        REFRESH_IDS();
        if (aid >= 0) { for (int v0 = aid; v0 < NB * (L / AT_Q) * REP2A; v0 += na) { const int v = v0 % (NB * (L / AT_Q)); attn_unit_mfma(F, args, v / (L / AT_Q), v % (L / AT_Q)); }
            if (F.G > 64) { __syncthreads(); cv_worker(F, args, (const unsigned*)(ws + WS_CTL) + CW_HGDONE, 64u * REP2H); } }
        if (r + 1 < REP2) xcd_barrier(bar); }
    } SEAM(2);

    if (IN(3)) { REFRESH_IDS();
        SchedDense S{(const bf16_t*)(ws + WS_YMIX), (const bf16_t*)(ws + WS_WOUT), T / 256, D / 256, F.G, (int)blockIdx.x};
        EpiOutProj E{(float*)(ws + WS_Z), args.in[0], (const float*)(ws + WS_STATS0), args.in[1], args.in[2], args.in[10]};
        for (int r = 0; r < REP3; ++r) { gemm_phase<EpiOutProj, SchedDense>(F.lds, S, E); if (r + 1 < REP3) xcd_barrier(bar); }
    } SEAM(3);

    if (IN(4)) { REFRESH_IDS(); p4_ln_router(F, args); } SEAM(4);

    if (IN(5)) { REFRESH_IDS(); __syncthreads(); cv_worker(F, args, nullptr, 0u); } SEAM(5);

    if (IN(6)) { REFRESH_IDS();
        const int nmt = moe_tables(F);
        SchedMoe<2048> S{(const void*)(ws + WS_H1Q), (const void*)(ws + WS_WGU), (size_t)4096 * KD, (const int*)(ws + WS_LIST),
                   (const LAS int*)(F.lds + LDSCTL_OFF + LC_PTS), (const LAS int*)(F.lds + LDSCTL_OFF + LC_CNT), (const LAS unsigned char*)(F.lds + LDSCTL_OFF + LC_TILEE), nmt, 16, F.G, (int)blockIdx.x, true};
        EpiMoe1F8 E{(unsigned char*)(ws + WS_HACT), args.in[16], args.in[18]};
        for (int r = 0; r < REP5; ++r) { gemm_phase<EpiMoe1F8, SchedMoe<2048>, true>(F.lds, S, E); if (r + 1 < REP5) xcd_barrier(bar); }
    } SEAM(6);

    if (IN(7)) { REFRESH_IDS();
        const int nmt = moe_tables(F);
        SchedMoe<2048> S{(const void*)(ws + WS_HACT), (const void*)(ws + WS_WD), (size_t)2048 * KD, (const int*)(ws + WS_LIST),
                   (const LAS int*)(F.lds + LDSCTL_OFF + LC_PTS), (const LAS int*)(F.lds + LDSCTL_OFF + LC_CNT), (const LAS unsigned char*)(F.lds + LDSCTL_OFF + LC_TILEE), nmt, 8, F.G, (int)blockIdx.x, false};
        EpiMoe2F8 E{(bf16_t*)(ws + WS_Y), args.in[20]};
        for (int r = 0; r < REP6; ++r) { gemm_phase<EpiMoe2F8, SchedMoe<2048>, true>(F.lds, S, E); if (r + 1 < REP6) xcd_barrier(bar); }
    } SEAM(7);

    if (IN(8)) { REFRESH_IDS(); (void)moe_tables(F); for (int r = 0; r < REP7; ++r) p7_combine(F, args); }
#undef IN
#undef SEAM
}
}

extern "C" void kernel_launch(void* const* d_in, const int* in_sizes, int n_in, void* d_out, int out_size, void* d_ws, size_t ws_size, hipStream_t stream) {
    static int grid = 0;
    if (grid == 0) {
        if (n_in != 23 || out_size != T * D || ws_size < WS_END) { fprintf(stderr, "kernel_launch: unexpected shapes (n_in %d out %d ws %zu need %zu)\n", n_in, out_size, ws_size, (size_t)WS_END); grid = -1; return; }
        int dev = 0, cus = 0, per_cu = 0;
        if (hipGetDevice(&dev) != hipSuccess || hipDeviceGetAttribute(&cus, hipDeviceAttributeMultiprocessorCount, dev) != hipSuccess) { grid = -1; return; }
        if (hipFuncSetAttribute((const void*)mk_fwd, hipFuncAttributeMaxDynamicSharedMemorySize, LDS_BYTES) != hipSuccess) { fprintf(stderr, "kernel_launch: hipFuncSetAttribute failed\n"); grid = -1; return; }
        if (hipOccupancyMaxActiveBlocksPerMultiprocessor(&per_cu, (const void*)mk_fwd, NTHR, LDS_BYTES) != hipSuccess || per_cu < 1) { fprintf(stderr, "kernel_launch: occupancy query says %d\n", per_cu); }
        (void)hipGetLastError();
        grid = cus;
    }
    if (grid < 0) return;
    if (hipMemsetAsync((char*)d_ws + WS_CTL, 0, CTL_ZERO_BYTES, stream) != hipSuccess) return;
    Args a{};
    for (int i = 0; i < 23; ++i) a.in[i] = (const float*)d_in[i];
    a.out = (float*)d_out; a.ws = (unsigned char*)d_ws;
#if MK_PER_PHASE
    for (int p = 0; p < NPHASE; ++p) { a.ph_lo = p; a.ph_hi = p + 1; hipLaunchKernelGGL(mk_fwd, dim3(grid), dim3(NTHR), LDS_BYTES, stream, a); }
#else
    a.ph_lo = 0; a.ph_hi = NPHASE; hipLaunchKernelGGL(mk_fwd, dim3(grid), dim3(NTHR), LDS_BYTES, stream, a);
#endif
}
```

```cpp
#include <hip/hip_runtime.h>
#include <cstdio>
#include <cstdint>

#ifndef MK_PER_PHASE
#define MK_PER_PHASE 0
#endif

#define LAS __attribute__((address_space(3)))
#define GAS __attribute__((address_space(1)))
typedef unsigned short bf16_t;
typedef short bf16x8 __attribute__((ext_vector_type(8)));
typedef float f32x4 __attribute__((ext_vector_type(4)));
typedef float f32x2 __attribute__((ext_vector_type(2)));
typedef unsigned u32x4 __attribute__((ext_vector_type(4)));
typedef unsigned u32x2 __attribute__((ext_vector_type(2)));
typedef GAS unsigned gu32;

namespace {
constexpr int D = 2048, NB = 8, L = 2048, T = NB * L;
constexpr int INC = 5376;
constexpr int NE = 32, FF = 2048, NA = T * 4;
constexpr int LISTCAP = T;
constexpr int MAXROWS = NA + NE * 256;
constexpr float ALPHA = 1.189207115002721f;
constexpr float EPS = 1e-5f;
constexpr int NWAVES = 8, NTHR = 512;
constexpr int NPHASE = 9;
constexpr int REP2H = 1, REP2A = 1;
constexpr int REP0 = 1, REP1 = 1, REP2 = 1, REP3 = 1, REP5 = 1, REP6 = 1, REP7 = 1;

constexpr size_t MiB = 1u << 20;
constexpr size_t WS_CTL = 0, CTL_ZERO_BYTES = 32768;
constexpr size_t WS_LB = 1 * MiB;
constexpr size_t WS_STATS0 = WS_LB + 4096;
constexpr size_t WS_LIST = 2 * MiB;
constexpr size_t WS_TOKE = 4 * MiB, WS_TOKP = WS_TOKE + (size_t)NA * 4, WS_TOKG = WS_TOKP + (size_t)NA * 4;
constexpr size_t WS_WRH = 5 * MiB, WS_WRL = WS_WRH + 131072;
constexpr size_t WS_WIN = 8 * MiB;
constexpr size_t WS_WOUT = 30 * MiB;
constexpr size_t WS_WGU = 40 * MiB;
constexpr size_t WS_WD = 552 * MiB;
constexpr size_t WS_H1 = 808 * MiB;
constexpr size_t WS_Z = 872 * MiB;
constexpr size_t WS_HACT = 1000 * MiB;
constexpr size_t WS_EARLY = 1288 * MiB;
constexpr size_t WS_H0 = WS_EARLY;
constexpr size_t WS_QH = WS_H0 + 64 * MiB, WS_KH = WS_QH + 32 * MiB, WS_VH = WS_KH + 32 * MiB, WS_OG = WS_VH + 32 * MiB, WS_AQ = WS_OG + 32 * MiB;
constexpr size_t WS_GH = WS_AQ + 32 * MiB;
constexpr size_t WS_AK = WS_GH + 64 * MiB, WS_AV = WS_AK + 4 * MiB;
constexpr size_t WS_YMIX = WS_AV + 4 * MiB;
constexpr size_t WS_H1Q = WS_KH;
constexpr size_t WS_Y = WS_EARLY;
constexpr size_t WS_END = WS_YMIX + 64 * MiB;
static_assert(WS_Y + (size_t)MAXROWS * 4096 <= WS_END + 0 * MiB || true, "");
static_assert(WS_END <= 2048 * MiB, "d_ws map");
constexpr int CW_CNT = 64;
constexpr int CW_CONV = 128, CW_P1DONE = 192, CW_HGDONE = 256;
constexpr int CW_BAR = 4096;

constexpr int RING_BYTES = 131072;
constexpr int CV_SCR = 17408;
constexpr int LDSCTL_OFF = 8 * CV_SCR;
constexpr int LDS_BYTES = 147456;
constexpr int LC_BAR = 0, LC_PTS = 64, LC_CNT = 256, LC_TILEE = 512, LC_MISC = 2048;

#define RLX_AGENT __ATOMIC_RELAXED, __HIP_MEMORY_SCOPE_AGENT
__device__ __forceinline__ unsigned f2bf(float f) { unsigned u = __builtin_bit_cast(unsigned, f); return (u + 0x7fffu + ((u >> 16) & 1u)) >> 16; }
__device__ __forceinline__ unsigned pk2(float lo, float hi) { return f2bf(lo) | (f2bf(hi) << 16); }
__device__ __forceinline__ float bf2f(unsigned short b) { return __builtin_bit_cast(float, (unsigned)b << 16); }
__device__ __forceinline__ float bflo(unsigned w) { return __builtin_bit_cast(float, w << 16); }
__device__ __forceinline__ float bfhi(unsigned w) { return __builtin_bit_cast(float, w & 0xffff0000u); }
typedef __bf16 bf16x2_t __attribute__((ext_vector_type(2)));
__device__ __forceinline__ unsigned cvt_pk_bf16_c(float lo, float hi) { f32x2 v = {lo, hi}; bf16x2_t b = __builtin_convertvector(v, bf16x2_t); return __builtin_bit_cast(unsigned, b); }
__device__ __forceinline__ unsigned cvt_pk_bf16(float lo, float hi) { unsigned r; asm volatile("v_cvt_pk_bf16_f32 %0, %1, %2" : "=v"(r) : "v"(lo), "v"(hi)); return r; }
__device__ __forceinline__ float wave_sum(float v) {
#pragma unroll
    for (int o = 1; o < 64; o <<= 1) v += __shfl_xor(v, o);
    return v;
}
__device__ __forceinline__ float sigm(float x) { return __builtin_amdgcn_rcpf(1.f + __expf(-x)); }

#define XB_TMO      128
#define XB_XCNT(j)  (256  + 64 * (j))
#define XB_XSUB(j)  (1280 + 64 * (j))
#define XB_XGEN(j)  (2304 + 64 * (j))
#define XB_TOP      3328
#define XB_TOPGEN   3392
#define XCD_BAR_WORDS 3456
#define XB_SPIN_CAP (1u << 18)
__device__ __forceinline__ unsigned xb_ld(unsigned* p)              { return __hip_atomic_load(p, __ATOMIC_RELAXED, __HIP_MEMORY_SCOPE_AGENT); }
__device__ __forceinline__ unsigned xb_add(unsigned* p, unsigned v) { return __hip_atomic_fetch_add(p, v, __ATOMIC_RELAXED, __HIP_MEMORY_SCOPE_AGENT); }
__device__ __forceinline__ unsigned xb_xcc_id() { return (unsigned)__builtin_amdgcn_s_getreg((3 << 11) | 20) & 0xFu; }
#define XB_SPIN(cond, bar) do { unsigned _sp = 0; while (cond) { __builtin_amdgcn_s_sleep(1); \
    if ((++_sp & 255u) == 0u) { if (xb_ld(&(bar)[XB_TMO])) break; if (_sp > XB_SPIN_CAP) { atomicAdd(&(bar)[XB_TMO], 1u); break; } } } } while (0)
struct XcdBarrier { unsigned* bar; unsigned x; volatile LAS unsigned* st; };
__device__ __forceinline__ XcdBarrier xcd_barrier_post(unsigned* bar, volatile LAS unsigned* st) {
    XcdBarrier b; b.bar = bar; b.x = xb_xcc_id(); b.st = st;
    if (threadIdx.x == 0) (void)xb_add(&bar[XB_XCNT(b.x)], 1u);
    return b;
}
__device__ __forceinline__ void xcd_barrier_complete(unsigned* bar, unsigned x, unsigned& nloc, unsigned& nx) {
    const unsigned G = gridDim.x * gridDim.y * gridDim.z;
    unsigned sum, cnt, mine, sp = 0u;
    for (;;) {
        sum = 0u; cnt = 0u; mine = 0u;
#pragma unroll
        for (unsigned j = 0; j < 16; ++j) { const unsigned c = xb_ld(&bar[XB_XCNT(j)]); sum += c; cnt += (c > 0u) ? 1u : 0u; mine = (j == x) ? c : mine; }
        if (sum == G) break;
        __builtin_amdgcn_s_sleep(1);
        if ((++sp & 255u) == 0u) { if (xb_ld(&bar[XB_TMO])) break; if (sp > XB_SPIN_CAP) { atomicAdd(&bar[XB_TMO], 1u); break; } }
    }
    nloc = mine > 0u ? mine : 1u; nx = cnt > 0u ? cnt : 1u;
}
__device__ __forceinline__ void xcd_barrier(const XcdBarrier& b) {
    asm volatile("s_waitcnt vmcnt(0)" ::: "memory");
    __syncthreads();
    if (threadIdx.x == 0) {
        unsigned* bar = b.bar;
        __builtin_amdgcn_s_waitcnt(0);
        unsigned nloc = b.st[0], nx = b.st[1];
        if (nloc == 0u) { xcd_barrier_complete(bar, b.x, nloc, nx); b.st[0] = nloc; b.st[1] = nx; }
        const unsigned old = xb_add(&bar[XB_XSUB(b.x)], 1u);
        const unsigned gen = old / nloc;
        if (old + 1u == (gen + 1u) * nloc) {
            __builtin_amdgcn_fence(__ATOMIC_RELEASE, "agent");
            asm volatile("s_waitcnt vmcnt(0)" ::: "memory");
            const unsigned og = xb_add(&bar[XB_TOP], 1u);
            const unsigned tg = og / nx;
            if (og + 1u == (tg + 1u) * nx) xb_add(&bar[XB_TOPGEN], 1u);
            else XB_SPIN(xb_ld(&bar[XB_TOPGEN]) == tg, bar);
            __builtin_amdgcn_fence(__ATOMIC_ACQUIRE, "agent");
            xb_add(&bar[XB_XGEN(b.x)], 1u);
            asm volatile("s_waitcnt vmcnt(0)" ::: "memory");
        } else {
            XB_SPIN(xb_ld(&bar[XB_XGEN(b.x)]) == gen, bar);
            __builtin_amdgcn_fence(__ATOMIC_ACQUIRE, "agent");
            asm volatile("s_waitcnt vmcnt(0)" ::: "memory");
        }
    }
    __syncthreads();
}

constexpr int BM = 256, BK = 64, HALF = 128, HTB = HALF * BK * 2, NXCD = 8, WGM = 8;
constexpr int KD = 2048, NT = KD / BK;
__device__ __forceinline__ int lds_byte(int r, int c) { const int st = (r >> 4) * 2 + (c >> 5), rr = r & 15, cc = c & 31, ob = rr * 64 + cc * 2; return st * 1024 + (ob ^ (((ob >> 9) & 1) << 5)); }
__device__ __forceinline__ void stage_rc(int b, int& R, int& C) { const int st = b / 1024, sb = b % 1024, swz = sb ^ (((sb >> 9) & 1) << 5); R = (st >> 1) * 16 + swz / 64; C = (st & 1) * 32 + (swz % 64) / 2; }
__device__ __forceinline__ int perm32(int rho) { const int n = rho >> 4, i = rho & 15; return 8 * (i >> 2) + 4 * n + (i & 3); }

struct GU { const char* A; const char* B; int pm, pn, e, mtl; };

__device__ __forceinline__ bool order_next(int i, int G, int c, int nM, int nN, int& pm, int& pn) {
    const int nwg = nM * nN; const long Lx = (long)i * G + c; if (Lx >= nwg) return false;
    int wgid = (int)Lx; { const int q = nwg / NXCD, r = nwg % NXCD, xcd = wgid % NXCD, off = wgid / NXCD; wgid = (xcd < r ? xcd * (q + 1) : r * (q + 1) + (xcd - r) * q) + off; }
    const int nig = WGM * nN, gid = wgid / nig, fm = gid * WGM, gsz = (nM - fm) < WGM ? (nM - fm) : WGM;
    pm = fm + ((wgid % nig) % gsz); pn = (wgid % nig) / gsz; return true;
}

typedef int v8i_t __attribute__((ext_vector_type(8)));
template <class Epi, class Sched, bool F8 = false>
__device__ __forceinline__ void gemm_phase(LAS unsigned char* lds, const Sched& S, const Epi& E) {
    const int tid = threadIdx.x, wid = __builtin_amdgcn_readfirstlane(tid >> 6), lane = tid & 63, wr = wid >> 2, wc = wid & 3, fr = lane & 15, fq = lane >> 4;
    constexpr int ROWB = F8 ? KD : KD * 2;
    constexpr int nt = ROWB / 128;
    int Rr[2], Cc[2]; unsigned voffB[2];
#pragma unroll
    for (int i = 0; i < 2; ++i) { stage_rc(tid * 16 + i * 8192, Rr[i], Cc[i]); const int Rb = Epi::PERM ? ((Rr[i] & ~31) + perm32(Rr[i] & 31)) : Rr[i]; voffB[i] = (unsigned)(Rb * ROWB + Cc[i] * 2); }
    const size_t kstep = (size_t)128;
    const size_t hstep = (size_t)HALF * ROWB;
    const unsigned ldsw = (unsigned)wid * 1024u;
    const int aoff = F8 ? lds_byte(wr * 64 + fr, fq * 16) : lds_byte(wr * 64 + fr, fq * 8), boff = F8 ? lds_byte(wc * 32 + fr, fq * 16) : lds_byte(wc * 32 + fr, fq * 8);
#define PG8_SA(b, h) (((b) * 2 + (h)) * HTB)
#define PG8_SB(b, h) ((4 + (b) * 2 + (h)) * HTB)
#define PG8_STAGE(bufoff, gbase, voff) do { _Pragma("unroll") for (int _i = 0; _i < 2; ++_i) \
        __builtin_amdgcn_global_load_lds((const unsigned*)((const char*)(gbase) + (voff)[_i]), (LAS unsigned*)(lds + (bufoff) + ldsw + _i * 8192), 16, 0, 0); } while (0)
#define PG8_LDA(dst, b, h) do { _Pragma("unroll") for (int m = 0; m < 4; ++m) _Pragma("unroll") for (int k = 0; k < 2; ++k) dst[m].q[k] = *(const LAS u32x4*)(lds + PG8_SA(b, h) + aoff + m * 2048 + k * (F8 ? 16 : 1024)); } while (0)
#define PG8_LDB(dst, b, h) do { _Pragma("unroll") for (int n = 0; n < 2; ++n) _Pragma("unroll") for (int k = 0; k < 2; ++k) dst[n].q[k] = *(const LAS u32x4*)(lds + PG8_SB(b, h) + boff + n * 2048 + k * (F8 ? 16 : 1024)); } while (0)
#define PG8_MMA(ai, bj, At, Bt) do { __builtin_amdgcn_s_setprio(1); _Pragma("unroll") for (int m = 0; m < 4; ++m) _Pragma("unroll") for (int n = 0; n < 2; ++n) { \
        if constexpr (F8) { asm volatile("v_mfma_scale_f32_16x16x128_f8f6f4 %0, %1, %2, %0, %3, %3 op_sel_hi:[0,0,0]" : "+v"(acc[ai][bj][m][n]) : "v"(Bt[n].v), "v"(At[m].v), "v"(f8sc)); } \
        else { _Pragma("unroll") for (int k = 0; k < 2; ++k) acc[ai][bj][m][n] = __builtin_amdgcn_mfma_f32_16x16x32_bf16(__builtin_bit_cast(bf16x8, Bt[n].q[k]), __builtin_bit_cast(bf16x8, At[m].q[k]), acc[ai][bj][m][n], 0, 0, 0); } } \
        __builtin_amdgcn_s_setprio(0); } while (0)
#define PG8_WAIT_V(n) asm volatile("s_waitcnt vmcnt(" #n ")" ::: "memory")
#define PG8_WAIT_L(n) asm volatile("s_waitcnt lgkmcnt(" #n ")" ::: "memory")
#define PG8_BAR __builtin_amdgcn_s_barrier()
#define PG8_SCHED __builtin_amdgcn_sched_barrier(0)
    GU cur, nxt; int ui = 0;
    if (!S.next(0, cur)) return;
    f32x4 acc[2][2][4][2];
#pragma unroll
    for (int a = 0; a < 2; ++a)
#pragma unroll
        for (int b = 0; b < 2; ++b)
#pragma unroll
            for (int m = 0; m < 4; ++m)
#pragma unroll
                for (int n = 0; n < 2; ++n) acc[a][b][m][n] = (f32x4){0.f, 0.f, 0.f, 0.f};
    int f8sc = 0x7f7f7f7f; asm volatile("" : "+v"(f8sc));
    union Frag { v8i_t v; u32x4 q[2]; };
    Frag At[4], B0[2], B1[2];
    unsigned oc0[2], oc1[2], on0[2], on1[2];
    S.a_off(cur, Rr, Cc, oc0, oc1);
    const char* cA = cur.A; const char* cB = cur.B;
    PG8_STAGE(PG8_SB(0, 0), cB, voffB); PG8_STAGE(PG8_SB(0, 1), cB + hstep, voffB); PG8_STAGE(PG8_SA(0, 0), cA, oc0); PG8_STAGE(PG8_SA(0, 1), cA, oc1);
    if (wr == 1) PG8_BAR;
    PG8_WAIT_V(2); PG8_BAR;
    PG8_STAGE(PG8_SB(1, 0), cB + kstep, voffB); PG8_STAGE(PG8_SA(1, 0), cA + kstep, oc0); PG8_STAGE(PG8_SB(1, 1), cB + hstep + kstep, voffB);
    PG8_WAIT_V(6); PG8_BAR;
    for (;;) {
        const bool has_next = S.next(ui + 1, nxt);
        const char* nA = has_next ? nxt.A : cA; const char* nB = has_next ? nxt.B : cB;
        for (int t = 0; t < nt; t += 2) {
            const bool last = (t == nt - 2);
            const char* a1 = cA + (size_t)(t + 1) * kstep;
            const char* a2 = last ? nA : cA + (size_t)(t + 2) * kstep; const char* b2 = last ? nB : cB + (size_t)(t + 2) * kstep;
            const char* a3 = a2 + kstep; const char* b3 = b2 + kstep;
            unsigned o20[2], o21[2];
            if (last) {
                if (has_next) S.a_off(nxt, Rr, Cc, on0, on1); else { on0[0] = oc0[0]; on0[1] = oc0[1]; on1[0] = oc1[0]; on1[1] = oc1[1]; }
                o20[0] = on0[0]; o20[1] = on0[1]; o21[0] = on1[0]; o21[1] = on1[1];
            } else { o20[0] = oc0[0]; o20[1] = oc0[1]; o21[0] = oc1[0]; o21[1] = oc1[1]; }
            PG8_LDB(B0, 0, 0); PG8_LDB(B1, 0, 1); PG8_SCHED; PG8_LDA(At, 0, 0); PG8_STAGE(PG8_SA(1, 1), a1, oc1);
            PG8_WAIT_V(8); PG8_WAIT_L(0); PG8_BAR; PG8_MMA(0, 0, At, B0); PG8_MMA(0, 1, At, B1); PG8_BAR; PG8_SCHED;
            PG8_LDA(At, 0, 1); PG8_STAGE(PG8_SB(0, 0), b2, voffB); PG8_STAGE(PG8_SB(0, 1), b2 + hstep, voffB); PG8_STAGE(PG8_SA(0, 0), a2, o20);
            PG8_WAIT_V(8); PG8_WAIT_L(0); PG8_BAR; PG8_MMA(1, 0, At, B0); PG8_MMA(1, 1, At, B1); PG8_BAR; PG8_SCHED;
            PG8_LDB(B0, 1, 0); PG8_LDB(B1, 1, 1); PG8_SCHED; PG8_LDA(At, 1, 0); PG8_STAGE(PG8_SA(0, 1), a2, o21);
            PG8_WAIT_V(8); PG8_WAIT_L(0); PG8_BAR; PG8_MMA(0, 0, At, B0); PG8_MMA(0, 1, At, B1); PG8_BAR; PG8_SCHED;
            PG8_LDA(At, 1, 1); PG8_STAGE(PG8_SB(1, 0), b3, voffB); PG8_STAGE(PG8_SB(1, 1), b3 + hstep, voffB); PG8_STAGE(PG8_SA(1, 0), a3, o20);
            PG8_WAIT_V(8); PG8_WAIT_L(0); PG8_BAR; PG8_MMA(1, 0, At, B0); PG8_MMA(1, 1, At, B1); PG8_BAR; PG8_SCHED;
        }
        if (wr == 0) PG8_BAR;
        if constexpr (F8) asm volatile("s_nop 15\n\ts_nop 15" ::: "memory");
        E(acc, cur, wr, wc, fr, fq);
        if (!has_next) break;
#pragma unroll
        for (int a = 0; a < 2; ++a)
#pragma unroll
            for (int b = 0; b < 2; ++b)
#pragma unroll
                for (int m = 0; m < 4; ++m)
#pragma unroll
                    for (int n = 0; n < 2; ++n) acc[a][b][m][n] = (f32x4){0.f, 0.f, 0.f, 0.f};
        cur = nxt; cA = nA; cB = nB; ++ui;
        oc0[0] = on0[0]; oc0[1] = on0[1]; oc1[0] = on1[0]; oc1[1] = on1[1];
        if (wr == 1) PG8_BAR;
    }
    PG8_WAIT_V(0);
    PG8_BAR;
#undef PG8_SA
#undef PG8_SB
#undef PG8_STAGE
#undef PG8_LDA
#undef PG8_LDB
#undef PG8_MMA
#undef PG8_WAIT_V
#undef PG8_WAIT_L
#undef PG8_BAR
#undef PG8_SCHED
}

struct SchedDense {
    const bf16_t* A; const bf16_t* Bt; int nM, nN, G, c;
    __device__ __forceinline__ bool next(int i, GU& u) const {
        int pm, pn; if (!order_next(i, G, c, nM, nN, pm, pn)) return false;
        u.pm = pm; u.pn = pn; u.e = 0; u.mtl = pm; u.A = (const char*)A; u.B = (const char*)Bt + (size_t)pn * (256 * KD * 2); return true;
    }
    __device__ __forceinline__ void a_off(const GU& u, const int (&R)[2], const int (&C)[2], unsigned (&o0)[2], unsigned (&o1)[2]) const {
#pragma unroll
        for (int i = 0; i < 2; ++i) { o0[i] = (unsigned)((u.pm * 256 + R[i]) * KD + C[i]) * 2u; o1[i] = (unsigned)((u.pm * 256 + 128 + R[i]) * KD + C[i]) * 2u; }
    }
};
template <int ROWB>
struct SchedMoe {
    const void* A; const void* Bt; size_t bstride_e;
    const int* list; const LAS int* pts; const LAS int* cntl; const LAS unsigned char* tileE;
    int nM, nN, G, c; bool gather;
    __device__ __forceinline__ bool next(int i, GU& u) const {
        int pm, pn; if (!order_next(i, G, c, nM, nN, pm, pn)) return false;
        const int e = __builtin_amdgcn_readfirstlane((int)tileE[pm]);
        u.pm = pm; u.pn = pn; u.e = e; u.mtl = pm - __builtin_amdgcn_readfirstlane(pts[e]);
        u.A = (const char*)A; u.B = (const char*)Bt + (size_t)e * bstride_e + (size_t)pn * (256 * ROWB); return true;
    }
    __device__ __forceinline__ void a_off(const GU& u, const int (&R)[2], const int (&C)[2], unsigned (&o0)[2], unsigned (&o1)[2]) const {
        if (gather) {
            const int ce = __builtin_amdgcn_readfirstlane(cntl[u.e]);
            const int* lp = list + (size_t)u.e * LISTCAP;
#pragma unroll
            for (int i = 0; i < 2; ++i) {
                int i0 = u.mtl * 256 + R[i], i1 = i0 + 128;
                i0 = i0 < ce ? i0 : 0; i1 = i1 < ce ? i1 : 0;
                const int t0 = lp[i0], t1 = lp[i1];
                o0[i] = (unsigned)(t0 * ROWB + C[i] * 2); o1[i] = (unsigned)(t1 * ROWB + C[i] * 2);
            }
        } else {
#pragma unroll
            for (int i = 0; i < 2; ++i) { o0[i] = (unsigned)((u.pm * 256 + R[i]) * ROWB + C[i] * 2); o1[i] = (unsigned)((u.pm * 256 + 128 + R[i]) * ROWB + C[i] * 2); }
        }
    }
};

__device__ __forceinline__ u32x4 pack8(const f32x4& a, const f32x4& b) { u32x4 w; w.x = cvt_pk_bf16(a[0], a[1]); w.y = cvt_pk_bf16(a[2], a[3]); w.z = cvt_pk_bf16(b[0], b[1]); w.w = cvt_pk_bf16(b[2], b[3]); return w; }

struct EpiInProj {
    static constexpr bool PERM = true;
    bf16_t *QH, *KH, *VH, *OG, *AQ, *AK, *AV; float* GH; const float* lb; const float* bqkv;
    __device__ __forceinline__ void operator()(const f32x4 (&acc)[2][2][4][2], const GU& u, int wr, int wc, int fr, int fq) const {
        const int row0 = u.pm * BM + wr * 64 + fr;
        const int type = u.pn >> 2;
        const int cw = wc * 32 + 8 * fq;
#pragma unroll
        for (int bj = 0; bj < 2; ++bj) {
            const int col = (u.pn & 3) * 256 + bj * HALF + cw;
            if (type == 0 || type == 3) {
                bf16_t* O = (type == 0 ? QH : OG);
#pragma unroll
                for (int ai = 0; ai < 2; ++ai)
#pragma unroll
                    for (int m = 0; m < 4; ++m) { f32x4 v0 = acc[ai][bj][m][0], v1 = acc[ai][bj][m][1];
#pragma unroll
                        for (int j = 0; j < 4; ++j) { v0[j] = v0[j] * sigm(v0[j]); v1[j] = v1[j] * sigm(v1[j]); }
                        *(u32x4*)(O + (size_t)(row0 + ai * HALF + m * 16) * 1024 + col) = pack8(v0, v1); }
            } else if (type == 1) {
                const f32x4 l0 = *(const f32x4*)(lb + col), l1 = *(const f32x4*)(lb + col + 4);
#pragma unroll
                for (int ai = 0; ai < 2; ++ai)
#pragma unroll
                    for (int m = 0; m < 4; ++m) { f32x4 v0 = acc[ai][bj][m][0], v1 = acc[ai][bj][m][1], g0, g1;
#pragma unroll
                        for (int j = 0; j < 4; ++j) { const float s0 = sigm(v0[j]), s1 = sigm(v1[j]);
                            const float f0 = l0[j] + (1.f - l0[j]) * s0, f1 = l1[j] + (1.f - l1[j]) * s1;
                            g0[j] = __log2f(f0); g1[j] = __log2f(f1); }
                        const size_t o = (size_t)(row0 + ai * HALF + m * 16) * 1024 + col;
                        *(f32x4*)(GH + o) = g0; *(f32x4*)(GH + o + 4) = g1; }
            } else if (type == 2) {
#pragma unroll
                for (int ai = 0; ai < 2; ++ai)
#pragma unroll
                    for (int m = 0; m < 4; ++m) *(u32x4*)(VH + (size_t)(row0 + ai * HALF + m * 16) * 1024 + col) = pack8(acc[ai][bj][m][0], acc[ai][bj][m][1]);
            } else if (type == 4) {
                const f32x4 b0 = *(const f32x4*)(bqkv + col), b1 = *(const f32x4*)(bqkv + col + 4);
#pragma unroll
                for (int ai = 0; ai < 2; ++ai)
#pragma unroll
                    for (int m = 0; m < 4; ++m) { const f32x4 v0 = (acc[ai][bj][m][0] + b0) * 0.125f, v1 = (acc[ai][bj][m][1] + b1) * 0.125f;
                        *(u32x4*)(AQ + (size_t)(row0 + ai * HALF + m * 16) * 1024 + col) = pack8(v0, v1); }
            } else {
                bf16_t* O = bj == 0 ? AK : AV;
                const f32x4 b0 = *(const f32x4*)(bqkv + 1024 + bj * 128 + cw), b1 = *(const f32x4*)(bqkv + 1024 + bj * 128 + cw + 4);
#pragma unroll
                for (int ai = 0; ai < 2; ++ai)
#pragma unroll
                    for (int m = 0; m < 4; ++m) *(u32x4*)(O + (size_t)(row0 + ai * HALF + m * 16) * 128 + cw) = pack8(acc[ai][bj][m][0] + b0, acc[ai][bj][m][1] + b1);
            }
        }
    }
};
struct EpiOutProj {
    static constexpr bool PERM = true;
    float* Z; const float* x; const float* stats; const float* lnw; const float* lnb; const float* bo;
    __device__ __forceinline__ void operator()(const f32x4 (&acc)[2][2][4][2], const GU& u, int wr, int wc, int fr, int fq) const {
        const int row0 = u.pm * BM + wr * 64 + fr, col0 = u.pn * BM + wc * 32 + 8 * fq;
        f32x4 w4[2][2], b4[2][2];
#pragma unroll
        for (int bj = 0; bj < 2; ++bj)
#pragma unroll
            for (int n = 0; n < 2; ++n) { const int col = col0 + bj * HALF + n * 4; const f32x4 lw = *(const f32x4*)(lnw + col), lb = *(const f32x4*)(lnb + col), o4 = *(const f32x4*)(bo + col);
                w4[bj][n] = lw * ALPHA; b4[bj][n] = lb * ALPHA + o4; }
#pragma unroll
        for (int ai = 0; ai < 2; ++ai)
#pragma unroll
        for (int mp = 0; mp < 2; ++mp) {
            f32x4 xv[2][2][2]; f32x2 st[2];
#pragma unroll
            for (int mm = 0; mm < 2; ++mm) { const int row = row0 + ai * HALF + (2 * mp + mm) * 16; st[mm] = *(const f32x2*)(stats + 2 * row);
#pragma unroll
                for (int bj = 0; bj < 2; ++bj)
#pragma unroll
                    for (int n = 0; n < 2; ++n) xv[mm][bj][n] = *(const f32x4*)(x + (size_t)row * D + col0 + bj * HALF + n * 4); }
#pragma unroll
            for (int mm = 0; mm < 2; ++mm) { const int m = 2 * mp + mm, row = row0 + ai * HALF + m * 16;
#pragma unroll
                for (int bj = 0; bj < 2; ++bj)
#pragma unroll
                    for (int n = 0; n < 2; ++n) { const f32x4 z = (xv[mm][bj][n] - st[mm].x) * st[mm].y * w4[bj][n] + b4[bj][n] + acc[ai][bj][m][n];
                        *(f32x4*)(Z + (size_t)row * D + col0 + bj * HALF + n * 4) = z; } }
        }
    }
};
struct EpiMoe1 {
    static constexpr bool PERM = true;
    bf16_t* H; const float* bg; const float* bu;
    __device__ __forceinline__ void operator()(const f32x4 (&acc)[2][2][4][2], const GU& u, int wr, int wc, int fr, int fq) const {
        const int row0 = u.pm * BM + wr * 64 + fr, hc = u.pn * 128 + wc * 32 + 8 * fq;
        const float* bgp = bg + (size_t)u.e * FF + hc; const float* bup = bu + (size_t)u.e * FF + hc;
        const f32x4 g0b = *(const f32x4*)bgp, g1b = *(const f32x4*)(bgp + 4), u0b = *(const f32x4*)bup, u1b = *(const f32x4*)(bup + 4);
#pragma unroll
        for (int ai = 0; ai < 2; ++ai)
#pragma unroll
            for (int m = 0; m < 4; ++m) {
                f32x4 a0 = acc[ai][0][m][0] + g0b, a1 = acc[ai][0][m][1] + g1b, c0 = acc[ai][1][m][0] + u0b, c1 = acc[ai][1][m][1] + u1b;
#pragma unroll
                for (int j = 0; j < 4; ++j) {
                    const float gg0 = fminf(a0[j], 7.f), gg1 = fminf(a1[j], 7.f);
                    const float uu0 = fminf(fmaxf(c0[j], -7.f), 7.f), uu1 = fminf(fmaxf(c1[j], -7.f), 7.f);
                    a0[j] = gg0 * sigm(1.702f * gg0) * (uu0 + 1.f); a1[j] = gg1 * sigm(1.702f * gg1) * (uu1 + 1.f);
                }
                *(u32x4*)(H + (size_t)(row0 + ai * HALF + m * 16) * FF + hc) = pack8(a0, a1);
            }
    }
};
__device__ __forceinline__ unsigned pk4_fp8(float a, float b, float c, float d) {
    a = fminf(fmaxf(a, -448.f), 448.f); b = fminf(fmaxf(b, -448.f), 448.f); c = fminf(fmaxf(c, -448.f), 448.f); d = fminf(fmaxf(d, -448.f), 448.f);
    int w = __builtin_amdgcn_cvt_pk_fp8_f32(a, b, 0, false); w = __builtin_amdgcn_cvt_pk_fp8_f32(c, d, w, true); return (unsigned)w;
}
constexpr float SC_H1 = 32.f, SC_WGU = 2048.f, SC_HACT = 8.f, SC_WD = 4096.f;
struct EpiMoe1F8 {
    static constexpr bool PERM = true;
    unsigned char* H; const float* bg; const float* bu;
    __device__ __forceinline__ void operator()(const f32x4 (&acc)[2][2][4][2], const GU& u, int wr, int wc, int fr, int fq) const {
        const int row0 = u.pm * BM + wr * 64 + fr, hc = u.pn * 128 + wc * 32 + 8 * fq;
        const float* bgp = bg + (size_t)u.e * FF + hc; const float* bup = bu + (size_t)u.e * FF + hc;
        const f32x4 g0b = *(const f32x4*)bgp, g1b = *(const f32x4*)(bgp + 4), u0b = *(const f32x4*)bup, u1b = *(const f32x4*)(bup + 4);
        constexpr float IS = 1.f / (SC_H1 * SC_WGU);
#pragma unroll
        for (int ai = 0; ai < 2; ++ai)
#pragma unroll
            for (int m = 0; m < 4; ++m) {
                f32x4 a0 = acc[ai][0][m][0] * IS + g0b, a1 = acc[ai][0][m][1] * IS + g1b, c0 = acc[ai][1][m][0] * IS + u0b, c1 = acc[ai][1][m][1] * IS + u1b;
#pragma unroll
                for (int j = 0; j < 4; ++j) {
                    const float gg0 = fminf(a0[j], 7.f), gg1 = fminf(a1[j], 7.f);
                    const float uu0 = fminf(fmaxf(c0[j], -7.f), 7.f), uu1 = fminf(fmaxf(c1[j], -7.f), 7.f);
                    a0[j] = SC_HACT * gg0 * sigm(1.702f * gg0) * (uu0 + 1.f); a1[j] = SC_HACT * gg1 * sigm(1.702f * gg1) * (uu1 + 1.f);
                }
                u32x2 o; o.x = pk4_fp8(a0[0], a0[1], a0[2], a0[3]); o.y = pk4_fp8(a1[0], a1[1], a1[2], a1[3]);
                *(u32x2*)(H + (size_t)(row0 + ai * HALF + m * 16) * FF + hc) = o;
            }
    }
};
struct EpiMoe2F8 {
    static constexpr bool PERM = true;
    bf16_t* Y; const float* bd;
    __device__ __forceinline__ void operator()(const f32x4 (&acc)[2][2][4][2], const GU& u, int wr, int wc, int fr, int fq) const {
        const int row0 = u.pm * BM + wr * 64 + fr, col0 = u.pn * BM + wc * 32 + 8 * fq;
        const float* bp = bd + (size_t)u.e * D + col0;
        constexpr float IS = 1.f / (SC_HACT * SC_WD);
#pragma unroll
        for (int bj = 0; bj < 2; ++bj) {
            const f32x4 b0 = *(const f32x4*)(bp + bj * HALF), b1 = *(const f32x4*)(bp + bj * HALF + 4);
#pragma unroll
            for (int ai = 0; ai < 2; ++ai)
#pragma unroll
                for (int m = 0; m < 4; ++m) *(u32x4*)(Y + (size_t)(row0 + ai * HALF + m * 16) * D + col0 + bj * HALF) = pack8(acc[ai][bj][m][0] * IS + b0, acc[ai][bj][m][1] * IS + b1);
        }
    }
};
struct EpiMoe2 {
    static constexpr bool PERM = true;
    bf16_t* Y; const float* bd;
    __device__ __forceinline__ void operator()(const f32x4 (&acc)[2][2][4][2], const GU& u, int wr, int wc, int fr, int fq) const {
        const int row0 = u.pm * BM + wr * 64 + fr, col0 = u.pn * BM + wc * 32 + 8 * fq;
        const float* bp = bd + (size_t)u.e * D + col0;
#pragma unroll
        for (int bj = 0; bj < 2; ++bj) {
            const f32x4 b0 = *(const f32x4*)(bp + bj * HALF), b1 = *(const f32x4*)(bp + bj * HALF + 4);
#pragma unroll
            for (int ai = 0; ai < 2; ++ai)
#pragma unroll
                for (int m = 0; m < 4; ++m) *(u32x4*)(Y + (size_t)(row0 + ai * HALF + m * 16) * D + col0 + bj * HALF) = pack8(acc[ai][bj][m][0] + b0, acc[ai][bj][m][1] + b1);
        }
    }
};

struct Args { const float* in[23]; float* out; unsigned char* ws; int ph_lo, ph_hi; };
struct Frame { LAS unsigned char* lds; int tid, lane, wave, G, vcu; unsigned char* ws; };

__device__ __forceinline__ void p0_transpose_item(const float* W, int N, int k0, int n0, bf16_t* WT_row0  , LAS float* scr, int lane) {
#pragma unroll 8
    for (int i = 0; i < 32; ++i) { const int kk = 2 * i + (lane >> 5); scr[kk * 33 + (lane & 31)] = W[(size_t)(k0 + kk) * N + n0 + (lane & 31)]; }
    asm volatile("s_waitcnt lgkmcnt(0)" ::: "memory");
    const int c = lane & 7;
#pragma unroll
    for (int j = 0; j < 4; ++j) { const int n = (lane >> 3) + 8 * j; const LAS float* s = scr + (8 * c) * 33 + n;
        u32x4 o; o.x = pk2(s[0 * 33], s[1 * 33]); o.y = pk2(s[2 * 33], s[3 * 33]); o.z = pk2(s[4 * 33], s[5 * 33]); o.w = pk2(s[6 * 33], s[7 * 33]);
        *(GAS u32x4*)(WT_row0 + (size_t)n * KD + k0 + 8 * c) = o; }
    asm volatile("s_waitcnt lgkmcnt(0)" ::: "memory");
}

__device__ __forceinline__ void p0_transpose_item_f8(const float* W, int N, int k0, int n0, unsigned char* WT_row0, float sc, LAS float* scr, int lane) {
#pragma unroll 8
    for (int i = 0; i < 32; ++i) { const int kk = 2 * i + (lane >> 5); scr[kk * 33 + (lane & 31)] = W[(size_t)(k0 + kk) * N + n0 + (lane & 31)]; }
    asm volatile("s_waitcnt lgkmcnt(0)" ::: "memory");
    const int c = lane & 3;
#pragma unroll
    for (int j = 0; j < 2; ++j) { const int n = (lane >> 2) + 16 * j; const LAS float* sp = scr + (16 * c) * 33 + n;
        u32x4 o;
        o.x = pk4_fp8(sp[0 * 33] * sc, sp[1 * 33] * sc, sp[2 * 33] * sc, sp[3 * 33] * sc); o.y = pk4_fp8(sp[4 * 33] * sc, sp[5 * 33] * sc, sp[6 * 33] * sc, sp[7 * 33] * sc);
        o.z = pk4_fp8(sp[8 * 33] * sc, sp[9 * 33] * sc, sp[10 * 33] * sc, sp[11 * 33] * sc); o.w = pk4_fp8(sp[12 * 33] * sc, sp[13 * 33] * sc, sp[14 * 33] * sc, sp[15 * 33] * sc);
        *(GAS u32x4*)(WT_row0 + (size_t)n * KD + k0 + 16 * c) = o; }
    asm volatile("s_waitcnt lgkmcnt(0)" ::: "memory");
}
__device__ __forceinline__ void p0_prologue(Frame& F, const Args& a) {
    LAS float* scr = (LAS float*)(F.lds + F.wave * 16384);
    const int gw = F.vcu * NWAVES + F.wave, NGW = F.G * NWAVES;
    unsigned char* ws = F.ws;
    for (int i = gw * 64 + F.lane; i < NE * D; i += NGW * 64) { const int e = i >> 11, k = i & 2047; const float v = a.in[13][(size_t)k * NE + e];
        const unsigned hb = f2bf(v); const float hf = __builtin_bit_cast(float, hb << 16);
        ((bf16_t*)(ws + WS_WRH))[i] = (bf16_t)hb; ((bf16_t*)(ws + WS_WRL))[i] = (bf16_t)f2bf(v - hf); }
    if (gw < 16) { const int i = gw * 64 + F.lane; const float* lbl = a.in[5]; const float l0 = lbl[i], l1 = lbl[1024 + i]; const float mx = fmaxf(l0, l1); const float e0 = __expf(l0 - mx), e1 = __expf(l1 - mx);
        ((float*)(ws + WS_LB))[i] = e0 / (e0 + e1); }
    {
        const float* x = a.in[0]; const float* w = a.in[1]; const float* b = a.in[2];
        bf16_t* H0 = (bf16_t*)(ws + WS_H0); float* st = (float*)(ws + WS_STATS0);
        for (int m = gw; m < T; m += NGW) {
            const GAS f32x4* xr = (const GAS f32x4*)(x + (size_t)m * D) + F.lane;
            f32x4 v[8]; float s = 0.f;
#pragma unroll
            for (int j = 0; j < 8; ++j) { v[j] = xr[64 * j]; s += (v[j][0] + v[j][1]) + (v[j][2] + v[j][3]); }
            const float mean = wave_sum(s) * (1.f / D); float s2 = 0.f;
#pragma unroll
            for (int j = 0; j < 8; ++j) { v[j] = v[j] - mean; s2 += (v[j][0] * v[j][0] + v[j][1] * v[j][1]) + (v[j][2] * v[j][2] + v[j][3] * v[j][3]); }
            const float rstd = rsqrtf(wave_sum(s2) * (1.f / D) + EPS);
            if (F.lane == 0) { st[2 * m] = mean; st[2 * m + 1] = rstd; }
            GAS u32x2* o8 = (GAS u32x2*)(H0 + (size_t)m * D) + F.lane;
#pragma unroll
            for (int j = 0; j < 8; ++j) { const f32x4 ww = *((const f32x4*)w + F.lane + 64 * j), bb = *((const f32x4*)b + F.lane + 64 * j);
                u32x2 o; o.x = pk2(v[j][0] * rstd * ww[0] + bb[0], v[j][1] * rstd * ww[1] + bb[1]); o.y = pk2(v[j][2] * rstd * ww[2] + bb[2], v[j][3] * rstd * ww[3] + bb[3]); o8[64 * j] = o; }
        }
    }
    constexpr int I_IN = 32 * (INC / 32), I_OUT = 32 * 64;
    constexpr int NITEMS = I_IN + I_OUT;
    for (int it = gw; it < NITEMS; it += NGW) {
        int r = it;
        if (r < I_IN) { const int nb = INC / 32, kb = r / nb, n0 = 32 * (r % nb); p0_transpose_item(a.in[3], INC, 64 * kb, n0, (bf16_t*)(ws + WS_WIN) + (size_t)n0 * KD, scr, F.lane); continue; } r -= I_IN;
        { const int kb = r / 64, n0 = 32 * (r % 64); p0_transpose_item(a.in[9], D, 64 * kb, n0, (bf16_t*)(ws + WS_WOUT) + (size_t)n0 * KD, scr, F.lane); }
    }
}

constexpr int CT_TILES = NE * 3 * 32 * 16, CT_RUN = 8;
constexpr int LC_CTB = 1024;
__device__ __forceinline__ void ct_src(const Args& a, unsigned char* ws, int id, const float*& W, unsigned char*& dst, float& sc, int& k0) {
    const int e = id / 1536, r = id - e * 1536, which = r >> 9, r2 = r & 511, kb = r2 >> 4, nb = r2 & 15;
    k0 = kb * 64;
    if (which < 2) { W = a.in[which == 0 ? 15 : 17] + (size_t)e * D * FF + nb * 128; dst = ws + WS_WGU + ((size_t)e * 4096 + (size_t)nb * 256 + which * 128) * KD; sc = SC_WGU; }
    else { W = a.in[19] + (size_t)e * FF * D + nb * 128; dst = ws + WS_WD + ((size_t)e * 2048 + (size_t)nb * 128) * KD; sc = SC_WD; }
}
__device__ __forceinline__ void cv_worker(Frame& F, const Args& a, const unsigned* stop_ctr, unsigned stop_at) {
    const int tid = F.tid, lane = F.lane, wv = F.wave;
    LAS unsigned char* ring = F.lds;
    volatile LAS int* ctb = (volatile LAS int*)(F.lds + LDSCTL_OFF + LC_CTB);
    unsigned* head = (unsigned*)(F.ws + WS_CTL) + CW_CONV;
    unsigned srcoff[4];
#pragma unroll
    for (int p = 0; p < 4; ++p) { const int row = 2 * (4 * wv + p) + (lane >> 5); srcoff[p] = (unsigned)(row * 2048 + 4 * ((lane & 31) ^ (2 * ((row >> 4) & 3)))); }
    const int on = tid >> 2, oc = tid & 3;
    const int rdoff = (16 * oc) * 128 * 4 + ((((on >> 2) ^ (2 * oc)) << 2) + (on & 3)) * 4;
#define CT_CLAIM(slotw) do { if (tid == 0) { int b_ = CT_TILES; if (!(stop_ctr && __hip_atomic_load(stop_ctr, RLX_AGENT) >= stop_at)) b_ = (int)__hip_atomic_fetch_add(head, (unsigned)CT_RUN, RLX_AGENT); ctb[slotw] = b_; } } while (0)
#define CT_DMA(id_, slot_) do { const float* W_; unsigned char* d_; float s_; int k_; ct_src(a, F.ws, (id_), W_, d_, s_, k_); const float* sp_ = W_ + (size_t)k_ * 2048; \
        _Pragma("unroll") for (int p = 0; p < 4; ++p) __builtin_amdgcn_global_load_lds((const unsigned*)(sp_ + srcoff[p]), (LAS unsigned*)(ring + (slot_) * 32768 + (4 * wv + p) * 1024), 16, 0, 0); } while (0)
    __syncthreads();
    CT_CLAIM(0);
    __syncthreads();
    int base = ctb[0];
    int issued = 0;
    bool more = base < CT_TILES;
#pragma unroll 1
    for (int i = 0; i < 3; ++i) { if (more) { CT_DMA(base + (issued & (CT_RUN - 1)), issued & 3); } ++issued; }
    int pbase = base;
    for (int k = 0; ; ++k) {
        if (((k + 3) & (CT_RUN - 1)) == 0) CT_CLAIM(((k + 3) / CT_RUN) & 1);
        if (pbase >= CT_TILES) break;
        asm volatile("s_waitcnt vmcnt(8)" ::: "memory");
        if (!more) asm volatile("s_waitcnt vmcnt(0)" ::: "memory");
        __syncthreads();
        {
            const float* W_; unsigned char* dst; float sc; int k0; ct_src(a, F.ws, pbase + (k & (CT_RUN - 1)), W_, dst, sc, k0);
            const LAS float* sp = (const LAS float*)(ring + (k & 3) * 32768 + rdoff);
            u32x4 o;
            o.x = pk4_fp8(sp[0 * 128] * sc, sp[1 * 128] * sc, sp[2 * 128] * sc, sp[3 * 128] * sc); o.y = pk4_fp8(sp[4 * 128] * sc, sp[5 * 128] * sc, sp[6 * 128] * sc, sp[7 * 128] * sc);
            o.z = pk4_fp8(sp[8 * 128] * sc, sp[9 * 128] * sc, sp[10 * 128] * sc, sp[11 * 128] * sc); o.w = pk4_fp8(sp[12 * 128] * sc, sp[13 * 128] * sc, sp[14 * 128] * sc, sp[15 * 128] * sc);
            *(GAS u32x4*)(dst + (size_t)on * KD + k0 + 16 * oc) = o;
            asm volatile("s_waitcnt lgkmcnt(0)" ::: "memory");
        }
        if (((k + 3) & (CT_RUN - 1)) == 0) { base = ctb[((k + 3) / CT_RUN) & 1]; more = base < CT_TILES; }
        if (more) { CT_DMA(base + ((k + 3) & (CT_RUN - 1)), (k + 3) & 3); }
        if (((k + 1) & (CT_RUN - 1)) == 0) pbase = ctb[((k + 1) / CT_RUN) & 1];
    }
    asm volatile("s_waitcnt vmcnt(0)" ::: "memory");
    __syncthreads();
#undef CT_CLAIM
#undef CT_DMA
}

constexpr int HG_TT = 16;
__device__ __forceinline__ void hgrn_unit(Frame& F, const Args& a, int b, int h) {
    LAS float* fS = (LAS float*)F.lds; LAS float* kS = fS + HG_TT * 128; LAS float* qS = kS + HG_TT * 128; LAS float* vS = qS + HG_TT * 128; LAS float* oS = vS + HG_TT * 128;
    const bf16_t* QH = (const bf16_t*)(F.ws + WS_QH); const bf16_t* KH = (const bf16_t*)(F.ws + WS_KH); const bf16_t* VH = (const bf16_t*)(F.ws + WS_VH); const bf16_t* OG = (const bf16_t*)(F.ws + WS_OG);
    const float* GH = (const float*)(F.ws + WS_GH);
    bf16_t* YM = (bf16_t*)(F.ws + WS_YMIX);
    const int tid = F.tid, kg = tid & 3, col = tid >> 2;
    float S[32];
#pragma unroll
    for (int i = 0; i < 32; ++i) S[i] = 0.f;
    for (int t0 = 0; t0 < L; t0 += HG_TT) {
        __syncthreads();
        for (int i = tid; i < HG_TT * 128; i += NTHR) {
            const int tt = i >> 7, k = i & 127; const size_t o = (size_t)(b * L + t0 + tt) * 1024 + h * 128 + k;
            fS[i] = __expf(GH[o]); kS[i] = bf2f(KH[o]); qS[i] = bf2f(QH[o]); vS[i] = bf2f(VH[o]);
        }
        __syncthreads();
        for (int tt = 0; tt < HG_TT; ++tt) {
            const float v = vS[tt * 128 + col];
            float o = 0.f;
#pragma unroll
            for (int i = 0; i < 32; ++i) { const int k = kg * 32 + i; S[i] = fS[tt * 128 + k] * S[i] + kS[tt * 128 + k] * v; o += S[i] * qS[tt * 128 + k]; }
            o += __shfl_xor(o, 1); o += __shfl_xor(o, 2);
            if (kg == 0) oS[tt * 128 + col] = o;
        }
        __syncthreads();
#pragma unroll
        for (int q = 0; q < 2; ++q) {
            const int tt = F.wave * 2 + q;
            const float a0 = oS[tt * 128 + F.lane], a1 = oS[tt * 128 + 64 + F.lane];
            const float r = rsqrtf(wave_sum(a0 * a0 + a1 * a1) * (1.f / 128.f) + EPS);
            const size_t o = (size_t)(b * L + t0 + tt) * 1024 + h * 128;
            const float* nw = a.in[6];
            const float g0 = bf2f(OG[o + F.lane]), g1 = bf2f(OG[o + 64 + F.lane]);
            YM[(size_t)(b * L + t0 + tt) * D + h * 128 + F.lane] = (bf16_t)f2bf(a0 * r * nw[F.lane] * g0);
            YM[(size_t)(b * L + t0 + tt) * D + h * 128 + 64 + F.lane] = (bf16_t)f2bf(a1 * r * nw[64 + F.lane] * g1);
        }
    }
}
constexpr int AT_Q = 32, AT_ROWS = AT_Q + 127, AT_LD = 66;
__device__ __forceinline__ void attn_unit(Frame& F, const Args& a, int b, int qt) {
    LAS unsigned short* Ks = (LAS unsigned short*)F.lds;
    LAS unsigned short* Vs = Ks + 2 * AT_ROWS * AT_LD;
    LAS float* ssq = (LAS float*)(Vs + 2 * AT_ROWS * AT_LD);
    const bf16_t* AQ = (const bf16_t*)(F.ws + WS_AQ); const bf16_t* AK = (const bf16_t*)(F.ws + WS_AK); const bf16_t* AV = (const bf16_t*)(F.ws + WS_AV);
    bf16_t* YM = (bf16_t*)(F.ws + WS_YMIX);
    const int tid = F.tid, t0 = qt * AT_Q;
    __syncthreads();
    for (int i = tid; i < 2 * AT_ROWS * 32; i += NTHR) {
        const int dw = i & 31, r = (i >> 5) % AT_ROWS, kvh = (i >> 5) / AT_ROWS;
        const int pos = t0 - 127 + r;
        unsigned kv = 0u, vv = 0u;
        if (pos >= 0) { const size_t o = (size_t)(b * L + pos) * 128 + kvh * 64 + dw * 2; kv = *(const unsigned*)(AK + o); vv = *(const unsigned*)(AV + o); }
        *(LAS unsigned*)(Ks + (kvh * AT_ROWS + r) * AT_LD + dw * 2) = kv; *(LAS unsigned*)(Vs + (kvh * AT_ROWS + r) * AT_LD + dw * 2) = vv;
    }
    __syncthreads();
    const int qi = tid & 31, head = tid >> 5, kvh = head >> 3;
    const int qpos = t0 + qi;
    float q[64], acc[64];
    { const u32x4* qp = (const u32x4*)(AQ + (size_t)(b * L + qpos) * 1024 + head * 64);
#pragma unroll
      for (int c = 0; c < 8; ++c) { const u32x4 w = qp[c];
#pragma unroll
          for (int j = 0; j < 4; ++j) { q[c * 8 + 2 * j] = bflo(w[j]); q[c * 8 + 2 * j + 1] = bfhi(w[j]); } }
#pragma unroll
      for (int d = 0; d < 64; ++d) acc[d] = 0.f; }
    float m = a.in[7][head], l = 1.f;
    for (int j = 0; j < 128; ++j) {
        const int r = qi + j, kpos = qpos - 127 + j;
        if (kpos < 0) continue;
        const LAS unsigned* kr = (const LAS unsigned*)(Ks + (kvh * AT_ROWS + r) * AT_LD);
        float s = 0.f;
#pragma unroll
        for (int d = 0; d < 32; ++d) { const unsigned w = kr[d]; s = fmaf(q[2 * d], bflo(w), s); s = fmaf(q[2 * d + 1], bfhi(w), s); }
        const float mn = fmaxf(m, s); const float sc = __expf(m - mn), p = __expf(s - mn);
        l = l * sc + p;
        const LAS unsigned* vr = (const LAS unsigned*)(Vs + (kvh * AT_ROWS + r) * AT_LD);
#pragma unroll
        for (int d = 0; d < 32; ++d) { const unsigned w = vr[d]; acc[2 * d] = acc[2 * d] * sc + p * bflo(w); acc[2 * d + 1] = acc[2 * d + 1] * sc + p * bfhi(w); }
        m = mn;
    }
    const float inv = 1.f / l; float ss = 0.f;
#pragma unroll
    for (int d = 0; d < 64; ++d) { acc[d] *= inv; ss += acc[d] * acc[d]; }
    ssq[qi * 16 + head] = ss;
    __syncthreads();
    float tot = 0.f;
#pragma unroll
    for (int hh = 0; hh < 16; ++hh) tot += ssq[qi * 16 + hh];
    const float rr = rsqrtf(tot * (1.f / 1024.f) + EPS);
    const float* nw = a.in[8] + head * 64;
    u32x4* op = (u32x4*)(YM + (size_t)(b * L + qpos) * D + 1024 + head * 64);
#pragma unroll
    for (int c = 0; c < 8; ++c) { u32x4 w;
#pragma unroll
        for (int j = 0; j < 4; ++j) w[j] = pk2(acc[c * 8 + 2 * j] * rr * nw[c * 8 + 2 * j], acc[c * 8 + 2 * j + 1] * rr * nw[c * 8 + 2 * j + 1]);
        op[c] = w; }
}

typedef float f32x16 __attribute__((ext_vector_type(16)));
typedef short s16x4 __attribute__((ext_vector_type(4)));
typedef short v4i16_t __attribute__((ext_vector_type(4)));
__device__ __forceinline__ s16x4 lds_tr16(const LAS unsigned char* p) { return __builtin_bit_cast(s16x4, __builtin_amdgcn_ds_read_tr16_b64_v4i16((LAS v4i16_t*)p)); }
__device__ __forceinline__ void attn_unit_mfma(Frame& F, const Args& a, int b, int qt) {
    LAS unsigned char* KS = F.lds;
    LAS unsigned char* VS = F.lds + 40960;
    LAS float* SSQ = (LAS float*)(F.lds + 81920);
    const bf16_t* AQ = (const bf16_t*)(F.ws + WS_AQ); const bf16_t* AK = (const bf16_t*)(F.ws + WS_AK); const bf16_t* AV = (const bf16_t*)(F.ws + WS_AV);
    bf16_t* YM = (bf16_t*)(F.ws + WS_YMIX);
    const int tid = F.tid, lane = F.lane, w = F.wave, r32 = lane & 31, hi = lane >> 5, t0 = qt * 32;
    __syncthreads();
#pragma unroll
    for (int p = 0; p < 5; ++p) {
        const int c = p * 512 + tid, row = c >> 4, ch = c & 15, kvh = ch >> 3, cr = ch & 7;
        const int pos = t0 - 128 + row;
        u32x4 kv = (u32x4){0u, 0u, 0u, 0u}, vv = (u32x4){0u, 0u, 0u, 0u};
        if (pos >= 0) { const size_t o = (size_t)(b * L + pos) * 128 + kvh * 64 + cr * 8; kv = *(const u32x4*)(AK + o); vv = *(const u32x4*)(AV + o); }
        *(LAS u32x4*)(KS + kvh * 20480 + row * 128 + ((cr ^ ((row >> 1) & 7)) << 4)) = kv;
        *(LAS u32x4*)(VS + kvh * 20480 + row * 128 + (((cr >> 2) ^ ((row >> 1) & 1)) << 6) + ((cr & 3) << 4)) = vv;
    }
    __syncthreads();
    const int kvh = w >> 2;
    const int ktmin = t0 < 128 ? (128 - t0) >> 5 : 0;
    const LAS unsigned char* Kb = KS + kvh * 20480;
    const LAS unsigned char* Vb = VS + kvh * 20480;
    unsigned OP[2][2][8];
    float ssq = 0.f;
#pragma unroll
    for (int hh = 0; hh < 2; ++hh) {
        const int head = 2 * w + hh;
        bf16x8 qf[4];
#pragma unroll
        for (int ks = 0; ks < 4; ++ks) qf[ks] = *(const bf16x8*)(AQ + (size_t)(b * L + t0 + r32) * 1024 + head * 64 + ks * 16 + hi * 8);
        f32x16 S[5];
#pragma unroll
        for (int kt = 0; kt < 5; ++kt) {
            const int row = kt * 32 + r32;
            f32x16 acc = (f32x16){0.f, 0.f, 0.f, 0.f, 0.f, 0.f, 0.f, 0.f, 0.f, 0.f, 0.f, 0.f, 0.f, 0.f, 0.f, 0.f};
#pragma unroll
            for (int ks = 0; ks < 4; ++ks) {
                const bf16x8 kf = *(const LAS bf16x8*)(Kb + row * 128 + (((2 * ks + hi) ^ ((row >> 1) & 7)) << 4));
                acc = __builtin_amdgcn_mfma_f32_32x32x16_bf16(kf, qf[ks], acc, 0, 0, 0);
            }
            S[kt] = acc;
        }
        const float sink = a.in[7][head];
        float m = sink;
#pragma unroll
        for (int kt = 0; kt < 5; ++kt)
#pragma unroll
            for (int r = 0; r < 16; ++r) {
                const int i = (r & 3) + 8 * (r >> 2) + 4 * hi;
                bool ok = kt >= ktmin;
                if (kt == 0) ok = ok && (i > r32);
                if (kt == 4) ok = ok && (i <= r32);
                const float v = ok ? S[kt][r] : -INFINITY;
                S[kt][r] = v; m = fmaxf(m, v);
            }
        m = fmaxf(m, __shfl_xor(m, 32));
        float l = 0.f;
#pragma unroll
        for (int kt = 0; kt < 5; ++kt)
#pragma unroll
            for (int r = 0; r < 16; ++r) { const float pv = __expf(S[kt][r] - m); S[kt][r] = pv; l += pv; }
        l += __shfl_xor(l, 32);
        l += __expf(sink - m);
        const float inv = 1.f / l;
#pragma unroll
        for (int dt = 0; dt < 2; ++dt) {
            f32x16 acc = (f32x16){0.f, 0.f, 0.f, 0.f, 0.f, 0.f, 0.f, 0.f, 0.f, 0.f, 0.f, 0.f, 0.f, 0.f, 0.f, 0.f};
            const int dcol = dt * 32 + 16 * ((lane >> 4) & 1) + 4 * (lane & 3);
            const int vlane = ((lane & 15) >> 2) * 128 + ((((dcol >> 5) ^ ((lane >> 3) & 1))) << 6) + (dcol & 31) * 2;
#pragma unroll
            for (int kt = 0; kt < 5; ++kt)
#pragma unroll
                for (int s2 = 0; s2 < 2; ++s2) {
                    const int rowb = kt * 32 + 16 * s2 + 4 * hi;
                    const s16x4 lo = lds_tr16(Vb + rowb * 128 + vlane), hi4 = lds_tr16(Vb + (rowb + 8) * 128 + vlane);
                    const bf16x8 vf = (bf16x8){lo[0], lo[1], lo[2], lo[3], hi4[0], hi4[1], hi4[2], hi4[3]};
                    u32x4 pw; pw.x = cvt_pk_bf16(S[kt][8 * s2 + 0], S[kt][8 * s2 + 1]); pw.y = cvt_pk_bf16(S[kt][8 * s2 + 2], S[kt][8 * s2 + 3]);
                    pw.z = cvt_pk_bf16(S[kt][8 * s2 + 4], S[kt][8 * s2 + 5]); pw.w = cvt_pk_bf16(S[kt][8 * s2 + 6], S[kt][8 * s2 + 7]);
                    acc = __builtin_amdgcn_mfma_f32_32x32x16_bf16(vf, __builtin_bit_cast(bf16x8, pw), acc, 0, 0, 0);
                }
#pragma unroll
            for (int r = 0; r < 16; ++r) { acc[r] *= inv; ssq += acc[r] * acc[r]; }
#pragma unroll
            for (int r = 0; r < 8; ++r) OP[hh][dt][r] = cvt_pk_bf16(acc[2 * r], acc[2 * r + 1]);
        }
    }
    ssq += __shfl_xor(ssq, 32);
    if (hi == 0) SSQ[w * 32 + r32] = ssq;
    __syncthreads();
    float tot = 0.f;
#pragma unroll
    for (int ww = 0; ww < 8; ++ww) tot += SSQ[ww * 32 + r32];
    const float rr = rsqrtf(tot * (1.f / 1024.f) + EPS);
    const float* nwp = a.in[8];
#pragma unroll
    for (int hh = 0; hh < 2; ++hh)
#pragma unroll
        for (int dt = 0; dt < 2; ++dt)
#pragma unroll
            for (int g4 = 0; g4 < 4; ++g4) {
                const int d = (2 * w + hh) * 64 + dt * 32 + 8 * g4 + 4 * hi;
                const f32x4 nw4 = *(const f32x4*)(nwp + d);
                const unsigned p0 = OP[hh][dt][2 * g4], p1 = OP[hh][dt][2 * g4 + 1];
                u32x2 o; o.x = pk2(bflo(p0) * rr * nw4[0], bfhi(p0) * rr * nw4[1]); o.y = pk2(bflo(p1) * rr * nw4[2], bfhi(p1) * rr * nw4[3]);
                *(u32x2*)(YM + (size_t)(b * L + t0 + r32) * D + 1024 + d) = o;
            }
}

constexpr int HL_QM = 0, HL_KM = 16384, HL_QS = 32768, HL_KE = 49152, HL_VT = 65536, HL_PL = 81920, HL_SEG = 90112, HL_DS = 94208, HL_SSQ = 94720;
__device__ __forceinline__ int trkey(int s) { return (s & 3) | (((s >> 3) & 1) << 2); }
__device__ __forceinline__ bf16x8 mk8(const s16x4& lo, const s16x4& hi) { return (bf16x8){lo[0], lo[1], lo[2], lo[3], hi[0], hi[1], hi[2], hi[3]}; }
__device__ __forceinline__ void hgrn_unit_mfma(Frame& F, const Args& a, int b, int h) {
    LAS unsigned char* lds = F.lds;
    const bf16_t* QH = (const bf16_t*)(F.ws + WS_QH); const bf16_t* VH = (const bf16_t*)(F.ws + WS_VH); const bf16_t* OG = (const bf16_t*)(F.ws + WS_OG);
    const float* GH = (const float*)(F.ws + WS_GH);
    bf16_t* YM = (bf16_t*)(F.ws + WS_YMIX);
    const int tid = F.tid, lane = F.lane, w = F.wave, r16 = lane & 15, g = lane >> 4, cp = lane;
    const size_t tokb = (size_t)b * L;
    const int hc = h * 128;
    f32x4 Sacc[8];
#pragma unroll
    for (int i = 0; i < 8; ++i) Sacc[i] = (f32x4){0.f, 0.f, 0.f, 0.f};
    f32x2 gpre[8]; unsigned qpre[8]; u32x4 vpre[2];
    const int vrow = tid >> 3, vc16 = tid & 7;
    const unsigned lo_g = 2u * (unsigned)cp, lo_v = (unsigned)(vrow * 1024 + vc16 * 8), lo_og = (unsigned)(r16 * 1024 + 4 * g), lo_ym = (unsigned)(r16 * 2048 + 4 * g);
    {
        const size_t rb = (tokb + 8 * w) * 1024 + hc;
        const float* gb = GH + rb; const bf16_t* qb = QH + rb; const bf16_t* vb = VH + tokb * 1024 + hc;
#pragma unroll
        for (int i = 0; i < 8; ++i) { gpre[i] = *(const f32x2*)(gb + i * 1024 + lo_g); qpre[i] = *(const unsigned*)(qb + i * 1024 + lo_g); }
        vpre[0] = *(const u32x4*)(vb + lo_v); vpre[1] = *(const u32x4*)(vb + 64 + lo_v);
    }
    const int keyl = ((lane & 15) >> 2) | ((g & 1) << 2);
    const int trrow = (8 * g + ((lane & 15) >> 2)) * 256 + 8 * (lane & 3);
    const unsigned wpar = (unsigned)(w & 1);
    const unsigned A1 = (((unsigned)cp >> 2) ^ (8u * wpar)) << 4, C1 = ((unsigned)cp & 3u) * 4u + (unsigned)w * 2048u;
    const unsigned A2 = (((unsigned)cp >> 1) ^ (16u * wpar)) << 3, C2 = ((unsigned)cp & 1u) * 4u + (unsigned)w * 2048u;
    const unsigned A3 = (((unsigned)cp >> 3) ^ (wpar << 2)) << 5, C3 = ((unsigned)cp & 7u) * 4u + (unsigned)w * 2048u;
    __syncthreads();
    for (int c = 0; c < L / 64; ++c) {
        int cc = c; asm volatile("" : "+s"(cc));
        const size_t tok0 = tokb + 64 * cc;
        { float run0 = 0.f, run1 = 0.f;
#pragma unroll
          for (int i = 0; i < 8; ++i) { run0 += gpre[i].x; run1 += gpre[i].y; }
          *(LAS f32x2*)(lds + HL_SEG + (w * 128 + 2 * cp) * 4) = (f32x2){run0, run1}; }
        { const int k0 = trkey(vrow);
          *(LAS u32x4*)(lds + HL_VT + vrow * 256 + ((((vc16 >> 1)) ^ k0) << 5) + (vc16 & 1) * 16) = vpre[0];
          *(LAS u32x4*)(lds + HL_VT + vrow * 256 + (((((vc16 + 8) >> 1)) ^ k0) << 5) + (vc16 & 1) * 16) = vpre[1]; }
        __syncthreads();
        f32x2 offc = (f32x2){0.f, 0.f}, rr = (f32x2){0.f, 0.f}, tot = (f32x2){0.f, 0.f};
#pragma unroll
        for (int sg = 0; sg < 8; ++sg) { const f32x2 sv = *(const LAS f32x2*)(lds + HL_SEG + (sg * 128 + 2 * cp) * 4);
            if (sg < w) offc += sv; if (sg < 4) rr += sv; tot += sv; }
        const f32x2 Rc = (f32x2){__builtin_amdgcn_exp2f(rr.x), __builtin_amdgcn_exp2f(rr.y)};
        const f32x2 C4 = (f32x2){__builtin_amdgcn_exp2f(tot.x - rr.x), __builtin_amdgcn_exp2f(tot.y - rr.y)};
        if (w == 0) *(LAS f32x2*)(lds + HL_DS + 2 * cp * 4) = (f32x2){__builtin_amdgcn_exp2f(tot.x), __builtin_amdgcn_exp2f(tot.y)};
#pragma unroll
        for (int i = 0; i < 8; ++i) {
            offc += gpre[i];
            const f32x2 d = offc - rr;
            const float E0 = __builtin_amdgcn_exp2f(fminf(fmaxf(d.x, -115.f), 115.f)), E1 = __builtin_amdgcn_exp2f(fminf(fmaxf(d.y, -115.f), 115.f));
            const float I0 = __builtin_amdgcn_rcpf(E0), I1 = __builtin_amdgcn_rcpf(E1);
            const float k0 = 1.f - __builtin_amdgcn_exp2f(gpre[i].x), k1 = 1.f - __builtin_amdgcn_exp2f(gpre[i].y);
            const f32x2 qm = (f32x2){bflo(qpre[i]) * E0, bfhi(qpre[i]) * E1}, km = (f32x2){k0 * I0, k1 * I1};
            const f32x2 qs = qm * Rc, ke = km * C4;
            LAS unsigned char* pq = lds + i * 256 + ((A1 ^ (unsigned)(i << 4)) + C1);
            *(LAS unsigned*)(pq + HL_QM) = cvt_pk_bf16_c(qm.x, qm.y);
            *(LAS unsigned*)(pq + HL_KM) = cvt_pk_bf16_c(km.x, km.y);
            *(LAS unsigned*)(lds + HL_QS + i * 256 + ((A2 ^ (unsigned)(i << 4)) + C2)) = cvt_pk_bf16_c(qs.x, qs.y);
            *(LAS unsigned*)(lds + HL_KE + i * 256 + ((A3 ^ (unsigned)((i & 3) << 5)) + C3)) = cvt_pk_bf16_c(ke.x, ke.y);
        }
        if (c + 1 < L / 64) {
            const size_t rb = (tok0 + 64 + 8 * w) * 1024 + hc;
            const float* gb = GH + rb; const bf16_t* qb = QH + rb; const bf16_t* vb = VH + (tok0 + 64) * 1024 + hc;
#pragma unroll
            for (int i = 0; i < 8; ++i) { gpre[i] = *(const f32x2*)(gb + i * 1024 + lo_g); qpre[i] = *(const unsigned*)(qb + i * 1024 + lo_g); }
            vpre[0] = *(const u32x4*)(vb + lo_v); vpre[1] = *(const u32x4*)(vb + 64 + lo_v);
        }
        __syncthreads();
#pragma unroll
        for (int rep = 0; rep < 2; ++rep) {
            if (rep == 1 && w >= 4) break;
            const int idx = rep == 0 ? w : 8 + w;
            const int si = (0xd940e4 >> (2 * idx)) & 3, ti = (0x8fb9e4 >> (2 * idx)) & 3;
            f32x4 pacc = (f32x4){0.f, 0.f, 0.f, 0.f};
            if (idx < 10) {
#pragma unroll
                for (int ks = 0; ks < 4; ++ks) {
                    const int ofs = r16 * 256 + (((4 * ks + g) ^ r16) << 4);
                    const bf16x8 af = *(const LAS bf16x8*)(lds + HL_KM + si * 4096 + ofs);
                    const bf16x8 bfr = *(const LAS bf16x8*)(lds + HL_QM + ti * 4096 + ofs);
                    pacc = __builtin_amdgcn_mfma_f32_16x16x32_bf16(af, bfr, pacc, 0, 0, 0);
                }
                const bool offd = si != ti;
#pragma unroll
                for (int r = 0; r < 4; ++r) pacc[r] = (offd || (4 * g + r <= r16)) ? pacc[r] : 0.f;
            }
            asm volatile("s_nop 7\n\ts_nop 7" ::: "memory");
            const int t = 16 * ti + r16;
            u32x2 pw; pw.x = cvt_pk_bf16_c(pacc[0], pacc[1]); pw.y = cvt_pk_bf16_c(pacc[2], pacc[3]);
            *(LAS u32x2*)(lds + HL_PL + t * 128 + (((2 * si + (g >> 1)) ^ ((t >> 1) & 7)) << 4) + (g & 1) * 8) = pw;
        }
        __syncthreads();
        u32x2 ogp[4];
        { const bf16_t* ob = OG + tok0 * 1024 + hc + 16 * w;
#pragma unroll
          for (int ti = 0; ti < 4; ++ti) ogp[ti] = *(const u32x2*)(ob + ti * 16384 + lo_og); }
#define HG_SB() __builtin_amdgcn_sched_barrier(0)
#define HG_QSLD(dst, kp) do { _Pragma("unroll") for (int ti = 0; ti < 4; ++ti) { const int t_ = 16 * ti + r16; \
            const u32x2 lo_ = *(const LAS u32x2*)(lds + HL_QS + t_ * 256 + (((8 * (kp) + g) ^ (r16 << 1)) << 3)); \
            const u32x2 hi_ = *(const LAS u32x2*)(lds + HL_QS + t_ * 256 + (((8 * (kp) + 4 + g) ^ (r16 << 1)) << 3)); \
            dst[ti] = (u32x4){lo_.x, lo_.y, hi_.x, hi_.y}; } } while (0)
#define HG_KELD(dst, kt) do { _Pragma("unroll") for (int ks = 0; ks < 2; ++ks) { const LAS unsigned char* pb_ = lds + HL_KE + ks * 32 * 256 + trrow + (((kt) ^ keyl) << 5); \
            dst[ks] = mk8(lds_tr16(pb_), lds_tr16(pb_ + 4 * 256)); } } while (0)
#define HG_INTER(kp, qsv) do { u32x4 sw_; sw_.x = cvt_pk_bf16_c(Sacc[2 * (kp)][0], Sacc[2 * (kp)][1]); sw_.y = cvt_pk_bf16_c(Sacc[2 * (kp)][2], Sacc[2 * (kp)][3]); \
            sw_.z = cvt_pk_bf16_c(Sacc[2 * (kp) + 1][0], Sacc[2 * (kp) + 1][1]); sw_.w = cvt_pk_bf16_c(Sacc[2 * (kp) + 1][2], Sacc[2 * (kp) + 1][3]); \
            const bf16x8 sf_ = __builtin_bit_cast(bf16x8, sw_); \
            _Pragma("unroll") for (int ti = 0; ti < 4; ++ti) Oa[ti] = __builtin_amdgcn_mfma_f32_16x16x32_bf16(sf_, __builtin_bit_cast(bf16x8, qsv[ti]), Oa[ti], 0, 0, 0); } while (0)
#define HG_SUPD(kt, kev, dsv) do { f32x4 sa_ = Sacc[kt] * dsv; \
            sa_ = __builtin_amdgcn_mfma_f32_16x16x32_bf16(kev[0], vf[0], sa_, 0, 0, 0); sa_ = __builtin_amdgcn_mfma_f32_16x16x32_bf16(kev[1], vf[1], sa_, 0, 0, 0); Sacc[kt] = sa_; } while (0)
        bf16x8 vf[2];
        bf16x8 pf[6];
        u32x4 qsA[4], qsB[4];
#pragma unroll
        for (int ks = 0; ks < 2; ++ks) {
            const LAS unsigned char* pb = lds + HL_VT + ks * 32 * 256 + trrow + ((w ^ keyl) << 5);
            vf[ks] = mk8(lds_tr16(pb), lds_tr16(pb + 4 * 256));
        }
        {
            const int t0_ = r16, t1_ = 16 + r16, t2_ = 32 + r16, t3_ = 48 + r16;
            pf[0] = *(const LAS bf16x8*)(lds + HL_PL + t0_ * 128 + (((g) ^ ((t0_ >> 1) & 7)) << 4));
            pf[1] = *(const LAS bf16x8*)(lds + HL_PL + t1_ * 128 + (((g) ^ ((t1_ >> 1) & 7)) << 4));
            pf[2] = *(const LAS bf16x8*)(lds + HL_PL + t2_ * 128 + (((g) ^ ((t2_ >> 1) & 7)) << 4));
            pf[3] = *(const LAS bf16x8*)(lds + HL_PL + t2_ * 128 + (((4 + g) ^ ((t2_ >> 1) & 7)) << 4));
            pf[4] = *(const LAS bf16x8*)(lds + HL_PL + t3_ * 128 + (((g) ^ ((t3_ >> 1) & 7)) << 4));
            pf[5] = *(const LAS bf16x8*)(lds + HL_PL + t3_ * 128 + (((4 + g) ^ ((t3_ >> 1) & 7)) << 4));
        }
        HG_QSLD(qsA, 0);
        HG_SB();
        f32x4 Oa[4];
        const f32x4 z4 = (f32x4){0.f, 0.f, 0.f, 0.f};
        Oa[0] = __builtin_amdgcn_mfma_f32_16x16x32_bf16(vf[0], pf[0], z4, 0, 0, 0);
        Oa[1] = __builtin_amdgcn_mfma_f32_16x16x32_bf16(vf[0], pf[1], z4, 0, 0, 0);
        Oa[2] = __builtin_amdgcn_mfma_f32_16x16x32_bf16(vf[0], pf[2], z4, 0, 0, 0);
        Oa[3] = __builtin_amdgcn_mfma_f32_16x16x32_bf16(vf[0], pf[4], z4, 0, 0, 0);
        Oa[2] = __builtin_amdgcn_mfma_f32_16x16x32_bf16(vf[1], pf[3], Oa[2], 0, 0, 0);
        Oa[3] = __builtin_amdgcn_mfma_f32_16x16x32_bf16(vf[1], pf[5], Oa[3], 0, 0, 0);
        HG_SB();
        HG_QSLD(qsB, 1);
        HG_SB();
        HG_INTER(0, qsA);
        HG_SB();
        HG_QSLD(qsA, 2);
        HG_SB();
        HG_INTER(1, qsB);
        HG_SB();
        HG_QSLD(qsB, 3);
        HG_SB();
#define HG_DSLD(kt) (*(const LAS f32x4*)(lds + HL_DS + (16 * (kt) + 4 * g) * 4))
        bf16x8 keA[2], keB[2], keC[2], keD[2]; f32x4 dA, dB, dC, dD;
        HG_KELD(keA, 0); HG_KELD(keB, 1); dA = HG_DSLD(0); dB = HG_DSLD(1);
        HG_SB();
        HG_INTER(2, qsA);
        HG_SB();
        HG_KELD(keC, 2); HG_KELD(keD, 3); dC = HG_DSLD(2); dD = HG_DSLD(3);
        HG_SB();
        HG_INTER(3, qsB);
        HG_SB();
        HG_SUPD(0, keA, dA); HG_SUPD(1, keB, dB);
        HG_SB();
        HG_KELD(keA, 4); HG_KELD(keB, 5); dA = HG_DSLD(4); dB = HG_DSLD(5);
        HG_SB();
        HG_SUPD(2, keC, dC); HG_SUPD(3, keD, dD);
        HG_SB();
        HG_KELD(keC, 6); HG_KELD(keD, 7); dC = HG_DSLD(6); dD = HG_DSLD(7);
        HG_SB();
        HG_SUPD(4, keA, dA); HG_SUPD(5, keB, dB);
        HG_SB();
        HG_SUPD(6, keC, dC); HG_SUPD(7, keD, dD);
#undef HG_DSLD
#undef HG_SB
#undef HG_QSLD
#undef HG_KELD
#undef HG_INTER
#undef HG_SUPD
#pragma unroll
        for (int ti = 0; ti < 4; ++ti) {
            float sq = (Oa[ti][0] * Oa[ti][0] + Oa[ti][1] * Oa[ti][1]) + (Oa[ti][2] * Oa[ti][2] + Oa[ti][3] * Oa[ti][3]);
            sq += __shfl_xor(sq, 16); sq += __shfl_xor(sq, 32);
            if (g == 0) *(LAS float*)(lds + HL_SSQ + (w * 64 + 16 * ti + r16) * 4) = sq;
        }
        __syncthreads();
#pragma unroll
        for (int ti = 0; ti < 4; ++ti) {
            const int t = 16 * ti + r16;
            float tot = 0.f;
#pragma unroll
            for (int ww = 0; ww < 8; ++ww) tot += *(const LAS float*)(lds + HL_SSQ + (ww * 64 + t) * 4);
            const float rs = rsqrtf(tot * (1.f / 128.f) + EPS);
            const f32x4 nw4 = *(const f32x4*)(a.in[6] + 16 * w + 4 * g);
            u32x2 o; o.x = pk2(Oa[ti][0] * rs * nw4[0] * bflo(ogp[ti].x), Oa[ti][1] * rs * nw4[1] * bfhi(ogp[ti].x));
            o.y = pk2(Oa[ti][2] * rs * nw4[2] * bflo(ogp[ti].y), Oa[ti][3] * rs * nw4[3] * bfhi(ogp[ti].y));
            *(u32x2*)(YM + tok0 * D + hc + 16 * w + ti * 32768 + lo_ym) = o;
        }
    }
}

constexpr int P4_HI = 0, P4_LO = 65536, P4_PL = 131072;
constexpr int LC_SEL = 2048, LC_CNTL = 4096, LC_BASE = 4224;
__device__ __forceinline__ void p4_ln_router(Frame& F, const Args& a) {
    LAS unsigned char* lds = F.lds;
    const float* Z = (const float*)(F.ws + WS_Z); bf16_t* H1 = (bf16_t*)(F.ws + WS_H1);
    const float* w = a.in[11]; const float* b = a.in[12]; const float* br = a.in[14];
    int* cnt = (int*)(F.ws + WS_CTL) + CW_CNT; int* list = (int*)(F.ws + WS_LIST);
    int* tok_e = (int*)(F.ws + WS_TOKE); int* tok_p = (int*)(F.ws + WS_TOKP); float* tok_g = (float*)(F.ws + WS_TOKG);
    const int tid = F.tid, lane = F.lane, wv = F.wave, r16 = lane & 15, g = lane >> 4, nh = wv & 1, q = wv >> 1;
    LAS u32x2* SEL = (LAS u32x2*)(lds + LDSCTL_OFF + LC_SEL); LAS int* CNTL = (LAS int*)(lds + LDSCTL_OFF + LC_CNTL); LAS int* BASE = (LAS int*)(lds + LDSCTL_OFF + LC_BASE);
    if (tid < 32) CNTL[tid] = 0;
    const size_t wo = (size_t)(16 * nh + r16) * D + 512 * q + 8 * g; const bf16_t* pl = (const bf16_t*)(F.ws + WS_WRL) + wo; const bf16_t* ph = (const bf16_t*)(F.ws + WS_WRH) + wo;
    int se0 = 0, se1 = 0, se2 = 0, se3 = 0; float sg0 = 0.f, sg1 = 0.f, sg2 = 0.f, sg3 = 0.f;
    const int ntile = T / 16;
    const int nmy = (ntile - F.vcu + F.G - 1) / F.G;

    for (int it = 0; it < nmy; ++it) {
        const int tile = F.vcu + it * F.G;
        __syncthreads();
#define P4_LN(v, th) do { const int tl = 2 * wv + (th), m = tile * 16 + tl; float s = 0.f; \
            _Pragma("unroll") for (int j = 0; j < 8; ++j) s += (v[j][0] + v[j][1]) + (v[j][2] + v[j][3]); \
            const float mean = wave_sum(s) * (1.f / D); float s2 = 0.f; \
            _Pragma("unroll") for (int j = 0; j < 8; ++j) { v[j] = v[j] - mean; s2 += (v[j][0] * v[j][0] + v[j][1] * v[j][1]) + (v[j][2] * v[j][2] + v[j][3] * v[j][3]); } \
            const float rstd = rsqrtf(wave_sum(s2) * (1.f / D) + EPS); \
            GAS u32x2* o8 = (GAS u32x2*)(H1 + (size_t)m * D) + lane; \
            _Pragma("unroll") for (int j = 0; j < 8; ++j) { const f32x4 ww = *((const f32x4*)w + lane + 64 * j), bb = *((const f32x4*)b + lane + 64 * j); \
                f32x4 hv; hv[0] = v[j][0] * rstd * ww[0] + bb[0]; hv[1] = v[j][1] * rstd * ww[1] + bb[1]; hv[2] = v[j][2] * rstd * ww[2] + bb[2]; hv[3] = v[j][3] * rstd * ww[3] + bb[3]; \
                const unsigned h01 = pk2(hv[0], hv[1]), h23 = pk2(hv[2], hv[3]); \
                u32x2 o; o.x = h01; o.y = h23; o8[64 * j] = o; \
                *((GAS unsigned*)(F.ws + WS_H1Q + (size_t)m * D) + lane + 64 * j) = pk4_fp8(hv[0] * SC_H1, hv[1] * SC_H1, hv[2] * SC_H1, hv[3] * SC_H1); \
                u32x2 lo; lo.x = pk2(hv[0] - bflo(h01), hv[1] - bfhi(h01)); lo.y = pk2(hv[2] - bflo(h23), hv[3] - bfhi(h23)); \
                const int off = tl * 4096 + ((((lane >> 1) + 32 * j) ^ tl) << 4) + (lane & 1) * 8; \
                *(LAS u32x2*)(lds + P4_HI + off) = o; *(LAS u32x2*)(lds + P4_LO + off) = lo; } } while (0)
        f32x4 v0[8], v1[8];
        { const GAS f32x4* z0 = (const GAS f32x4*)(Z + (size_t)(tile * 16 + 2 * wv) * D) + lane;
#pragma unroll
          for (int j = 0; j < 8; ++j) { v0[j] = z0[64 * j]; v1[j] = z0[64 * j + 512]; } }
        P4_LN(v0, 0); P4_LN(v1, 1);
#undef P4_LN
        __builtin_amdgcn_sched_barrier(0);
        bf16x8 wh[16], wl[16];
#pragma unroll
        for (int ks = 0; ks < 16; ++ks) { wh[ks] = *(const bf16x8*)(ph + 32 * ks); wl[ks] = *(const bf16x8*)(pl + 32 * ks); }
        __syncthreads();
        f32x4 acc = (f32x4){0.f, 0.f, 0.f, 0.f};
#pragma unroll
        for (int ks = 0; ks < 16; ++ks) {
            const int off = r16 * 4096 + (((64 * q + 4 * ks + g) ^ r16) << 4);
            const bf16x8 th = *(const LAS bf16x8*)(lds + P4_HI + off), tl8 = *(const LAS bf16x8*)(lds + P4_LO + off);
            acc = __builtin_amdgcn_mfma_f32_16x16x32_bf16(wh[ks], th, acc, 0, 0, 0);
            acc = __builtin_amdgcn_mfma_f32_16x16x32_bf16(wh[ks], tl8, acc, 0, 0, 0);
            acc = __builtin_amdgcn_mfma_f32_16x16x32_bf16(wl[ks], th, acc, 0, 0, 0);
        }
        *(LAS f32x4*)(lds + P4_PL + ((q * 16 + r16) * 32 + 16 * nh + 4 * g) * 4) = acc;
        __builtin_amdgcn_sched_barrier(0);
        __syncthreads();
        {
            const int e = lane & 31, th = lane >> 5, tl = 2 * wv + th;
            float sl = br[e];
#pragma unroll
            for (int qq = 0; qq < 4; ++qq) sl += *(const LAS float*)(lds + P4_PL + ((qq * 16 + tl) * 32 + e) * 4);
            float val = sl; int te[4]; float tv[4];
#pragma unroll
            for (int r = 0; r < 4; ++r) {
                float bv = val; int bi = e;
#pragma unroll
                for (int o = 1; o < 32; o <<= 1) { const float ov = __shfl_xor(bv, o); const int oi = __shfl_xor(bi, o); if (ov > bv || (ov == bv && oi < bi)) { bv = ov; bi = oi; } }
                te[r] = bi; tv[r] = bv; if (e == bi) val = -INFINITY;
            }
            float p[4], ps = 0.f;
#pragma unroll
            for (int r = 0; r < 4; ++r) { p[r] = __expf(tv[r] - tv[0]); ps += p[r]; }
            if (e < 4) {
                int ee = te[0]; float gg = p[0];
                if (e == 1) { ee = te[1]; gg = p[1]; } else if (e == 2) { ee = te[2]; gg = p[2]; } else if (e == 3) { ee = te[3]; gg = p[3]; }
                const float gn = gg / ps;
                if (it == 0) { se0 = ee; sg0 = gn; } else if (it == 1) { se1 = ee; sg1 = gn; } else if (it == 2) { se2 = ee; sg2 = gn; } else { se3 = ee; sg3 = gn; }
            }
        }
    }
    __syncthreads();
    const bool own = (lane & 31) < 4;
    int rk0 = 0, rk1 = 0, rk2 = 0, rk3 = 0;
    if (own) {
        if (nmy > 0) rk0 = __hip_atomic_fetch_add((LAS int*)&CNTL[se0], 1, __ATOMIC_RELAXED, __HIP_MEMORY_SCOPE_WORKGROUP);
        if (nmy > 1) rk1 = __hip_atomic_fetch_add((LAS int*)&CNTL[se1], 1, __ATOMIC_RELAXED, __HIP_MEMORY_SCOPE_WORKGROUP);
        if (nmy > 2) rk2 = __hip_atomic_fetch_add((LAS int*)&CNTL[se2], 1, __ATOMIC_RELAXED, __HIP_MEMORY_SCOPE_WORKGROUP);
        if (nmy > 3) rk3 = __hip_atomic_fetch_add((LAS int*)&CNTL[se3], 1, __ATOMIC_RELAXED, __HIP_MEMORY_SCOPE_WORKGROUP);
    }
    __syncthreads();
    if (tid < 32) { const int c = CNTL[tid]; BASE[tid] = c > 0 ? atomicAdd(&cnt[tid], c) : 0; }
    __syncthreads();
    if (own) {
        const int k = lane & 31, tl = 2 * wv + (lane >> 5);
#define P4_EMIT(itx, sex, sgx, rkx) do { if (nmy > (itx)) { const int m = (F.vcu + (itx) * F.G) * 16 + tl, pos = BASE[sex] + (rkx); \
            list[(size_t)(sex) * LISTCAP + pos] = m; tok_e[m * 4 + k] = (sex); tok_p[m * 4 + k] = pos; tok_g[m * 4 + k] = (sgx); } } while (0)
        P4_EMIT(0, se0, sg0, rk0); P4_EMIT(1, se1, sg1, rk1); P4_EMIT(2, se2, sg2, rk2); P4_EMIT(3, se3, sg3, rk3);
#undef P4_EMIT
    }
}
__device__ __forceinline__ int moe_tables(Frame& F) {
    LAS int* pts = (LAS int*)(F.lds + LDSCTL_OFF + LC_PTS); LAS int* cl = (LAS int*)(F.lds + LDSCTL_OFF + LC_CNT); LAS unsigned char* tileE = (LAS unsigned char*)(F.lds + LDSCTL_OFF + LC_TILEE);
    const int* cnt = (const int*)(F.ws + WS_CTL) + CW_CNT;
    __syncthreads();
    if (F.tid < 64) {
        const int e = F.tid & 31; const int c = __hip_atomic_load(cnt + e, RLX_AGENT); const int tl = (c + 255) >> 8;
        int incl = tl;
#pragma unroll
        for (int o = 1; o < 32; o <<= 1) { const int v = __shfl_up(incl, o, 32); if (e >= o) incl += v; }
        if (F.tid < 32) { cl[e] = c; pts[e] = incl - tl; if (e == 31) pts[32] = incl; }
    }
    __syncthreads();
    const int nmt = pts[32];
    for (int t = F.tid; t < nmt; t += NTHR) { int e = 0;
        for (int j = 0; j < 32; ++j) if (t >= pts[j + 1]) e = j + 1;
        tileE[t] = (unsigned char)e; }
    __syncthreads();
    return __builtin_amdgcn_readfirstlane(nmt);
}
__device__ __forceinline__ void p7_combine(Frame& F, const Args& a) {
    const LAS int* pts = (const LAS int*)(F.lds + LDSCTL_OFF + LC_PTS);
    const bf16_t* H1 = (const bf16_t*)(F.ws + WS_H1); const bf16_t* Y = (const bf16_t*)(F.ws + WS_Y);
    const int* tok_e = (const int*)(F.ws + WS_TOKE); const int* tok_p = (const int*)(F.ws + WS_TOKP); const float* tok_g = (const float*)(F.ws + WS_TOKG);
    const float* w = a.in[21]; const float* b = a.in[22]; float* out = a.out;
    const int gw = F.vcu * NWAVES + F.wave, NGW = F.G * NWAVES, lane = F.lane;
    for (int m = gw; m < T; m += NGW) {
        f32x4 v[8];
        { const GAS u32x2* hr = (const GAS u32x2*)(H1 + (size_t)m * D) + lane;
#pragma unroll
          for (int j = 0; j < 8; ++j) { const u32x2 hw = hr[64 * j]; v[j][0] = ALPHA * bflo(hw.x); v[j][1] = ALPHA * bfhi(hw.x); v[j][2] = ALPHA * bflo(hw.y); v[j][3] = ALPHA * bfhi(hw.y); } }
#pragma unroll
        for (int k = 0; k < 4; ++k) {
            const int e = tok_e[m * 4 + k]; const int row = pts[e] * 256 + tok_p[m * 4 + k]; const float g = tok_g[m * 4 + k];
            const GAS u32x2* yr = (const GAS u32x2*)(Y + (size_t)row * D) + lane;
#pragma unroll
            for (int j = 0; j < 8; ++j) { const u32x2 yw = yr[64 * j]; v[j][0] += g * bflo(yw.x); v[j][1] += g * bfhi(yw.x); v[j][2] += g * bflo(yw.y); v[j][3] += g * bfhi(yw.y); }
        }
        float s = 0.f;
#pragma unroll
        for (int j = 0; j < 8; ++j) s += (v[j][0] + v[j][1]) + (v[j][2] + v[j][3]);
        const float mean = wave_sum(s) * (1.f / D); float s2 = 0.f;
#pragma unroll
        for (int j = 0; j < 8; ++j) { v[j] = v[j] - mean; s2 += (v[j][0] * v[j][0] + v[j][1] * v[j][1]) + (v[j][2] * v[j][2] + v[j][3] * v[j][3]); }
        const float rstd = rsqrtf(wave_sum(s2) * (1.f / D) + EPS);
        GAS f32x4* orow = (GAS f32x4*)(out + (size_t)m * D) + lane;
#pragma unroll
        for (int j = 0; j < 8; ++j) { const f32x4 ww = *((const f32x4*)w + lane + 64 * j), bb = *((const f32x4*)b + lane + 64 * j);
            f32x4 o; o[0] = v[j][0] * rstd * ww[0] + bb[0]; o[1] = v[j][1] * rstd * ww[1] + bb[1]; o[2] = v[j][2] * rstd * ww[2] + bb[2]; o[3] = v[j][3] * rstd * ww[3] + bb[3]; orow[64 * j] = o; }
    }
}

__global__ void __launch_bounds__(NTHR, 2) mk_fwd(Args args) {
    extern __shared__ __attribute__((aligned(16))) unsigned char lds_raw[];
    Frame F;
    F.lds = (LAS unsigned char*)lds_raw;
    F.tid = threadIdx.x; F.lane = F.tid & 63; F.wave = __builtin_amdgcn_readfirstlane(F.tid >> 6);
    F.G = gridDim.x; { const int bx = blockIdx.x; F.vcu = (F.G % 8 == 0) ? (bx % 8) * (F.G / 8) + bx / 8 : bx; }
    F.ws = args.ws;
    unsigned char* ws = args.ws;
    for (int u = F.tid; u < (LDS_BYTES - LDSCTL_OFF) / 4; u += NTHR) ((LAS unsigned*)(F.lds + LDSCTL_OFF))[u] = 0u;
    __syncthreads();
    XcdBarrier bar; bar.bar = (unsigned*)(ws + WS_CTL) + CW_BAR; bar.x = 0; bar.st = nullptr;
#if !MK_PER_PHASE
    bar = xcd_barrier_post((unsigned*)(ws + WS_CTL) + CW_BAR, (volatile LAS unsigned*)(F.lds + LDSCTL_OFF + LC_BAR));
#endif
    const int lo = args.ph_lo, hi = args.ph_hi;
#define IN(k) (lo <= (k) && (k) < hi)
#define REFRESH_IDS() do { int t_ = threadIdx.x; asm volatile("" : "+v"(t_)); F.tid = t_; F.lane = t_ & 63; F.wave = __builtin_amdgcn_readfirstlane(t_ >> 6); } while (0)
#define SEAM(k) do { if (IN(k) && IN((k) + 1)) xcd_barrier(bar); } while (0)

    if (IN(0)) { REFRESH_IDS(); for (int r = 0; r < REP0; ++r) { p0_prologue(F, args); if (r + 1 < REP0) xcd_barrier(bar); } } SEAM(0);

    if (IN(1)) { REFRESH_IDS();
        const int Gg = F.G;
        SchedDense S{(const bf16_t*)(ws + WS_H0), (const bf16_t*)(ws + WS_WIN), T / 256, INC / 256, Gg, (int)blockIdx.x};
        EpiInProj E{(bf16_t*)(ws + WS_QH), (bf16_t*)(ws + WS_KH), (bf16_t*)(ws + WS_VH), (bf16_t*)(ws + WS_OG), (bf16_t*)(ws + WS_AQ), (bf16_t*)(ws + WS_AK), (bf16_t*)(ws + WS_AV),
                    (float*)(ws + WS_GH), (const float*)(ws + WS_LB), args.in[4]};
        for (int r = 0; r < REP1; ++r) { gemm_phase<EpiInProj, SchedDense>(F.lds, S, E); if (r + 1 < REP1) xcd_barrier(bar); }
        {
            const int nwg = (T / 256) * (INC / 256), full = nwg / F.G, extra = nwg - full * F.G;
            const bool has_extra = (int)blockIdx.x < extra;
            if (has_extra) { if (threadIdx.x == 0) __hip_atomic_fetch_add((unsigned*)(ws + WS_CTL) + CW_P1DONE, 1u, RLX_AGENT); }
            else if (extra > 0) { __syncthreads(); cv_worker(F, args, (const unsigned*)(ws + WS_CTL) + CW_P1DONE, (unsigned)extra); }
        }
    } SEAM(1);

    if (IN(2)) { REFRESH_IDS();
        for (int r = 0; r < REP2; ++r) {
        const int nh = F.G > 64 ? 64 : F.G;
        const int a0 = F.G >= 192 ? 64 : 0, na = F.G >= 192 ? 64 : F.G;
        if ((int)blockIdx.x < nh) { for (int hu = blockIdx.x; hu < 64 * REP2H; hu += nh) hgrn_unit_mfma(F, args, (hu & 63) >> 3, hu & 7); }
        REFRESH_IDS();
        if ((int)blockIdx.x >= a0 && (int)blockIdx.x < a0 + na) {
            for (int v0 = (int)blockIdx.x - a0; v0 < NB * (L / AT_Q) * REP2A; v0 += na) { const int v = v0 % (NB * (L / AT_Q)); attn_unit_mfma(F, args, v / (L / AT_Q), v % (L / AT_Q)); }
        }
        __syncthreads();
        REFRESH_IDS();
        cv_worker(F, args, nullptr, 0u);
        if (r + 1 < REP2) xcd_barrier(bar); }
    } SEAM(2);

    if (IN(3)) { REFRESH_IDS();
        SchedDense S{(const bf16_t*)(ws + WS_YMIX), (const bf16_t*)(ws + WS_WOUT), T / 256, D / 256, F.G, (int)blockIdx.x};
        EpiOutProj E{(float*)(ws + WS_Z), args.in[0], (const float*)(ws + WS_STATS0), args.in[1], args.in[2], args.in[10]};
        for (int r = 0; r < REP3; ++r) { gemm_phase<EpiOutProj, SchedDense>(F.lds, S, E); if (r + 1 < REP3) xcd_barrier(bar); }
    } SEAM(3);

    if (IN(4)) { REFRESH_IDS(); p4_ln_router(F, args); }

    if (IN(5) && !IN(4)) { REFRESH_IDS(); __syncthreads(); cv_worker(F, args, nullptr, 0u); }
    if (IN(4) || IN(5)) { if (IN(6)) xcd_barrier(bar); }

    if (IN(6)) { REFRESH_IDS();
        const int nmt = moe_tables(F);
        SchedMoe<2048> S{(const void*)(ws + WS_H1Q), (const void*)(ws + WS_WGU), (size_t)4096 * KD, (const int*)(ws + WS_LIST),
                   (const LAS int*)(F.lds + LDSCTL_OFF + LC_PTS), (const LAS int*)(F.lds + LDSCTL_OFF + LC_CNT), (const LAS unsigned char*)(F.lds + LDSCTL_OFF + LC_TILEE), nmt, 16, F.G, (int)blockIdx.x, true};
        EpiMoe1F8 E{(unsigned char*)(ws + WS_HACT), args.in[16], args.in[18]};
        for (int r = 0; r < REP5; ++r) { gemm_phase<EpiMoe1F8, SchedMoe<2048>, true>(F.lds, S, E); if (r + 1 < REP5) xcd_barrier(bar); }
    } SEAM(6);

    if (IN(7)) { REFRESH_IDS();
        const int nmt = moe_tables(F);
        SchedMoe<2048> S{(const void*)(ws + WS_HACT), (const void*)(ws + WS_WD), (size_t)2048 * KD, (const int*)(ws + WS_LIST),
                   (const LAS int*)(F.lds + LDSCTL_OFF + LC_PTS), (const LAS int*)(F.lds + LDSCTL_OFF + LC_CNT), (const LAS unsigned char*)(F.lds + LDSCTL_OFF + LC_TILEE), nmt, 8, F.G, (int)blockIdx.x, false};
        EpiMoe2F8 E{(bf16_t*)(ws + WS_Y), args.in[20]};
        for (int r = 0; r < REP6; ++r) { gemm_phase<EpiMoe2F8, SchedMoe<2048>, true>(F.lds, S, E); if (r + 1 < REP6) xcd_barrier(bar); }
    } SEAM(7);

    if (IN(8)) { REFRESH_IDS(); (void)moe_tables(F); for (int r = 0; r < REP7; ++r) p7_combine(F, args); }
#undef IN
#undef SEAM
}
}

extern "C" void kernel_launch(void* const* d_in, const int* in_sizes, int n_in, void* d_out, int out_size, void* d_ws, size_t ws_size, hipStream_t stream) {
    static int grid = 0;
    if (grid == 0) {
        if (n_in != 23 || out_size != T * D || ws_size < WS_END) { fprintf(stderr, "kernel_launch: unexpected shapes (n_in %d out %d ws %zu need %zu)\n", n_in, out_size, ws_size, (size_t)WS_END); grid = -1; return; }
        int dev = 0, cus = 0, per_cu = 0;
        if (hipGetDevice(&dev) != hipSuccess || hipDeviceGetAttribute(&cus, hipDeviceAttributeMultiprocessorCount, dev) != hipSuccess) { grid = -1; return; }
        if (hipFuncSetAttribute((const void*)mk_fwd, hipFuncAttributeMaxDynamicSharedMemorySize, LDS_BYTES) != hipSuccess) { fprintf(stderr, "kernel_launch: hipFuncSetAttribute failed\n"); grid = -1; return; }
        if (hipOccupancyMaxActiveBlocksPerMultiprocessor(&per_cu, (const void*)mk_fwd, NTHR, LDS_BYTES) != hipSuccess || per_cu < 1) { fprintf(stderr, "kernel_launch: occupancy query says %d\n", per_cu); }
        (void)hipGetLastError();
        grid = cus;
    }
    if (grid < 0) return;
    if (hipMemsetAsync((char*)d_ws + WS_CTL, 0, CTL_ZERO_BYTES, stream) != hipSuccess) return;
    Args a{};
    for (int i = 0; i < 23; ++i) a.in[i] = (const float*)d_in[i];
    a.out = (float*)d_out; a.ws = (unsigned char*)d_ws;
#if MK_PER_PHASE
    for (int p = 0; p < NPHASE; ++p) { a.ph_lo = p; a.ph_hi = p + 1; hipLaunchKernelGGL(mk_fwd, dim3(grid), dim3(NTHR), LDS_BYTES, stream, a); }
#else
    a.ph_lo = 0; a.ph_hi = NPHASE; hipLaunchKernelGGL(mk_fwd, dim3(grid), dim3(NTHR), LDS_BYTES, stream, a);
#endif
}
```

```cpp
#include <hip/hip_runtime.h>
#include <cstdio>
#include <cstdint>

#ifndef MK_PER_PHASE
#define MK_PER_PHASE 0
#endif

#define LAS __attribute__((address_space(3)))
#define GAS __attribute__((address_space(1)))
typedef unsigned short bf16_t;
typedef short bf16x8 __attribute__((ext_vector_type(8)));
typedef float f32x4 __attribute__((ext_vector_type(4)));
typedef float f32x2 __attribute__((ext_vector_type(2)));
typedef unsigned u32x4 __attribute__((ext_vector_type(4)));
typedef unsigned u32x2 __attribute__((ext_vector_type(2)));
typedef GAS unsigned gu32;

namespace {
constexpr int D = 2048, NB = 8, L = 2048, T = NB * L;
constexpr int INC = 5376;
constexpr int NE = 32, FF = 2048, NA = T * 4;
constexpr int LISTCAP = T;
constexpr int MAXROWS = NA + NE * 256;
constexpr float ALPHA = 1.189207115002721f;
constexpr float EPS = 1e-5f;
constexpr int NWAVES = 8, NTHR = 512;
constexpr int NPHASE = 9;
constexpr int REP2H = 1, REP2A = 1;
constexpr int REP0 = 1, REP1 = 1, REP2 = 1, REP3 = 1, REP5 = 1, REP6 = 1, REP7 = 1;

constexpr size_t MiB = 1u << 20;
constexpr size_t WS_CTL = 0, CTL_ZERO_BYTES = 32768;
constexpr size_t WS_LB = 1 * MiB;
constexpr size_t WS_STATS0 = WS_LB + 4096;
constexpr size_t WS_LIST = 2 * MiB;
constexpr size_t WS_TOKE = 4 * MiB, WS_TOKP = WS_TOKE + (size_t)NA * 4, WS_TOKG = WS_TOKP + (size_t)NA * 4;
constexpr size_t WS_WRH = 5 * MiB;
constexpr size_t WS_WIN = 8 * MiB;
constexpr size_t WS_WOUT = 30 * MiB;
constexpr size_t WS_WGU = 40 * MiB;
constexpr size_t WS_WD = 552 * MiB;
constexpr size_t WS_H1 = 808 * MiB;
constexpr size_t WS_Z = 872 * MiB;
constexpr size_t WS_HACT = 1000 * MiB;
constexpr size_t WS_EARLY = 1288 * MiB;
constexpr size_t WS_H0 = WS_EARLY;
constexpr size_t WS_QH = WS_H0 + 64 * MiB, WS_KH = WS_QH + 32 * MiB, WS_VH = WS_KH + 32 * MiB, WS_OG = WS_VH + 32 * MiB, WS_AQ = WS_OG + 32 * MiB;
constexpr size_t WS_GH = WS_AQ + 32 * MiB;
constexpr size_t WS_AK = WS_GH + 64 * MiB, WS_AV = WS_AK + 4 * MiB;
constexpr size_t WS_YMIX = WS_AV + 4 * MiB;
constexpr size_t WS_H1Q = WS_KH;
constexpr size_t WS_Y = WS_EARLY;
constexpr size_t WS_END = WS_YMIX + 64 * MiB;
static_assert(WS_Y + (size_t)MAXROWS * 4096 <= WS_END + 0 * MiB || true, "");
static_assert(WS_END <= 2048 * MiB, "d_ws map");
constexpr int CW_CNT = 64;
constexpr int CW_CONV = 128, CW_P1DONE = 192, CW_HGDONE = 256;
constexpr int CW_BAR = 4096;

constexpr int RING_BYTES = 131072;
constexpr int CV_SCR = 17408;
constexpr int LDSCTL_OFF = 8 * CV_SCR;
constexpr int LDS_BYTES = 147456;
constexpr int LC_BAR = 0, LC_PTS = 64, LC_CNT = 256, LC_TILEE = 512, LC_MISC = 2048;

#define RLX_AGENT __ATOMIC_RELAXED, __HIP_MEMORY_SCOPE_AGENT
__device__ __forceinline__ unsigned f2bf(float f) { unsigned u = __builtin_bit_cast(unsigned, f); return (u + 0x7fffu + ((u >> 16) & 1u)) >> 16; }
__device__ __forceinline__ unsigned pk2(float lo, float hi) { return f2bf(lo) | (f2bf(hi) << 16); }
__device__ __forceinline__ float bf2f(unsigned short b) { return __builtin_bit_cast(float, (unsigned)b << 16); }
__device__ __forceinline__ float bflo(unsigned w) { return __builtin_bit_cast(float, w << 16); }
__device__ __forceinline__ float bfhi(unsigned w) { return __builtin_bit_cast(float, w & 0xffff0000u); }
typedef __bf16 bf16x2_t __attribute__((ext_vector_type(2)));
__device__ __forceinline__ unsigned cvt_pk_bf16_c(float lo, float hi) { f32x2 v = {lo, hi}; bf16x2_t b = __builtin_convertvector(v, bf16x2_t); return __builtin_bit_cast(unsigned, b); }
__device__ __forceinline__ unsigned cvt_pk_bf16(float lo, float hi) { unsigned r; asm volatile("v_cvt_pk_bf16_f32 %0, %1, %2" : "=v"(r) : "v"(lo), "v"(hi)); return r; }
__device__ __forceinline__ float wave_sum(float v) {
#pragma unroll
    for (int o = 1; o < 64; o <<= 1) v += __shfl_xor(v, o);
    return v;
}
__device__ __forceinline__ float sigm(float x) { return __builtin_amdgcn_rcpf(1.f + __expf(-x)); }

#define XB_TMO      128
#define XB_XCNT(j)  (256  + 64 * (j))
#define XB_XSUB(j)  (1280 + 64 * (j))
#define XB_XGEN(j)  (2304 + 64 * (j))
#define XB_TOP      3328
#define XB_TOPGEN   3392
#define XCD_BAR_WORDS 3456
#define XB_SPIN_CAP (1u << 18)
__device__ __forceinline__ unsigned xb_ld(unsigned* p)              { return __hip_atomic_load(p, __ATOMIC_RELAXED, __HIP_MEMORY_SCOPE_AGENT); }
__device__ __forceinline__ unsigned xb_add(unsigned* p, unsigned v) { return __hip_atomic_fetch_add(p, v, __ATOMIC_RELAXED, __HIP_MEMORY_SCOPE_AGENT); }
__device__ __forceinline__ unsigned xb_xcc_id() { return (unsigned)__builtin_amdgcn_s_getreg((3 << 11) | 20) & 0xFu; }
#define XB_SPIN(cond, bar) do { unsigned _sp = 0; while (cond) { __builtin_amdgcn_s_sleep(1); \
    if ((++_sp & 255u) == 0u) { if (xb_ld(&(bar)[XB_TMO])) break; if (_sp > XB_SPIN_CAP) { atomicAdd(&(bar)[XB_TMO], 1u); break; } } } } while (0)
struct XcdBarrier { unsigned* bar; unsigned x; volatile LAS unsigned* st; };
__device__ __forceinline__ XcdBarrier xcd_barrier_post(unsigned* bar, volatile LAS unsigned* st) {
    XcdBarrier b; b.bar = bar; b.x = xb_xcc_id(); b.st = st;
    if (threadIdx.x == 0) (void)xb_add(&bar[XB_XCNT(b.x)], 1u);
    return b;
}
__device__ __forceinline__ void xcd_barrier_complete(unsigned* bar, unsigned x, unsigned& nloc, unsigned& nx) {
    const unsigned G = gridDim.x * gridDim.y * gridDim.z;
    unsigned sum, cnt, mine, sp = 0u;
    for (;;) {
        sum = 0u; cnt = 0u; mine = 0u;
#pragma unroll
        for (unsigned j = 0; j < 16; ++j) { const unsigned c = xb_ld(&bar[XB_XCNT(j)]); sum += c; cnt += (c > 0u) ? 1u : 0u; mine = (j == x) ? c : mine; }
        if (sum == G) break;
        __builtin_amdgcn_s_sleep(1);
        if ((++sp & 255u) == 0u) { if (xb_ld(&bar[XB_TMO])) break; if (sp > XB_SPIN_CAP) { atomicAdd(&bar[XB_TMO], 1u); break; } }
    }
    nloc = mine > 0u ? mine : 1u; nx = cnt > 0u ? cnt : 1u;
}
__device__ __forceinline__ void xcd_barrier(const XcdBarrier& b) {
    asm volatile("s_waitcnt vmcnt(0)" ::: "memory");
    __syncthreads();
    if (threadIdx.x == 0) {
        unsigned* bar = b.bar;
        __builtin_amdgcn_s_waitcnt(0);
        unsigned nloc = b.st[0], nx = b.st[1];
        if (nloc == 0u) { xcd_barrier_complete(bar, b.x, nloc, nx); b.st[0] = nloc; b.st[1] = nx; }
        const unsigned old = xb_add(&bar[XB_XSUB(b.x)], 1u);
        const unsigned gen = old / nloc;
        if (old + 1u == (gen + 1u) * nloc) {
            __builtin_amdgcn_fence(__ATOMIC_RELEASE, "agent");
            asm volatile("s_waitcnt vmcnt(0)" ::: "memory");
            const unsigned og = xb_add(&bar[XB_TOP], 1u);
            const unsigned tg = og / nx;
            if (og + 1u == (tg + 1u) * nx) xb_add(&bar[XB_TOPGEN], 1u);
            else XB_SPIN(xb_ld(&bar[XB_TOPGEN]) == tg, bar);
            __builtin_amdgcn_fence(__ATOMIC_ACQUIRE, "agent");
            xb_add(&bar[XB_XGEN(b.x)], 1u);
            asm volatile("s_waitcnt vmcnt(0)" ::: "memory");
        } else {
            XB_SPIN(xb_ld(&bar[XB_XGEN(b.x)]) == gen, bar);
            __builtin_amdgcn_fence(__ATOMIC_ACQUIRE, "agent");
            asm volatile("s_waitcnt vmcnt(0)" ::: "memory");
        }
    }
    __syncthreads();
}

constexpr int BM = 256, BK = 64, HALF = 128, HTB = HALF * BK * 2, NXCD = 8, WGM = 8;
constexpr int KD = 2048, NT = KD / BK;
__device__ __forceinline__ int lds_byte(int r, int c) { const int st = (r >> 4) * 2 + (c >> 5), rr = r & 15, cc = c & 31, ob = rr * 64 + cc * 2; return st * 1024 + (ob ^ (((ob >> 9) & 1) << 5)); }
__device__ __forceinline__ void stage_rc(int b, int& R, int& C) { const int st = b / 1024, sb = b % 1024, swz = sb ^ (((sb >> 9) & 1) << 5); R = (st >> 1) * 16 + swz / 64; C = (st & 1) * 32 + (swz % 64) / 2; }
__device__ __forceinline__ int perm32(int rho) { const int n = rho >> 4, i = rho & 15; return 8 * (i >> 2) + 4 * n + (i & 3); }

struct GU { const char* A; const char* B; int pm, pn, e, mtl; };

__device__ __forceinline__ bool order_next(int i, int G, int c, int nM, int nN, int& pm, int& pn) {
    const int nwg = nM * nN; const long Lx = (long)i * G + c; if (Lx >= nwg) return false;
    int wgid = (int)Lx; { const int q = nwg / NXCD, r = nwg % NXCD, xcd = wgid % NXCD, off = wgid / NXCD; wgid = (xcd < r ? xcd * (q + 1) : r * (q + 1) + (xcd - r) * q) + off; }
    const int nig = WGM * nN, gid = wgid / nig, fm = gid * WGM, gsz = (nM - fm) < WGM ? (nM - fm) : WGM;
    pm = fm + ((wgid % nig) % gsz); pn = (wgid % nig) / gsz; return true;
}

typedef int v8i_t __attribute__((ext_vector_type(8)));
template <class Epi, class Sched, bool F8 = false>
__device__ __forceinline__ void gemm_phase(LAS unsigned char* lds, const Sched& S, const Epi& E) {
    const int tid = threadIdx.x, wid = __builtin_amdgcn_readfirstlane(tid >> 6), lane = tid & 63, wr = wid >> 2, wc = wid & 3, fr = lane & 15, fq = lane >> 4;
    constexpr int ROWB = F8 ? KD : KD * 2;
    constexpr int nt = ROWB / 128;
    int Rr[2], Cc[2]; unsigned voffB[2];
#pragma unroll
    for (int i = 0; i < 2; ++i) { stage_rc(tid * 16 + i * 8192, Rr[i], Cc[i]); const int Rb = Epi::PERM ? ((Rr[i] & ~31) + perm32(Rr[i] & 31)) : Rr[i]; voffB[i] = (unsigned)(Rb * ROWB + Cc[i] * 2); }
    const size_t kstep = (size_t)128;
    const size_t hstep = (size_t)HALF * ROWB;
    const unsigned ldsw = (unsigned)wid * 1024u;
    const int aoff = F8 ? lds_byte(wr * 64 + fr, fq * 16) : lds_byte(wr * 64 + fr, fq * 8), boff = F8 ? lds_byte(wc * 32 + fr, fq * 16) : lds_byte(wc * 32 + fr, fq * 8);
#define PG8_SA(b, h) (((b) * 2 + (h)) * HTB)
#define PG8_SB(b, h) ((4 + (b) * 2 + (h)) * HTB)
#define PG8_STAGE(bufoff, gbase, voff) do { _Pragma("unroll") for (int _i = 0; _i < 2; ++_i) \
        __builtin_amdgcn_global_load_lds((const unsigned*)((const char*)(gbase) + (voff)[_i]), (LAS unsigned*)(lds + (bufoff) + ldsw + _i * 8192), 16, 0, 0); } while (0)
#define PG8_LDA(dst, b, h) do { _Pragma("unroll") for (int m = 0; m < 4; ++m) _Pragma("unroll") for (int k = 0; k < 2; ++k) dst[m].q[k] = *(const LAS u32x4*)(lds + PG8_SA(b, h) + aoff + m * 2048 + k * (F8 ? 16 : 1024)); } while (0)
#define PG8_LDB(dst, b, h) do { _Pragma("unroll") for (int n = 0; n < 2; ++n) _Pragma("unroll") for (int k = 0; k < 2; ++k) dst[n].q[k] = *(const LAS u32x4*)(lds + PG8_SB(b, h) + boff + n * 2048 + k * (F8 ? 16 : 1024)); } while (0)
#define PG8_MMA(ai, bj, At, Bt) do { __builtin_amdgcn_s_setprio(1); _Pragma("unroll") for (int m = 0; m < 4; ++m) _Pragma("unroll") for (int n = 0; n < 2; ++n) { \
        if constexpr (F8) { asm volatile("v_mfma_scale_f32_16x16x128_f8f6f4 %0, %1, %2, %0, %3, %3 op_sel_hi:[0,0,0]" : "+v"(acc[ai][bj][m][n]) : "v"(Bt[n].v), "v"(At[m].v), "v"(f8sc)); } \
        else { _Pragma("unroll") for (int k = 0; k < 2; ++k) acc[ai][bj][m][n] = __builtin_amdgcn_mfma_f32_16x16x32_bf16(__builtin_bit_cast(bf16x8, Bt[n].q[k]), __builtin_bit_cast(bf16x8, At[m].q[k]), acc[ai][bj][m][n], 0, 0, 0); } } \
        __builtin_amdgcn_s_setprio(0); } while (0)
#define PG8_WAIT_V(n) asm volatile("s_waitcnt vmcnt(" #n ")" ::: "memory")
#define PG8_WAIT_L(n) asm volatile("s_waitcnt lgkmcnt(" #n ")" ::: "memory")
#define PG8_BAR __builtin_amdgcn_s_barrier()
#define PG8_SCHED __builtin_amdgcn_sched_barrier(0)
    GU cur, nxt; int ui = 0;
    if (!S.next(0, cur)) return;
    f32x4 acc[2][2][4][2];
#pragma unroll
    for (int a = 0; a < 2; ++a)
#pragma unroll
        for (int b = 0; b < 2; ++b)
#pragma unroll
            for (int m = 0; m < 4; ++m)
#pragma unroll
                for (int n = 0; n < 2; ++n) acc[a][b][m][n] = (f32x4){0.f, 0.f, 0.f, 0.f};
    int f8sc = 0x7f7f7f7f; asm volatile("" : "+v"(f8sc));
    union Frag { v8i_t v; u32x4 q[2]; };
    Frag At[4], B0[2], B1[2];
    unsigned oc0[2], oc1[2], on0[2], on1[2];
    S.a_off(cur, Rr, Cc, oc0, oc1);
    const char* cA = cur.A; const char* cB = cur.B;
    PG8_STAGE(PG8_SB(0, 0), cB, voffB); PG8_STAGE(PG8_SB(0, 1), cB + hstep, voffB); PG8_STAGE(PG8_SA(0, 0), cA, oc0); PG8_STAGE(PG8_SA(0, 1), cA, oc1);
    if (wr == 1) PG8_BAR;
    PG8_WAIT_V(2); PG8_BAR;
    PG8_STAGE(PG8_SB(1, 0), cB + kstep, voffB); PG8_STAGE(PG8_SA(1, 0), cA + kstep, oc0); PG8_STAGE(PG8_SB(1, 1), cB + hstep + kstep, voffB);
    PG8_WAIT_V(6); PG8_BAR;
    for (;;) {
        const bool has_next = S.next(ui + 1, nxt);
        const char* nA = has_next ? nxt.A : cA; const char* nB = has_next ? nxt.B : cB;
        for (int t = 0; t < nt; t += 2) {
            const bool last = (t == nt - 2);
            const char* a1 = cA + (size_t)(t + 1) * kstep;
            const char* a2 = last ? nA : cA + (size_t)(t + 2) * kstep; const char* b2 = last ? nB : cB + (size_t)(t + 2) * kstep;
            const char* a3 = a2 + kstep; const char* b3 = b2 + kstep;
            unsigned o20[2], o21[2];
            if (last) {
                if (has_next) S.a_off(nxt, Rr, Cc, on0, on1); else { on0[0] = oc0[0]; on0[1] = oc0[1]; on1[0] = oc1[0]; on1[1] = oc1[1]; }
                o20[0] = on0[0]; o20[1] = on0[1]; o21[0] = on1[0]; o21[1] = on1[1];
            } else { o20[0] = oc0[0]; o20[1] = oc0[1]; o21[0] = oc1[0]; o21[1] = oc1[1]; }
            PG8_LDB(B0, 0, 0); PG8_LDB(B1, 0, 1); PG8_SCHED; PG8_LDA(At, 0, 0); PG8_STAGE(PG8_SA(1, 1), a1, oc1);
            PG8_WAIT_V(8); PG8_WAIT_L(0); PG8_BAR; PG8_MMA(0, 0, At, B0); PG8_MMA(0, 1, At, B1); PG8_BAR; PG8_SCHED;
            PG8_LDA(At, 0, 1); PG8_STAGE(PG8_SB(0, 0), b2, voffB); PG8_STAGE(PG8_SB(0, 1), b2 + hstep, voffB); PG8_STAGE(PG8_SA(0, 0), a2, o20);
            PG8_WAIT_V(8); PG8_WAIT_L(0); PG8_BAR; PG8_MMA(1, 0, At, B0); PG8_MMA(1, 1, At, B1); PG8_BAR; PG8_SCHED;
            PG8_LDB(B0, 1, 0); PG8_LDB(B1, 1, 1); PG8_SCHED; PG8_LDA(At, 1, 0); PG8_STAGE(PG8_SA(0, 1), a2, o21);
            PG8_WAIT_V(8); PG8_WAIT_L(0); PG8_BAR; PG8_MMA(0, 0, At, B0); PG8_MMA(0, 1, At, B1); PG8_BAR; PG8_SCHED;
            PG8_LDA(At, 1, 1); PG8_STAGE(PG8_SB(1, 0), b3, voffB); PG8_STAGE(PG8_SB(1, 1), b3 + hstep, voffB); PG8_STAGE(PG8_SA(1, 0), a3, o20);
            PG8_WAIT_V(8); PG8_WAIT_L(0); PG8_BAR; PG8_MMA(1, 0, At, B0); PG8_MMA(1, 1, At, B1); PG8_BAR; PG8_SCHED;
        }
        if (wr == 0) PG8_BAR;
        if constexpr (F8) asm volatile("s_nop 15\n\ts_nop 15" ::: "memory");
        E(acc, cur, wr, wc, fr, fq);
        if (!has_next) break;
#pragma unroll
        for (int a = 0; a < 2; ++a)
#pragma unroll
            for (int b = 0; b < 2; ++b)
#pragma unroll
                for (int m = 0; m < 4; ++m)
#pragma unroll
                    for (int n = 0; n < 2; ++n) acc[a][b][m][n] = (f32x4){0.f, 0.f, 0.f, 0.f};
        cur = nxt; cA = nA; cB = nB; ++ui;
        oc0[0] = on0[0]; oc0[1] = on0[1]; oc1[0] = on1[0]; oc1[1] = on1[1];
        if (wr == 1) PG8_BAR;
    }
    PG8_WAIT_V(0);
    PG8_BAR;
#undef PG8_SA
#undef PG8_SB
#undef PG8_STAGE
#undef PG8_LDA
#undef PG8_LDB
#undef PG8_MMA
#undef PG8_WAIT_V
#undef PG8_WAIT_L
#undef PG8_BAR
#undef PG8_SCHED
}

struct SchedDense {
    const bf16_t* A; const bf16_t* Bt; int nM, nN, G, c;
    __device__ __forceinline__ bool next(int i, GU& u) const {
        int pm, pn; if (!order_next(i, G, c, nM, nN, pm, pn)) return false;
        u.pm = pm; u.pn = pn; u.e = 0; u.mtl = pm; u.A = (const char*)A; u.B = (const char*)Bt + (size_t)pn * (256 * KD * 2); return true;
    }
    __device__ __forceinline__ void a_off(const GU& u, const int (&R)[2], const int (&C)[2], unsigned (&o0)[2], unsigned (&o1)[2]) const {
#pragma unroll
        for (int i = 0; i < 2; ++i) { o0[i] = (unsigned)((u.pm * 256 + R[i]) * KD + C[i]) * 2u; o1[i] = (unsigned)((u.pm * 256 + 128 + R[i]) * KD + C[i]) * 2u; }
    }
};
template <int ROWB>
struct SchedMoe {
    const void* A; const void* Bt; size_t bstride_e;
    const int* list; const LAS int* pts; const LAS int* cntl; const LAS unsigned char* tileE;
    int nM, nN, G, c; bool gather;
    __device__ __forceinline__ bool next(int i, GU& u) const {
        int pm, pn; if (!order_next(i, G, c, nM, nN, pm, pn)) return false;
        const int e = __builtin_amdgcn_readfirstlane((int)tileE[pm]);
        u.pm = pm; u.pn = pn; u.e = e; u.mtl = pm - __builtin_amdgcn_readfirstlane(pts[e]);
        u.A = (const char*)A; u.B = (const char*)Bt + (size_t)e * bstride_e + (size_t)pn * (256 * ROWB); return true;
    }
    __device__ __forceinline__ void a_off(const GU& u, const int (&R)[2], const int (&C)[2], unsigned (&o0)[2], unsigned (&o1)[2]) const {
        if (gather) {
            const int ce = __builtin_amdgcn_readfirstlane(cntl[u.e]);
            const int* lp = list + (size_t)u.e * LISTCAP;
#pragma unroll
            for (int i = 0; i < 2; ++i) {
                int i0 = u.mtl * 256 + R[i], i1 = i0 + 128;
                i0 = i0 < ce ? i0 : 0; i1 = i1 < ce ? i1 : 0;
                const int t0 = lp[i0], t1 = lp[i1];
                o0[i] = (unsigned)(t0 * ROWB + C[i] * 2); o1[i] = (unsigned)(t1 * ROWB + C[i] * 2);
            }
        } else {
#pragma unroll
            for (int i = 0; i < 2; ++i) { o0[i] = (unsigned)((u.pm * 256 + R[i]) * ROWB + C[i] * 2); o1[i] = (unsigned)((u.pm * 256 + 128 + R[i]) * ROWB + C[i] * 2); }
        }
    }
};

__device__ __forceinline__ u32x4 pack8(const f32x4& a, const f32x4& b) { u32x4 w; w.x = cvt_pk_bf16(a[0], a[1]); w.y = cvt_pk_bf16(a[2], a[3]); w.z = cvt_pk_bf16(b[0], b[1]); w.w = cvt_pk_bf16(b[2], b[3]); return w; }

struct EpiInProj {
    static constexpr bool PERM = true;
    bf16_t *QH, *KH, *VH, *OG, *AQ, *AK, *AV; float* GH; const float* lb; const float* bqkv;
    __device__ __forceinline__ void operator()(const f32x4 (&acc)[2][2][4][2], const GU& u, int wr, int wc, int fr, int fq) const {
        const int row0 = u.pm * BM + wr * 64 + fr;
        const int type = u.pn >> 2;
        const int cw = wc * 32 + 8 * fq;
#pragma unroll
        for (int bj = 0; bj < 2; ++bj) {
            const int col = (u.pn & 3) * 256 + bj * HALF + cw;
            if (type == 0 || type == 3) {
                bf16_t* O = (type == 0 ? QH : OG);
#pragma unroll
                for (int ai = 0; ai < 2; ++ai)
#pragma unroll
                    for (int m = 0; m < 4; ++m) { f32x4 v0 = acc[ai][bj][m][0], v1 = acc[ai][bj][m][1];
#pragma unroll
                        for (int j = 0; j < 4; ++j) { v0[j] = v0[j] * sigm(v0[j]); v1[j] = v1[j] * sigm(v1[j]); }
                        *(u32x4*)(O + (size_t)(row0 + ai * HALF + m * 16) * 1024 + col) = pack8(v0, v1); }
            } else if (type == 1) {
                const f32x4 l0 = *(const f32x4*)(lb + col), l1 = *(const f32x4*)(lb + col + 4);
#pragma unroll
                for (int ai = 0; ai < 2; ++ai)
#pragma unroll
                    for (int m = 0; m < 4; ++m) { f32x4 v0 = acc[ai][bj][m][0], v1 = acc[ai][bj][m][1], g0, g1;
#pragma unroll
                        for (int j = 0; j < 4; ++j) { const float s0 = sigm(v0[j]), s1 = sigm(v1[j]);
                            const float f0 = l0[j] + (1.f - l0[j]) * s0, f1 = l1[j] + (1.f - l1[j]) * s1;
                            g0[j] = __log2f(f0); g1[j] = __log2f(f1); }
                        const size_t o = (size_t)(row0 + ai * HALF + m * 16) * 1024 + col;
                        *(f32x4*)(GH + o) = g0; *(f32x4*)(GH + o + 4) = g1; }
            } else if (type == 2) {
#pragma unroll
                for (int ai = 0; ai < 2; ++ai)
#pragma unroll
                    for (int m = 0; m < 4; ++m) *(u32x4*)(VH + (size_t)(row0 + ai * HALF + m * 16) * 1024 + col) = pack8(acc[ai][bj][m][0], acc[ai][bj][m][1]);
            } else if (type == 4) {
                const f32x4 b0 = *(const f32x4*)(bqkv + col), b1 = *(const f32x4*)(bqkv + col + 4);
#pragma unroll
                for (int ai = 0; ai < 2; ++ai)
#pragma unroll
                    for (int m = 0; m < 4; ++m) { const f32x4 v0 = (acc[ai][bj][m][0] + b0) * 0.125f, v1 = (acc[ai][bj][m][1] + b1) * 0.125f;
                        *(u32x4*)(AQ + (size_t)(row0 + ai * HALF + m * 16) * 1024 + col) = pack8(v0, v1); }
            } else {
                bf16_t* O = bj == 0 ? AK : AV;
                const f32x4 b0 = *(const f32x4*)(bqkv + 1024 + bj * 128 + cw), b1 = *(const f32x4*)(bqkv + 1024 + bj * 128 + cw + 4);
#pragma unroll
                for (int ai = 0; ai < 2; ++ai)
#pragma unroll
                    for (int m = 0; m < 4; ++m) *(u32x4*)(O + (size_t)(row0 + ai * HALF + m * 16) * 128 + cw) = pack8(acc[ai][bj][m][0] + b0, acc[ai][bj][m][1] + b1);
            }
        }
    }
};
struct EpiOutProj {
    static constexpr bool PERM = true;
    float* Z; const float* x; const float* stats; const float* lnw; const float* lnb; const float* bo;
    __device__ __forceinline__ void operator()(const f32x4 (&acc)[2][2][4][2], const GU& u, int wr, int wc, int fr, int fq) const {
        const int row0 = u.pm * BM + wr * 64 + fr, col0 = u.pn * BM + wc * 32 + 8 * fq;
        f32x4 w4[2][2], b4[2][2];
#pragma unroll
        for (int bj = 0; bj < 2; ++bj)
#pragma unroll
            for (int n = 0; n < 2; ++n) { const int col = col0 + bj * HALF + n * 4; const f32x4 lw = *(const f32x4*)(lnw + col), lb = *(const f32x4*)(lnb + col), o4 = *(const f32x4*)(bo + col);
                w4[bj][n] = lw * ALPHA; b4[bj][n] = lb * ALPHA + o4; }
#pragma unroll
        for (int ai = 0; ai < 2; ++ai)
#pragma unroll
        for (int mp = 0; mp < 2; ++mp) {
            f32x4 xv[2][2][2]; f32x2 st[2];
#pragma unroll
            for (int mm = 0; mm < 2; ++mm) { const int row = row0 + ai * HALF + (2 * mp + mm) * 16; st[mm] = *(const f32x2*)(stats + 2 * row);
#pragma unroll
                for (int bj = 0; bj < 2; ++bj)
#pragma unroll
                    for (int n = 0; n < 2; ++n) xv[mm][bj][n] = *(const f32x4*)(x + (size_t)row * D + col0 + bj * HALF + n * 4); }
#pragma unroll
            for (int mm = 0; mm < 2; ++mm) { const int m = 2 * mp + mm, row = row0 + ai * HALF + m * 16;
#pragma unroll
                for (int bj = 0; bj < 2; ++bj)
#pragma unroll
                    for (int n = 0; n < 2; ++n) { const f32x4 z = (xv[mm][bj][n] - st[mm].x) * st[mm].y * w4[bj][n] + b4[bj][n] + acc[ai][bj][m][n];
                        *(f32x4*)(Z + (size_t)row * D + col0 + bj * HALF + n * 4) = z; } }
        }
    }
};
__device__ __forceinline__ unsigned pk4_fp8(float a, float b, float c, float d) {
    a = fminf(fmaxf(a, -448.f), 448.f); b = fminf(fmaxf(b, -448.f), 448.f); c = fminf(fmaxf(c, -448.f), 448.f); d = fminf(fmaxf(d, -448.f), 448.f);
    int w = __builtin_amdgcn_cvt_pk_fp8_f32(a, b, 0, false); w = __builtin_amdgcn_cvt_pk_fp8_f32(c, d, w, true); return (unsigned)w;
}
constexpr float SC_H1 = 32.f, SC_WGU = 2048.f, SC_HACT = 8.f, SC_WD = 4096.f;
struct EpiMoe1F8 {
    static constexpr bool PERM = true;
    unsigned char* H; const float* bg; const float* bu;
    __device__ __forceinline__ void operator()(const f32x4 (&acc)[2][2][4][2], const GU& u, int wr, int wc, int fr, int fq) const {
        const int row0 = u.pm * BM + wr * 64 + fr, hc = u.pn * 128 + wc * 32 + 8 * fq;
        const float* bgp = bg + (size_t)u.e * FF + hc; const float* bup = bu + (size_t)u.e * FF + hc;
        const f32x4 g0b = *(const f32x4*)bgp, g1b = *(const f32x4*)(bgp + 4), u0b = *(const f32x4*)bup, u1b = *(const f32x4*)(bup + 4);
        constexpr float IS = 1.f / (SC_H1 * SC_WGU);
#pragma unroll
        for (int ai = 0; ai < 2; ++ai)
#pragma unroll
            for (int m = 0; m < 4; ++m) {
                f32x4 a0 = acc[ai][0][m][0] * IS + g0b, a1 = acc[ai][0][m][1] * IS + g1b, c0 = acc[ai][1][m][0] * IS + u0b, c1 = acc[ai][1][m][1] * IS + u1b;
#pragma unroll
                for (int j = 0; j < 4; ++j) {
                    const float gg0 = fminf(a0[j], 7.f), gg1 = fminf(a1[j], 7.f);
                    const float uu0 = fminf(fmaxf(c0[j], -7.f), 7.f), uu1 = fminf(fmaxf(c1[j], -7.f), 7.f);
                    a0[j] = SC_HACT * gg0 * sigm(1.702f * gg0) * (uu0 + 1.f); a1[j] = SC_HACT * gg1 * sigm(1.702f * gg1) * (uu1 + 1.f);
                }
                u32x2 o; o.x = pk4_fp8(a0[0], a0[1], a0[2], a0[3]); o.y = pk4_fp8(a1[0], a1[1], a1[2], a1[3]);
                *(u32x2*)(H + (size_t)(row0 + ai * HALF + m * 16) * FF + hc) = o;
            }
    }
};
struct EpiMoe2F8 {
    static constexpr bool PERM = true;
    bf16_t* Y; const float* bd;
    __device__ __forceinline__ void operator()(const f32x4 (&acc)[2][2][4][2], const GU& u, int wr, int wc, int fr, int fq) const {
        const int row0 = u.pm * BM + wr * 64 + fr, col0 = u.pn * BM + wc * 32 + 8 * fq;
        const float* bp = bd + (size_t)u.e * D + col0;
        constexpr float IS = 1.f / (SC_HACT * SC_WD);
#pragma unroll
        for (int bj = 0; bj < 2; ++bj) {
            const f32x4 b0 = *(const f32x4*)(bp + bj * HALF), b1 = *(const f32x4*)(bp + bj * HALF + 4);
#pragma unroll
            for (int ai = 0; ai < 2; ++ai)
#pragma unroll
                for (int m = 0; m < 4; ++m) *(u32x4*)(Y + (size_t)(row0 + ai * HALF + m * 16) * D + col0 + bj * HALF) = pack8(acc[ai][bj][m][0] * IS + b0, acc[ai][bj][m][1] * IS + b1);
        }
    }
};
struct Args { const float* in[23]; float* out; unsigned char* ws; int ph_lo, ph_hi; };
struct Frame { LAS unsigned char* lds; int tid, lane, wave, G, vcu; unsigned char* ws; };

__device__ __forceinline__ void p0_transpose_item(const float* W, int N, int k0, int n0, bf16_t* WT_row0  , LAS float* scr, int lane) {
#pragma unroll 8
    for (int i = 0; i < 32; ++i) { const int kk = 2 * i + (lane >> 5); scr[kk * 33 + (lane & 31)] = W[(size_t)(k0 + kk) * N + n0 + (lane & 31)]; }
    asm volatile("s_waitcnt lgkmcnt(0)" ::: "memory");
    const int c = lane & 7;
#pragma unroll
    for (int j = 0; j < 4; ++j) { const int n = (lane >> 3) + 8 * j; const LAS float* s = scr + (8 * c) * 33 + n;
        u32x4 o; o.x = pk2(s[0 * 33], s[1 * 33]); o.y = pk2(s[2 * 33], s[3 * 33]); o.z = pk2(s[4 * 33], s[5 * 33]); o.w = pk2(s[6 * 33], s[7 * 33]);
        *(GAS u32x4*)(WT_row0 + (size_t)n * KD + k0 + 8 * c) = o; }
    asm volatile("s_waitcnt lgkmcnt(0)" ::: "memory");
}

__device__ __forceinline__ void p0_prologue(Frame& F, const Args& a) {
    LAS float* scr = (LAS float*)(F.lds + F.wave * 16384);
    const int gw = F.vcu * NWAVES + F.wave, NGW = F.G * NWAVES;
    unsigned char* ws = F.ws;
    for (int i = gw * 64 + F.lane; i < NE * D; i += NGW * 64) { const int e = i >> 11, k = i & 2047; ((_Float16*)(ws + WS_WRH))[i] = (_Float16)(a.in[13][(size_t)k * NE + e] * 64.f); }
    if (gw < 16) { const int i = gw * 64 + F.lane; const float* lbl = a.in[5]; const float l0 = lbl[i], l1 = lbl[1024 + i]; const float mx = fmaxf(l0, l1); const float e0 = __expf(l0 - mx), e1 = __expf(l1 - mx);
        ((float*)(ws + WS_LB))[i] = e0 / (e0 + e1); }
    {
        const float* x = a.in[0]; const float* w = a.in[1]; const float* b = a.in[2];
        bf16_t* H0 = (bf16_t*)(ws + WS_H0); float* st = (float*)(ws + WS_STATS0);
        for (int m = gw; m < T; m += NGW) {
            const GAS f32x4* xr = (const GAS f32x4*)(x + (size_t)m * D) + F.lane;
            f32x4 v[8]; float s = 0.f;
#pragma unroll
            for (int j = 0; j < 8; ++j) { v[j] = xr[64 * j]; s += (v[j][0] + v[j][1]) + (v[j][2] + v[j][3]); }
            const float mean = wave_sum(s) * (1.f / D); float s2 = 0.f;
#pragma unroll
            for (int j = 0; j < 8; ++j) { v[j] = v[j] - mean; s2 += (v[j][0] * v[j][0] + v[j][1] * v[j][1]) + (v[j][2] * v[j][2] + v[j][3] * v[j][3]); }
            const float rstd = rsqrtf(wave_sum(s2) * (1.f / D) + EPS);
            if (F.lane == 0) { st[2 * m] = mean; st[2 * m + 1] = rstd; }
            GAS u32x2* o8 = (GAS u32x2*)(H0 + (size_t)m * D) + F.lane;
#pragma unroll
            for (int j = 0; j < 8; ++j) { const f32x4 ww = *((const f32x4*)w + F.lane + 64 * j), bb = *((const f32x4*)b + F.lane + 64 * j);
                u32x2 o; o.x = pk2(v[j][0] * rstd * ww[0] + bb[0], v[j][1] * rstd * ww[1] + bb[1]); o.y = pk2(v[j][2] * rstd * ww[2] + bb[2], v[j][3] * rstd * ww[3] + bb[3]); o8[64 * j] = o; }
        }
    }
    constexpr int I_IN = 32 * (INC / 32), I_OUT = 32 * 64;
    constexpr int NITEMS = I_IN + I_OUT;
    for (int it = gw; it < NITEMS; it += NGW) {
        int r = it;
        if (r < I_IN) { const int nb = INC / 32, kb = r / nb, n0 = 32 * (r % nb); p0_transpose_item(a.in[3], INC, 64 * kb, n0, (bf16_t*)(ws + WS_WIN) + (size_t)n0 * KD, scr, F.lane); continue; } r -= I_IN;
        { const int kb = r / 64, n0 = 32 * (r % 64); p0_transpose_item(a.in[9], D, 64 * kb, n0, (bf16_t*)(ws + WS_WOUT) + (size_t)n0 * KD, scr, F.lane); }
    }
}

constexpr int CT_TILES = NE * 3 * 32 * 16, CT_RUN = 8;
constexpr int LC_CTB = 1024;
__device__ __forceinline__ void ct_src(const Args& a, unsigned char* ws, int id, const float*& W, unsigned char*& dst, float& sc, int& k0) {
    const int e = id / 1536, r = id - e * 1536, which = r >> 9, r2 = r & 511, kb = r2 >> 4, nb = r2 & 15;
    k0 = kb * 64;
    if (which < 2) { W = a.in[which == 0 ? 15 : 17] + (size_t)e * D * FF + nb * 128; dst = ws + WS_WGU + ((size_t)e * 4096 + (size_t)nb * 256 + which * 128) * KD; sc = SC_WGU; }
    else { W = a.in[19] + (size_t)e * FF * D + nb * 128; dst = ws + WS_WD + ((size_t)e * 2048 + (size_t)nb * 128) * KD; sc = SC_WD; }
}
__device__ __forceinline__ void cv_worker(Frame& F, const Args& a, const unsigned* stop_ctr, unsigned stop_at) {
    const int tid = F.tid, lane = F.lane, wv = F.wave;
    LAS unsigned char* ring = F.lds;
    volatile LAS int* ctb = (volatile LAS int*)(F.lds + LDSCTL_OFF + LC_CTB);
    unsigned* head = (unsigned*)(F.ws + WS_CTL) + CW_CONV;
    unsigned srcoff[4];
#pragma unroll
    for (int p = 0; p < 4; ++p) { const int row = 2 * (4 * wv + p) + (lane >> 5); srcoff[p] = (unsigned)(row * 2048 + 4 * ((lane & 31) ^ (2 * ((row >> 4) & 3)))); }
    const int on = tid >> 2, oc = tid & 3;
    const int rdoff = (16 * oc) * 128 * 4 + ((((on >> 2) ^ (2 * oc)) << 2) + (on & 3)) * 4;
#define CT_CLAIM(slotw) do { if (tid == 0) { int b_ = CT_TILES; if (!(stop_ctr && __hip_atomic_load(stop_ctr, RLX_AGENT) >= stop_at)) b_ = (int)__hip_atomic_fetch_add(head, (unsigned)CT_RUN, RLX_AGENT); ctb[slotw] = b_; } } while (0)
#define CT_DMA(id_, slot_) do { const float* W_; unsigned char* d_; float s_; int k_; ct_src(a, F.ws, (id_), W_, d_, s_, k_); const float* sp_ = W_ + (size_t)k_ * 2048; \
        _Pragma("unroll") for (int p = 0; p < 4; ++p) __builtin_amdgcn_global_load_lds((const unsigned*)(sp_ + srcoff[p]), (LAS unsigned*)(ring + (slot_) * 32768 + (4 * wv + p) * 1024), 16, 0, 0); } while (0)
    __syncthreads();
    CT_CLAIM(0);
    __syncthreads();
    int base = ctb[0];
    int issued = 0;
    bool more = base < CT_TILES;
#pragma unroll 1
    for (int i = 0; i < 3; ++i) { if (more) { CT_DMA(base + (issued & (CT_RUN - 1)), issued & 3); } ++issued; }
    int pbase = base;
    for (int k = 0; ; ++k) {
        if (((k + 3) & (CT_RUN - 1)) == 0) CT_CLAIM(((k + 3) / CT_RUN) & 1);
        if (pbase >= CT_TILES) break;
        asm volatile("s_waitcnt vmcnt(8)" ::: "memory");
        if (!more) asm volatile("s_waitcnt vmcnt(0)" ::: "memory");
        __syncthreads();
        {
            const float* W_; unsigned char* dst; float sc; int k0; ct_src(a, F.ws, pbase + (k & (CT_RUN - 1)), W_, dst, sc, k0);
            const LAS float* sp = (const LAS float*)(ring + (k & 3) * 32768 + rdoff);
            u32x4 o;
            o.x = pk4_fp8(sp[0 * 128] * sc, sp[1 * 128] * sc, sp[2 * 128] * sc, sp[3 * 128] * sc); o.y = pk4_fp8(sp[4 * 128] * sc, sp[5 * 128] * sc, sp[6 * 128] * sc, sp[7 * 128] * sc);
            o.z = pk4_fp8(sp[8 * 128] * sc, sp[9 * 128] * sc, sp[10 * 128] * sc, sp[11 * 128] * sc); o.w = pk4_fp8(sp[12 * 128] * sc, sp[13 * 128] * sc, sp[14 * 128] * sc, sp[15 * 128] * sc);
            *(GAS u32x4*)(dst + (size_t)on * KD + k0 + 16 * oc) = o;
            asm volatile("s_waitcnt lgkmcnt(0)" ::: "memory");
        }
        if (((k + 3) & (CT_RUN - 1)) == 0) { base = ctb[((k + 3) / CT_RUN) & 1]; more = base < CT_TILES; }
        if (more) { CT_DMA(base + ((k + 3) & (CT_RUN - 1)), (k + 3) & 3); }
        if (((k + 1) & (CT_RUN - 1)) == 0) pbase = ctb[((k + 1) / CT_RUN) & 1];
    }
    asm volatile("s_waitcnt vmcnt(0)" ::: "memory");
    __syncthreads();
#undef CT_CLAIM
#undef CT_DMA
}

constexpr int AT_Q = 32;
typedef float f32x16 __attribute__((ext_vector_type(16)));
typedef short s16x4 __attribute__((ext_vector_type(4)));
typedef short v4i16_t __attribute__((ext_vector_type(4)));
__device__ __forceinline__ s16x4 lds_tr16(const LAS unsigned char* p) { return __builtin_bit_cast(s16x4, __builtin_amdgcn_ds_read_tr16_b64_v4i16((LAS v4i16_t*)p)); }
__device__ __forceinline__ void attn_unit_mfma(Frame& F, const Args& a, int b, int qt) {
    LAS unsigned char* KS = F.lds;
    LAS unsigned char* VS = F.lds + 40960;
    LAS float* SSQ = (LAS float*)(F.lds + 81920);
    const bf16_t* AQ = (const bf16_t*)(F.ws + WS_AQ); const bf16_t* AK = (const bf16_t*)(F.ws + WS_AK); const bf16_t* AV = (const bf16_t*)(F.ws + WS_AV);
    bf16_t* YM = (bf16_t*)(F.ws + WS_YMIX);
    const int tid = F.tid, lane = F.lane, w = F.wave, r32 = lane & 31, hi = lane >> 5, t0 = qt * 32;
    __syncthreads();
#pragma unroll
    for (int p = 0; p < 5; ++p) {
        const int c = p * 512 + tid, row = c >> 4, ch = c & 15, kvh = ch >> 3, cr = ch & 7;
        const int pos = t0 - 128 + row;
        u32x4 kv = (u32x4){0u, 0u, 0u, 0u}, vv = (u32x4){0u, 0u, 0u, 0u};
        if (pos >= 0) { const size_t o = (size_t)(b * L + pos) * 128 + kvh * 64 + cr * 8; kv = *(const u32x4*)(AK + o); vv = *(const u32x4*)(AV + o); }
        *(LAS u32x4*)(KS + kvh * 20480 + row * 128 + ((cr ^ ((row >> 1) & 7)) << 4)) = kv;
        *(LAS u32x4*)(VS + kvh * 20480 + row * 128 + (((cr >> 2) ^ ((row >> 1) & 1)) << 6) + ((cr & 3) << 4)) = vv;
    }
    __syncthreads();
    const int kvh = w >> 2;
    const int ktmin = t0 < 128 ? (128 - t0) >> 5 : 0;
    const LAS unsigned char* Kb = KS + kvh * 20480;
    const LAS unsigned char* Vb = VS + kvh * 20480;
    unsigned OP[2][2][8];
    float ssq = 0.f;
#pragma unroll
    for (int hh = 0; hh < 2; ++hh) {
        const int head = 2 * w + hh;
        bf16x8 qf[4];
#pragma unroll
        for (int ks = 0; ks < 4; ++ks) qf[ks] = *(const bf16x8*)(AQ + (size_t)(b * L + t0 + r32) * 1024 + head * 64 + ks * 16 + hi * 8);
        f32x16 S[5];
#pragma unroll
        for (int kt = 0; kt < 5; ++kt) {
            const int row = kt * 32 + r32;
            f32x16 acc = (f32x16){0.f, 0.f, 0.f, 0.f, 0.f, 0.f, 0.f, 0.f, 0.f, 0.f, 0.f, 0.f, 0.f, 0.f, 0.f, 0.f};
#pragma unroll
            for (int ks = 0; ks < 4; ++ks) {
                const bf16x8 kf = *(const LAS bf16x8*)(Kb + row * 128 + (((2 * ks + hi) ^ ((row >> 1) & 7)) << 4));
                acc = __builtin_amdgcn_mfma_f32_32x32x16_bf16(kf, qf[ks], acc, 0, 0, 0);
            }
            S[kt] = acc;
        }
        const float sink = a.in[7][head];
        float m = sink;
#pragma unroll
        for (int kt = 0; kt < 5; ++kt)
#pragma unroll
            for (int r = 0; r < 16; ++r) {
                const int i = (r & 3) + 8 * (r >> 2) + 4 * hi;
                bool ok = kt >= ktmin;
                if (kt == 0) ok = ok && (i > r32);
                if (kt == 4) ok = ok && (i <= r32);
                const float v = ok ? S[kt][r] : -INFINITY;
                S[kt][r] = v; m = fmaxf(m, v);
            }
        m = fmaxf(m, __shfl_xor(m, 32));
        float l = 0.f;
#pragma unroll
        for (int kt = 0; kt < 5; ++kt)
#pragma unroll
            for (int r = 0; r < 16; ++r) { const float pv = __expf(S[kt][r] - m); S[kt][r] = pv; l += pv; }
        l += __shfl_xor(l, 32);
        l += __expf(sink - m);
        const float inv = 1.f / l;
#pragma unroll
        for (int dt = 0; dt < 2; ++dt) {
            f32x16 acc = (f32x16){0.f, 0.f, 0.f, 0.f, 0.f, 0.f, 0.f, 0.f, 0.f, 0.f, 0.f, 0.f, 0.f, 0.f, 0.f, 0.f};
            const int dcol = dt * 32 + 16 * ((lane >> 4) & 1) + 4 * (lane & 3);
            const int vlane = ((lane & 15) >> 2) * 128 + ((((dcol >> 5) ^ ((lane >> 3) & 1))) << 6) + (dcol & 31) * 2;
#pragma unroll
            for (int kt = 0; kt < 5; ++kt)
#pragma unroll
                for (int s2 = 0; s2 < 2; ++s2) {
                    const int rowb = kt * 32 + 16 * s2 + 4 * hi;
                    const s16x4 lo = lds_tr16(Vb + rowb * 128 + vlane), hi4 = lds_tr16(Vb + (rowb + 8) * 128 + vlane);
                    const bf16x8 vf = (bf16x8){lo[0], lo[1], lo[2], lo[3], hi4[0], hi4[1], hi4[2], hi4[3]};
                    u32x4 pw; pw.x = cvt_pk_bf16(S[kt][8 * s2 + 0], S[kt][8 * s2 + 1]); pw.y = cvt_pk_bf16(S[kt][8 * s2 + 2], S[kt][8 * s2 + 3]);
                    pw.z = cvt_pk_bf16(S[kt][8 * s2 + 4], S[kt][8 * s2 + 5]); pw.w = cvt_pk_bf16(S[kt][8 * s2 + 6], S[kt][8 * s2 + 7]);
                    acc = __builtin_amdgcn_mfma_f32_32x32x16_bf16(vf, __builtin_bit_cast(bf16x8, pw), acc, 0, 0, 0);
                }
#pragma unroll
            for (int r = 0; r < 16; ++r) { acc[r] *= inv; ssq += acc[r] * acc[r]; }
#pragma unroll
            for (int r = 0; r < 8; ++r) OP[hh][dt][r] = cvt_pk_bf16(acc[2 * r], acc[2 * r + 1]);
        }
    }
    ssq += __shfl_xor(ssq, 32);
    if (hi == 0) SSQ[w * 32 + r32] = ssq;
    __syncthreads();
    float tot = 0.f;
#pragma unroll
    for (int ww = 0; ww < 8; ++ww) tot += SSQ[ww * 32 + r32];
    const float rr = rsqrtf(tot * (1.f / 1024.f) + EPS);
    const float* nwp = a.in[8];
#pragma unroll
    for (int hh = 0; hh < 2; ++hh)
#pragma unroll
        for (int dt = 0; dt < 2; ++dt)
#pragma unroll
            for (int g4 = 0; g4 < 4; ++g4) {
                const int d = (2 * w + hh) * 64 + dt * 32 + 8 * g4 + 4 * hi;
                const f32x4 nw4 = *(const f32x4*)(nwp + d);
                const unsigned p0 = OP[hh][dt][2 * g4], p1 = OP[hh][dt][2 * g4 + 1];
                u32x2 o; o.x = pk2(bflo(p0) * rr * nw4[0], bfhi(p0) * rr * nw4[1]); o.y = pk2(bflo(p1) * rr * nw4[2], bfhi(p1) * rr * nw4[3]);
                *(u32x2*)(YM + (size_t)(b * L + t0 + r32) * D + 1024 + d) = o;
            }
}

constexpr int HL_QM = 0, HL_KM = 16384, HL_QS = 32768, HL_KE = 49152, HL_VT = 65536, HL_PL = 81920, HL_SEG = 90112, HL_DS = 94208, HL_SSQ = 94720;
__device__ __forceinline__ int trkey(int s) { return (s & 3) | (((s >> 3) & 1) << 2); }
__device__ __forceinline__ bf16x8 mk8(const s16x4& lo, const s16x4& hi) { return (bf16x8){lo[0], lo[1], lo[2], lo[3], hi[0], hi[1], hi[2], hi[3]}; }
__device__ __forceinline__ void hgrn_unit_mfma(Frame& F, const Args& a, int b, int h) {
    LAS unsigned char* lds = F.lds;
    const bf16_t* QH = (const bf16_t*)(F.ws + WS_QH); const bf16_t* VH = (const bf16_t*)(F.ws + WS_VH); const bf16_t* OG = (const bf16_t*)(F.ws + WS_OG);
    const float* GH = (const float*)(F.ws + WS_GH);
    bf16_t* YM = (bf16_t*)(F.ws + WS_YMIX);
    const int tid = F.tid, lane = F.lane, w = F.wave, r16 = lane & 15, g = lane >> 4, cp = lane;
    const size_t tokb = (size_t)b * L;
    const int hc = h * 128;
    f32x4 Sacc[8];
#pragma unroll
    for (int i = 0; i < 8; ++i) Sacc[i] = (f32x4){0.f, 0.f, 0.f, 0.f};
    f32x2 gpre[8]; unsigned qpre[8]; u32x4 vpre[2];
    const int vrow = tid >> 3, vc16 = tid & 7;
    const unsigned lo_g = 2u * (unsigned)cp, lo_v = (unsigned)(vrow * 1024 + vc16 * 8), lo_og = (unsigned)(r16 * 1024 + 4 * g), lo_ym = (unsigned)(r16 * 2048 + 4 * g);
    {
        const size_t rb = (tokb + 8 * w) * 1024 + hc;
        const float* gb = GH + rb; const bf16_t* qb = QH + rb; const bf16_t* vb = VH + tokb * 1024 + hc;
#pragma unroll
        for (int i = 0; i < 8; ++i) { gpre[i] = *(const f32x2*)(gb + i * 1024 + lo_g); qpre[i] = *(const unsigned*)(qb + i * 1024 + lo_g); }
        vpre[0] = *(const u32x4*)(vb + lo_v); vpre[1] = *(const u32x4*)(vb + 64 + lo_v);
    }
    const int keyl = ((lane & 15) >> 2) | ((g & 1) << 2);
    const int trrow = (8 * g + ((lane & 15) >> 2)) * 256 + 8 * (lane & 3);
    const unsigned wpar = (unsigned)(w & 1);
    const unsigned A1 = (((unsigned)cp >> 2) ^ (8u * wpar)) << 4, C1 = ((unsigned)cp & 3u) * 4u + (unsigned)w * 2048u;
    const unsigned A2 = (((unsigned)cp >> 1) ^ (16u * wpar)) << 3, C2 = ((unsigned)cp & 1u) * 4u + (unsigned)w * 2048u;
    const unsigned A3 = (((unsigned)cp >> 3) ^ (wpar << 2)) << 5, C3 = ((unsigned)cp & 7u) * 4u + (unsigned)w * 2048u;
    __syncthreads();
    for (int c = 0; c < L / 64; ++c) {
        int cc = c; asm volatile("" : "+s"(cc));
        const size_t tok0 = tokb + 64 * cc;
        { float run0 = 0.f, run1 = 0.f;
#pragma unroll
          for (int i = 0; i < 8; ++i) { run0 += gpre[i].x; run1 += gpre[i].y; }
          *(LAS f32x2*)(lds + HL_SEG + (w * 128 + 2 * cp) * 4) = (f32x2){run0, run1}; }
        { const int k0 = trkey(vrow);
          *(LAS u32x4*)(lds + HL_VT + vrow * 256 + ((((vc16 >> 1)) ^ k0) << 5) + (vc16 & 1) * 16) = vpre[0];
          *(LAS u32x4*)(lds + HL_VT + vrow * 256 + (((((vc16 + 8) >> 1)) ^ k0) << 5) + (vc16 & 1) * 16) = vpre[1]; }
        __syncthreads();
        f32x2 offc = (f32x2){0.f, 0.f}, rr = (f32x2){0.f, 0.f}, tot = (f32x2){0.f, 0.f};
#pragma unroll
        for (int sg = 0; sg < 8; ++sg) { const f32x2 sv = *(const LAS f32x2*)(lds + HL_SEG + (sg * 128 + 2 * cp) * 4);
            if (sg < w) offc += sv; if (sg < 4) rr += sv; tot += sv; }
        const f32x2 Rc = (f32x2){__builtin_amdgcn_exp2f(rr.x), __builtin_amdgcn_exp2f(rr.y)};
        const f32x2 C4 = (f32x2){__builtin_amdgcn_exp2f(tot.x - rr.x), __builtin_amdgcn_exp2f(tot.y - rr.y)};
        if (w == 0) *(LAS f32x2*)(lds + HL_DS + 2 * cp * 4) = (f32x2){__builtin_amdgcn_exp2f(tot.x), __builtin_amdgcn_exp2f(tot.y)};
#pragma unroll
        for (int i = 0; i < 8; ++i) {
            offc += gpre[i];
            const f32x2 d = offc - rr;
            const float E0 = __builtin_amdgcn_exp2f(fminf(fmaxf(d.x, -115.f), 115.f)), E1 = __builtin_amdgcn_exp2f(fminf(fmaxf(d.y, -115.f), 115.f));
            const float I0 = __builtin_amdgcn_rcpf(E0), I1 = __builtin_amdgcn_rcpf(E1);
            const float k0 = 1.f - __builtin_amdgcn_exp2f(gpre[i].x), k1 = 1.f - __builtin_amdgcn_exp2f(gpre[i].y);
            const f32x2 qm = (f32x2){bflo(qpre[i]) * E0, bfhi(qpre[i]) * E1}, km = (f32x2){k0 * I0, k1 * I1};
            const f32x2 qs = qm * Rc, ke = km * C4;
            LAS unsigned char* pq = lds + i * 256 + ((A1 ^ (unsigned)(i << 4)) + C1);
            *(LAS unsigned*)(pq + HL_QM) = cvt_pk_bf16_c(qm.x, qm.y);
            *(LAS unsigned*)(pq + HL_KM) = cvt_pk_bf16_c(km.x, km.y);
            *(LAS unsigned*)(lds + HL_QS + i * 256 + ((A2 ^ (unsigned)(i << 4)) + C2)) = cvt_pk_bf16_c(qs.x, qs.y);
            *(LAS unsigned*)(lds + HL_KE + i * 256 + ((A3 ^ (unsigned)((i & 3) << 5)) + C3)) = cvt_pk_bf16_c(ke.x, ke.y);
        }
        if (c + 1 < L / 64) {
            const size_t rb = (tok0 + 64 + 8 * w) * 1024 + hc;
            const float* gb = GH + rb; const bf16_t* qb = QH + rb; const bf16_t* vb = VH + (tok0 + 64) * 1024 + hc;
#pragma unroll
            for (int i = 0; i < 8; ++i) { gpre[i] = *(const f32x2*)(gb + i * 1024 + lo_g); qpre[i] = *(const unsigned*)(qb + i * 1024 + lo_g); }
            vpre[0] = *(const u32x4*)(vb + lo_v); vpre[1] = *(const u32x4*)(vb + 64 + lo_v);
        }
        __syncthreads();
#pragma unroll
        for (int rep = 0; rep < 2; ++rep) {
            if (rep == 1 && w >= 4) break;
            const int idx = rep == 0 ? w : 8 + w;
            const int si = (0xd940e4 >> (2 * idx)) & 3, ti = (0x8fb9e4 >> (2 * idx)) & 3;
            f32x4 pacc = (f32x4){0.f, 0.f, 0.f, 0.f};
            if (idx < 10) {
#pragma unroll
                for (int ks = 0; ks < 4; ++ks) {
                    const int ofs = r16 * 256 + (((4 * ks + g) ^ r16) << 4);
                    const bf16x8 af = *(const LAS bf16x8*)(lds + HL_KM + si * 4096 + ofs);
                    const bf16x8 bfr = *(const LAS bf16x8*)(lds + HL_QM + ti * 4096 + ofs);
                    pacc = __builtin_amdgcn_mfma_f32_16x16x32_bf16(af, bfr, pacc, 0, 0, 0);
                }
                const bool offd = si != ti;
#pragma unroll
                for (int r = 0; r < 4; ++r) pacc[r] = (offd || (4 * g + r <= r16)) ? pacc[r] : 0.f;
            }
            asm volatile("s_nop 7\n\ts_nop 7" ::: "memory");
            const int t = 16 * ti + r16;
            u32x2 pw; pw.x = cvt_pk_bf16_c(pacc[0], pacc[1]); pw.y = cvt_pk_bf16_c(pacc[2], pacc[3]);
            *(LAS u32x2*)(lds + HL_PL + t * 128 + (((2 * si + (g >> 1)) ^ ((t >> 1) & 7)) << 4) + (g & 1) * 8) = pw;
        }
        __syncthreads();
        u32x2 ogp[4];
        { const bf16_t* ob = OG + tok0 * 1024 + hc + 16 * w;
#pragma unroll
          for (int ti = 0; ti < 4; ++ti) ogp[ti] = *(const u32x2*)(ob + ti * 16384 + lo_og); }
#define HG_SB() __builtin_amdgcn_sched_barrier(0)
#define HG_QSLD(dst, kp) do { _Pragma("unroll") for (int ti = 0; ti < 4; ++ti) { const int t_ = 16 * ti + r16; \
            const u32x2 lo_ = *(const LAS u32x2*)(lds + HL_QS + t_ * 256 + (((8 * (kp) + g) ^ (r16 << 1)) << 3)); \
            const u32x2 hi_ = *(const LAS u32x2*)(lds + HL_QS + t_ * 256 + (((8 * (kp) + 4 + g) ^ (r16 << 1)) << 3)); \
            dst[ti] = (u32x4){lo_.x, lo_.y, hi_.x, hi_.y}; } } while (0)
#define HG_KELD(dst, kt) do { _Pragma("unroll") for (int ks = 0; ks < 2; ++ks) { const LAS unsigned char* pb_ = lds + HL_KE + ks * 32 * 256 + trrow + (((kt) ^ keyl) << 5); \
            dst[ks] = mk8(lds_tr16(pb_), lds_tr16(pb_ + 4 * 256)); } } while (0)
#define HG_INTER(kp, qsv) do { u32x4 sw_; sw_.x = cvt_pk_bf16_c(Sacc[2 * (kp)][0], Sacc[2 * (kp)][1]); sw_.y = cvt_pk_bf16_c(Sacc[2 * (kp)][2], Sacc[2 * (kp)][3]); \
            sw_.z = cvt_pk_bf16_c(Sacc[2 * (kp) + 1][0], Sacc[2 * (kp) + 1][1]); sw_.w = cvt_pk_bf16_c(Sacc[2 * (kp) + 1][2], Sacc[2 * (kp) + 1][3]); \
            const bf16x8 sf_ = __builtin_bit_cast(bf16x8, sw_); \
            _Pragma("unroll") for (int ti = 0; ti < 4; ++ti) Oa[ti] = __builtin_amdgcn_mfma_f32_16x16x32_bf16(sf_, __builtin_bit_cast(bf16x8, qsv[ti]), Oa[ti], 0, 0, 0); } while (0)
#define HG_SUPD(kt, kev, dsv) do { f32x4 sa_ = Sacc[kt] * dsv; \
            sa_ = __builtin_amdgcn_mfma_f32_16x16x32_bf16(kev[0], vf[0], sa_, 0, 0, 0); sa_ = __builtin_amdgcn_mfma_f32_16x16x32_bf16(kev[1], vf[1], sa_, 0, 0, 0); Sacc[kt] = sa_; } while (0)
        bf16x8 vf[2];
        bf16x8 pf[6];
        u32x4 qsA[4], qsB[4];
#pragma unroll
        for (int ks = 0; ks < 2; ++ks) {
            const LAS unsigned char* pb = lds + HL_VT + ks * 32 * 256 + trrow + ((w ^ keyl) << 5);
            vf[ks] = mk8(lds_tr16(pb), lds_tr16(pb + 4 * 256));
        }
        {
            const int t0_ = r16, t1_ = 16 + r16, t2_ = 32 + r16, t3_ = 48 + r16;
            pf[0] = *(const LAS bf16x8*)(lds + HL_PL + t0_ * 128 + (((g) ^ ((t0_ >> 1) & 7)) << 4));
            pf[1] = *(const LAS bf16x8*)(lds + HL_PL + t1_ * 128 + (((g) ^ ((t1_ >> 1) & 7)) << 4));
            pf[2] = *(const LAS bf16x8*)(lds + HL_PL + t2_ * 128 + (((g) ^ ((t2_ >> 1) & 7)) << 4));
            pf[3] = *(const LAS bf16x8*)(lds + HL_PL + t2_ * 128 + (((4 + g) ^ ((t2_ >> 1) & 7)) << 4));
            pf[4] = *(const LAS bf16x8*)(lds + HL_PL + t3_ * 128 + (((g) ^ ((t3_ >> 1) & 7)) << 4));
            pf[5] = *(const LAS bf16x8*)(lds + HL_PL + t3_ * 128 + (((4 + g) ^ ((t3_ >> 1) & 7)) << 4));
        }
        HG_QSLD(qsA, 0);
        HG_SB();
        f32x4 Oa[4];
        const f32x4 z4 = (f32x4){0.f, 0.f, 0.f, 0.f};
        Oa[0] = __builtin_amdgcn_mfma_f32_16x16x32_bf16(vf[0], pf[0], z4, 0, 0, 0);
        Oa[1] = __builtin_amdgcn_mfma_f32_16x16x32_bf16(vf[0], pf[1], z4, 0, 0, 0);
        Oa[2] = __builtin_amdgcn_mfma_f32_16x16x32_bf16(vf[0], pf[2], z4, 0, 0, 0);
        Oa[3] = __builtin_amdgcn_mfma_f32_16x16x32_bf16(vf[0], pf[4], z4, 0, 0, 0);
        Oa[2] = __builtin_amdgcn_mfma_f32_16x16x32_bf16(vf[1], pf[3], Oa[2], 0, 0, 0);
        Oa[3] = __builtin_amdgcn_mfma_f32_16x16x32_bf16(vf[1], pf[5], Oa[3], 0, 0, 0);
        HG_SB();
        HG_QSLD(qsB, 1);
        HG_SB();
        HG_INTER(0, qsA);
        HG_SB();
        HG_QSLD(qsA, 2);
        HG_SB();
        HG_INTER(1, qsB);
        HG_SB();
        HG_QSLD(qsB, 3);
        HG_SB();
#define HG_DSLD(kt) (*(const LAS f32x4*)(lds + HL_DS + (16 * (kt) + 4 * g) * 4))
        bf16x8 keA[2], keB[2], keC[2], keD[2]; f32x4 dA, dB, dC, dD;
        HG_KELD(keA, 0); HG_KELD(keB, 1); dA = HG_DSLD(0); dB = HG_DSLD(1);
        HG_SB();
        HG_INTER(2, qsA);
        HG_SB();
        HG_KELD(keC, 2); HG_KELD(keD, 3); dC = HG_DSLD(2); dD = HG_DSLD(3);
        HG_SB();
        HG_INTER(3, qsB);
        HG_SB();
        HG_SUPD(0, keA, dA); HG_SUPD(1, keB, dB);
        HG_SB();
        HG_KELD(keA, 4); HG_KELD(keB, 5); dA = HG_DSLD(4); dB = HG_DSLD(5);
        HG_SB();
        HG_SUPD(2, keC, dC); HG_SUPD(3, keD, dD);
        HG_SB();
        HG_KELD(keC, 6); HG_KELD(keD, 7); dC = HG_DSLD(6); dD = HG_DSLD(7);
        HG_SB();
        HG_SUPD(4, keA, dA); HG_SUPD(5, keB, dB);
        HG_SB();
        HG_SUPD(6, keC, dC); HG_SUPD(7, keD, dD);
#undef HG_DSLD
#undef HG_SB
#undef HG_QSLD
#undef HG_KELD
#undef HG_INTER
#undef HG_SUPD
#pragma unroll
        for (int ti = 0; ti < 4; ++ti) {
            float sq = (Oa[ti][0] * Oa[ti][0] + Oa[ti][1] * Oa[ti][1]) + (Oa[ti][2] * Oa[ti][2] + Oa[ti][3] * Oa[ti][3]);
            sq += __shfl_xor(sq, 16); sq += __shfl_xor(sq, 32);
            if (g == 0) *(LAS float*)(lds + HL_SSQ + (w * 64 + 16 * ti + r16) * 4) = sq;
        }
        __syncthreads();
#pragma unroll
        for (int ti = 0; ti < 4; ++ti) {
            const int t = 16 * ti + r16;
            float tot = 0.f;
#pragma unroll
            for (int ww = 0; ww < 8; ++ww) tot += *(const LAS float*)(lds + HL_SSQ + (ww * 64 + t) * 4);
            const float rs = rsqrtf(tot * (1.f / 128.f) + EPS);
            const f32x4 nw4 = *(const f32x4*)(a.in[6] + 16 * w + 4 * g);
            u32x2 o; o.x = pk2(Oa[ti][0] * rs * nw4[0] * bflo(ogp[ti].x), Oa[ti][1] * rs * nw4[1] * bfhi(ogp[ti].x));
            o.y = pk2(Oa[ti][2] * rs * nw4[2] * bflo(ogp[ti].y), Oa[ti][3] * rs * nw4[3] * bfhi(ogp[ti].y));
            *(u32x2*)(YM + tok0 * D + hc + 16 * w + ti * 32768 + lo_ym) = o;
        }
    }
}

typedef _Float16 f16x8 __attribute__((ext_vector_type(8)));
typedef _Float16 f16x2 __attribute__((ext_vector_type(2)));
__device__ __forceinline__ unsigned pkh(float a, float b) { const f16x2 h = {(_Float16)a, (_Float16)b}; return __builtin_bit_cast(unsigned, h); }
constexpr int LC_CNTL = 4096, LC_BASE = 4224;
__device__ __forceinline__ void p4_ln_router(Frame& F, const Args& a) {
    LAS unsigned char* lds = F.lds;
    const float* Z = (const float*)(F.ws + WS_Z); bf16_t* H1 = (bf16_t*)(F.ws + WS_H1);
    const float* w = a.in[11]; const float* b = a.in[12]; const float* br = a.in[14];
    int* cnt = (int*)(F.ws + WS_CTL) + CW_CNT; int* list = (int*)(F.ws + WS_LIST);
    int* tok_e = (int*)(F.ws + WS_TOKE); int* tok_p = (int*)(F.ws + WS_TOKP); float* tok_g = (float*)(F.ws + WS_TOKG);
    const int tid = F.tid, lane = F.lane, wv = F.wave, r16 = lane & 15, g = lane >> 4, nh = wv & 1, q = wv >> 1;
    LAS int* CNTL = (LAS int*)(lds + LDSCTL_OFF + LC_CNTL); LAS int* BASE = (LAS int*)(lds + LDSCTL_OFF + LC_BASE);
    if (tid < 32) CNTL[tid] = 0;
    f16x8 wf[16];
    { const _Float16* ph = (const _Float16*)(F.ws + WS_WRH) + (size_t)(16 * nh + r16) * D + 512 * q + 8 * g;
#pragma unroll
      for (int ks = 0; ks < 16; ++ks) wf[ks] = *(const f16x8*)(ph + 32 * ks); }
    int se0 = 0, se1 = 0, se2 = 0, se3 = 0; float sg0 = 0.f, sg1 = 0.f, sg2 = 0.f, sg3 = 0.f;
    const int ntile = T / 32;
    const int nmy = (ntile - F.vcu + F.G - 1) / F.G;
    for (int it = 0; it < nmy; ++it) {
        const int tile = F.vcu + it * F.G;
        __syncthreads();
#define P4_LN(v, tlx) do { const int tl = (tlx), m = tile * 32 + tl; float s = 0.f; \
            _Pragma("unroll") for (int j = 0; j < 8; ++j) s += (v[j][0] + v[j][1]) + (v[j][2] + v[j][3]); \
            const float mean = wave_sum(s) * (1.f / D); float s2 = 0.f; \
            _Pragma("unroll") for (int j = 0; j < 8; ++j) { v[j] = v[j] - mean; s2 += (v[j][0] * v[j][0] + v[j][1] * v[j][1]) + (v[j][2] * v[j][2] + v[j][3] * v[j][3]); } \
            const float rstd = rsqrtf(wave_sum(s2) * (1.f / D) + EPS); \
            GAS u32x2* o8 = (GAS u32x2*)(H1 + (size_t)m * D) + lane; \
            _Pragma("unroll") for (int j = 0; j < 8; ++j) { const f32x4 ww = *((const f32x4*)w + lane + 64 * j), bb = *((const f32x4*)b + lane + 64 * j); \
                f32x4 hv; hv[0] = v[j][0] * rstd * ww[0] + bb[0]; hv[1] = v[j][1] * rstd * ww[1] + bb[1]; hv[2] = v[j][2] * rstd * ww[2] + bb[2]; hv[3] = v[j][3] * rstd * ww[3] + bb[3]; \
                u32x2 o; o.x = pk2(hv[0], hv[1]); o.y = pk2(hv[2], hv[3]); o8[64 * j] = o; \
                *((GAS unsigned*)(F.ws + WS_H1Q + (size_t)m * D) + lane + 64 * j) = pk4_fp8(hv[0] * SC_H1, hv[1] * SC_H1, hv[2] * SC_H1, hv[3] * SC_H1); \
                u32x2 hh; hh.x = pkh(hv[0], hv[1]); hh.y = pkh(hv[2], hv[3]); \
                *(LAS u32x2*)(lds + tl * 4096 + ((((lane >> 1) + 32 * j) ^ (tl & 15)) << 4) + (lane & 1) * 8) = hh; } } while (0)
#pragma unroll 1
        for (int ps = 0; ps < 2; ++ps) {
            f32x4 v0[8], v1[8];
            { const GAS f32x4* z0 = (const GAS f32x4*)(Z + (size_t)(tile * 32 + 4 * wv + 2 * ps) * D) + lane;
#pragma unroll
              for (int j = 0; j < 8; ++j) { v0[j] = z0[64 * j]; v1[j] = z0[64 * j + 512]; } }
            P4_LN(v0, 4 * wv + 2 * ps); P4_LN(v1, 4 * wv + 2 * ps + 1);
        }
#undef P4_LN
        __syncthreads();
        f32x4 acc0 = (f32x4){0.f, 0.f, 0.f, 0.f}, acc1 = (f32x4){0.f, 0.f, 0.f, 0.f};
#pragma unroll
        for (int ks = 0; ks < 16; ++ks) {
            const int off = r16 * 4096 + (((64 * q + 4 * ks + g) ^ r16) << 4);
            const f16x8 t0 = *(const LAS f16x8*)(lds + off), t1 = *(const LAS f16x8*)(lds + 65536 + off);
            acc0 = __builtin_amdgcn_mfma_f32_16x16x32_f16(wf[ks], t0, acc0, 0, 0, 0);
            acc1 = __builtin_amdgcn_mfma_f32_16x16x32_f16(wf[ks], t1, acc1, 0, 0, 0);
        }
        __syncthreads();
        *(LAS f32x4*)(lds + ((q * 32 + r16) * 32 + 16 * nh + 4 * g) * 4) = acc0;
        *(LAS f32x4*)(lds + ((q * 32 + 16 + r16) * 32 + 16 * nh + 4 * g) * 4) = acc1;
        __syncthreads();
#pragma unroll
        for (int ps = 0; ps < 2; ++ps) {
            const int e = lane & 31, tl = 4 * wv + 2 * ps + (lane >> 5);
            float sl = 0.f;
#pragma unroll
            for (int qq = 0; qq < 4; ++qq) sl += *(const LAS float*)(lds + ((qq * 32 + tl) * 32 + e) * 4);
            sl = sl * (1.f / 64.f) + br[e];
            float val = sl; int te[4]; float tv[4];
#pragma unroll
            for (int r = 0; r < 4; ++r) {
                float bv = val; int bi = e;
#pragma unroll
                for (int o = 1; o < 32; o <<= 1) { const float ov = __shfl_xor(bv, o); const int oi = __shfl_xor(bi, o); if (ov > bv || (ov == bv && oi < bi)) { bv = ov; bi = oi; } }
                te[r] = bi; tv[r] = bv; if (e == bi) val = -INFINITY;
            }
            float p[4], psum = 0.f;
#pragma unroll
            for (int r = 0; r < 4; ++r) { p[r] = __expf(tv[r] - tv[0]); psum += p[r]; }
            if (e < 4) {
                int ee = te[0]; float gg = p[0];
                if (e == 1) { ee = te[1]; gg = p[1]; } else if (e == 2) { ee = te[2]; gg = p[2]; } else if (e == 3) { ee = te[3]; gg = p[3]; }
                const float gn = gg / psum; const int idx = it * 2 + ps;
                if (idx == 0) { se0 = ee; sg0 = gn; } else if (idx == 1) { se1 = ee; sg1 = gn; } else if (idx == 2) { se2 = ee; sg2 = gn; } else { se3 = ee; sg3 = gn; }
            }
        }
    }
    __syncthreads();
    const bool own = (lane & 31) < 4;
    const int nent = nmy * 2;
    int rk0 = 0, rk1 = 0, rk2 = 0, rk3 = 0;
    if (own) {
        if (nent > 0) rk0 = __hip_atomic_fetch_add((LAS int*)&CNTL[se0], 1, __ATOMIC_RELAXED, __HIP_MEMORY_SCOPE_WORKGROUP);
        if (nent > 1) rk1 = __hip_atomic_fetch_add((LAS int*)&CNTL[se1], 1, __ATOMIC_RELAXED, __HIP_MEMORY_SCOPE_WORKGROUP);
        if (nent > 2) rk2 = __hip_atomic_fetch_add((LAS int*)&CNTL[se2], 1, __ATOMIC_RELAXED, __HIP_MEMORY_SCOPE_WORKGROUP);
        if (nent > 3) rk3 = __hip_atomic_fetch_add((LAS int*)&CNTL[se3], 1, __ATOMIC_RELAXED, __HIP_MEMORY_SCOPE_WORKGROUP);
    }
    __syncthreads();
    if (tid < 32) { const int c = CNTL[tid]; BASE[tid] = c > 0 ? atomicAdd(&cnt[tid], c) : 0; }
    __syncthreads();
    if (own) {
        const int k = lane & 31;
#define P4_EMIT(idx, sex, sgx, rkx) do { if (nent > (idx)) { const int m = (F.vcu + ((idx) >> 1) * F.G) * 32 + 4 * wv + 2 * ((idx) & 1) + (lane >> 5), pos = BASE[sex] + (rkx); \
            list[(size_t)(sex) * LISTCAP + pos] = m; tok_e[m * 4 + k] = (sex); tok_p[m * 4 + k] = pos; tok_g[m * 4 + k] = (sgx); } } while (0)
        P4_EMIT(0, se0, sg0, rk0); P4_EMIT(1, se1, sg1, rk1); P4_EMIT(2, se2, sg2, rk2); P4_EMIT(3, se3, sg3, rk3);
#undef P4_EMIT
    }
}
__device__ __forceinline__ int moe_tables(Frame& F) {
    LAS int* pts = (LAS int*)(F.lds + LDSCTL_OFF + LC_PTS); LAS int* cl = (LAS int*)(F.lds + LDSCTL_OFF + LC_CNT); LAS unsigned char* tileE = (LAS unsigned char*)(F.lds + LDSCTL_OFF + LC_TILEE);
    const int* cnt = (const int*)(F.ws + WS_CTL) + CW_CNT;
    __syncthreads();
    if (F.tid < 64) {
        const int e = F.tid & 31; const int c = __hip_atomic_load(cnt + e, RLX_AGENT); const int tl = (c + 255) >> 8;
        int incl = tl;
#pragma unroll
        for (int o = 1; o < 32; o <<= 1) { const int v = __shfl_up(incl, o, 32); if (e >= o) incl += v; }
        if (F.tid < 32) { cl[e] = c; pts[e] = incl - tl; if (e == 31) pts[32] = incl; }
    }
    __syncthreads();
    const int nmt = pts[32];
    for (int t = F.tid; t < nmt; t += NTHR) { int e = 0;
        for (int j = 0; j < 32; ++j) if (t >= pts[j + 1]) e = j + 1;
        tileE[t] = (unsigned char)e; }
    __syncthreads();
    return __builtin_amdgcn_readfirstlane(nmt);
}
__device__ __forceinline__ void p7_combine(Frame& F, const Args& a) {
    const LAS int* pts = (const LAS int*)(F.lds + LDSCTL_OFF + LC_PTS);
    const bf16_t* H1 = (const bf16_t*)(F.ws + WS_H1); const bf16_t* Y = (const bf16_t*)(F.ws + WS_Y);
    const int* tok_e = (const int*)(F.ws + WS_TOKE); const int* tok_p = (const int*)(F.ws + WS_TOKP); const float* tok_g = (const float*)(F.ws + WS_TOKG);
    const float* w = a.in[21]; const float* b = a.in[22]; float* out = a.out;
    const int gw = F.vcu * NWAVES + F.wave, NGW = F.G * NWAVES, lane = F.lane;
    const int ntok = (T - gw + NGW - 1) / NGW;
    int rowv = 0; float gv = 0.f;
    { const int i = lane >> 2, k = lane & 3; if (i < ntok) { const int m = gw + i * NGW; const int e = tok_e[m * 4 + k]; rowv = pts[e] * 256 + tok_p[m * 4 + k]; gv = tok_g[m * 4 + k]; } }
#define P8_LOAD(hx, yx, i) do { const int m_ = gw + (i) * NGW; const GAS u32x2* hr_ = (const GAS u32x2*)(H1 + (size_t)m_ * D) + lane; \
        _Pragma("unroll") for (int j = 0; j < 8; ++j) hx[j] = hr_[64 * j]; \
        _Pragma("unroll") for (int k = 0; k < 4; ++k) { const int row_ = __builtin_amdgcn_readlane(rowv, 4 * (i) + k); const GAS u32x2* yr_ = (const GAS u32x2*)(Y + (size_t)row_ * D) + lane; \
            _Pragma("unroll") for (int j = 0; j < 8; ++j) yx[k][j] = yr_[64 * j]; } } while (0)
#define P8_DO(hx, yx, i) do { const int m_ = gw + (i) * NGW; f32x4 v[8]; \
        _Pragma("unroll") for (int j = 0; j < 8; ++j) { v[j][0] = ALPHA * bflo(hx[j].x); v[j][1] = ALPHA * bfhi(hx[j].x); v[j][2] = ALPHA * bflo(hx[j].y); v[j][3] = ALPHA * bfhi(hx[j].y); } \
        _Pragma("unroll") for (int k = 0; k < 4; ++k) { const float g_ = __builtin_bit_cast(float, __builtin_amdgcn_readlane(__builtin_bit_cast(int, gv), 4 * (i) + k)); \
            _Pragma("unroll") for (int j = 0; j < 8; ++j) { v[j][0] += g_ * bflo(yx[k][j].x); v[j][1] += g_ * bfhi(yx[k][j].x); v[j][2] += g_ * bflo(yx[k][j].y); v[j][3] += g_ * bfhi(yx[k][j].y); } } \
        float s = 0.f; _Pragma("unroll") for (int j = 0; j < 8; ++j) s += (v[j][0] + v[j][1]) + (v[j][2] + v[j][3]); \
        const float mean = wave_sum(s) * (1.f / D); float s2 = 0.f; \
        _Pragma("unroll") for (int j = 0; j < 8; ++j) { v[j] = v[j] - mean; s2 += (v[j][0] * v[j][0] + v[j][1] * v[j][1]) + (v[j][2] * v[j][2] + v[j][3] * v[j][3]); } \
        const float rstd = rsqrtf(wave_sum(s2) * (1.f / D) + EPS); GAS f32x4* orow = (GAS f32x4*)(out + (size_t)m_ * D) + lane; \
        _Pragma("unroll") for (int j = 0; j < 8; ++j) { const f32x4 ww = *((const f32x4*)w + lane + 64 * j), bb = *((const f32x4*)b + lane + 64 * j); \
            f32x4 o; o[0] = v[j][0] * rstd * ww[0] + bb[0]; o[1] = v[j][1] * rstd * ww[1] + bb[1]; o[2] = v[j][2] * rstd * ww[2] + bb[2]; o[3] = v[j][3] * rstd * ww[3] + bb[3]; orow[64 * j] = o; } } while (0)
    u32x2 hA[8], yA[4][8], hB[8], yB[4][8];
    if (ntok > 0) P8_LOAD(hA, yA, 0);
    for (int i = 0; i < ntok; i += 2) {
        if (i + 1 < ntok) P8_LOAD(hB, yB, i + 1);
        P8_DO(hA, yA, i);
        if (i + 1 < ntok) { if (i + 2 < ntok) P8_LOAD(hA, yA, i + 2); P8_DO(hB, yB, i + 1); }
    }
#undef P8_LOAD
#undef P8_DO
}

__global__ void __launch_bounds__(NTHR, 2) mk_fwd(Args args) {
    extern __shared__ __attribute__((aligned(16))) unsigned char lds_raw[];
    Frame F;
    F.lds = (LAS unsigned char*)lds_raw;
    F.tid = threadIdx.x; F.lane = F.tid & 63; F.wave = __builtin_amdgcn_readfirstlane(F.tid >> 6);
    F.G = gridDim.x; { const int bx = blockIdx.x; F.vcu = (F.G % 8 == 0) ? (bx % 8) * (F.G / 8) + bx / 8 : bx; }
    F.ws = args.ws;
    unsigned char* ws = args.ws;
    for (int u = F.tid; u < (LDS_BYTES - LDSCTL_OFF) / 4; u += NTHR) ((LAS unsigned*)(F.lds + LDSCTL_OFF))[u] = 0u;
    __syncthreads();
    XcdBarrier bar; bar.bar = (unsigned*)(ws + WS_CTL) + CW_BAR; bar.x = 0; bar.st = nullptr;
#if !MK_PER_PHASE
    bar = xcd_barrier_post((unsigned*)(ws + WS_CTL) + CW_BAR, (volatile LAS unsigned*)(F.lds + LDSCTL_OFF + LC_BAR));
#endif
    const int lo = args.ph_lo, hi = args.ph_hi;
#define IN(k) (lo <= (k) && (k) < hi)
#define REFRESH_IDS() do { int t_ = threadIdx.x; asm volatile("" : "+v"(t_)); F.tid = t_; F.lane = t_ & 63; F.wave = __builtin_amdgcn_readfirstlane(t_ >> 6); } while (0)
#define SEAM(k) do { if (IN(k) && IN((k) + 1)) xcd_barrier(bar); } while (0)

    if (IN(0)) { REFRESH_IDS(); for (int r = 0; r < REP0; ++r) { p0_prologue(F, args); if (r + 1 < REP0) xcd_barrier(bar); } } SEAM(0);

    if (IN(1)) { REFRESH_IDS();
        const int Gg = F.G;
        SchedDense S{(const bf16_t*)(ws + WS_H0), (const bf16_t*)(ws + WS_WIN), T / 256, INC / 256, Gg, (int)blockIdx.x};
        EpiInProj E{(bf16_t*)(ws + WS_QH), (bf16_t*)(ws + WS_KH), (bf16_t*)(ws + WS_VH), (bf16_t*)(ws + WS_OG), (bf16_t*)(ws + WS_AQ), (bf16_t*)(ws + WS_AK), (bf16_t*)(ws + WS_AV),
                    (float*)(ws + WS_GH), (const float*)(ws + WS_LB), args.in[4]};
        for (int r = 0; r < REP1; ++r) { gemm_phase<EpiInProj, SchedDense>(F.lds, S, E); if (r + 1 < REP1) xcd_barrier(bar); }
        {
            const int nwg = (T / 256) * (INC / 256), full = nwg / F.G, extra = nwg - full * F.G;
            const bool has_extra = (int)blockIdx.x < extra;
            if (has_extra) { if (threadIdx.x == 0) __hip_atomic_fetch_add((unsigned*)(ws + WS_CTL) + CW_P1DONE, 1u, RLX_AGENT); }
            else if (extra > 0) { __syncthreads(); cv_worker(F, args, (const unsigned*)(ws + WS_CTL) + CW_P1DONE, (unsigned)extra); }
        }
    } SEAM(1);

    if (IN(2)) { REFRESH_IDS();
        for (int r = 0; r < REP2; ++r) {
        const int nh = F.G > 64 ? 64 : F.G;
        const int a0 = F.G >= 192 ? 64 : 0, na = F.G >= 192 ? 64 : F.G;
        if ((int)blockIdx.x < nh) { for (int hu = blockIdx.x; hu < 64 * REP2H; hu += nh) hgrn_unit_mfma(F, args, (hu & 63) >> 3, hu & 7); }
        REFRESH_IDS();
        if ((int)blockIdx.x >= a0 && (int)blockIdx.x < a0 + na) {
            for (int v0 = (int)blockIdx.x - a0; v0 < NB * (L / AT_Q) * REP2A; v0 += na) { const int v = v0 % (NB * (L / AT_Q)); attn_unit_mfma(F, args, v / (L / AT_Q), v % (L / AT_Q)); }
        }
        __syncthreads();
        REFRESH_IDS();
        cv_worker(F, args, nullptr, 0u);
        if (r + 1 < REP2) xcd_barrier(bar); }
    } SEAM(2);

    if (IN(3)) { REFRESH_IDS();
        SchedDense S{(const bf16_t*)(ws + WS_YMIX), (const bf16_t*)(ws + WS_WOUT), T / 256, D / 256, F.G, (int)blockIdx.x};
        EpiOutProj E{(float*)(ws + WS_Z), args.in[0], (const float*)(ws + WS_STATS0), args.in[1], args.in[2], args.in[10]};
        for (int r = 0; r < REP3; ++r) { gemm_phase<EpiOutProj, SchedDense>(F.lds, S, E); if (r + 1 < REP3) xcd_barrier(bar); }
    } SEAM(3);

    if (IN(4)) { REFRESH_IDS(); p4_ln_router(F, args); }

    if (IN(5) && !IN(4)) { REFRESH_IDS(); __syncthreads(); cv_worker(F, args, nullptr, 0u); }
    if (IN(4) || IN(5)) { if (IN(6)) xcd_barrier(bar); }

    if (IN(6)) { REFRESH_IDS();
        const int nmt = moe_tables(F);
        SchedMoe<2048> S{(const void*)(ws + WS_H1Q), (const void*)(ws + WS_WGU), (size_t)4096 * KD, (const int*)(ws + WS_LIST),
                   (const LAS int*)(F.lds + LDSCTL_OFF + LC_PTS), (const LAS int*)(F.lds + LDSCTL_OFF + LC_CNT), (const LAS unsigned char*)(F.lds + LDSCTL_OFF + LC_TILEE), nmt, 16, F.G, (int)blockIdx.x, true};
        EpiMoe1F8 E{(unsigned char*)(ws + WS_HACT), args.in[16], args.in[18]};
        for (int r = 0; r < REP5; ++r) { gemm_phase<EpiMoe1F8, SchedMoe<2048>, true>(F.lds, S, E); if (r + 1 < REP5) xcd_barrier(bar); }
    } SEAM(6);

    if (IN(7)) { REFRESH_IDS();
        const int nmt = moe_tables(F);
        SchedMoe<2048> S{(const void*)(ws + WS_HACT), (const void*)(ws + WS_WD), (size_t)2048 * KD, (const int*)(ws + WS_LIST),
                   (const LAS int*)(F.lds + LDSCTL_OFF + LC_PTS), (const LAS int*)(F.lds + LDSCTL_OFF + LC_CNT), (const LAS unsigned char*)(F.lds + LDSCTL_OFF + LC_TILEE), nmt, 8, F.G, (int)blockIdx.x, false};
        EpiMoe2F8 E{(bf16_t*)(ws + WS_Y), args.in[20]};
        for (int r = 0; r < REP6; ++r) { gemm_phase<EpiMoe2F8, SchedMoe<2048>, true>(F.lds, S, E); if (r + 1 < REP6) xcd_barrier(bar); }
    } SEAM(7);

    if (IN(8)) { REFRESH_IDS(); (void)moe_tables(F); for (int r = 0; r < REP7; ++r) p7_combine(F, args); }
#undef IN
#undef SEAM
}
}

extern "C" void kernel_launch(void* const* d_in, const int* in_sizes, int n_in, void* d_out, int out_size, void* d_ws, size_t ws_size, hipStream_t stream) {
    static int grid = 0;
    if (grid == 0) {
        if (n_in != 23 || out_size != T * D || ws_size < WS_END) { fprintf(stderr, "kernel_launch: unexpected shapes (n_in %d out %d ws %zu need %zu)\n", n_in, out_size, ws_size, (size_t)WS_END); grid = -1; return; }
        int dev = 0, cus = 0, per_cu = 0;
        if (hipGetDevice(&dev) != hipSuccess || hipDeviceGetAttribute(&cus, hipDeviceAttributeMultiprocessorCount, dev) != hipSuccess) { grid = -1; return; }
        if (hipFuncSetAttribute((const void*)mk_fwd, hipFuncAttributeMaxDynamicSharedMemorySize, LDS_BYTES) != hipSuccess) { fprintf(stderr, "kernel_launch: hipFuncSetAttribute failed\n"); grid = -1; return; }
        if (hipOccupancyMaxActiveBlocksPerMultiprocessor(&per_cu, (const void*)mk_fwd, NTHR, LDS_BYTES) != hipSuccess || per_cu < 1) { fprintf(stderr, "kernel_launch: occupancy query says %d\n", per_cu); }
        (void)hipGetLastError();
        grid = cus;
    }
    if (grid < 0) return;
    if (hipMemsetAsync((char*)d_ws + WS_CTL, 0, CTL_ZERO_BYTES, stream) != hipSuccess) return;
    Args a{};
    for (int i = 0; i < 23; ++i) a.in[i] = (const float*)d_in[i];
    a.out = (float*)d_out; a.ws = (unsigned char*)d_ws;
#if MK_PER_PHASE
    for (int p = 0; p < NPHASE; ++p) { a.ph_lo = p; a.ph_hi = p + 1; hipLaunchKernelGGL(mk_fwd, dim3(grid), dim3(NTHR), LDS_BYTES, stream, a); }
#else
    a.ph_lo = 0; a.ph_hi = NPHASE; hipLaunchKernelGGL(mk_fwd, dim3(grid), dim3(NTHR), LDS_BYTES, stream, a);
#endif
}
```

```cpp
#include <hip/hip_runtime.h>
#include <cstdio>
#include <cstdint>

#ifndef MK_PER_PHASE
#define MK_PER_PHASE 0
#endif

#define LAS __attribute__((address_space(3)))
#define GAS __attribute__((address_space(1)))
typedef unsigned short bf16_t;
typedef short bf16x8 __attribute__((ext_vector_type(8)));
typedef float f32x4 __attribute__((ext_vector_type(4)));
typedef float f32x2 __attribute__((ext_vector_type(2)));
typedef unsigned u32x4 __attribute__((ext_vector_type(4)));
typedef unsigned u32x2 __attribute__((ext_vector_type(2)));
typedef GAS unsigned gu32;

namespace {
constexpr int D = 2048, NB = 8, L = 2048, T = NB * L;
constexpr int INC = 5376;
constexpr int NE = 32, FF = 2048, NA = T * 4;
constexpr int LISTCAP = T;
constexpr int MAXROWS = NA + NE * 256;
constexpr float ALPHA = 1.189207115002721f;
constexpr float EPS = 1e-5f;
constexpr int NWAVES = 8, NTHR = 512;
constexpr int NPHASE = 9;
constexpr int REP2H = 1, REP2A = 1;
constexpr int REP0 = 1, REP1 = 1, REP2 = 1, REP3 = 1, REP5 = 1, REP6 = 1, REP7 = 1;

constexpr size_t MiB = 1u << 20;
constexpr size_t WS_CTL = 0, CTL_ZERO_BYTES = 32768;
constexpr size_t WS_LB = 1 * MiB;
constexpr size_t WS_STATS0 = WS_LB + 4096;
constexpr size_t WS_LIST = 2 * MiB;
constexpr size_t WS_TOKE = 4 * MiB, WS_TOKP = WS_TOKE + (size_t)NA * 4, WS_TOKG = WS_TOKP + (size_t)NA * 4;
constexpr size_t WS_WRH = 5 * MiB;
constexpr size_t WS_WIN = 8 * MiB;
constexpr size_t WS_WOUT = 30 * MiB;
constexpr size_t WS_WGU = 40 * MiB;
constexpr size_t WS_WD = 552 * MiB;
constexpr size_t WS_H1 = 808 * MiB;
constexpr size_t WS_Z = 872 * MiB;
constexpr size_t WS_HACT = 1000 * MiB;
constexpr size_t WS_EARLY = 1288 * MiB;
constexpr size_t WS_H0 = WS_EARLY;
constexpr size_t WS_QH = WS_H0 + 64 * MiB, WS_KH = WS_QH + 32 * MiB, WS_VH = WS_KH + 32 * MiB, WS_OG = WS_VH + 32 * MiB, WS_AQ = WS_OG + 32 * MiB;
constexpr size_t WS_GH = WS_AQ + 32 * MiB;
constexpr size_t WS_AK = WS_GH + 64 * MiB, WS_AV = WS_AK + 4 * MiB;
constexpr size_t WS_YMIX = WS_AV + 4 * MiB;
constexpr size_t WS_H1Q = WS_KH;
constexpr size_t WS_Y = WS_EARLY;
constexpr size_t WS_END = WS_YMIX + 64 * MiB;
static_assert(WS_Y + (size_t)MAXROWS * 4096 <= WS_END + 0 * MiB || true, "");
static_assert(WS_END <= 2048 * MiB, "d_ws map");
constexpr int CW_CNT = 64;
constexpr int CW_CONV = 128, CW_P1DONE = 192, CW_HGDONE = 256;
constexpr int CW_BAR = 4096;

constexpr int RING_BYTES = 131072;
constexpr int CV_SCR = 17408;
constexpr int LDSCTL_OFF = 8 * CV_SCR;
constexpr int LDS_BYTES = 147456;
constexpr int LC_BAR = 0, LC_PTS = 64, LC_CNT = 256, LC_TILEE = 512, LC_MISC = 2048;

#define RLX_AGENT __ATOMIC_RELAXED, __HIP_MEMORY_SCOPE_AGENT
__device__ __forceinline__ unsigned f2bf(float f) { unsigned u = __builtin_bit_cast(unsigned, f); return (u + 0x7fffu + ((u >> 16) & 1u)) >> 16; }
__device__ __forceinline__ unsigned pk2(float lo, float hi) { return f2bf(lo) | (f2bf(hi) << 16); }
__device__ __forceinline__ float bf2f(unsigned short b) { return __builtin_bit_cast(float, (unsigned)b << 16); }
__device__ __forceinline__ float bflo(unsigned w) { return __builtin_bit_cast(float, w << 16); }
__device__ __forceinline__ float bfhi(unsigned w) { return __builtin_bit_cast(float, w & 0xffff0000u); }
typedef __bf16 bf16x2_t __attribute__((ext_vector_type(2)));
__device__ __forceinline__ unsigned cvt_pk_bf16_c(float lo, float hi) { f32x2 v = {lo, hi}; bf16x2_t b = __builtin_convertvector(v, bf16x2_t); return __builtin_bit_cast(unsigned, b); }
__device__ __forceinline__ unsigned cvt_pk_bf16(float lo, float hi) { unsigned r; asm volatile("v_cvt_pk_bf16_f32 %0, %1, %2" : "=v"(r) : "v"(lo), "v"(hi)); return r; }
__device__ __forceinline__ float wave_sum(float v) {
#pragma unroll
    for (int o = 1; o < 64; o <<= 1) v += __shfl_xor(v, o);
    return v;
}
__device__ __forceinline__ float sigm(float x) { return __builtin_amdgcn_rcpf(1.f + __expf(-x)); }

#define XB_TMO      128
#define XB_XCNT(j)  (256  + 64 * (j))
#define XB_XSUB(j)  (1280 + 64 * (j))
#define XB_XGEN(j)  (2304 + 64 * (j))
#define XB_TOP      3328
#define XB_TOPGEN   3392
#define XCD_BAR_WORDS 3456
#define XB_SPIN_CAP (1u << 18)
__device__ __forceinline__ unsigned xb_ld(unsigned* p)              { return __hip_atomic_load(p, __ATOMIC_RELAXED, __HIP_MEMORY_SCOPE_AGENT); }
__device__ __forceinline__ unsigned xb_add(unsigned* p, unsigned v) { return __hip_atomic_fetch_add(p, v, __ATOMIC_RELAXED, __HIP_MEMORY_SCOPE_AGENT); }
__device__ __forceinline__ unsigned xb_xcc_id() { return (unsigned)__builtin_amdgcn_s_getreg((3 << 11) | 20) & 0xFu; }
#define XB_SPIN(cond, bar) do { unsigned _sp = 0; while (cond) { __builtin_amdgcn_s_sleep(1); \
    if ((++_sp & 255u) == 0u) { if (xb_ld(&(bar)[XB_TMO])) break; if (_sp > XB_SPIN_CAP) { atomicAdd(&(bar)[XB_TMO], 1u); break; } } } } while (0)
struct XcdBarrier { unsigned* bar; unsigned x; volatile LAS unsigned* st; };
__device__ __forceinline__ XcdBarrier xcd_barrier_post(unsigned* bar, volatile LAS unsigned* st) {
    XcdBarrier b; b.bar = bar; b.x = xb_xcc_id(); b.st = st;
    if (threadIdx.x == 0) (void)xb_add(&bar[XB_XCNT(b.x)], 1u);
    return b;
}
__device__ __forceinline__ void xcd_barrier_complete(unsigned* bar, unsigned x, unsigned& nloc, unsigned& nx) {
    const unsigned G = gridDim.x * gridDim.y * gridDim.z;
    unsigned sum, cnt, mine, sp = 0u;
    for (;;) {
        sum = 0u; cnt = 0u; mine = 0u;
#pragma unroll
        for (unsigned j = 0; j < 16; ++j) { const unsigned c = xb_ld(&bar[XB_XCNT(j)]); sum += c; cnt += (c > 0u) ? 1u : 0u; mine = (j == x) ? c : mine; }
        if (sum == G) break;
        __builtin_amdgcn_s_sleep(1);
        if ((++sp & 255u) == 0u) { if (xb_ld(&bar[XB_TMO])) break; if (sp > XB_SPIN_CAP) { atomicAdd(&bar[XB_TMO], 1u); break; } }
    }
    nloc = mine > 0u ? mine : 1u; nx = cnt > 0u ? cnt : 1u;
}
__device__ __forceinline__ void xcd_barrier(const XcdBarrier& b) {
    asm volatile("s_waitcnt vmcnt(0)" ::: "memory");
    __syncthreads();
    if (threadIdx.x == 0) {
        unsigned* bar = b.bar;
        __builtin_amdgcn_s_waitcnt(0);
        unsigned nloc = b.st[0], nx = b.st[1];
        if (nloc == 0u) { xcd_barrier_complete(bar, b.x, nloc, nx); b.st[0] = nloc; b.st[1] = nx; }
        const unsigned old = xb_add(&bar[XB_XSUB(b.x)], 1u);
        const unsigned gen = old / nloc;
        if (old + 1u == (gen + 1u) * nloc) {
            __builtin_amdgcn_fence(__ATOMIC_RELEASE, "agent");
            asm volatile("s_waitcnt vmcnt(0)" ::: "memory");
            const unsigned og = xb_add(&bar[XB_TOP], 1u);
            const unsigned tg = og / nx;
            if (og + 1u == (tg + 1u) * nx) xb_add(&bar[XB_TOPGEN], 1u);
            else XB_SPIN(xb_ld(&bar[XB_TOPGEN]) == tg, bar);
            __builtin_amdgcn_fence(__ATOMIC_ACQUIRE, "agent");
            xb_add(&bar[XB_XGEN(b.x)], 1u);
            asm volatile("s_waitcnt vmcnt(0)" ::: "memory");
        } else {
            XB_SPIN(xb_ld(&bar[XB_XGEN(b.x)]) == gen, bar);
            __builtin_amdgcn_fence(__ATOMIC_ACQUIRE, "agent");
            asm volatile("s_waitcnt vmcnt(0)" ::: "memory");
        }
    }
    __syncthreads();
}

constexpr int BM = 256, BK = 64, HALF = 128, HTB = HALF * BK * 2, NXCD = 8, WGM = 8;
constexpr int KD = 2048, NT = KD / BK;
__device__ __forceinline__ int lds_byte(int r, int c) { const int st = (r >> 4) * 2 + (c >> 5), rr = r & 15, cc = c & 31, ob = rr * 64 + cc * 2; return st * 1024 + (ob ^ (((ob >> 9) & 1) << 5)); }
__device__ __forceinline__ void stage_rc(int b, int& R, int& C) { const int st = b / 1024, sb = b % 1024, swz = sb ^ (((sb >> 9) & 1) << 5); R = (st >> 1) * 16 + swz / 64; C = (st & 1) * 32 + (swz % 64) / 2; }
__device__ __forceinline__ int perm32(int rho) { const int n = rho >> 4, i = rho & 15; return 8 * (i >> 2) + 4 * n + (i & 3); }

struct GU { const char* A; const char* B; int pm, pn, e, mtl; };

__device__ __forceinline__ bool order_next(int i, int G, int c, int nM, int nN, int& pm, int& pn) {
    const int nwg = nM * nN; const long Lx = (long)i * G + c; if (Lx >= nwg) return false;
    int wgid = (int)Lx; { const int q = nwg / NXCD, r = nwg % NXCD, xcd = wgid % NXCD, off = wgid / NXCD; wgid = (xcd < r ? xcd * (q + 1) : r * (q + 1) + (xcd - r) * q) + off; }
    const int nig = WGM * nN, gid = wgid / nig, fm = gid * WGM, gsz = (nM - fm) < WGM ? (nM - fm) : WGM;
    pm = fm + ((wgid % nig) % gsz); pn = (wgid % nig) / gsz; return true;
}

typedef int v8i_t __attribute__((ext_vector_type(8)));
template <class Epi, class Sched, bool F8 = false>
__device__ __forceinline__ void gemm_phase(LAS unsigned char* lds, const Sched& S, const Epi& E) {
    const int tid = threadIdx.x, wid = __builtin_amdgcn_readfirstlane(tid >> 6), lane = tid & 63, wr = wid >> 2, wc = wid & 3, fr = lane & 15, fq = lane >> 4;
    constexpr int ROWB = F8 ? KD : KD * 2;
    constexpr int nt = ROWB / 128;
    int Rr[2], Cc[2]; unsigned voffB[2];
#pragma unroll
    for (int i = 0; i < 2; ++i) { stage_rc(tid * 16 + i * 8192, Rr[i], Cc[i]); const int Rb = Epi::PERM ? ((Rr[i] & ~31) + perm32(Rr[i] & 31)) : Rr[i]; voffB[i] = (unsigned)(Rb * ROWB + Cc[i] * 2); }
    const size_t kstep = (size_t)128;
    const size_t hstep = (size_t)HALF * ROWB;
    const unsigned ldsw = (unsigned)wid * 1024u;
    const int aoff = lds_byte(wr * 64 + fr, fq * 8), boff = lds_byte(wc * 32 + fr, fq * 8);
#define PG8_SA(b, h) (((b) * 2 + (h)) * HTB)
#define PG8_SB(b, h) ((4 + (b) * 2 + (h)) * HTB)
#define PG8_STAGE(bufoff, gbase, voff) do { _Pragma("unroll") for (int _i = 0; _i < 2; ++_i) \
        __builtin_amdgcn_global_load_lds((const unsigned*)((const char*)(gbase) + (voff)[_i]), (LAS unsigned*)(lds + (bufoff) + ldsw + _i * 8192), 16, 0, 0); } while (0)
#define PG8_LDA(dst, b, h) do { _Pragma("unroll") for (int m = 0; m < 4; ++m) _Pragma("unroll") for (int k = 0; k < 2; ++k) dst[m].q[k] = *(const LAS u32x4*)(lds + PG8_SA(b, h) + aoff + m * 2048 + k * 1024); } while (0)
#define PG8_LDB(dst, b, h) do { _Pragma("unroll") for (int n = 0; n < 2; ++n) _Pragma("unroll") for (int k = 0; k < 2; ++k) dst[n].q[k] = *(const LAS u32x4*)(lds + PG8_SB(b, h) + boff + n * 2048 + k * 1024); } while (0)
#define PG8_MMA(ai, bj, At, Bt) do { __builtin_amdgcn_s_setprio(1); _Pragma("unroll") for (int m = 0; m < 4; ++m) _Pragma("unroll") for (int n = 0; n < 2; ++n) { \
        if constexpr (F8) { asm volatile("v_mfma_scale_f32_16x16x128_f8f6f4 %0, %1, %2, %0, %3, %3 op_sel_hi:[0,0,0]" : "+v"(acc[ai][bj][m][n]) : "v"(Bt[n].v), "v"(At[m].v), "v"(f8sc)); } \
        else { _Pragma("unroll") for (int k = 0; k < 2; ++k) acc[ai][bj][m][n] = __builtin_amdgcn_mfma_f32_16x16x32_bf16(__builtin_bit_cast(bf16x8, Bt[n].q[k]), __builtin_bit_cast(bf16x8, At[m].q[k]), acc[ai][bj][m][n], 0, 0, 0); } } \
        __builtin_amdgcn_s_setprio(0); } while (0)
#define PG8_WAIT_V(n) asm volatile("s_waitcnt vmcnt(" #n ")" ::: "memory")
#define PG8_WAIT_L(n) asm volatile("s_waitcnt lgkmcnt(" #n ")" ::: "memory")
#define PG8_BAR __builtin_amdgcn_s_barrier()
#define PG8_SCHED __builtin_amdgcn_sched_barrier(0)
    GU cur, nxt; int ui = 0;
    if (!S.next(0, cur)) return;
    f32x4 acc[2][2][4][2];
#pragma unroll
    for (int a = 0; a < 2; ++a)
#pragma unroll
        for (int b = 0; b < 2; ++b)
#pragma unroll
            for (int m = 0; m < 4; ++m)
#pragma unroll
                for (int n = 0; n < 2; ++n) acc[a][b][m][n] = (f32x4){0.f, 0.f, 0.f, 0.f};
    int f8sc = 0x7f7f7f7f; asm volatile("" : "+v"(f8sc));
    union Frag { v8i_t v; u32x4 q[2]; };
    Frag At[4], B0[2], B1[2];
    unsigned oc0[2], oc1[2], on0[2], on1[2];
    S.a_off(cur, Rr, Cc, oc0, oc1);
    const char* cA = cur.A; const char* cB = cur.B;
    PG8_STAGE(PG8_SB(0, 0), cB, voffB); PG8_STAGE(PG8_SB(0, 1), cB + hstep, voffB); PG8_STAGE(PG8_SA(0, 0), cA, oc0); PG8_STAGE(PG8_SA(0, 1), cA, oc1);
    if (wr == 1) PG8_BAR;
    PG8_WAIT_V(2); PG8_BAR;
    PG8_STAGE(PG8_SB(1, 0), cB + kstep, voffB); PG8_STAGE(PG8_SA(1, 0), cA + kstep, oc0); PG8_STAGE(PG8_SB(1, 1), cB + hstep + kstep, voffB);
    PG8_WAIT_V(6); PG8_BAR;
    for (;;) {
        const bool has_next = S.next(ui + 1, nxt);
        const char* nA = has_next ? nxt.A : cA; const char* nB = has_next ? nxt.B : cB;
        for (int t = 0; t < nt; t += 2) {
            const bool last = (t == nt - 2);
            const char* a1 = cA + (size_t)(t + 1) * kstep;
            const char* a2 = last ? nA : cA + (size_t)(t + 2) * kstep; const char* b2 = last ? nB : cB + (size_t)(t + 2) * kstep;
            const char* a3 = a2 + kstep; const char* b3 = b2 + kstep;
            unsigned o20[2], o21[2];
            if (last) {
                if (has_next) S.a_off(nxt, Rr, Cc, on0, on1); else { on0[0] = oc0[0]; on0[1] = oc0[1]; on1[0] = oc1[0]; on1[1] = oc1[1]; }
                o20[0] = on0[0]; o20[1] = on0[1]; o21[0] = on1[0]; o21[1] = on1[1];
            } else { o20[0] = oc0[0]; o20[1] = oc0[1]; o21[0] = oc1[0]; o21[1] = oc1[1]; }
            PG8_LDB(B0, 0, 0); PG8_LDB(B1, 0, 1); PG8_SCHED; PG8_LDA(At, 0, 0); PG8_STAGE(PG8_SA(1, 1), a1, oc1);
            PG8_WAIT_V(8); PG8_WAIT_L(0); PG8_BAR; PG8_MMA(0, 0, At, B0); PG8_MMA(0, 1, At, B1); PG8_BAR; PG8_SCHED;
            PG8_LDA(At, 0, 1); PG8_STAGE(PG8_SB(0, 0), b2, voffB); PG8_STAGE(PG8_SB(0, 1), b2 + hstep, voffB); PG8_STAGE(PG8_SA(0, 0), a2, o20);
            PG8_WAIT_V(8); PG8_WAIT_L(0); PG8_BAR; PG8_MMA(1, 0, At, B0); PG8_MMA(1, 1, At, B1); PG8_BAR; PG8_SCHED;
            PG8_LDB(B0, 1, 0); PG8_LDB(B1, 1, 1); PG8_SCHED; PG8_LDA(At, 1, 0); PG8_STAGE(PG8_SA(0, 1), a2, o21);
            PG8_WAIT_V(8); PG8_WAIT_L(0); PG8_BAR; PG8_MMA(0, 0, At, B0); PG8_MMA(0, 1, At, B1); PG8_BAR; PG8_SCHED;
            PG8_LDA(At, 1, 1); PG8_STAGE(PG8_SB(1, 0), b3, voffB); PG8_STAGE(PG8_SB(1, 1), b3 + hstep, voffB); PG8_STAGE(PG8_SA(1, 0), a3, o20);
            PG8_WAIT_V(8); PG8_WAIT_L(0); PG8_BAR; PG8_MMA(1, 0, At, B0); PG8_MMA(1, 1, At, B1); PG8_BAR; PG8_SCHED;
        }
        if (wr == 0) PG8_BAR;
        if constexpr (F8) asm volatile("s_nop 15\n\ts_nop 15" ::: "memory");
        E(acc, cur, wr, wc, fr, fq);
        if (!has_next) break;
#pragma unroll
        for (int a = 0; a < 2; ++a)
#pragma unroll
            for (int b = 0; b < 2; ++b)
#pragma unroll
                for (int m = 0; m < 4; ++m)
#pragma unroll
                    for (int n = 0; n < 2; ++n) acc[a][b][m][n] = (f32x4){0.f, 0.f, 0.f, 0.f};
        cur = nxt; cA = nA; cB = nB; ++ui;
        oc0[0] = on0[0]; oc0[1] = on0[1]; oc1[0] = on1[0]; oc1[1] = on1[1];
        if (wr == 1) PG8_BAR;
    }
    PG8_WAIT_V(0);
    PG8_BAR;
#undef PG8_SA
#undef PG8_SB
#undef PG8_STAGE
#undef PG8_LDA
#undef PG8_LDB
#undef PG8_MMA
#undef PG8_WAIT_V
#undef PG8_WAIT_L
#undef PG8_BAR
#undef PG8_SCHED
}

struct SchedDense {
    const bf16_t* A; const bf16_t* Bt; int nM, nN, G, c;
    __device__ __forceinline__ bool next(int i, GU& u) const {
        int pm, pn; if (!order_next(i, G, c, nM, nN, pm, pn)) return false;
        u.pm = pm; u.pn = pn; u.e = 0; u.mtl = pm; u.A = (const char*)A; u.B = (const char*)Bt + (size_t)pn * (256 * KD * 2); return true;
    }
    __device__ __forceinline__ void a_off(const GU& u, const int (&R)[2], const int (&C)[2], unsigned (&o0)[2], unsigned (&o1)[2]) const {
#pragma unroll
        for (int i = 0; i < 2; ++i) { o0[i] = (unsigned)((u.pm * 256 + R[i]) * KD + C[i]) * 2u; o1[i] = (unsigned)((u.pm * 256 + 128 + R[i]) * KD + C[i]) * 2u; }
    }
};
template <int ROWB>
struct SchedMoe {
    const void* A; const void* Bt; size_t bstride_e;
    const int* list; const LAS int* pts; const LAS int* cntl; const LAS unsigned char* tileE;
    int nM, nN, G, c; bool gather;
    __device__ __forceinline__ bool next(int i, GU& u) const {
        int pm, pn; if (!order_next(i, G, c, nM, nN, pm, pn)) return false;
        const int e = __builtin_amdgcn_readfirstlane((int)tileE[pm]);
        u.pm = pm; u.pn = pn; u.e = e; u.mtl = pm - __builtin_amdgcn_readfirstlane(pts[e]);
        u.A = (const char*)A; u.B = (const char*)Bt + (size_t)e * bstride_e + (size_t)pn * (256 * ROWB); return true;
    }
    __device__ __forceinline__ void a_off(const GU& u, const int (&R)[2], const int (&C)[2], unsigned (&o0)[2], unsigned (&o1)[2]) const {
        if (gather) {
            const int ce = __builtin_amdgcn_readfirstlane(cntl[u.e]);
            const int* lp = list + (size_t)u.e * LISTCAP;
#pragma unroll
            for (int i = 0; i < 2; ++i) {
                int i0 = u.mtl * 256 + R[i], i1 = i0 + 128;
                i0 = i0 < ce ? i0 : 0; i1 = i1 < ce ? i1 : 0;
                const int t0 = lp[i0], t1 = lp[i1];
                o0[i] = (unsigned)(t0 * ROWB + C[i] * 2); o1[i] = (unsigned)(t1 * ROWB + C[i] * 2);
            }
        } else {
#pragma unroll
            for (int i = 0; i < 2; ++i) { o0[i] = (unsigned)((u.pm * 256 + R[i]) * ROWB + C[i] * 2); o1[i] = (unsigned)((u.pm * 256 + 128 + R[i]) * ROWB + C[i] * 2); }
        }
    }
};

__device__ __forceinline__ u32x4 pack8(const f32x4& a, const f32x4& b) { u32x4 w; w.x = cvt_pk_bf16(a[0], a[1]); w.y = cvt_pk_bf16(a[2], a[3]); w.z = cvt_pk_bf16(b[0], b[1]); w.w = cvt_pk_bf16(b[2], b[3]); return w; }

struct EpiInProj {
    static constexpr bool PERM = true;
    bf16_t *QH, *KH, *VH, *OG, *AQ, *AK, *AV; float* GH; const float* lb; const float* bqkv;
    __device__ __forceinline__ void operator()(const f32x4 (&acc)[2][2][4][2], const GU& u, int wr, int wc, int fr, int fq) const {
        const int row0 = u.pm * BM + wr * 64 + fr;
        const int type = u.pn >> 2;
        const int cw = wc * 32 + 8 * fq;
#pragma unroll
        for (int bj = 0; bj < 2; ++bj) {
            const int col = (u.pn & 3) * 256 + bj * HALF + cw;
            if (type == 0 || type == 3) {
                bf16_t* O = (type == 0 ? QH : OG);
#pragma unroll
                for (int ai = 0; ai < 2; ++ai)
#pragma unroll
                    for (int m = 0; m < 4; ++m) { f32x4 v0 = acc[ai][bj][m][0], v1 = acc[ai][bj][m][1];
#pragma unroll
                        for (int j = 0; j < 4; ++j) { v0[j] = v0[j] * sigm(v0[j]); v1[j] = v1[j] * sigm(v1[j]); }
                        *(u32x4*)(O + (size_t)(row0 + ai * HALF + m * 16) * 1024 + col) = pack8(v0, v1); }
            } else if (type == 1) {
                const f32x4 l0 = *(const f32x4*)(lb + col), l1 = *(const f32x4*)(lb + col + 4);
#pragma unroll
                for (int ai = 0; ai < 2; ++ai)
#pragma unroll
                    for (int m = 0; m < 4; ++m) { f32x4 v0 = acc[ai][bj][m][0], v1 = acc[ai][bj][m][1], g0, g1;
#pragma unroll
                        for (int j = 0; j < 4; ++j) { const float s0 = sigm(v0[j]), s1 = sigm(v1[j]);
                            const float f0 = l0[j] + (1.f - l0[j]) * s0, f1 = l1[j] + (1.f - l1[j]) * s1;
                            g0[j] = __log2f(f0); g1[j] = __log2f(f1); }
                        const size_t o = (size_t)(row0 + ai * HALF + m * 16) * 1024 + col;
                        *(f32x4*)(GH + o) = g0; *(f32x4*)(GH + o + 4) = g1; }
            } else if (type == 2) {
#pragma unroll
                for (int ai = 0; ai < 2; ++ai)
#pragma unroll
                    for (int m = 0; m < 4; ++m) *(u32x4*)(VH + (size_t)(row0 + ai * HALF + m * 16) * 1024 + col) = pack8(acc[ai][bj][m][0], acc[ai][bj][m][1]);
            } else if (type == 4) {
                const f32x4 b0 = *(const f32x4*)(bqkv + col), b1 = *(const f32x4*)(bqkv + col + 4);
#pragma unroll
                for (int ai = 0; ai < 2; ++ai)
#pragma unroll
                    for (int m = 0; m < 4; ++m) { const f32x4 v0 = (acc[ai][bj][m][0] + b0) * 0.125f, v1 = (acc[ai][bj][m][1] + b1) * 0.125f;
                        *(u32x4*)(AQ + (size_t)(row0 + ai * HALF + m * 16) * 1024 + col) = pack8(v0, v1); }
            } else {
                bf16_t* O = bj == 0 ? AK : AV;
                const f32x4 b0 = *(const f32x4*)(bqkv + 1024 + bj * 128 + cw), b1 = *(const f32x4*)(bqkv + 1024 + bj * 128 + cw + 4);
#pragma unroll
                for (int ai = 0; ai < 2; ++ai)
#pragma unroll
                    for (int m = 0; m < 4; ++m) *(u32x4*)(O + (size_t)(row0 + ai * HALF + m * 16) * 128 + cw) = pack8(acc[ai][bj][m][0] + b0, acc[ai][bj][m][1] + b1);
            }
        }
    }
};
struct EpiOutProj {
    static constexpr bool PERM = true;
    float* Z; const float* x; const float* stats; const float* lnw; const float* lnb; const float* bo;
    __device__ __forceinline__ void operator()(const f32x4 (&acc)[2][2][4][2], const GU& u, int wr, int wc, int fr, int fq) const {
        const int row0 = u.pm * BM + wr * 64 + fr, col0 = u.pn * BM + wc * 32 + 8 * fq;
        f32x4 w4[2][2], b4[2][2];
#pragma unroll
        for (int bj = 0; bj < 2; ++bj)
#pragma unroll
            for (int n = 0; n < 2; ++n) { const int col = col0 + bj * HALF + n * 4; const f32x4 lw = *(const f32x4*)(lnw + col), lb = *(const f32x4*)(lnb + col), o4 = *(const f32x4*)(bo + col);
                w4[bj][n] = lw * ALPHA; b4[bj][n] = lb * ALPHA + o4; }
#pragma unroll
        for (int ai = 0; ai < 2; ++ai)
#pragma unroll
        for (int mp = 0; mp < 2; ++mp) {
            f32x4 xv[2][2][2]; f32x2 st[2];
#pragma unroll
            for (int mm = 0; mm < 2; ++mm) { const int row = row0 + ai * HALF + (2 * mp + mm) * 16; st[mm] = *(const f32x2*)(stats + 2 * row);
#pragma unroll
                for (int bj = 0; bj < 2; ++bj)
#pragma unroll
                    for (int n = 0; n < 2; ++n) xv[mm][bj][n] = *(const f32x4*)(x + (size_t)row * D + col0 + bj * HALF + n * 4); }
#pragma unroll
            for (int mm = 0; mm < 2; ++mm) { const int m = 2 * mp + mm, row = row0 + ai * HALF + m * 16;
#pragma unroll
                for (int bj = 0; bj < 2; ++bj)
#pragma unroll
                    for (int n = 0; n < 2; ++n) { const f32x4 z = (xv[mm][bj][n] - st[mm].x) * st[mm].y * w4[bj][n] + b4[bj][n] + acc[ai][bj][m][n];
                        *(f32x4*)(Z + (size_t)row * D + col0 + bj * HALF + n * 4) = z; } }
        }
    }
};
__device__ __forceinline__ unsigned pk4_fp8(float a, float b, float c, float d) {
    a = fminf(fmaxf(a, -448.f), 448.f); b = fminf(fmaxf(b, -448.f), 448.f); c = fminf(fmaxf(c, -448.f), 448.f); d = fminf(fmaxf(d, -448.f), 448.f);
    int w = __builtin_amdgcn_cvt_pk_fp8_f32(a, b, 0, false); w = __builtin_amdgcn_cvt_pk_fp8_f32(c, d, w, true); return (unsigned)w;
}
constexpr float SC_H1 = 32.f, SC_WGU = 2048.f, SC_HACT = 8.f, SC_WD = 4096.f;
struct EpiMoe1F8 {
    static constexpr bool PERM = true;
    unsigned char* H; const float* bg; const float* bu;
    __device__ __forceinline__ void operator()(const f32x4 (&acc)[2][2][4][2], const GU& u, int wr, int wc, int fr, int fq) const {
        const int row0 = u.pm * BM + wr * 64 + fr, hc = u.pn * 128 + wc * 32 + 8 * fq;
        const float* bgp = bg + (size_t)u.e * FF + hc; const float* bup = bu + (size_t)u.e * FF + hc;
        const f32x4 g0b = *(const f32x4*)bgp, g1b = *(const f32x4*)(bgp + 4), u0b = *(const f32x4*)bup, u1b = *(const f32x4*)(bup + 4);
        constexpr float IS = 1.f / (SC_H1 * SC_WGU);
#pragma unroll
        for (int ai = 0; ai < 2; ++ai)
#pragma unroll
            for (int m = 0; m < 4; ++m) {
                f32x4 a0 = acc[ai][0][m][0] * IS + g0b, a1 = acc[ai][0][m][1] * IS + g1b, c0 = acc[ai][1][m][0] * IS + u0b, c1 = acc[ai][1][m][1] * IS + u1b;
#pragma unroll
                for (int j = 0; j < 4; ++j) {
                    const float gg0 = fminf(a0[j], 7.f), gg1 = fminf(a1[j], 7.f);
                    const float uu0 = fminf(fmaxf(c0[j], -7.f), 7.f), uu1 = fminf(fmaxf(c1[j], -7.f), 7.f);
                    a0[j] = SC_HACT * gg0 * sigm(1.702f * gg0) * (uu0 + 1.f); a1[j] = SC_HACT * gg1 * sigm(1.702f * gg1) * (uu1 + 1.f);
                }
                u32x2 o; o.x = pk4_fp8(a0[0], a0[1], a0[2], a0[3]); o.y = pk4_fp8(a1[0], a1[1], a1[2], a1[3]);
                *(u32x2*)(H + (size_t)(row0 + ai * HALF + m * 16) * FF + hc) = o;
            }
    }
};
struct EpiMoe2F8 {
    static constexpr bool PERM = true;
    bf16_t* Y; const float* bd;
    __device__ __forceinline__ void operator()(const f32x4 (&acc)[2][2][4][2], const GU& u, int wr, int wc, int fr, int fq) const {
        const int row0 = u.pm * BM + wr * 64 + fr, col0 = u.pn * BM + wc * 32 + 8 * fq;
        const float* bp = bd + (size_t)u.e * D + col0;
        constexpr float IS = 1.f / (SC_HACT * SC_WD);
#pragma unroll
        for (int bj = 0; bj < 2; ++bj) {
            const f32x4 b0 = *(const f32x4*)(bp + bj * HALF), b1 = *(const f32x4*)(bp + bj * HALF + 4);
#pragma unroll
            for (int ai = 0; ai < 2; ++ai)
#pragma unroll
                for (int m = 0; m < 4; ++m) *(u32x4*)(Y + (size_t)(row0 + ai * HALF + m * 16) * D + col0 + bj * HALF) = pack8(acc[ai][bj][m][0] * IS + b0, acc[ai][bj][m][1] * IS + b1);
        }
    }
};
struct Args { const float* in[23]; float* out; unsigned char* ws; int ph_lo, ph_hi; };
struct Frame { LAS unsigned char* lds; int tid, lane, wave, G, vcu; unsigned char* ws; };

__device__ __forceinline__ void p0_transpose_item(const float* W, int N, int k0, int n0, bf16_t* WT_row0  , LAS float* scr, int lane) {
#pragma unroll 8
    for (int i = 0; i < 32; ++i) { const int kk = 2 * i + (lane >> 5); scr[kk * 33 + (lane & 31)] = W[(size_t)(k0 + kk) * N + n0 + (lane & 31)]; }
    asm volatile("s_waitcnt lgkmcnt(0)" ::: "memory");
    const int c = lane & 7;
#pragma unroll
    for (int j = 0; j < 4; ++j) { const int n = (lane >> 3) + 8 * j; const LAS float* s = scr + (8 * c) * 33 + n;
        u32x4 o; o.x = pk2(s[0 * 33], s[1 * 33]); o.y = pk2(s[2 * 33], s[3 * 33]); o.z = pk2(s[4 * 33], s[5 * 33]); o.w = pk2(s[6 * 33], s[7 * 33]);
        *(GAS u32x4*)(WT_row0 + (size_t)n * KD + k0 + 8 * c) = o; }
    asm volatile("s_waitcnt lgkmcnt(0)" ::: "memory");
}

__device__ __forceinline__ void p0_prologue(Frame& F, const Args& a) {
    LAS float* scr = (LAS float*)(F.lds + F.wave * 16384);
    const int gw = F.vcu * NWAVES + F.wave, NGW = F.G * NWAVES;
    unsigned char* ws = F.ws;
    for (int i = gw * 64 + F.lane; i < NE * D; i += NGW * 64) { const int e = i >> 11, k = i & 2047; ((_Float16*)(ws + WS_WRH))[i] = (_Float16)(a.in[13][(size_t)k * NE + e] * 64.f); }
    if (gw < 16) { const int i = gw * 64 + F.lane; const float* lbl = a.in[5]; const float l0 = lbl[i], l1 = lbl[1024 + i]; const float mx = fmaxf(l0, l1); const float e0 = __expf(l0 - mx), e1 = __expf(l1 - mx);
        ((float*)(ws + WS_LB))[i] = e0 / (e0 + e1); }
    {
        const float* x = a.in[0]; const float* w = a.in[1]; const float* b = a.in[2];
        bf16_t* H0 = (bf16_t*)(ws + WS_H0); float* st = (float*)(ws + WS_STATS0);
        for (int m = gw; m < T; m += NGW) {
            const GAS f32x4* xr = (const GAS f32x4*)(x + (size_t)m * D) + F.lane;
            f32x4 v[8]; float s = 0.f;
#pragma unroll
            for (int j = 0; j < 8; ++j) { v[j] = xr[64 * j]; s += (v[j][0] + v[j][1]) + (v[j][2] + v[j][3]); }
            const float mean = wave_sum(s) * (1.f / D); float s2 = 0.f;
#pragma unroll
            for (int j = 0; j < 8; ++j) { v[j] = v[j] - mean; s2 += (v[j][0] * v[j][0] + v[j][1] * v[j][1]) + (v[j][2] * v[j][2] + v[j][3] * v[j][3]); }
            const float rstd = rsqrtf(wave_sum(s2) * (1.f / D) + EPS);
            if (F.lane == 0) { st[2 * m] = mean; st[2 * m + 1] = rstd; }
            GAS u32x2* o8 = (GAS u32x2*)(H0 + (size_t)m * D) + F.lane;
#pragma unroll
            for (int j = 0; j < 8; ++j) { const f32x4 ww = *((const f32x4*)w + F.lane + 64 * j), bb = *((const f32x4*)b + F.lane + 64 * j);
                u32x2 o; o.x = pk2(v[j][0] * rstd * ww[0] + bb[0], v[j][1] * rstd * ww[1] + bb[1]); o.y = pk2(v[j][2] * rstd * ww[2] + bb[2], v[j][3] * rstd * ww[3] + bb[3]); o8[64 * j] = o; }
        }
    }
    constexpr int I_IN = 32 * (INC / 32), I_OUT = 32 * 64;
    constexpr int NITEMS = I_IN + I_OUT;
    for (int it = gw; it < NITEMS; it += NGW) {
        int r = it;
        if (r < I_IN) { const int nb = INC / 32, kb = r / nb, n0 = 32 * (r % nb); p0_transpose_item(a.in[3], INC, 64 * kb, n0, (bf16_t*)(ws + WS_WIN) + (size_t)n0 * KD, scr, F.lane); continue; } r -= I_IN;
        { const int kb = r / 64, n0 = 32 * (r % 64); p0_transpose_item(a.in[9], D, 64 * kb, n0, (bf16_t*)(ws + WS_WOUT) + (size_t)n0 * KD, scr, F.lane); }
    }
}

constexpr int CT_TILES = NE * 3 * 32 * 16, CT_RUN = 8;
constexpr int LC_CTB = 1024;
__device__ __forceinline__ void ct_src(const Args& a, unsigned char* ws, int id, const float*& W, unsigned char*& dst, float& sc, int& k0) {
    const int e = id / 1536, r = id - e * 1536, which = r >> 9, r2 = r & 511, kb = r2 >> 4, nb = r2 & 15;
    k0 = kb * 64;
    if (which < 2) { W = a.in[which == 0 ? 15 : 17] + (size_t)e * D * FF + nb * 128; dst = ws + WS_WGU + ((size_t)e * 4096 + (size_t)nb * 256 + which * 128) * KD; sc = SC_WGU; }
    else { W = a.in[19] + (size_t)e * FF * D + nb * 128; dst = ws + WS_WD + ((size_t)e * 2048 + (size_t)nb * 128) * KD; sc = SC_WD; }
}
__device__ __forceinline__ void cv_worker(Frame& F, const Args& a, const unsigned* stop_ctr, unsigned stop_at) {
    const int tid = F.tid, lane = F.lane, wv = F.wave;
    LAS unsigned char* ring = F.lds;
    volatile LAS int* ctb = (volatile LAS int*)(F.lds + LDSCTL_OFF + LC_CTB);
    unsigned* head = (unsigned*)(F.ws + WS_CTL) + CW_CONV;
    unsigned srcoff[4];
#pragma unroll
    for (int p = 0; p < 4; ++p) { const int row = 2 * (4 * wv + p) + (lane >> 5); srcoff[p] = (unsigned)(row * 2048 + 4 * ((lane & 31) ^ (2 * ((row >> 4) & 3)))); }
    const int on = tid >> 2, oc = tid & 3;
    const int rdoff = (16 * oc) * 128 * 4 + ((((on >> 2) ^ (2 * oc)) << 2) + (on & 3)) * 4;
#define CT_CLAIM(slotw) do { if (tid == 0) { int b_ = CT_TILES; if (!(stop_ctr && __hip_atomic_load(stop_ctr, RLX_AGENT) >= stop_at)) b_ = (int)__hip_atomic_fetch_add(head, (unsigned)CT_RUN, RLX_AGENT); ctb[slotw] = b_; } } while (0)
#define CT_DMA(id_, slot_) do { const float* W_; unsigned char* d_; float s_; int k_; ct_src(a, F.ws, (id_), W_, d_, s_, k_); const float* sp_ = W_ + (size_t)k_ * 2048; \
        _Pragma("unroll") for (int p = 0; p < 4; ++p) __builtin_amdgcn_global_load_lds((const unsigned*)(sp_ + srcoff[p]), (LAS unsigned*)(ring + (slot_) * 32768 + (4 * wv + p) * 1024), 16, 0, 0); } while (0)
    __syncthreads();
    CT_CLAIM(0);
    __syncthreads();
    int base = ctb[0];
    int issued = 0;
    bool more = base < CT_TILES;
#pragma unroll 1
    for (int i = 0; i < 3; ++i) { if (more) { CT_DMA(base + (issued & (CT_RUN - 1)), issued & 3); } ++issued; }
    int pbase = base;
    for (int k = 0; ; ++k) {
        if (((k + 3) & (CT_RUN - 1)) == 0) CT_CLAIM(((k + 3) / CT_RUN) & 1);
        if (pbase >= CT_TILES) break;
        asm volatile("s_waitcnt vmcnt(8)" ::: "memory");
        if (!more) asm volatile("s_waitcnt vmcnt(0)" ::: "memory");
        __syncthreads();
        {
            const float* W_; unsigned char* dst; float sc; int k0; ct_src(a, F.ws, pbase + (k & (CT_RUN - 1)), W_, dst, sc, k0);
            const LAS float* sp = (const LAS float*)(ring + (k & 3) * 32768 + rdoff);
            u32x4 o;
            o.x = pk4_fp8(sp[0 * 128] * sc, sp[1 * 128] * sc, sp[2 * 128] * sc, sp[3 * 128] * sc); o.y = pk4_fp8(sp[4 * 128] * sc, sp[5 * 128] * sc, sp[6 * 128] * sc, sp[7 * 128] * sc);
            o.z = pk4_fp8(sp[8 * 128] * sc, sp[9 * 128] * sc, sp[10 * 128] * sc, sp[11 * 128] * sc); o.w = pk4_fp8(sp[12 * 128] * sc, sp[13 * 128] * sc, sp[14 * 128] * sc, sp[15 * 128] * sc);
            *(GAS u32x4*)(dst + (size_t)on * KD + k0 + 16 * oc) = o;
            asm volatile("s_waitcnt lgkmcnt(0)" ::: "memory");
        }
        if (((k + 3) & (CT_RUN - 1)) == 0) { base = ctb[((k + 3) / CT_RUN) & 1]; more = base < CT_TILES; }
        if (more) { CT_DMA(base + ((k + 3) & (CT_RUN - 1)), (k + 3) & 3); }
        if (((k + 1) & (CT_RUN - 1)) == 0) pbase = ctb[((k + 1) / CT_RUN) & 1];
    }
    asm volatile("s_waitcnt vmcnt(0)" ::: "memory");
    __syncthreads();
#undef CT_CLAIM
#undef CT_DMA
}

constexpr int AT_Q = 32;
typedef float f32x16 __attribute__((ext_vector_type(16)));
typedef short s16x4 __attribute__((ext_vector_type(4)));
typedef short v4i16_t __attribute__((ext_vector_type(4)));
__device__ __forceinline__ s16x4 lds_tr16(const LAS unsigned char* p) { return __builtin_bit_cast(s16x4, __builtin_amdgcn_ds_read_tr16_b64_v4i16((LAS v4i16_t*)p)); }
__device__ __forceinline__ void attn_unit_mfma(Frame& F, const Args& a, int b, int qt) {
    LAS unsigned char* KS = F.lds;
    LAS unsigned char* VS = F.lds + 40960;
    LAS float* SSQ = (LAS float*)(F.lds + 81920);
    const bf16_t* AQ = (const bf16_t*)(F.ws + WS_AQ); const bf16_t* AK = (const bf16_t*)(F.ws + WS_AK); const bf16_t* AV = (const bf16_t*)(F.ws + WS_AV);
    bf16_t* YM = (bf16_t*)(F.ws + WS_YMIX);
    const int tid = F.tid, lane = F.lane, w = F.wave, r32 = lane & 31, hi = lane >> 5, t0 = qt * 32;
    __syncthreads();
#pragma unroll
    for (int p = 0; p < 5; ++p) {
        const int c = p * 512 + tid, row = c >> 4, ch = c & 15, kvh = ch >> 3, cr = ch & 7;
        const int pos = t0 - 128 + row;
        u32x4 kv = (u32x4){0u, 0u, 0u, 0u}, vv = (u32x4){0u, 0u, 0u, 0u};
        if (pos >= 0) { const size_t o = (size_t)(b * L + pos) * 128 + kvh * 64 + cr * 8; kv = *(const u32x4*)(AK + o); vv = *(const u32x4*)(AV + o); }
        *(LAS u32x4*)(KS + kvh * 20480 + row * 128 + ((cr ^ ((row >> 1) & 7)) << 4)) = kv;
        *(LAS u32x4*)(VS + kvh * 20480 + row * 128 + (((cr >> 2) ^ ((row >> 1) & 1)) << 6) + ((cr & 3) << 4)) = vv;
    }
    __syncthreads();
    const int kvh = w >> 2;
    const int ktmin = t0 < 128 ? (128 - t0) >> 5 : 0;
    const LAS unsigned char* Kb = KS + kvh * 20480;
    const LAS unsigned char* Vb = VS + kvh * 20480;
    unsigned OP[2][2][8];
    float ssq = 0.f;
#pragma unroll
    for (int hh = 0; hh < 2; ++hh) {
        const int head = 2 * w + hh;
        bf16x8 qf[4];
#pragma unroll
        for (int ks = 0; ks < 4; ++ks) qf[ks] = *(const bf16x8*)(AQ + (size_t)(b * L + t0 + r32) * 1024 + head * 64 + ks * 16 + hi * 8);
        f32x16 S[5];
#pragma unroll
        for (int kt = 0; kt < 5; ++kt) {
            const int row = kt * 32 + r32;
            f32x16 acc = (f32x16){0.f, 0.f, 0.f, 0.f, 0.f, 0.f, 0.f, 0.f, 0.f, 0.f, 0.f, 0.f, 0.f, 0.f, 0.f, 0.f};
#pragma unroll
            for (int ks = 0; ks < 4; ++ks) {
                const bf16x8 kf = *(const LAS bf16x8*)(Kb + row * 128 + (((2 * ks + hi) ^ ((row >> 1) & 7)) << 4));
                acc = __builtin_amdgcn_mfma_f32_32x32x16_bf16(kf, qf[ks], acc, 0, 0, 0);
            }
            S[kt] = acc;
        }
        const float sink = a.in[7][head];
        float m = sink;
#pragma unroll
        for (int kt = 0; kt < 5; ++kt)
#pragma unroll
            for (int r = 0; r < 16; ++r) {
                const int i = (r & 3) + 8 * (r >> 2) + 4 * hi;
                bool ok = kt >= ktmin;
                if (kt == 0) ok = ok && (i > r32);
                if (kt == 4) ok = ok && (i <= r32);
                const float v = ok ? S[kt][r] : -INFINITY;
                S[kt][r] = v; m = fmaxf(m, v);
            }
        m = fmaxf(m, __shfl_xor(m, 32));
        float l = 0.f;
#pragma unroll
        for (int kt = 0; kt < 5; ++kt)
#pragma unroll
            for (int r = 0; r < 16; ++r) { const float pv = __expf(S[kt][r] - m); S[kt][r] = pv; l += pv; }
        l += __shfl_xor(l, 32);
        l += __expf(sink - m);
        const float inv = 1.f / l;
#pragma unroll
        for (int dt = 0; dt < 2; ++dt) {
            f32x16 acc = (f32x16){0.f, 0.f, 0.f, 0.f, 0.f, 0.f, 0.f, 0.f, 0.f, 0.f, 0.f, 0.f, 0.f, 0.f, 0.f, 0.f};
            const int dcol = dt * 32 + 16 * ((lane >> 4) & 1) + 4 * (lane & 3);
            const int vlane = ((lane & 15) >> 2) * 128 + ((((dcol >> 5) ^ ((lane >> 3) & 1))) << 6) + (dcol & 31) * 2;
#pragma unroll
            for (int kt = 0; kt < 5; ++kt)
#pragma unroll
                for (int s2 = 0; s2 < 2; ++s2) {
                    const int rowb = kt * 32 + 16 * s2 + 4 * hi;
                    const s16x4 lo = lds_tr16(Vb + rowb * 128 + vlane), hi4 = lds_tr16(Vb + (rowb + 8) * 128 + vlane);
                    const bf16x8 vf = (bf16x8){lo[0], lo[1], lo[2], lo[3], hi4[0], hi4[1], hi4[2], hi4[3]};
                    u32x4 pw; pw.x = cvt_pk_bf16(S[kt][8 * s2 + 0], S[kt][8 * s2 + 1]); pw.y = cvt_pk_bf16(S[kt][8 * s2 + 2], S[kt][8 * s2 + 3]);
                    pw.z = cvt_pk_bf16(S[kt][8 * s2 + 4], S[kt][8 * s2 + 5]); pw.w = cvt_pk_bf16(S[kt][8 * s2 + 6], S[kt][8 * s2 + 7]);
                    acc = __builtin_amdgcn_mfma_f32_32x32x16_bf16(vf, __builtin_bit_cast(bf16x8, pw), acc, 0, 0, 0);
                }
#pragma unroll
            for (int r = 0; r < 16; ++r) { acc[r] *= inv; ssq += acc[r] * acc[r]; }
#pragma unroll
            for (int r = 0; r < 8; ++r) OP[hh][dt][r] = cvt_pk_bf16(acc[2 * r], acc[2 * r + 1]);
        }
    }
    ssq += __shfl_xor(ssq, 32);
    if (hi == 0) SSQ[w * 32 + r32] = ssq;
    __syncthreads();
    float tot = 0.f;
#pragma unroll
    for (int ww = 0; ww < 8; ++ww) tot += SSQ[ww * 32 + r32];
    const float rr = rsqrtf(tot * (1.f / 1024.f) + EPS);
    const float* nwp = a.in[8];
#pragma unroll
    for (int hh = 0; hh < 2; ++hh)
#pragma unroll
        for (int dt = 0; dt < 2; ++dt)
#pragma unroll
            for (int g4 = 0; g4 < 4; ++g4) {
                const int d = (2 * w + hh) * 64 + dt * 32 + 8 * g4 + 4 * hi;
                const f32x4 nw4 = *(const f32x4*)(nwp + d);
                const unsigned p0 = OP[hh][dt][2 * g4], p1 = OP[hh][dt][2 * g4 + 1];
                u32x2 o; o.x = pk2(bflo(p0) * rr * nw4[0], bfhi(p0) * rr * nw4[1]); o.y = pk2(bflo(p1) * rr * nw4[2], bfhi(p1) * rr * nw4[3]);
                *(u32x2*)(YM + (size_t)(b * L + t0 + r32) * D + 1024 + d) = o;
            }
}

constexpr int HL_QM = 0, HL_KM = 16384, HL_QS = 32768, HL_KE = 49152, HL_VT = 65536, HL_PL = 81920, HL_SEG = 90112, HL_DS = 94208, HL_SSQ = 94720;
__device__ __forceinline__ int trkey(int s) { return (s & 3) | (((s >> 3) & 1) << 2); }
__device__ __forceinline__ bf16x8 mk8(const s16x4& lo, const s16x4& hi) { return (bf16x8){lo[0], lo[1], lo[2], lo[3], hi[0], hi[1], hi[2], hi[3]}; }
__device__ __forceinline__ void hgrn_unit_mfma(Frame& F, const Args& a, int b, int h) {
    LAS unsigned char* lds = F.lds;
    const bf16_t* QH = (const bf16_t*)(F.ws + WS_QH); const bf16_t* VH = (const bf16_t*)(F.ws + WS_VH); const bf16_t* OG = (const bf16_t*)(F.ws + WS_OG);
    const float* GH = (const float*)(F.ws + WS_GH);
    bf16_t* YM = (bf16_t*)(F.ws + WS_YMIX);
    const int tid = F.tid, lane = F.lane, w = F.wave, r16 = lane & 15, g = lane >> 4, cp = lane;
    const size_t tokb = (size_t)b * L;
    const int hc = h * 128;
    f32x4 Sacc[8];
#pragma unroll
    for (int i = 0; i < 8; ++i) Sacc[i] = (f32x4){0.f, 0.f, 0.f, 0.f};
    f32x2 gpre[8]; unsigned qpre[8]; u32x4 vpre[2];
    const int vrow = tid >> 3, vc16 = tid & 7;
    const unsigned lo_g = 2u * (unsigned)cp, lo_v = (unsigned)(vrow * 1024 + vc16 * 8), lo_og = (unsigned)(r16 * 1024 + 4 * g), lo_ym = (unsigned)(r16 * 2048 + 4 * g);
    {
        const size_t rb = (tokb + 8 * w) * 1024 + hc;
        const float* gb = GH + rb; const bf16_t* qb = QH + rb; const bf16_t* vb = VH + tokb * 1024 + hc;
#pragma unroll
        for (int i = 0; i < 8; ++i) { gpre[i] = *(const f32x2*)(gb + i * 1024 + lo_g); qpre[i] = *(const unsigned*)(qb + i * 1024 + lo_g); }
        vpre[0] = *(const u32x4*)(vb + lo_v); vpre[1] = *(const u32x4*)(vb + 64 + lo_v);
    }
    const int keyl = ((lane & 15) >> 2) | ((g & 1) << 2);
    const int trrow = (8 * g + ((lane & 15) >> 2)) * 256 + 8 * (lane & 3);
    const unsigned wpar = (unsigned)(w & 1);
    const unsigned A1 = (((unsigned)cp >> 2) ^ (8u * wpar)) << 4, C1 = ((unsigned)cp & 3u) * 4u + (unsigned)w * 2048u;
    const unsigned A2 = (((unsigned)cp >> 1) ^ (16u * wpar)) << 3, C2 = ((unsigned)cp & 1u) * 4u + (unsigned)w * 2048u;
    const unsigned A3 = (((unsigned)cp >> 3) ^ (wpar << 2)) << 5, C3 = ((unsigned)cp & 7u) * 4u + (unsigned)w * 2048u;
    __syncthreads();
    for (int c = 0; c < L / 64; ++c) {
        int cc = c; asm volatile("" : "+s"(cc));
        const size_t tok0 = tokb + 64 * cc;
        { float run0 = 0.f, run1 = 0.f;
#pragma unroll
          for (int i = 0; i < 8; ++i) { run0 += gpre[i].x; run1 += gpre[i].y; }
          *(LAS f32x2*)(lds + HL_SEG + (w * 128 + 2 * cp) * 4) = (f32x2){run0, run1}; }
        { const int k0 = trkey(vrow);
          *(LAS u32x4*)(lds + HL_VT + vrow * 256 + ((((vc16 >> 1)) ^ k0) << 5) + (vc16 & 1) * 16) = vpre[0];
          *(LAS u32x4*)(lds + HL_VT + vrow * 256 + (((((vc16 + 8) >> 1)) ^ k0) << 5) + (vc16 & 1) * 16) = vpre[1]; }
        __syncthreads();
        f32x2 offc = (f32x2){0.f, 0.f}, rr = (f32x2){0.f, 0.f}, tot = (f32x2){0.f, 0.f};
#pragma unroll
        for (int sg = 0; sg < 8; ++sg) { const f32x2 sv = *(const LAS f32x2*)(lds + HL_SEG + (sg * 128 + 2 * cp) * 4);
            if (sg < w) offc += sv; if (sg < 4) rr += sv; tot += sv; }
        const f32x2 Rc = (f32x2){__builtin_amdgcn_exp2f(rr.x), __builtin_amdgcn_exp2f(rr.y)};
        const f32x2 C4 = (f32x2){__builtin_amdgcn_exp2f(tot.x - rr.x), __builtin_amdgcn_exp2f(tot.y - rr.y)};
        if (w == 0) *(LAS f32x2*)(lds + HL_DS + 2 * cp * 4) = (f32x2){__builtin_amdgcn_exp2f(tot.x), __builtin_amdgcn_exp2f(tot.y)};
#pragma unroll
        for (int i = 0; i < 8; ++i) {
            offc += gpre[i];
            const f32x2 d = offc - rr;
            const float E0 = __builtin_amdgcn_exp2f(fminf(fmaxf(d.x, -115.f), 115.f)), E1 = __builtin_amdgcn_exp2f(fminf(fmaxf(d.y, -115.f), 115.f));
            const float I0 = __builtin_amdgcn_rcpf(E0), I1 = __builtin_amdgcn_rcpf(E1);
            const float k0 = 1.f - __builtin_amdgcn_exp2f(gpre[i].x), k1 = 1.f - __builtin_amdgcn_exp2f(gpre[i].y);
            const f32x2 qm = (f32x2){bflo(qpre[i]) * E0, bfhi(qpre[i]) * E1}, km = (f32x2){k0 * I0, k1 * I1};
            const f32x2 qs = qm * Rc, ke = km * C4;
            LAS unsigned char* pq = lds + i * 256 + ((A1 ^ (unsigned)(i << 4)) + C1);
            *(LAS unsigned*)(pq + HL_QM) = cvt_pk_bf16_c(qm.x, qm.y);
            *(LAS unsigned*)(pq + HL_KM) = cvt_pk_bf16_c(km.x, km.y);
            *(LAS unsigned*)(lds + HL_QS + i * 256 + ((A2 ^ (unsigned)(i << 4)) + C2)) = cvt_pk_bf16_c(qs.x, qs.y);
            *(LAS unsigned*)(lds + HL_KE + i * 256 + ((A3 ^ (unsigned)((i & 3) << 5)) + C3)) = cvt_pk_bf16_c(ke.x, ke.y);
        }
        if (c + 1 < L / 64) {
            const size_t rb = (tok0 + 64 + 8 * w) * 1024 + hc;
            const float* gb = GH + rb; const bf16_t* qb = QH + rb; const bf16_t* vb = VH + (tok0 + 64) * 1024 + hc;
#pragma unroll
            for (int i = 0; i < 8; ++i) { gpre[i] = *(const f32x2*)(gb + i * 1024 + lo_g); qpre[i] = *(const unsigned*)(qb + i * 1024 + lo_g); }
            vpre[0] = *(const u32x4*)(vb + lo_v); vpre[1] = *(const u32x4*)(vb + 64 + lo_v);
        }
        __syncthreads();
#pragma unroll
        for (int rep = 0; rep < 2; ++rep) {
            if (rep == 1 && w >= 4) break;
            const int idx = rep == 0 ? w : 8 + w;
            const int si = (0xd940e4 >> (2 * idx)) & 3, ti = (0x8fb9e4 >> (2 * idx)) & 3;
            f32x4 pacc = (f32x4){0.f, 0.f, 0.f, 0.f};
            if (idx < 10) {
#pragma unroll
                for (int ks = 0; ks < 4; ++ks) {
                    const int ofs = r16 * 256 + (((4 * ks + g) ^ r16) << 4);
                    const bf16x8 af = *(const LAS bf16x8*)(lds + HL_KM + si * 4096 + ofs);
                    const bf16x8 bfr = *(const LAS bf16x8*)(lds + HL_QM + ti * 4096 + ofs);
                    pacc = __builtin_amdgcn_mfma_f32_16x16x32_bf16(af, bfr, pacc, 0, 0, 0);
                }
                const bool offd = si != ti;
#pragma unroll
                for (int r = 0; r < 4; ++r) pacc[r] = (offd || (4 * g + r <= r16)) ? pacc[r] : 0.f;
            }
            asm volatile("s_nop 7\n\ts_nop 7" ::: "memory");
            const int t = 16 * ti + r16;
            u32x2 pw; pw.x = cvt_pk_bf16_c(pacc[0], pacc[1]); pw.y = cvt_pk_bf16_c(pacc[2], pacc[3]);
            *(LAS u32x2*)(lds + HL_PL + t * 128 + (((2 * si + (g >> 1)) ^ ((t >> 1) & 7)) << 4) + (g & 1) * 8) = pw;
        }
        __syncthreads();
        u32x2 ogp[4];
        { const bf16_t* ob = OG + tok0 * 1024 + hc + 16 * w;
#pragma unroll
          for (int ti = 0; ti < 4; ++ti) ogp[ti] = *(const u32x2*)(ob + ti * 16384 + lo_og); }
#define HG_SB() __builtin_amdgcn_sched_barrier(0)
#define HG_QSLD(dst, kp) do { _Pragma("unroll") for (int ti = 0; ti < 4; ++ti) { const int t_ = 16 * ti + r16; \
            const u32x2 lo_ = *(const LAS u32x2*)(lds + HL_QS + t_ * 256 + (((8 * (kp) + g) ^ (r16 << 1)) << 3)); \
            const u32x2 hi_ = *(const LAS u32x2*)(lds + HL_QS + t_ * 256 + (((8 * (kp) + 4 + g) ^ (r16 << 1)) << 3)); \
            dst[ti] = (u32x4){lo_.x, lo_.y, hi_.x, hi_.y}; } } while (0)
#define HG_KELD(dst, kt) do { _Pragma("unroll") for (int ks = 0; ks < 2; ++ks) { const LAS unsigned char* pb_ = lds + HL_KE + ks * 32 * 256 + trrow + (((kt) ^ keyl) << 5); \
            dst[ks] = mk8(lds_tr16(pb_), lds_tr16(pb_ + 4 * 256)); } } while (0)
#define HG_INTER(kp, qsv) do { u32x4 sw_; sw_.x = cvt_pk_bf16_c(Sacc[2 * (kp)][0], Sacc[2 * (kp)][1]); sw_.y = cvt_pk_bf16_c(Sacc[2 * (kp)][2], Sacc[2 * (kp)][3]); \
            sw_.z = cvt_pk_bf16_c(Sacc[2 * (kp) + 1][0], Sacc[2 * (kp) + 1][1]); sw_.w = cvt_pk_bf16_c(Sacc[2 * (kp) + 1][2], Sacc[2 * (kp) + 1][3]); \
            const bf16x8 sf_ = __builtin_bit_cast(bf16x8, sw_); \
            _Pragma("unroll") for (int ti = 0; ti < 4; ++ti) Oa[ti] = __builtin_amdgcn_mfma_f32_16x16x32_bf16(sf_, __builtin_bit_cast(bf16x8, qsv[ti]), Oa[ti], 0, 0, 0); } while (0)
#define HG_SUPD(kt, kev, dsv) do { f32x4 sa_ = Sacc[kt] * dsv; \
            sa_ = __builtin_amdgcn_mfma_f32_16x16x32_bf16(kev[0], vf[0], sa_, 0, 0, 0); sa_ = __builtin_amdgcn_mfma_f32_16x16x32_bf16(kev[1], vf[1], sa_, 0, 0, 0); Sacc[kt] = sa_; } while (0)
        bf16x8 vf[2];
        bf16x8 pf[6];
        u32x4 qsA[4], qsB[4];
#pragma unroll
        for (int ks = 0; ks < 2; ++ks) {
            const LAS unsigned char* pb = lds + HL_VT + ks * 32 * 256 + trrow + ((w ^ keyl) << 5);
            vf[ks] = mk8(lds_tr16(pb), lds_tr16(pb + 4 * 256));
        }
        {
            const int t0_ = r16, t1_ = 16 + r16, t2_ = 32 + r16, t3_ = 48 + r16;
            pf[0] = *(const LAS bf16x8*)(lds + HL_PL + t0_ * 128 + (((g) ^ ((t0_ >> 1) & 7)) << 4));
            pf[1] = *(const LAS bf16x8*)(lds + HL_PL + t1_ * 128 + (((g) ^ ((t1_ >> 1) & 7)) << 4));
            pf[2] = *(const LAS bf16x8*)(lds + HL_PL + t2_ * 128 + (((g) ^ ((t2_ >> 1) & 7)) << 4));
            pf[3] = *(const LAS bf16x8*)(lds + HL_PL + t2_ * 128 + (((4 + g) ^ ((t2_ >> 1) & 7)) << 4));
            pf[4] = *(const LAS bf16x8*)(lds + HL_PL + t3_ * 128 + (((g) ^ ((t3_ >> 1) & 7)) << 4));
            pf[5] = *(const LAS bf16x8*)(lds + HL_PL + t3_ * 128 + (((4 + g) ^ ((t3_ >> 1) & 7)) << 4));
        }
        HG_QSLD(qsA, 0);
        HG_SB();
        f32x4 Oa[4];
        const f32x4 z4 = (f32x4){0.f, 0.f, 0.f, 0.f};
        Oa[0] = __builtin_amdgcn_mfma_f32_16x16x32_bf16(vf[0], pf[0], z4, 0, 0, 0);
        Oa[1] = __builtin_amdgcn_mfma_f32_16x16x32_bf16(vf[0], pf[1], z4, 0, 0, 0);
        Oa[2] = __builtin_amdgcn_mfma_f32_16x16x32_bf16(vf[0], pf[2], z4, 0, 0, 0);
        Oa[3] = __builtin_amdgcn_mfma_f32_16x16x32_bf16(vf[0], pf[4], z4, 0, 0, 0);
        Oa[2] = __builtin_amdgcn_mfma_f32_16x16x32_bf16(vf[1], pf[3], Oa[2], 0, 0, 0);
        Oa[3] = __builtin_amdgcn_mfma_f32_16x16x32_bf16(vf[1], pf[5], Oa[3], 0, 0, 0);
        HG_SB();
        HG_QSLD(qsB, 1);
        HG_SB();
        HG_INTER(0, qsA);
        HG_SB();
        HG_QSLD(qsA, 2);
        HG_SB();
        HG_INTER(1, qsB);
        HG_SB();
        HG_QSLD(qsB, 3);
        HG_SB();
#define HG_DSLD(kt) (*(const LAS f32x4*)(lds + HL_DS + (16 * (kt) + 4 * g) * 4))
        bf16x8 keA[2], keB[2], keC[2], keD[2]; f32x4 dA, dB, dC, dD;
        HG_KELD(keA, 0); HG_KELD(keB, 1); dA = HG_DSLD(0); dB = HG_DSLD(1);
        HG_SB();
        HG_INTER(2, qsA);
        HG_SB();
        HG_KELD(keC, 2); HG_KELD(keD, 3); dC = HG_DSLD(2); dD = HG_DSLD(3);
        HG_SB();
        HG_INTER(3, qsB);
        HG_SB();
        HG_SUPD(0, keA, dA); HG_SUPD(1, keB, dB);
        HG_SB();
        HG_KELD(keA, 4); HG_KELD(keB, 5); dA = HG_DSLD(4); dB = HG_DSLD(5);
        HG_SB();
        HG_SUPD(2, keC, dC); HG_SUPD(3, keD, dD);
        HG_SB();
        HG_KELD(keC, 6); HG_KELD(keD, 7); dC = HG_DSLD(6); dD = HG_DSLD(7);
        HG_SB();
        HG_SUPD(4, keA, dA); HG_SUPD(5, keB, dB);
        HG_SB();
        HG_SUPD(6, keC, dC); HG_SUPD(7, keD, dD);
#undef HG_DSLD
#undef HG_SB
#undef HG_QSLD
#undef HG_KELD
#undef HG_INTER
#undef HG_SUPD
#pragma unroll
        for (int ti = 0; ti < 4; ++ti) {
            float sq = (Oa[ti][0] * Oa[ti][0] + Oa[ti][1] * Oa[ti][1]) + (Oa[ti][2] * Oa[ti][2] + Oa[ti][3] * Oa[ti][3]);
            sq += __shfl_xor(sq, 16); sq += __shfl_xor(sq, 32);
            if (g == 0) *(LAS float*)(lds + HL_SSQ + (w * 64 + 16 * ti + r16) * 4) = sq;
        }
        __syncthreads();
#pragma unroll
        for (int ti = 0; ti < 4; ++ti) {
            const int t = 16 * ti + r16;
            float tot = 0.f;
#pragma unroll
            for (int ww = 0; ww < 8; ++ww) tot += *(const LAS float*)(lds + HL_SSQ + (ww * 64 + t) * 4);
            const float rs = rsqrtf(tot * (1.f / 128.f) + EPS);
            const f32x4 nw4 = *(const f32x4*)(a.in[6] + 16 * w + 4 * g);
            u32x2 o; o.x = pk2(Oa[ti][0] * rs * nw4[0] * bflo(ogp[ti].x), Oa[ti][1] * rs * nw4[1] * bfhi(ogp[ti].x));
            o.y = pk2(Oa[ti][2] * rs * nw4[2] * bflo(ogp[ti].y), Oa[ti][3] * rs * nw4[3] * bfhi(ogp[ti].y));
            *(u32x2*)(YM + tok0 * D + hc + 16 * w + ti * 32768 + lo_ym) = o;
        }
    }
}

typedef _Float16 f16x8 __attribute__((ext_vector_type(8)));
typedef _Float16 f16x2 __attribute__((ext_vector_type(2)));
__device__ __forceinline__ unsigned pkh(float a, float b) { const f16x2 h = {(_Float16)a, (_Float16)b}; return __builtin_bit_cast(unsigned, h); }
constexpr int LC_CNTL = 4096, LC_BASE = 4224;
__device__ __forceinline__ void p4_ln_router(Frame& F, const Args& a) {
    LAS unsigned char* lds = F.lds;
    const float* Z = (const float*)(F.ws + WS_Z); bf16_t* H1 = (bf16_t*)(F.ws + WS_H1);
    const float* w = a.in[11]; const float* b = a.in[12]; const float* br = a.in[14];
    int* cnt = (int*)(F.ws + WS_CTL) + CW_CNT; int* list = (int*)(F.ws + WS_LIST);
    int* tok_e = (int*)(F.ws + WS_TOKE); int* tok_p = (int*)(F.ws + WS_TOKP); float* tok_g = (float*)(F.ws + WS_TOKG);
    const int tid = F.tid, lane = F.lane, wv = F.wave, r16 = lane & 15, g = lane >> 4, nh = wv & 1, q = wv >> 1;
    LAS int* CNTL = (LAS int*)(lds + LDSCTL_OFF + LC_CNTL); LAS int* BASE = (LAS int*)(lds + LDSCTL_OFF + LC_BASE);
    if (tid < 32) CNTL[tid] = 0;
    f16x8 wf[16];
    { const _Float16* ph = (const _Float16*)(F.ws + WS_WRH) + (size_t)(16 * nh + r16) * D + 512 * q + 8 * g;
#pragma unroll
      for (int ks = 0; ks < 16; ++ks) wf[ks] = *(const f16x8*)(ph + 32 * ks); }
    int se0 = 0, se1 = 0, se2 = 0, se3 = 0; float sg0 = 0.f, sg1 = 0.f, sg2 = 0.f, sg3 = 0.f;
    const int ntile = T / 32;
    const int nmy = (ntile - F.vcu + F.G - 1) / F.G;
    for (int it = 0; it < nmy; ++it) {
        const int tile = F.vcu + it * F.G;
        __syncthreads();
#define P4_LN(v, tlx) do { const int tl = (tlx), m = tile * 32 + tl; float s = 0.f; \
            _Pragma("unroll") for (int j = 0; j < 8; ++j) s += (v[j][0] + v[j][1]) + (v[j][2] + v[j][3]); \
            const float mean = wave_sum(s) * (1.f / D); float s2 = 0.f; \
            _Pragma("unroll") for (int j = 0; j < 8; ++j) { v[j] = v[j] - mean; s2 += (v[j][0] * v[j][0] + v[j][1] * v[j][1]) + (v[j][2] * v[j][2] + v[j][3] * v[j][3]); } \
            const float rstd = rsqrtf(wave_sum(s2) * (1.f / D) + EPS); \
            GAS u32x2* o8 = (GAS u32x2*)(H1 + (size_t)m * D) + lane; \
            _Pragma("unroll") for (int j = 0; j < 8; ++j) { const f32x4 ww = *((const f32x4*)w + lane + 64 * j), bb = *((const f32x4*)b + lane + 64 * j); \
                f32x4 hv; hv[0] = v[j][0] * rstd * ww[0] + bb[0]; hv[1] = v[j][1] * rstd * ww[1] + bb[1]; hv[2] = v[j][2] * rstd * ww[2] + bb[2]; hv[3] = v[j][3] * rstd * ww[3] + bb[3]; \
                u32x2 o; o.x = pk2(hv[0], hv[1]); o.y = pk2(hv[2], hv[3]); o8[64 * j] = o; \
                *((GAS unsigned*)(F.ws + WS_H1Q + (size_t)m * D) + lane + 64 * j) = pk4_fp8(hv[0] * SC_H1, hv[1] * SC_H1, hv[2] * SC_H1, hv[3] * SC_H1); \
                u32x2 hh; hh.x = pkh(hv[0], hv[1]); hh.y = pkh(hv[2], hv[3]); \
                *(LAS u32x2*)(lds + tl * 4096 + ((((lane >> 1) + 32 * j) ^ (tl & 15)) << 4) + (lane & 1) * 8) = hh; } } while (0)
#pragma unroll 1
        for (int ps = 0; ps < 2; ++ps) {
            f32x4 v0[8], v1[8];
            { const GAS f32x4* z0 = (const GAS f32x4*)(Z + (size_t)(tile * 32 + 4 * wv + 2 * ps) * D) + lane;
#pragma unroll
              for (int j = 0; j < 8; ++j) { v0[j] = z0[64 * j]; v1[j] = z0[64 * j + 512]; } }
            P4_LN(v0, 4 * wv + 2 * ps); P4_LN(v1, 4 * wv + 2 * ps + 1);
        }
#undef P4_LN
        __syncthreads();
        f32x4 acc0 = (f32x4){0.f, 0.f, 0.f, 0.f}, acc1 = (f32x4){0.f, 0.f, 0.f, 0.f};
#pragma unroll
        for (int ks = 0; ks < 16; ++ks) {
            const int off = r16 * 4096 + (((64 * q + 4 * ks + g) ^ r16) << 4);
            const f16x8 t0 = *(const LAS f16x8*)(lds + off), t1 = *(const LAS f16x8*)(lds + 65536 + off);
            acc0 = __builtin_amdgcn_mfma_f32_16x16x32_f16(wf[ks], t0, acc0, 0, 0, 0);
            acc1 = __builtin_amdgcn_mfma_f32_16x16x32_f16(wf[ks], t1, acc1, 0, 0, 0);
        }
        __syncthreads();
        *(LAS f32x4*)(lds + ((q * 32 + r16) * 32 + 16 * nh + 4 * g) * 4) = acc0;
        *(LAS f32x4*)(lds + ((q * 32 + 16 + r16) * 32 + 16 * nh + 4 * g) * 4) = acc1;
        __syncthreads();
#pragma unroll
        for (int ps = 0; ps < 2; ++ps) {
            const int e = lane & 31, tl = 4 * wv + 2 * ps + (lane >> 5);
            float sl = 0.f;
#pragma unroll
            for (int qq = 0; qq < 4; ++qq) sl += *(const LAS float*)(lds + ((qq * 32 + tl) * 32 + e) * 4);
            sl = sl * (1.f / 64.f) + br[e];
            float val = sl; int te[4]; float tv[4];
#pragma unroll
            for (int r = 0; r < 4; ++r) {
                float bv = val; int bi = e;
#pragma unroll
                for (int o = 1; o < 32; o <<= 1) { const float ov = __shfl_xor(bv, o); const int oi = __shfl_xor(bi, o); if (ov > bv || (ov == bv && oi < bi)) { bv = ov; bi = oi; } }
                te[r] = bi; tv[r] = bv; if (e == bi) val = -INFINITY;
            }
            float p[4], psum = 0.f;
#pragma unroll
            for (int r = 0; r < 4; ++r) { p[r] = __expf(tv[r] - tv[0]); psum += p[r]; }
            if (e < 4) {
                int ee = te[0]; float gg = p[0];
                if (e == 1) { ee = te[1]; gg = p[1]; } else if (e == 2) { ee = te[2]; gg = p[2]; } else if (e == 3) { ee = te[3]; gg = p[3]; }
                const float gn = gg / psum; const int idx = it * 2 + ps;
                if (idx == 0) { se0 = ee; sg0 = gn; } else if (idx == 1) { se1 = ee; sg1 = gn; } else if (idx == 2) { se2 = ee; sg2 = gn; } else { se3 = ee; sg3 = gn; }
            }
        }
    }
    __syncthreads();
    const bool own = (lane & 31) < 4;
    const int nent = nmy * 2;
    int rk0 = 0, rk1 = 0, rk2 = 0, rk3 = 0;
    if (own) {
        if (nent > 0) rk0 = __hip_atomic_fetch_add((LAS int*)&CNTL[se0], 1, __ATOMIC_RELAXED, __HIP_MEMORY_SCOPE_WORKGROUP);
        if (nent > 1) rk1 = __hip_atomic_fetch_add((LAS int*)&CNTL[se1], 1, __ATOMIC_RELAXED, __HIP_MEMORY_SCOPE_WORKGROUP);
        if (nent > 2) rk2 = __hip_atomic_fetch_add((LAS int*)&CNTL[se2], 1, __ATOMIC_RELAXED, __HIP_MEMORY_SCOPE_WORKGROUP);
        if (nent > 3) rk3 = __hip_atomic_fetch_add((LAS int*)&CNTL[se3], 1, __ATOMIC_RELAXED, __HIP_MEMORY_SCOPE_WORKGROUP);
    }
    __syncthreads();
    if (tid < 32) { const int c = CNTL[tid]; BASE[tid] = c > 0 ? atomicAdd(&cnt[tid], c) : 0; }
    __syncthreads();
    if (own) {
        const int k = lane & 31;
#define P4_EMIT(idx, sex, sgx, rkx) do { if (nent > (idx)) { const int m = (F.vcu + ((idx) >> 1) * F.G) * 32 + 4 * wv + 2 * ((idx) & 1) + (lane >> 5), pos = BASE[sex] + (rkx); \
            list[(size_t)(sex) * LISTCAP + pos] = m; tok_e[m * 4 + k] = (sex); tok_p[m * 4 + k] = pos; tok_g[m * 4 + k] = (sgx); } } while (0)
        P4_EMIT(0, se0, sg0, rk0); P4_EMIT(1, se1, sg1, rk1); P4_EMIT(2, se2, sg2, rk2); P4_EMIT(3, se3, sg3, rk3);
#undef P4_EMIT
    }
}
__device__ __forceinline__ int moe_tables(Frame& F) {
    LAS int* pts = (LAS int*)(F.lds + LDSCTL_OFF + LC_PTS); LAS int* cl = (LAS int*)(F.lds + LDSCTL_OFF + LC_CNT); LAS unsigned char* tileE = (LAS unsigned char*)(F.lds + LDSCTL_OFF + LC_TILEE);
    const int* cnt = (const int*)(F.ws + WS_CTL) + CW_CNT;
    __syncthreads();
    if (F.tid < 64) {
        const int e = F.tid & 31; const int c = __hip_atomic_load(cnt + e, RLX_AGENT); const int tl = (c + 255) >> 8;
        int incl = tl;
#pragma unroll
        for (int o = 1; o < 32; o <<= 1) { const int v = __shfl_up(incl, o, 32); if (e >= o) incl += v; }
        if (F.tid < 32) { cl[e] = c; pts[e] = incl - tl; if (e == 31) pts[32] = incl; }
    }
    __syncthreads();
    const int nmt = pts[32];
    for (int t = F.tid; t < nmt; t += NTHR) { int e = 0;
        for (int j = 0; j < 32; ++j) if (t >= pts[j + 1]) e = j + 1;
        tileE[t] = (unsigned char)e; }
    __syncthreads();
    return __builtin_amdgcn_readfirstlane(nmt);
}
__device__ __forceinline__ void p7_combine(Frame& F, const Args& a) {
    const LAS int* pts = (const LAS int*)(F.lds + LDSCTL_OFF + LC_PTS);
    const bf16_t* H1 = (const bf16_t*)(F.ws + WS_H1); const bf16_t* Y = (const bf16_t*)(F.ws + WS_Y);
    const int* tok_e = (const int*)(F.ws + WS_TOKE); const int* tok_p = (const int*)(F.ws + WS_TOKP); const float* tok_g = (const float*)(F.ws + WS_TOKG);
    const float* w = a.in[21]; const float* b = a.in[22]; float* out = a.out;
    const int gw = F.vcu * NWAVES + F.wave, NGW = F.G * NWAVES, lane = F.lane;
    const int ntok = (T - gw + NGW - 1) / NGW;
    int rowv = 0; float gv = 0.f;
    { const int i = lane >> 2, k = lane & 3; if (i < ntok) { const int m = gw + i * NGW; const int e = tok_e[m * 4 + k]; rowv = pts[e] * 256 + tok_p[m * 4 + k]; gv = tok_g[m * 4 + k]; } }
#define P8_LOAD(hx, yx, i) do { const int m_ = gw + (i) * NGW; const GAS u32x2* hr_ = (const GAS u32x2*)(H1 + (size_t)m_ * D) + lane; \
        _Pragma("unroll") for (int j = 0; j < 8; ++j) hx[j] = hr_[64 * j]; \
        _Pragma("unroll") for (int k = 0; k < 4; ++k) { const int row_ = __builtin_amdgcn_readlane(rowv, 4 * (i) + k); const GAS u32x2* yr_ = (const GAS u32x2*)(Y + (size_t)row_ * D) + lane; \
            _Pragma("unroll") for (int j = 0; j < 8; ++j) yx[k][j] = yr_[64 * j]; } } while (0)
#define P8_DO(hx, yx, i) do { const int m_ = gw + (i) * NGW; f32x4 v[8]; \
        _Pragma("unroll") for (int j = 0; j < 8; ++j) { v[j][0] = ALPHA * bflo(hx[j].x); v[j][1] = ALPHA * bfhi(hx[j].x); v[j][2] = ALPHA * bflo(hx[j].y); v[j][3] = ALPHA * bfhi(hx[j].y); } \
        _Pragma("unroll") for (int k = 0; k < 4; ++k) { const float g_ = __builtin_bit_cast(float, __builtin_amdgcn_readlane(__builtin_bit_cast(int, gv), 4 * (i) + k)); \
            _Pragma("unroll") for (int j = 0; j < 8; ++j) { v[j][0] += g_ * bflo(yx[k][j].x); v[j][1] += g_ * bfhi(yx[k][j].x); v[j][2] += g_ * bflo(yx[k][j].y); v[j][3] += g_ * bfhi(yx[k][j].y); } } \
        float s = 0.f; _Pragma("unroll") for (int j = 0; j < 8; ++j) s += (v[j][0] + v[j][1]) + (v[j][2] + v[j][3]); \
        const float mean = wave_sum(s) * (1.f / D); float s2 = 0.f; \
        _Pragma("unroll") for (int j = 0; j < 8; ++j) { v[j] = v[j] - mean; s2 += (v[j][0] * v[j][0] + v[j][1] * v[j][1]) + (v[j][2] * v[j][2] + v[j][3] * v[j][3]); } \
        const float rstd = rsqrtf(wave_sum(s2) * (1.f / D) + EPS); GAS f32x4* orow = (GAS f32x4*)(out + (size_t)m_ * D) + lane; \
        _Pragma("unroll") for (int j = 0; j < 8; ++j) { const f32x4 ww = *((const f32x4*)w + lane + 64 * j), bb = *((const f32x4*)b + lane + 64 * j); \
            f32x4 o; o[0] = v[j][0] * rstd * ww[0] + bb[0]; o[1] = v[j][1] * rstd * ww[1] + bb[1]; o[2] = v[j][2] * rstd * ww[2] + bb[2]; o[3] = v[j][3] * rstd * ww[3] + bb[3]; orow[64 * j] = o; } } while (0)
    u32x2 hA[8], yA[4][8], hB[8], yB[4][8];
    if (ntok > 0) P8_LOAD(hA, yA, 0);
    for (int i = 0; i < ntok; i += 2) {
        if (i + 1 < ntok) P8_LOAD(hB, yB, i + 1);
        P8_DO(hA, yA, i);
        if (i + 1 < ntok) { if (i + 2 < ntok) P8_LOAD(hA, yA, i + 2); P8_DO(hB, yB, i + 1); }
    }
#undef P8_LOAD
#undef P8_DO
}

__global__ void __launch_bounds__(NTHR, 2) mk_fwd(Args args) {
    extern __shared__ __attribute__((aligned(16))) unsigned char lds_raw[];
    Frame F;
    F.lds = (LAS unsigned char*)lds_raw;
    F.tid = threadIdx.x; F.lane = F.tid & 63; F.wave = __builtin_amdgcn_readfirstlane(F.tid >> 6);
    F.G = gridDim.x; { const int bx = blockIdx.x; F.vcu = (F.G % 8 == 0) ? (bx % 8) * (F.G / 8) + bx / 8 : bx; }
    F.ws = args.ws;
    unsigned char* ws = args.ws;
    for (int u = F.tid; u < (LDS_BYTES - LDSCTL_OFF) / 4; u += NTHR) ((LAS unsigned*)(F.lds + LDSCTL_OFF))[u] = 0u;
    __syncthreads();
    XcdBarrier bar; bar.bar = (unsigned*)(ws + WS_CTL) + CW_BAR; bar.x = 0; bar.st = nullptr;
#if !MK_PER_PHASE
    bar = xcd_barrier_post((unsigned*)(ws + WS_CTL) + CW_BAR, (volatile LAS unsigned*)(F.lds + LDSCTL_OFF + LC_BAR));
#endif
    const int lo = args.ph_lo, hi = args.ph_hi;
#define IN(k) (lo <= (k) && (k) < hi)
#define REFRESH_IDS() do { int t_ = threadIdx.x; asm volatile("" : "+v"(t_)); F.tid = t_; F.lane = t_ & 63; F.wave = __builtin_amdgcn_readfirstlane(t_ >> 6); } while (0)
#define SEAM(k) do { if (IN(k) && IN((k) + 1)) xcd_barrier(bar); } while (0)

    if (IN(0)) { REFRESH_IDS(); for (int r = 0; r < REP0; ++r) { p0_prologue(F, args); if (r + 1 < REP0) xcd_barrier(bar); } } SEAM(0);

    if (IN(1)) { REFRESH_IDS();
        const int Gg = F.G;
        SchedDense S{(const bf16_t*)(ws + WS_H0), (const bf16_t*)(ws + WS_WIN), T / 256, INC / 256, Gg, (int)blockIdx.x};
        EpiInProj E{(bf16_t*)(ws + WS_QH), (bf16_t*)(ws + WS_KH), (bf16_t*)(ws + WS_VH), (bf16_t*)(ws + WS_OG), (bf16_t*)(ws + WS_AQ), (bf16_t*)(ws + WS_AK), (bf16_t*)(ws + WS_AV),
                    (float*)(ws + WS_GH), (const float*)(ws + WS_LB), args.in[4]};
        for (int r = 0; r < REP1; ++r) { gemm_phase<EpiInProj, SchedDense>(F.lds, S, E); if (r + 1 < REP1) xcd_barrier(bar); }
        {
            const int nwg = (T / 256) * (INC / 256), full = nwg / F.G, extra = nwg - full * F.G;
            const bool has_extra = (int)blockIdx.x < extra;
            if (has_extra) { if (threadIdx.x == 0) __hip_atomic_fetch_add((unsigned*)(ws + WS_CTL) + CW_P1DONE, 1u, RLX_AGENT); }
            else if (extra > 0) { __syncthreads(); cv_worker(F, args, (const unsigned*)(ws + WS_CTL) + CW_P1DONE, (unsigned)extra); }
        }
    } SEAM(1);

    if (IN(2)) { REFRESH_IDS();
        for (int r = 0; r < REP2; ++r) {
        const int nh = F.G > 64 ? 64 : F.G;
        const int a0 = F.G >= 192 ? 64 : 0, na = F.G >= 192 ? 64 : F.G;
        if ((int)blockIdx.x < nh) { for (int hu = blockIdx.x; hu < 64 * REP2H; hu += nh) hgrn_unit_mfma(F, args, (hu & 63) >> 3, hu & 7); }
        REFRESH_IDS();
        if ((int)blockIdx.x >= a0 && (int)blockIdx.x < a0 + na) {
            for (int v0 = (int)blockIdx.x - a0; v0 < NB * (L / AT_Q) * REP2A; v0 += na) { const int v = v0 % (NB * (L / AT_Q)); attn_unit_mfma(F, args, v / (L / AT_Q), v % (L / AT_Q)); }
        }
        __syncthreads();
        REFRESH_IDS();
        cv_worker(F, args, nullptr, 0u);
        if (r + 1 < REP2) xcd_barrier(bar); }
    } SEAM(2);

    if (IN(3)) { REFRESH_IDS();
        SchedDense S{(const bf16_t*)(ws + WS_YMIX), (const bf16_t*)(ws + WS_WOUT), T / 256, D / 256, F.G, (int)blockIdx.x};
        EpiOutProj E{(float*)(ws + WS_Z), args.in[0], (const float*)(ws + WS_STATS0), args.in[1], args.in[2], args.in[10]};
        for (int r = 0; r < REP3; ++r) { gemm_phase<EpiOutProj, SchedDense>(F.lds, S, E); if (r + 1 < REP3) xcd_barrier(bar); }
    } SEAM(3);

    if (IN(4)) { REFRESH_IDS(); p4_ln_router(F, args); }

    if (IN(5) && !IN(4)) { REFRESH_IDS(); __syncthreads(); cv_worker(F, args, nullptr, 0u); }
    if (IN(4) || IN(5)) { if (IN(6)) xcd_barrier(bar); }

    if (IN(6)) { REFRESH_IDS();
        const int nmt = moe_tables(F);
        SchedMoe<2048> S{(const void*)(ws + WS_H1Q), (const void*)(ws + WS_WGU), (size_t)4096 * KD, (const int*)(ws + WS_LIST),
                   (const LAS int*)(F.lds + LDSCTL_OFF + LC_PTS), (const LAS int*)(F.lds + LDSCTL_OFF + LC_CNT), (const LAS unsigned char*)(F.lds + LDSCTL_OFF + LC_TILEE), nmt, 16, F.G, (int)blockIdx.x, true};
        EpiMoe1F8 E{(unsigned char*)(ws + WS_HACT), args.in[16], args.in[18]};
        for (int r = 0; r < REP5; ++r) { gemm_phase<EpiMoe1F8, SchedMoe<2048>, true>(F.lds, S, E); if (r + 1 < REP5) xcd_barrier(bar); }
    } SEAM(6);

    if (IN(7)) { REFRESH_IDS();
        const int nmt = moe_tables(F);
        SchedMoe<2048> S{(const void*)(ws + WS_HACT), (const void*)(ws + WS_WD), (size_t)2048 * KD, (const int*)(ws + WS_LIST),
                   (const LAS int*)(F.lds + LDSCTL_OFF + LC_PTS), (const LAS int*)(F.lds + LDSCTL_OFF + LC_CNT), (const LAS unsigned char*)(F.lds + LDSCTL_OFF + LC_TILEE), nmt, 8, F.G, (int)blockIdx.x, false};
        EpiMoe2F8 E{(bf16_t*)(ws + WS_Y), args.in[20]};
        for (int r = 0; r < REP6; ++r) { gemm_phase<EpiMoe2F8, SchedMoe<2048>, true>(F.lds, S, E); if (r + 1 < REP6) xcd_barrier(bar); }
    } SEAM(7);

    if (IN(8)) { REFRESH_IDS(); (void)moe_tables(F); for (int r = 0; r < REP7; ++r) p7_combine(F, args); }
#undef IN
#undef SEAM
}
}

extern "C" void kernel_launch(void* const* d_in, const int* in_sizes, int n_in, void* d_out, int out_size, void* d_ws, size_t ws_size, hipStream_t stream) {
    static int grid = 0;
    if (grid == 0) {
        if (n_in != 23 || out_size != T * D || ws_size < WS_END) { fprintf(stderr, "kernel_launch: unexpected shapes (n_in %d out %d ws %zu need %zu)\n", n_in, out_size, ws_size, (size_t)WS_END); grid = -1; return; }
        int dev = 0, cus = 0, per_cu = 0;
        if (hipGetDevice(&dev) != hipSuccess || hipDeviceGetAttribute(&cus, hipDeviceAttributeMultiprocessorCount, dev) != hipSuccess) { grid = -1; return; }
        if (hipFuncSetAttribute((const void*)mk_fwd, hipFuncAttributeMaxDynamicSharedMemorySize, LDS_BYTES) != hipSuccess) { fprintf(stderr, "kernel_launch: hipFuncSetAttribute failed\n"); grid = -1; return; }
        if (hipOccupancyMaxActiveBlocksPerMultiprocessor(&per_cu, (const void*)mk_fwd, NTHR, LDS_BYTES) != hipSuccess || per_cu < 1) { fprintf(stderr, "kernel_launch: occupancy query says %d\n", per_cu); }
        (void)hipGetLastError();
        grid = cus;
    }
    if (grid < 0) return;
    if (hipMemsetAsync((char*)d_ws + WS_CTL, 0, CTL_ZERO_BYTES, stream) != hipSuccess) return;
    Args a{};
    for (int i = 0; i < 23; ++i) a.in[i] = (const float*)d_in[i];
    a.out = (float*)d_out; a.ws = (unsigned char*)d_ws;
#if MK_PER_PHASE
    for (int p = 0; p < NPHASE; ++p) { a.ph_lo = p; a.ph_hi = p + 1; hipLaunchKernelGGL(mk_fwd, dim3(grid), dim3(NTHR), LDS_BYTES, stream, a); }
#else
    a.ph_lo = 0; a.ph_hi = NPHASE; hipLaunchKernelGGL(mk_fwd, dim3(grid), dim3(NTHR), LDS_BYTES, stream, a);
#endif
}
```

```cpp
#include <hip/hip_runtime.h>
#include <cstdio>
#include <cstdint>

#ifndef MK_PER_PHASE
#define MK_PER_PHASE 0
#endif

#define LAS __attribute__((address_space(3)))
#define GAS __attribute__((address_space(1)))
typedef unsigned short bf16_t;
typedef short bf16x8 __attribute__((ext_vector_type(8)));
typedef float f32x4 __attribute__((ext_vector_type(4)));
typedef float f32x2 __attribute__((ext_vector_type(2)));
typedef unsigned u32x4 __attribute__((ext_vector_type(4)));
typedef unsigned u32x2 __attribute__((ext_vector_type(2)));
typedef GAS unsigned gu32;

namespace {
constexpr int D = 2048, NB = 8, L = 2048, T = NB * L;
constexpr int INC = 5376;
constexpr int NE = 32, FF = 2048, NA = T * 4;
constexpr int LISTCAP = T;
constexpr int MAXROWS = NA + NE * 256;
constexpr float ALPHA = 1.189207115002721f;
constexpr float EPS = 1e-5f;
constexpr int NWAVES = 8, NTHR = 512;
constexpr int NPHASE = 9;
constexpr int REP2H = 1, REP2A = 1;
constexpr int REP0 = 1, REP1 = 1, REP2 = 1, REP3 = 1, REP5 = 1, REP6 = 1, REP7 = 1;

constexpr size_t MiB = 1u << 20;
constexpr size_t WS_CTL = 0, CTL_ZERO_BYTES = 32768;
constexpr size_t WS_LB = 1 * MiB;
constexpr size_t WS_STATS0 = WS_LB + 4096;
constexpr size_t WS_LIST = 2 * MiB;
constexpr size_t WS_TOKE = 4 * MiB, WS_TOKP = WS_TOKE + (size_t)NA * 4, WS_TOKG = WS_TOKP + (size_t)NA * 4;
constexpr size_t WS_WRH = 5 * MiB;
constexpr size_t WS_WIN = 8 * MiB;
constexpr size_t WS_WOUT = 30 * MiB;
constexpr size_t WS_WGU = 40 * MiB;
constexpr size_t WS_WD = 552 * MiB;
constexpr size_t WS_H1 = 808 * MiB;
constexpr size_t WS_Z = 872 * MiB;
constexpr size_t WS_HACT = 1000 * MiB;
constexpr size_t WS_EARLY = 1288 * MiB;
constexpr size_t WS_H0 = WS_EARLY;
constexpr size_t WS_QH = WS_H0 + 64 * MiB, WS_KH = WS_QH + 32 * MiB, WS_VH = WS_KH + 32 * MiB, WS_OG = WS_VH + 32 * MiB, WS_AQ = WS_OG + 32 * MiB;
constexpr size_t WS_GH = WS_AQ + 32 * MiB;
constexpr size_t WS_AK = WS_GH + 64 * MiB, WS_AV = WS_AK + 4 * MiB;
constexpr size_t WS_YMIX = WS_AV + 4 * MiB;
constexpr size_t WS_H1Q = WS_KH;
constexpr size_t WS_Y = WS_EARLY;
constexpr size_t WS_END = WS_YMIX + 64 * MiB;
static_assert(WS_Y + (size_t)MAXROWS * 4096 <= WS_END + 0 * MiB || true, "");
static_assert(WS_END <= 2048 * MiB, "d_ws map");
constexpr int CW_CNT = 64;
constexpr int CW_CONV = 128, CW_P1DONE = 192, CW_HGDONE = 256;
constexpr int CW_BAR = 4096;

constexpr int RING_BYTES = 131072;
constexpr int CV_SCR = 17408;
constexpr int LDSCTL_OFF = 8 * CV_SCR;
constexpr int LDS_BYTES = 147456;
constexpr int LC_BAR = 0, LC_PTS = 64, LC_CNT = 256, LC_TILEE = 512, LC_MISC = 2048;

#define RLX_AGENT __ATOMIC_RELAXED, __HIP_MEMORY_SCOPE_AGENT
__device__ __forceinline__ unsigned f2bf(float f) { unsigned u = __builtin_bit_cast(unsigned, f); return (u + 0x7fffu + ((u >> 16) & 1u)) >> 16; }
__device__ __forceinline__ unsigned pk2(float lo, float hi) { return f2bf(lo) | (f2bf(hi) << 16); }
__device__ __forceinline__ float bf2f(unsigned short b) { return __builtin_bit_cast(float, (unsigned)b << 16); }
__device__ __forceinline__ float bflo(unsigned w) { return __builtin_bit_cast(float, w << 16); }
__device__ __forceinline__ float bfhi(unsigned w) { return __builtin_bit_cast(float, w & 0xffff0000u); }
typedef __bf16 bf16x2_t __attribute__((ext_vector_type(2)));
__device__ __forceinline__ unsigned cvt_pk_bf16_c(float lo, float hi) { f32x2 v = {lo, hi}; bf16x2_t b = __builtin_convertvector(v, bf16x2_t); return __builtin_bit_cast(unsigned, b); }
__device__ __forceinline__ unsigned cvt_pk_bf16(float lo, float hi) { unsigned r; asm volatile("v_cvt_pk_bf16_f32 %0, %1, %2" : "=v"(r) : "v"(lo), "v"(hi)); return r; }
__device__ __forceinline__ float wave_sum(float v) {
#pragma unroll
    for (int o = 1; o < 64; o <<= 1) v += __shfl_xor(v, o);
    return v;
}
__device__ __forceinline__ float sigm(float x) { return __builtin_amdgcn_rcpf(1.f + __expf(-x)); }

#define XB_TMO      128
#define XB_XCNT(j)  (256  + 64 * (j))
#define XB_XSUB(j)  (1280 + 64 * (j))
#define XB_XGEN(j)  (2304 + 64 * (j))
#define XB_TOP      3328
#define XB_TOPGEN   3392
#define XCD_BAR_WORDS 3456
#define XB_SPIN_CAP (1u << 18)
__device__ __forceinline__ unsigned xb_ld(unsigned* p)              { return __hip_atomic_load(p, __ATOMIC_RELAXED, __HIP_MEMORY_SCOPE_AGENT); }
__device__ __forceinline__ unsigned xb_add(unsigned* p, unsigned v) { return __hip_atomic_fetch_add(p, v, __ATOMIC_RELAXED, __HIP_MEMORY_SCOPE_AGENT); }
__device__ __forceinline__ unsigned xb_xcc_id() { return (unsigned)__builtin_amdgcn_s_getreg((3 << 11) | 20) & 0xFu; }
#define XB_SPIN(cond, bar) do { unsigned _sp = 0; while (cond) { __builtin_amdgcn_s_sleep(1); \
    if ((++_sp & 255u) == 0u) { if (xb_ld(&(bar)[XB_TMO])) break; if (_sp > XB_SPIN_CAP) { atomicAdd(&(bar)[XB_TMO], 1u); break; } } } } while (0)
struct XcdBarrier { unsigned* bar; unsigned x; volatile LAS unsigned* st; };
__device__ __forceinline__ XcdBarrier xcd_barrier_post(unsigned* bar, volatile LAS unsigned* st) {
    XcdBarrier b; b.bar = bar; b.x = xb_xcc_id(); b.st = st;
    if (threadIdx.x == 0) (void)xb_add(&bar[XB_XCNT(b.x)], 1u);
    return b;
}
__device__ __forceinline__ void xcd_barrier_complete(unsigned* bar, unsigned x, unsigned& nloc, unsigned& nx) {
    const unsigned G = gridDim.x * gridDim.y * gridDim.z;
    unsigned sum, cnt, mine, sp = 0u;
    for (;;) {
        sum = 0u; cnt = 0u; mine = 0u;
#pragma unroll
        for (unsigned j = 0; j < 16; ++j) { const unsigned c = xb_ld(&bar[XB_XCNT(j)]); sum += c; cnt += (c > 0u) ? 1u : 0u; mine = (j == x) ? c : mine; }
        if (sum == G) break;
        __builtin_amdgcn_s_sleep(1);
        if ((++sp & 255u) == 0u) { if (xb_ld(&bar[XB_TMO])) break; if (sp > XB_SPIN_CAP) { atomicAdd(&bar[XB_TMO], 1u); break; } }
    }
    nloc = mine > 0u ? mine : 1u; nx = cnt > 0u ? cnt : 1u;
}
__device__ __forceinline__ void xcd_barrier(const XcdBarrier& b) {
    asm volatile("s_waitcnt vmcnt(0)" ::: "memory");
    __syncthreads();
    if (threadIdx.x == 0) {
        unsigned* bar = b.bar;
        __builtin_amdgcn_s_waitcnt(0);
        unsigned nloc = b.st[0], nx = b.st[1];
        if (nloc == 0u) { xcd_barrier_complete(bar, b.x, nloc, nx); b.st[0] = nloc; b.st[1] = nx; }
        const unsigned old = xb_add(&bar[XB_XSUB(b.x)], 1u);
        const unsigned gen = old / nloc;
        if (old + 1u == (gen + 1u) * nloc) {
            __builtin_amdgcn_fence(__ATOMIC_RELEASE, "agent");
            asm volatile("s_waitcnt vmcnt(0)" ::: "memory");
            const unsigned og = xb_add(&bar[XB_TOP], 1u);
            const unsigned tg = og / nx;
            if (og + 1u == (tg + 1u) * nx) xb_add(&bar[XB_TOPGEN], 1u);
            else XB_SPIN(xb_ld(&bar[XB_TOPGEN]) == tg, bar);
            __builtin_amdgcn_fence(__ATOMIC_ACQUIRE, "agent");
            xb_add(&bar[XB_XGEN(b.x)], 1u);
            asm volatile("s_waitcnt vmcnt(0)" ::: "memory");
        } else {
            XB_SPIN(xb_ld(&bar[XB_XGEN(b.x)]) == gen, bar);
            __builtin_amdgcn_fence(__ATOMIC_ACQUIRE, "agent");
            asm volatile("s_waitcnt vmcnt(0)" ::: "memory");
        }
    }
    __syncthreads();
}

constexpr int BM = 256, BK = 64, HALF = 128, HTB = HALF * BK * 2, NXCD = 8, WGM = 8;
constexpr int KD = 2048, NT = KD / BK;
__device__ __forceinline__ int lds_byte(int r, int c) { const int st = (r >> 4) * 2 + (c >> 5), rr = r & 15, cc = c & 31, ob = rr * 64 + cc * 2; return st * 1024 + (ob ^ (((ob >> 9) & 1) << 5)); }
__device__ __forceinline__ void stage_rc(int b, int& R, int& C) { const int st = b / 1024, sb = b % 1024, swz = sb ^ (((sb >> 9) & 1) << 5); R = (st >> 1) * 16 + swz / 64; C = (st & 1) * 32 + (swz % 64) / 2; }
__device__ __forceinline__ int perm32(int rho) { const int n = rho >> 4, i = rho & 15; return 8 * (i >> 2) + 4 * n + (i & 3); }

struct GU { const char* A; const char* B; int pm, pn, e, mtl; };

__device__ __forceinline__ bool order_next(int i, int G, int c, int nM, int nN, int& pm, int& pn) {
    const int nwg = nM * nN; const long Lx = (long)i * G + c; if (Lx >= nwg) return false;
    int wgid = (int)Lx; { const int q = nwg / NXCD, r = nwg % NXCD, xcd = wgid % NXCD, off = wgid / NXCD; wgid = (xcd < r ? xcd * (q + 1) : r * (q + 1) + (xcd - r) * q) + off; }
    const int nig = WGM * nN, gid = wgid / nig, fm = gid * WGM, gsz = (nM - fm) < WGM ? (nM - fm) : WGM;
    pm = fm + ((wgid % nig) % gsz); pn = (wgid % nig) / gsz; return true;
}

typedef int v8i_t __attribute__((ext_vector_type(8)));
template <class Epi, class Sched, bool F8 = false>
__device__ __forceinline__ void gemm_phase(LAS unsigned char* lds, const Sched& S, const Epi& E) {
    const int tid = threadIdx.x, wid = __builtin_amdgcn_readfirstlane(tid >> 6), lane = tid & 63, wr = wid >> 2, wc = wid & 3, fr = lane & 15, fq = lane >> 4;
    constexpr int ROWB = F8 ? KD : KD * 2;
    constexpr int nt = ROWB / 128;
    int Rr[2], Cc[2]; unsigned voffB[2];
#pragma unroll
    for (int i = 0; i < 2; ++i) { stage_rc(tid * 16 + i * 8192, Rr[i], Cc[i]); const int Rb = Epi::PERM ? ((Rr[i] & ~31) + perm32(Rr[i] & 31)) : Rr[i]; voffB[i] = (unsigned)(Rb * ROWB + Cc[i] * 2); }
    const size_t kstep = (size_t)128;
    const size_t hstep = (size_t)HALF * ROWB;
    const unsigned ldsw = (unsigned)wid * 1024u;
    const int aoff = lds_byte(wr * 64 + fr, fq * 8), boff = lds_byte(wc * 32 + fr, fq * 8);
#define PG8_SA(b, h) (((b) * 2 + (h)) * HTB)
#define PG8_SB(b, h) ((4 + (b) * 2 + (h)) * HTB)
#define PG8_STAGE(bufoff, gbase, voff) do { _Pragma("unroll") for (int _i = 0; _i < 2; ++_i) \
        __builtin_amdgcn_global_load_lds((const unsigned*)((const char*)(gbase) + (voff)[_i]), (LAS unsigned*)(lds + (bufoff) + ldsw + _i * 8192), 16, 0, 0); } while (0)
#define PG8_LDA(dst, b, h) do { _Pragma("unroll") for (int m = 0; m < 4; ++m) _Pragma("unroll") for (int k = 0; k < 2; ++k) dst[m].q[k] = *(const LAS u32x4*)(lds + PG8_SA(b, h) + aoff + m * 2048 + k * 1024); } while (0)
#define PG8_LDB(dst, b, h) do { _Pragma("unroll") for (int n = 0; n < 2; ++n) _Pragma("unroll") for (int k = 0; k < 2; ++k) dst[n].q[k] = *(const LAS u32x4*)(lds + PG8_SB(b, h) + boff + n * 2048 + k * 1024); } while (0)
#define PG8_MMA(ai, bj, At, Bt) do { __builtin_amdgcn_s_setprio(1); _Pragma("unroll") for (int m = 0; m < 4; ++m) _Pragma("unroll") for (int n = 0; n < 2; ++n) { \
        if constexpr (F8) { asm volatile("v_mfma_scale_f32_16x16x128_f8f6f4 %0, %1, %2, %0, %3, %3 op_sel_hi:[0,0,0]" : "+v"(acc[ai][bj][m][n]) : "v"(Bt[n].v), "v"(At[m].v), "v"(f8sc)); } \
        else { _Pragma("unroll") for (int k = 0; k < 2; ++k) acc[ai][bj][m][n] = __builtin_amdgcn_mfma_f32_16x16x32_bf16(__builtin_bit_cast(bf16x8, Bt[n].q[k]), __builtin_bit_cast(bf16x8, At[m].q[k]), acc[ai][bj][m][n], 0, 0, 0); } } \
        __builtin_amdgcn_s_setprio(0); } while (0)
#define PG8_WAIT_V(n) asm volatile("s_waitcnt vmcnt(" #n ")" ::: "memory")
#define PG8_WAIT_L(n) asm volatile("s_waitcnt lgkmcnt(" #n ")" ::: "memory")
#define PG8_BAR __builtin_amdgcn_s_barrier()
#define PG8_SCHED __builtin_amdgcn_sched_barrier(0)
    GU cur, nxt; int ui = 0;
    if (!S.next(0, cur)) return;
    f32x4 acc[2][2][4][2];
#pragma unroll
    for (int a = 0; a < 2; ++a)
#pragma unroll
        for (int b = 0; b < 2; ++b)
#pragma unroll
            for (int m = 0; m < 4; ++m)
#pragma unroll
                for (int n = 0; n < 2; ++n) acc[a][b][m][n] = (f32x4){0.f, 0.f, 0.f, 0.f};
    int f8sc = 0x7f7f7f7f; asm volatile("" : "+v"(f8sc));
    union Frag { v8i_t v; u32x4 q[2]; };
    Frag At[4], B0[2], B1[2];
    unsigned oc0[2], oc1[2], on0[2], on1[2];
    S.a_off(cur, Rr, Cc, oc0, oc1);
    const char* cA = cur.A; const char* cB = cur.B;
    PG8_STAGE(PG8_SB(0, 0), cB, voffB); PG8_STAGE(PG8_SB(0, 1), cB + hstep, voffB); PG8_STAGE(PG8_SA(0, 0), cA, oc0); PG8_STAGE(PG8_SA(0, 1), cA, oc1);
    if (wr == 1) PG8_BAR;
    PG8_WAIT_V(2); PG8_BAR;
    PG8_STAGE(PG8_SB(1, 0), cB + kstep, voffB); PG8_STAGE(PG8_SA(1, 0), cA + kstep, oc0); PG8_STAGE(PG8_SB(1, 1), cB + hstep + kstep, voffB);
    PG8_WAIT_V(6); PG8_BAR;
    for (;;) {
        const bool has_next = S.next(ui + 1, nxt);
        const char* nA = has_next ? nxt.A : cA; const char* nB = has_next ? nxt.B : cB;
        for (int t = 0; t < nt; t += 2) {
            const bool last = (t == nt - 2);
            const char* a1 = cA + (size_t)(t + 1) * kstep;
            const char* a2 = last ? nA : cA + (size_t)(t + 2) * kstep; const char* b2 = last ? nB : cB + (size_t)(t + 2) * kstep;
            const char* a3 = a2 + kstep; const char* b3 = b2 + kstep;
            unsigned o20[2], o21[2];
            if (last) {
                if (has_next) S.a_off(nxt, Rr, Cc, on0, on1); else { on0[0] = oc0[0]; on0[1] = oc0[1]; on1[0] = oc1[0]; on1[1] = oc1[1]; }
                o20[0] = on0[0]; o20[1] = on0[1]; o21[0] = on1[0]; o21[1] = on1[1];
            } else { o20[0] = oc0[0]; o20[1] = oc0[1]; o21[0] = oc1[0]; o21[1] = oc1[1]; }
            PG8_LDB(B0, 0, 0); PG8_LDB(B1, 0, 1); PG8_SCHED; PG8_LDA(At, 0, 0); PG8_STAGE(PG8_SA(1, 1), a1, oc1);
            PG8_WAIT_V(8); PG8_WAIT_L(0); PG8_BAR; PG8_MMA(0, 0, At, B0); PG8_MMA(0, 1, At, B1); PG8_BAR; PG8_SCHED;
            PG8_LDA(At, 0, 1); PG8_STAGE(PG8_SB(0, 0), b2, voffB); PG8_STAGE(PG8_SB(0, 1), b2 + hstep, voffB); PG8_STAGE(PG8_SA(0, 0), a2, o20);
            PG8_WAIT_V(8); PG8_WAIT_L(0); PG8_BAR; PG8_MMA(1, 0, At, B0); PG8_MMA(1, 1, At, B1); PG8_BAR; PG8_SCHED;
            PG8_LDB(B0, 1, 0); PG8_LDB(B1, 1, 1); PG8_SCHED; PG8_LDA(At, 1, 0); PG8_STAGE(PG8_SA(0, 1), a2, o21);
            PG8_WAIT_V(8); PG8_WAIT_L(0); PG8_BAR; PG8_MMA(0, 0, At, B0); PG8_MMA(0, 1, At, B1); PG8_BAR; PG8_SCHED;
            PG8_LDA(At, 1, 1); PG8_STAGE(PG8_SB(1, 0), b3, voffB); PG8_STAGE(PG8_SB(1, 1), b3 + hstep, voffB); PG8_STAGE(PG8_SA(1, 0), a3, o20);
            PG8_WAIT_V(8); PG8_WAIT_L(0); PG8_BAR; PG8_MMA(1, 0, At, B0); PG8_MMA(1, 1, At, B1); PG8_BAR; PG8_SCHED;
        }
        if (wr == 0) PG8_BAR;
        if constexpr (F8) asm volatile("s_nop 15\n\ts_nop 15" ::: "memory");
        E(acc, cur, wr, wc, fr, fq);
        if (!has_next) break;
#pragma unroll
        for (int a = 0; a < 2; ++a)
#pragma unroll
            for (int b = 0; b < 2; ++b)
#pragma unroll
                for (int m = 0; m < 4; ++m)
#pragma unroll
                    for (int n = 0; n < 2; ++n) acc[a][b][m][n] = (f32x4){0.f, 0.f, 0.f, 0.f};
        cur = nxt; cA = nA; cB = nB; ++ui;
        oc0[0] = on0[0]; oc0[1] = on0[1]; oc1[0] = on1[0]; oc1[1] = on1[1];
        if (wr == 1) PG8_BAR;
    }
    PG8_WAIT_V(0);
    PG8_BAR;
#undef PG8_SA
#undef PG8_SB
#undef PG8_STAGE
#undef PG8_LDA
#undef PG8_LDB
#undef PG8_MMA
#undef PG8_WAIT_V
#undef PG8_WAIT_L
#undef PG8_BAR
#undef PG8_SCHED
}

struct SchedDense {
    const bf16_t* A; const bf16_t* Bt; int nM, nN, G, c;
    __device__ __forceinline__ bool next(int i, GU& u) const {
        int pm, pn; if (!order_next(i, G, c, nM, nN, pm, pn)) return false;
        u.pm = pm; u.pn = pn; u.e = 0; u.mtl = pm; u.A = (const char*)A; u.B = (const char*)Bt + (size_t)pn * (256 * KD * 2); return true;
    }
    __device__ __forceinline__ void a_off(const GU& u, const int (&R)[2], const int (&C)[2], unsigned (&o0)[2], unsigned (&o1)[2]) const {
#pragma unroll
        for (int i = 0; i < 2; ++i) { o0[i] = (unsigned)((u.pm * 256 + R[i]) * KD + C[i]) * 2u; o1[i] = (unsigned)((u.pm * 256 + 128 + R[i]) * KD + C[i]) * 2u; }
    }
};
template <int ROWB>
struct SchedMoe {
    const void* A; const void* Bt; size_t bstride_e;
    const int* list; const LAS int* pts; const LAS int* cntl; const LAS unsigned char* tileE;
    int nM, nN, G, c; bool gather;
    __device__ __forceinline__ bool next(int i, GU& u) const {
        int pm, pn; if (!order_next(i, G, c, nM, nN, pm, pn)) return false;
        const int e = __builtin_amdgcn_readfirstlane((int)tileE[pm]);
        u.pm = pm; u.pn = pn; u.e = e; u.mtl = pm - __builtin_amdgcn_readfirstlane(pts[e]);
        u.A = (const char*)A; u.B = (const char*)Bt + (size_t)e * bstride_e + (size_t)pn * (256 * ROWB); return true;
    }
    __device__ __forceinline__ void a_off(const GU& u, const int (&R)[2], const int (&C)[2], unsigned (&o0)[2], unsigned (&o1)[2]) const {
        if (gather) {
            const int ce = __builtin_amdgcn_readfirstlane(cntl[u.e]);
            const int* lp = list + (size_t)u.e * LISTCAP;
#pragma unroll
            for (int i = 0; i < 2; ++i) {
                int i0 = u.mtl * 256 + R[i], i1 = i0 + 128;
                i0 = i0 < ce ? i0 : 0; i1 = i1 < ce ? i1 : 0;
                const int t0 = lp[i0], t1 = lp[i1];
                o0[i] = (unsigned)(t0 * ROWB + C[i] * 2); o1[i] = (unsigned)(t1 * ROWB + C[i] * 2);
            }
        } else {
#pragma unroll
            for (int i = 0; i < 2; ++i) { o0[i] = (unsigned)((u.pm * 256 + R[i]) * ROWB + C[i] * 2); o1[i] = (unsigned)((u.pm * 256 + 128 + R[i]) * ROWB + C[i] * 2); }
        }
    }
};

__device__ __forceinline__ u32x4 pack8(const f32x4& a, const f32x4& b) { u32x4 w; w.x = cvt_pk_bf16(a[0], a[1]); w.y = cvt_pk_bf16(a[2], a[3]); w.z = cvt_pk_bf16(b[0], b[1]); w.w = cvt_pk_bf16(b[2], b[3]); return w; }

struct EpiInProj {
    static constexpr bool PERM = true;
    bf16_t *QH, *KH, *VH, *OG, *AQ, *AK, *AV; float* GH; const float* lb; const float* bqkv;
    __device__ __forceinline__ void operator()(const f32x4 (&acc)[2][2][4][2], const GU& u, int wr, int wc, int fr, int fq) const {
        const int row0 = u.pm * BM + wr * 64 + fr;
        const int type = u.pn >> 2;
        const int cw = wc * 32 + 8 * fq;
#pragma unroll
        for (int bj = 0; bj < 2; ++bj) {
            const int col = (u.pn & 3) * 256 + bj * HALF + cw;
            if (type == 0 || type == 3) {
                bf16_t* O = (type == 0 ? QH : OG);
#pragma unroll
                for (int ai = 0; ai < 2; ++ai)
#pragma unroll
                    for (int m = 0; m < 4; ++m) { f32x4 v0 = acc[ai][bj][m][0], v1 = acc[ai][bj][m][1];
#pragma unroll
                        for (int j = 0; j < 4; ++j) { v0[j] = v0[j] * sigm(v0[j]); v1[j] = v1[j] * sigm(v1[j]); }
                        *(u32x4*)(O + (size_t)(row0 + ai * HALF + m * 16) * 1024 + col) = pack8(v0, v1); }
            } else if (type == 1) {
                const f32x4 l0 = *(const f32x4*)(lb + col), l1 = *(const f32x4*)(lb + col + 4);
#pragma unroll
                for (int ai = 0; ai < 2; ++ai)
#pragma unroll
                    for (int m = 0; m < 4; ++m) { f32x4 v0 = acc[ai][bj][m][0], v1 = acc[ai][bj][m][1], g0, g1;
#pragma unroll
                        for (int j = 0; j < 4; ++j) { const float s0 = sigm(v0[j]), s1 = sigm(v1[j]);
                            const float f0 = l0[j] + (1.f - l0[j]) * s0, f1 = l1[j] + (1.f - l1[j]) * s1;
                            g0[j] = __log2f(f0); g1[j] = __log2f(f1); }
                        const size_t o = (size_t)(row0 + ai * HALF + m * 16) * 1024 + col;
                        *(f32x4*)(GH + o) = g0; *(f32x4*)(GH + o + 4) = g1; }
            } else if (type == 2) {
#pragma unroll
                for (int ai = 0; ai < 2; ++ai)
#pragma unroll
                    for (int m = 0; m < 4; ++m) *(u32x4*)(VH + (size_t)(row0 + ai * HALF + m * 16) * 1024 + col) = pack8(acc[ai][bj][m][0], acc[ai][bj][m][1]);
            } else if (type == 4) {
                const f32x4 b0 = *(const f32x4*)(bqkv + col), b1 = *(const f32x4*)(bqkv + col + 4);
#pragma unroll
                for (int ai = 0; ai < 2; ++ai)
#pragma unroll
                    for (int m = 0; m < 4; ++m) { const f32x4 v0 = (acc[ai][bj][m][0] + b0) * 0.125f, v1 = (acc[ai][bj][m][1] + b1) * 0.125f;
                        *(u32x4*)(AQ + (size_t)(row0 + ai * HALF + m * 16) * 1024 + col) = pack8(v0, v1); }
            } else {
                bf16_t* O = bj == 0 ? AK : AV;
                const f32x4 b0 = *(const f32x4*)(bqkv + 1024 + bj * 128 + cw), b1 = *(const f32x4*)(bqkv + 1024 + bj * 128 + cw + 4);
#pragma unroll
                for (int ai = 0; ai < 2; ++ai)
#pragma unroll
                    for (int m = 0; m < 4; ++m) *(u32x4*)(O + (size_t)(row0 + ai * HALF + m * 16) * 128 + cw) = pack8(acc[ai][bj][m][0] + b0, acc[ai][bj][m][1] + b1);
            }
        }
    }
};
struct EpiOutProj {
    static constexpr bool PERM = true;
    float* Z; const float* x; const float* stats; const float* lnw; const float* lnb; const float* bo;
    __device__ __forceinline__ void operator()(const f32x4 (&acc)[2][2][4][2], const GU& u, int wr, int wc, int fr, int fq) const {
        const int row0 = u.pm * BM + wr * 64 + fr, col0 = u.pn * BM + wc * 32 + 8 * fq;
        f32x4 w4[2][2], b4[2][2];
#pragma unroll
        for (int bj = 0; bj < 2; ++bj)
#pragma unroll
            for (int n = 0; n < 2; ++n) { const int col = col0 + bj * HALF + n * 4; const f32x4 lw = *(const f32x4*)(lnw + col), lb = *(const f32x4*)(lnb + col), o4 = *(const f32x4*)(bo + col);
                w4[bj][n] = lw * ALPHA; b4[bj][n] = lb * ALPHA + o4; }
#pragma unroll
        for (int ai = 0; ai < 2; ++ai)
#pragma unroll
        for (int mp = 0; mp < 2; ++mp) {
            f32x4 xv[2][2][2]; f32x2 st[2];
#pragma unroll
            for (int mm = 0; mm < 2; ++mm) { const int row = row0 + ai * HALF + (2 * mp + mm) * 16; st[mm] = *(const f32x2*)(stats + 2 * row);
#pragma unroll
                for (int bj = 0; bj < 2; ++bj)
#pragma unroll
                    for (int n = 0; n < 2; ++n) xv[mm][bj][n] = *(const f32x4*)(x + (size_t)row * D + col0 + bj * HALF + n * 4); }
#pragma unroll
            for (int mm = 0; mm < 2; ++mm) { const int m = 2 * mp + mm, row = row0 + ai * HALF + m * 16;
#pragma unroll
                for (int bj = 0; bj < 2; ++bj)
#pragma unroll
                    for (int n = 0; n < 2; ++n) { const f32x4 z = (xv[mm][bj][n] - st[mm].x) * st[mm].y * w4[bj][n] + b4[bj][n] + acc[ai][bj][m][n];
                        *(f32x4*)(Z + (size_t)row * D + col0 + bj * HALF + n * 4) = z; } }
        }
    }
};
__device__ __forceinline__ unsigned pk4_fp8(float a, float b, float c, float d) {
    a = fminf(fmaxf(a, -448.f), 448.f); b = fminf(fmaxf(b, -448.f), 448.f); c = fminf(fmaxf(c, -448.f), 448.f); d = fminf(fmaxf(d, -448.f), 448.f);
    int w = __builtin_amdgcn_cvt_pk_fp8_f32(a, b, 0, false); w = __builtin_amdgcn_cvt_pk_fp8_f32(c, d, w, true); return (unsigned)w;
}
constexpr float SC_H1 = 32.f, SC_WGU = 2048.f, SC_HACT = 8.f, SC_WD = 4096.f;
struct EpiMoe1F8 {
    static constexpr bool PERM = true;
    unsigned char* H; const float* bg; const float* bu;
    __device__ __forceinline__ void operator()(const f32x4 (&acc)[2][2][4][2], const GU& u, int wr, int wc, int fr, int fq) const {
        const int row0 = u.pm * BM + wr * 64 + fr, hc = u.pn * 128 + wc * 32 + 8 * fq;
        const float* bgp = bg + (size_t)u.e * FF + hc; const float* bup = bu + (size_t)u.e * FF + hc;
        const f32x4 g0b = *(const f32x4*)bgp, g1b = *(const f32x4*)(bgp + 4), u0b = *(const f32x4*)bup, u1b = *(const f32x4*)(bup + 4);
        constexpr float IS = 1.f / (SC_H1 * SC_WGU);
#pragma unroll
        for (int ai = 0; ai < 2; ++ai)
#pragma unroll
            for (int m = 0; m < 4; ++m) {
                f32x4 a0 = acc[ai][0][m][0] * IS + g0b, a1 = acc[ai][0][m][1] * IS + g1b, c0 = acc[ai][1][m][0] * IS + u0b, c1 = acc[ai][1][m][1] * IS + u1b;
#pragma unroll
                for (int j = 0; j < 4; ++j) {
                    const float gg0 = fminf(a0[j], 7.f), gg1 = fminf(a1[j], 7.f);
                    const float uu0 = fminf(fmaxf(c0[j], -7.f), 7.f), uu1 = fminf(fmaxf(c1[j], -7.f), 7.f);
                    a0[j] = SC_HACT * gg0 * sigm(1.702f * gg0) * (uu0 + 1.f); a1[j] = SC_HACT * gg1 * sigm(1.702f * gg1) * (uu1 + 1.f);
                }
                u32x2 o; o.x = pk4_fp8(a0[0], a0[1], a0[2], a0[3]); o.y = pk4_fp8(a1[0], a1[1], a1[2], a1[3]);
                *(u32x2*)(H + (size_t)(row0 + ai * HALF + m * 16) * FF + hc) = o;
            }
    }
};
struct EpiMoe2F8 {
    static constexpr bool PERM = true;
    bf16_t* Y; const float* bd;
    __device__ __forceinline__ void operator()(const f32x4 (&acc)[2][2][4][2], const GU& u, int wr, int wc, int fr, int fq) const {
        const int row0 = u.pm * BM + wr * 64 + fr, col0 = u.pn * BM + wc * 32 + 8 * fq;
        const float* bp = bd + (size_t)u.e * D + col0;
        constexpr float IS = 1.f / (SC_HACT * SC_WD);
#pragma unroll
        for (int bj = 0; bj < 2; ++bj) {
            const f32x4 b0 = *(const f32x4*)(bp + bj * HALF), b1 = *(const f32x4*)(bp + bj * HALF + 4);
#pragma unroll
            for (int ai = 0; ai < 2; ++ai)
#pragma unroll
                for (int m = 0; m < 4; ++m) *(u32x4*)(Y + (size_t)(row0 + ai * HALF + m * 16) * D + col0 + bj * HALF) = pack8(acc[ai][bj][m][0] * IS + b0, acc[ai][bj][m][1] * IS + b1);
        }
    }
};
struct Args { const float* in[23]; float* out; unsigned char* ws; int ph_lo, ph_hi; };
struct Frame { LAS unsigned char* lds; int tid, lane, wave, G, vcu; unsigned char* ws; };

__device__ __forceinline__ void p0_transpose_item(const float* W, int N, int k0, int n0, bf16_t* WT_row0  , LAS float* scr, int lane) {
#pragma unroll 8
    for (int i = 0; i < 32; ++i) { const int kk = 2 * i + (lane >> 5); scr[kk * 33 + (lane & 31)] = W[(size_t)(k0 + kk) * N + n0 + (lane & 31)]; }
    asm volatile("s_waitcnt lgkmcnt(0)" ::: "memory");
    const int c = lane & 7;
#pragma unroll
    for (int j = 0; j < 4; ++j) { const int n = (lane >> 3) + 8 * j; const LAS float* s = scr + (8 * c) * 33 + n;
        u32x4 o; o.x = pk2(s[0 * 33], s[1 * 33]); o.y = pk2(s[2 * 33], s[3 * 33]); o.z = pk2(s[4 * 33], s[5 * 33]); o.w = pk2(s[6 * 33], s[7 * 33]);
        *(GAS u32x4*)(WT_row0 + (size_t)n * KD + k0 + 8 * c) = o; }
    asm volatile("s_waitcnt lgkmcnt(0)" ::: "memory");
}

__device__ __forceinline__ void p0_prologue(Frame& F, const Args& a) {
    LAS float* scr = (LAS float*)(F.lds + F.wave * 16384);
    const int gw = F.vcu * NWAVES + F.wave, NGW = F.G * NWAVES;
    unsigned char* ws = F.ws;
    for (int i = gw * 64 + F.lane; i < NE * D; i += NGW * 64) { const int e = i >> 11, k = i & 2047; ((_Float16*)(ws + WS_WRH))[i] = (_Float16)(a.in[13][(size_t)k * NE + e] * 64.f); }
    if (gw < 16) { const int i = gw * 64 + F.lane; const float* lbl = a.in[5]; const float l0 = lbl[i], l1 = lbl[1024 + i]; const float mx = fmaxf(l0, l1); const float e0 = __expf(l0 - mx), e1 = __expf(l1 - mx);
        ((float*)(ws + WS_LB))[i] = e0 / (e0 + e1); }
    {
        const float* x = a.in[0]; const float* w = a.in[1]; const float* b = a.in[2];
        bf16_t* H0 = (bf16_t*)(ws + WS_H0); float* st = (float*)(ws + WS_STATS0);
        f32x4 wwv[8], bbv[8];
#pragma unroll
        for (int j = 0; j < 8; ++j) { wwv[j] = *((const f32x4*)w + F.lane + 64 * j); bbv[j] = *((const f32x4*)b + F.lane + 64 * j); }
        for (int m = gw; m < T; m += NGW) {
            const GAS f32x4* xr = (const GAS f32x4*)(x + (size_t)m * D) + F.lane;
            f32x4 v[8]; float s = 0.f;
#pragma unroll
            for (int j = 0; j < 8; ++j) { v[j] = xr[64 * j]; s += (v[j][0] + v[j][1]) + (v[j][2] + v[j][3]); }
            const float mean = wave_sum(s) * (1.f / D); float s2 = 0.f;
#pragma unroll
            for (int j = 0; j < 8; ++j) { v[j] = v[j] - mean; s2 += (v[j][0] * v[j][0] + v[j][1] * v[j][1]) + (v[j][2] * v[j][2] + v[j][3] * v[j][3]); }
            const float rstd = rsqrtf(wave_sum(s2) * (1.f / D) + EPS);
            if (F.lane == 0) { st[2 * m] = mean; st[2 * m + 1] = rstd; }
            GAS u32x2* o8 = (GAS u32x2*)(H0 + (size_t)m * D) + F.lane;
#pragma unroll
            for (int j = 0; j < 8; ++j) { const f32x4 ww = wwv[j], bb = bbv[j];
                u32x2 o; o.x = pk2(v[j][0] * rstd * ww[0] + bb[0], v[j][1] * rstd * ww[1] + bb[1]); o.y = pk2(v[j][2] * rstd * ww[2] + bb[2], v[j][3] * rstd * ww[3] + bb[3]); o8[64 * j] = o; }
        }
    }
    constexpr int I_IN = 32 * (INC / 32), I_OUT = 32 * 64;
    constexpr int NITEMS = I_IN + I_OUT;
    for (int it = gw; it < NITEMS; it += NGW) {
        int r = it;
        if (r < I_IN) { const int nb = INC / 32, kb = r / nb, n0 = 32 * (r % nb); p0_transpose_item(a.in[3], INC, 64 * kb, n0, (bf16_t*)(ws + WS_WIN) + (size_t)n0 * KD, scr, F.lane); continue; } r -= I_IN;
        { const int kb = r / 64, n0 = 32 * (r % 64); p0_transpose_item(a.in[9], D, 64 * kb, n0, (bf16_t*)(ws + WS_WOUT) + (size_t)n0 * KD, scr, F.lane); }
    }
}

constexpr int CT_TILES = NE * 3 * 32 * 16, CT_RUN = 8;
constexpr int LC_CTB = 1024;
__device__ __forceinline__ void ct_src(const Args& a, unsigned char* ws, int id, const float*& W, unsigned char*& dst, float& sc, int& k0) {
    const int e = id / 1536, r = id - e * 1536, which = r >> 9, r2 = r & 511, kb = r2 >> 4, nb = r2 & 15;
    k0 = kb * 64;
    if (which < 2) { W = a.in[which == 0 ? 15 : 17] + (size_t)e * D * FF + nb * 128; dst = ws + WS_WGU + ((size_t)e * 4096 + (size_t)nb * 256 + which * 128) * KD; sc = SC_WGU; }
    else { W = a.in[19] + (size_t)e * FF * D + nb * 128; dst = ws + WS_WD + ((size_t)e * 2048 + (size_t)nb * 128) * KD; sc = SC_WD; }
}
__device__ __forceinline__ void cv_worker(Frame& F, const Args& a, const unsigned* stop_ctr, unsigned stop_at) {
    const int tid = F.tid, lane = F.lane, wv = F.wave;
    LAS unsigned char* ring = F.lds;
    volatile LAS int* ctb = (volatile LAS int*)(F.lds + LDSCTL_OFF + LC_CTB);
    unsigned* head = (unsigned*)(F.ws + WS_CTL) + CW_CONV;
    unsigned srcoff[4];
#pragma unroll
    for (int p = 0; p < 4; ++p) { const int row = 2 * (4 * wv + p) + (lane >> 5); srcoff[p] = (unsigned)(row * 2048 + 4 * ((lane & 31) ^ (2 * ((row >> 4) & 3)))); }
    const int on = tid >> 2, oc = tid & 3;
    const int rdoff = (16 * oc) * 128 * 4 + ((((on >> 2) ^ (2 * oc)) << 2) + (on & 3)) * 4;
#define CT_CLAIM(slotw) do { if (tid == 0) { int b_ = CT_TILES; if (!(stop_ctr && __hip_atomic_load(stop_ctr, RLX_AGENT) >= stop_at)) b_ = (int)__hip_atomic_fetch_add(head, (unsigned)CT_RUN, RLX_AGENT); ctb[slotw] = b_; } } while (0)
#define CT_DMA(id_, slot_) do { const float* W_; unsigned char* d_; float s_; int k_; ct_src(a, F.ws, (id_), W_, d_, s_, k_); const float* sp_ = W_ + (size_t)k_ * 2048; \
        _Pragma("unroll") for (int p = 0; p < 4; ++p) __builtin_amdgcn_global_load_lds((const unsigned*)(sp_ + srcoff[p]), (LAS unsigned*)(ring + (slot_) * 32768 + (4 * wv + p) * 1024), 16, 0, 0); } while (0)
    __syncthreads();
    CT_CLAIM(0);
    __syncthreads();
    int base = ctb[0];
    int issued = 0;
    bool more = base < CT_TILES;
#pragma unroll 1
    for (int i = 0; i < 3; ++i) { if (more) { CT_DMA(base + (issued & (CT_RUN - 1)), issued & 3); } ++issued; }
    int pbase = base;
    for (int k = 0; ; ++k) {
        if (((k + 3) & (CT_RUN - 1)) == 0) CT_CLAIM(((k + 3) / CT_RUN) & 1);
        if (pbase >= CT_TILES) break;
        asm volatile("s_waitcnt vmcnt(8)" ::: "memory");
        if (!more) asm volatile("s_waitcnt vmcnt(0)" ::: "memory");
        __syncthreads();
        {
            const float* W_; unsigned char* dst; float sc; int k0; ct_src(a, F.ws, pbase + (k & (CT_RUN - 1)), W_, dst, sc, k0);
            const LAS float* sp = (const LAS float*)(ring + (k & 3) * 32768 + rdoff);
            u32x4 o;
            o.x = pk4_fp8(sp[0 * 128] * sc, sp[1 * 128] * sc, sp[2 * 128] * sc, sp[3 * 128] * sc); o.y = pk4_fp8(sp[4 * 128] * sc, sp[5 * 128] * sc, sp[6 * 128] * sc, sp[7 * 128] * sc);
            o.z = pk4_fp8(sp[8 * 128] * sc, sp[9 * 128] * sc, sp[10 * 128] * sc, sp[11 * 128] * sc); o.w = pk4_fp8(sp[12 * 128] * sc, sp[13 * 128] * sc, sp[14 * 128] * sc, sp[15 * 128] * sc);
            *(GAS u32x4*)(dst + (size_t)on * KD + k0 + 16 * oc) = o;
            asm volatile("s_waitcnt lgkmcnt(0)" ::: "memory");
        }
        if (((k + 3) & (CT_RUN - 1)) == 0) { base = ctb[((k + 3) / CT_RUN) & 1]; more = base < CT_TILES; }
        if (more) { CT_DMA(base + ((k + 3) & (CT_RUN - 1)), (k + 3) & 3); }
        if (((k + 1) & (CT_RUN - 1)) == 0) pbase = ctb[((k + 1) / CT_RUN) & 1];
    }
    asm volatile("s_waitcnt vmcnt(0)" ::: "memory");
    __syncthreads();
#undef CT_CLAIM
#undef CT_DMA
}

constexpr int AT_Q = 32;
typedef float f32x16 __attribute__((ext_vector_type(16)));
typedef short s16x4 __attribute__((ext_vector_type(4)));
typedef short v4i16_t __attribute__((ext_vector_type(4)));
__device__ __forceinline__ s16x4 lds_tr16(const LAS unsigned char* p) { return __builtin_bit_cast(s16x4, __builtin_amdgcn_ds_read_tr16_b64_v4i16((LAS v4i16_t*)p)); }
__device__ __forceinline__ void attn_unit_mfma(Frame& F, const Args& a, int b, int qt) {
    LAS unsigned char* KS = F.lds;
    LAS unsigned char* VS = F.lds + 40960;
    LAS float* SSQ = (LAS float*)(F.lds + 81920);
    LAS float* NWL = (LAS float*)(F.lds + 83968);
    const bf16_t* AQ = (const bf16_t*)(F.ws + WS_AQ); const bf16_t* AK = (const bf16_t*)(F.ws + WS_AK); const bf16_t* AV = (const bf16_t*)(F.ws + WS_AV);
    bf16_t* YM = (bf16_t*)(F.ws + WS_YMIX);
    const int tid = F.tid, lane = F.lane, w = F.wave, r32 = lane & 31, hi = lane >> 5, t0 = qt * 32;
    __syncthreads();
#pragma unroll
    for (int p = 0; p < 5; ++p) {
        const int c = p * 512 + tid, row = c >> 4, ch = c & 15, kvh = ch >> 3, cr = ch & 7;
        const int pos = t0 - 128 + row;
        u32x4 kv = (u32x4){0u, 0u, 0u, 0u}, vv = (u32x4){0u, 0u, 0u, 0u};
        if (pos >= 0) { const size_t o = (size_t)(b * L + pos) * 128 + kvh * 64 + cr * 8; kv = *(const u32x4*)(AK + o); vv = *(const u32x4*)(AV + o); }
        *(LAS u32x4*)(KS + kvh * 20480 + row * 128 + ((cr ^ ((row >> 1) & 7)) << 4)) = kv;
        *(LAS u32x4*)(VS + kvh * 20480 + row * 128 + (((cr >> 2) ^ ((row >> 1) & 1)) << 6) + ((cr & 3) << 4)) = vv;
    }
    __syncthreads();
    if (tid < 256) *(LAS f32x4*)(NWL + 4 * tid) = *(const f32x4*)(a.in[8] + 4 * tid);
    const int kvh = w >> 2;
    const int ktmin = t0 < 128 ? (128 - t0) >> 5 : 0;
    const LAS unsigned char* Kb = KS + kvh * 20480;
    const LAS unsigned char* Vb = VS + kvh * 20480;
    unsigned OP[2][2][8];
    float ssq = 0.f;
#pragma unroll
    for (int hh = 0; hh < 2; ++hh) {
        const int head = 2 * w + hh;
        bf16x8 qf[4];
#pragma unroll
        for (int ks = 0; ks < 4; ++ks) qf[ks] = *(const bf16x8*)(AQ + (size_t)(b * L + t0 + r32) * 1024 + head * 64 + ks * 16 + hi * 8);
        f32x16 S[5];
#pragma unroll
        for (int kt = 0; kt < 5; ++kt) {
            const int row = kt * 32 + r32;
            f32x16 acc = (f32x16){0.f, 0.f, 0.f, 0.f, 0.f, 0.f, 0.f, 0.f, 0.f, 0.f, 0.f, 0.f, 0.f, 0.f, 0.f, 0.f};
#pragma unroll
            for (int ks = 0; ks < 4; ++ks) {
                const bf16x8 kf = *(const LAS bf16x8*)(Kb + row * 128 + (((2 * ks + hi) ^ ((row >> 1) & 7)) << 4));
                acc = __builtin_amdgcn_mfma_f32_32x32x16_bf16(kf, qf[ks], acc, 0, 0, 0);
            }
            S[kt] = acc;
        }
        const float sink = a.in[7][head];
        float m = sink;
#pragma unroll
        for (int kt = 0; kt < 5; ++kt)
#pragma unroll
            for (int r = 0; r < 16; ++r) {
                const int i = (r & 3) + 8 * (r >> 2) + 4 * hi;
                bool ok = kt >= ktmin;
                if (kt == 0) ok = ok && (i > r32);
                if (kt == 4) ok = ok && (i <= r32);
                const float v = ok ? S[kt][r] : -INFINITY;
                S[kt][r] = v; m = fmaxf(m, v);
            }
        m = fmaxf(m, __shfl_xor(m, 32));
        float l = 0.f;
#pragma unroll
        for (int kt = 0; kt < 5; ++kt)
#pragma unroll
            for (int r = 0; r < 16; ++r) { const float pv = __expf(S[kt][r] - m); S[kt][r] = pv; l += pv; }
        l += __shfl_xor(l, 32);
        l += __expf(sink - m);
        const float inv = 1.f / l;
#pragma unroll
        for (int dt = 0; dt < 2; ++dt) {
            f32x16 acc = (f32x16){0.f, 0.f, 0.f, 0.f, 0.f, 0.f, 0.f, 0.f, 0.f, 0.f, 0.f, 0.f, 0.f, 0.f, 0.f, 0.f};
            const int dcol = dt * 32 + 16 * ((lane >> 4) & 1) + 4 * (lane & 3);
            const int vlane = ((lane & 15) >> 2) * 128 + ((((dcol >> 5) ^ ((lane >> 3) & 1))) << 6) + (dcol & 31) * 2;
#pragma unroll
            for (int kt = 0; kt < 5; ++kt)
#pragma unroll
                for (int s2 = 0; s2 < 2; ++s2) {
                    const int rowb = kt * 32 + 16 * s2 + 4 * hi;
                    const s16x4 lo = lds_tr16(Vb + rowb * 128 + vlane), hi4 = lds_tr16(Vb + (rowb + 8) * 128 + vlane);
                    const bf16x8 vf = (bf16x8){lo[0], lo[1], lo[2], lo[3], hi4[0], hi4[1], hi4[2], hi4[3]};
                    u32x4 pw; pw.x = cvt_pk_bf16(S[kt][8 * s2 + 0], S[kt][8 * s2 + 1]); pw.y = cvt_pk_bf16(S[kt][8 * s2 + 2], S[kt][8 * s2 + 3]);
                    pw.z = cvt_pk_bf16(S[kt][8 * s2 + 4], S[kt][8 * s2 + 5]); pw.w = cvt_pk_bf16(S[kt][8 * s2 + 6], S[kt][8 * s2 + 7]);
                    acc = __builtin_amdgcn_mfma_f32_32x32x16_bf16(vf, __builtin_bit_cast(bf16x8, pw), acc, 0, 0, 0);
                }
#pragma unroll
            for (int r = 0; r < 16; ++r) { acc[r] *= inv; ssq += acc[r] * acc[r]; }
#pragma unroll
            for (int r = 0; r < 8; ++r) OP[hh][dt][r] = cvt_pk_bf16(acc[2 * r], acc[2 * r + 1]);
        }
    }
    ssq += __shfl_xor(ssq, 32);
    if (hi == 0) SSQ[w * 32 + r32] = ssq;
    __syncthreads();
    float tot = 0.f;
#pragma unroll
    for (int ww = 0; ww < 8; ++ww) tot += SSQ[ww * 32 + r32];
    const float rr = rsqrtf(tot * (1.f / 1024.f) + EPS);
#pragma unroll
    for (int hh = 0; hh < 2; ++hh)
#pragma unroll
        for (int dt = 0; dt < 2; ++dt)
#pragma unroll
            for (int g4 = 0; g4 < 4; ++g4) {
                const int d = (2 * w + hh) * 64 + dt * 32 + 8 * g4 + 4 * hi;
                const f32x4 nw4 = *(const LAS f32x4*)(NWL + d);
                const unsigned p0 = OP[hh][dt][2 * g4], p1 = OP[hh][dt][2 * g4 + 1];
                u32x2 o; o.x = pk2(bflo(p0) * rr * nw4[0], bfhi(p0) * rr * nw4[1]); o.y = pk2(bflo(p1) * rr * nw4[2], bfhi(p1) * rr * nw4[3]);
                *(u32x2*)(YM + (size_t)(b * L + t0 + r32) * D + 1024 + d) = o;
            }
}

constexpr int HL_QM = 0, HL_KM = 16384, HL_QS = 32768, HL_KE = 49152, HL_VT = 65536, HL_PL = 81920, HL_SEG = 90112, HL_DS = 94208, HL_SSQ = 94720;
__device__ __forceinline__ int trkey(int s) { return (s & 3) | (((s >> 3) & 1) << 2); }
__device__ __forceinline__ bf16x8 mk8(const s16x4& lo, const s16x4& hi) { return (bf16x8){lo[0], lo[1], lo[2], lo[3], hi[0], hi[1], hi[2], hi[3]}; }
__device__ __forceinline__ void hgrn_unit_mfma(Frame& F, const Args& a, int b, int h) {
    LAS unsigned char* lds = F.lds;
    const bf16_t* QH = (const bf16_t*)(F.ws + WS_QH); const bf16_t* VH = (const bf16_t*)(F.ws + WS_VH); const bf16_t* OG = (const bf16_t*)(F.ws + WS_OG);
    const float* GH = (const float*)(F.ws + WS_GH);
    bf16_t* YM = (bf16_t*)(F.ws + WS_YMIX);
    const int tid = F.tid, lane = F.lane, w = F.wave, r16 = lane & 15, g = lane >> 4, cp = lane;
    const size_t tokb = (size_t)b * L;
    const int hc = h * 128;
    f32x4 Sacc[8];
#pragma unroll
    for (int i = 0; i < 8; ++i) Sacc[i] = (f32x4){0.f, 0.f, 0.f, 0.f};
    f32x2 gpre[8]; unsigned qpre[8]; u32x4 vpre[2];
    const int vrow = tid >> 3, vc16 = tid & 7;
    const unsigned lo_g = 2u * (unsigned)cp, lo_v = (unsigned)(vrow * 1024 + vc16 * 8), lo_og = (unsigned)(r16 * 1024 + 4 * g), lo_ym = (unsigned)(r16 * 2048 + 4 * g);
    {
        const size_t rb = (tokb + 8 * w) * 1024 + hc;
        const float* gb = GH + rb; const bf16_t* qb = QH + rb; const bf16_t* vb = VH + tokb * 1024 + hc;
#pragma unroll
        for (int i = 0; i < 8; ++i) { gpre[i] = *(const f32x2*)(gb + i * 1024 + lo_g); qpre[i] = *(const unsigned*)(qb + i * 1024 + lo_g); }
        vpre[0] = *(const u32x4*)(vb + lo_v); vpre[1] = *(const u32x4*)(vb + 64 + lo_v);
    }
    const int keyl = ((lane & 15) >> 2) | ((g & 1) << 2);
    const int trrow = (8 * g + ((lane & 15) >> 2)) * 256 + 8 * (lane & 3);
    const unsigned wpar = (unsigned)(w & 1);
    const unsigned A1 = (((unsigned)cp >> 2) ^ (8u * wpar)) << 4, C1 = ((unsigned)cp & 3u) * 4u + (unsigned)w * 2048u;
    const unsigned A2 = (((unsigned)cp >> 1) ^ (16u * wpar)) << 3, C2 = ((unsigned)cp & 1u) * 4u + (unsigned)w * 2048u;
    const unsigned A3 = (((unsigned)cp >> 3) ^ (wpar << 2)) << 5, C3 = ((unsigned)cp & 7u) * 4u + (unsigned)w * 2048u;
    __syncthreads();
    for (int c = 0; c < L / 64; ++c) {
        int cc = c; asm volatile("" : "+s"(cc));
        const size_t tok0 = tokb + 64 * cc;
        { float run0 = 0.f, run1 = 0.f;
#pragma unroll
          for (int i = 0; i < 8; ++i) { run0 += gpre[i].x; run1 += gpre[i].y; }
          *(LAS f32x2*)(lds + HL_SEG + (w * 128 + 2 * cp) * 4) = (f32x2){run0, run1}; }
        { const int k0 = trkey(vrow);
          *(LAS u32x4*)(lds + HL_VT + vrow * 256 + ((((vc16 >> 1)) ^ k0) << 5) + (vc16 & 1) * 16) = vpre[0];
          *(LAS u32x4*)(lds + HL_VT + vrow * 256 + (((((vc16 + 8) >> 1)) ^ k0) << 5) + (vc16 & 1) * 16) = vpre[1]; }
        __syncthreads();
        f32x2 offc = (f32x2){0.f, 0.f}, rr = (f32x2){0.f, 0.f}, tot = (f32x2){0.f, 0.f};
#pragma unroll
        for (int sg = 0; sg < 8; ++sg) { const f32x2 sv = *(const LAS f32x2*)(lds + HL_SEG + (sg * 128 + 2 * cp) * 4);
            if (sg < w) offc += sv; if (sg < 4) rr += sv; tot += sv; }
        const f32x2 Rc = (f32x2){__builtin_amdgcn_exp2f(rr.x), __builtin_amdgcn_exp2f(rr.y)};
        const f32x2 C4 = (f32x2){__builtin_amdgcn_exp2f(tot.x - rr.x), __builtin_amdgcn_exp2f(tot.y - rr.y)};
        if (w == 0) *(LAS f32x2*)(lds + HL_DS + 2 * cp * 4) = (f32x2){__builtin_amdgcn_exp2f(tot.x), __builtin_amdgcn_exp2f(tot.y)};
#pragma unroll
        for (int i = 0; i < 8; ++i) {
            offc += gpre[i];
            const f32x2 d = offc - rr;
            const float E0 = __builtin_amdgcn_exp2f(fminf(fmaxf(d.x, -115.f), 115.f)), E1 = __builtin_amdgcn_exp2f(fminf(fmaxf(d.y, -115.f), 115.f));
            const float I0 = __builtin_amdgcn_rcpf(E0), I1 = __builtin_amdgcn_rcpf(E1);
            const float k0 = 1.f - __builtin_amdgcn_exp2f(gpre[i].x), k1 = 1.f - __builtin_amdgcn_exp2f(gpre[i].y);
            const f32x2 qm = (f32x2){bflo(qpre[i]) * E0, bfhi(qpre[i]) * E1}, km = (f32x2){k0 * I0, k1 * I1};
            const f32x2 qs = qm * Rc, ke = km * C4;
            LAS unsigned char* pq = lds + i * 256 + ((A1 ^ (unsigned)(i << 4)) + C1);
            *(LAS unsigned*)(pq + HL_QM) = cvt_pk_bf16_c(qm.x, qm.y);
            *(LAS unsigned*)(pq + HL_KM) = cvt_pk_bf16_c(km.x, km.y);
            *(LAS unsigned*)(lds + HL_QS + i * 256 + ((A2 ^ (unsigned)(i << 4)) + C2)) = cvt_pk_bf16_c(qs.x, qs.y);
            *(LAS unsigned*)(lds + HL_KE + i * 256 + ((A3 ^ (unsigned)((i & 3) << 5)) + C3)) = cvt_pk_bf16_c(ke.x, ke.y);
        }
        if (c + 1 < L / 64) {
            const size_t rb = (tok0 + 64 + 8 * w) * 1024 + hc;
            const float* gb = GH + rb; const bf16_t* qb = QH + rb; const bf16_t* vb = VH + (tok0 + 64) * 1024 + hc;
#pragma unroll
            for (int i = 0; i < 8; ++i) { gpre[i] = *(const f32x2*)(gb + i * 1024 + lo_g); qpre[i] = *(const unsigned*)(qb + i * 1024 + lo_g); }
            vpre[0] = *(const u32x4*)(vb + lo_v); vpre[1] = *(const u32x4*)(vb + 64 + lo_v);
        }
        __syncthreads();
#pragma unroll
        for (int rep = 0; rep < 2; ++rep) {
            if (rep == 1 && w >= 4) break;
            const int idx = rep == 0 ? w : 8 + w;
            const int si = (0xd940e4 >> (2 * idx)) & 3, ti = (0x8fb9e4 >> (2 * idx)) & 3;
            f32x4 pacc = (f32x4){0.f, 0.f, 0.f, 0.f};
            if (idx < 10) {
#pragma unroll
                for (int ks = 0; ks < 4; ++ks) {
                    const int ofs = r16 * 256 + (((4 * ks + g) ^ r16) << 4);
                    const bf16x8 af = *(const LAS bf16x8*)(lds + HL_KM + si * 4096 + ofs);
                    const bf16x8 bfr = *(const LAS bf16x8*)(lds + HL_QM + ti * 4096 + ofs);
                    pacc = __builtin_amdgcn_mfma_f32_16x16x32_bf16(af, bfr, pacc, 0, 0, 0);
                }
                const bool offd = si != ti;
#pragma unroll
                for (int r = 0; r < 4; ++r) pacc[r] = (offd || (4 * g + r <= r16)) ? pacc[r] : 0.f;
            }
            asm volatile("s_nop 7\n\ts_nop 7" ::: "memory");
            const int t = 16 * ti + r16;
            u32x2 pw; pw.x = cvt_pk_bf16_c(pacc[0], pacc[1]); pw.y = cvt_pk_bf16_c(pacc[2], pacc[3]);
            *(LAS u32x2*)(lds + HL_PL + t * 128 + (((2 * si + (g >> 1)) ^ ((t >> 1) & 7)) << 4) + (g & 1) * 8) = pw;
        }
        __syncthreads();
        const f32x4 nw4 = *(const f32x4*)(a.in[6] + 16 * w + 4 * g);
        u32x2 ogp[4];
        { const bf16_t* ob = OG + tok0 * 1024 + hc + 16 * w;
#pragma unroll
          for (int ti = 0; ti < 4; ++ti) ogp[ti] = *(const u32x2*)(ob + ti * 16384 + lo_og); }
#define HG_SB() __builtin_amdgcn_sched_barrier(0)
#define HG_QSLD(dst, kp) do { _Pragma("unroll") for (int ti = 0; ti < 4; ++ti) { const int t_ = 16 * ti + r16; \
            const u32x2 lo_ = *(const LAS u32x2*)(lds + HL_QS + t_ * 256 + (((8 * (kp) + g) ^ (r16 << 1)) << 3)); \
            const u32x2 hi_ = *(const LAS u32x2*)(lds + HL_QS + t_ * 256 + (((8 * (kp) + 4 + g) ^ (r16 << 1)) << 3)); \
            dst[ti] = (u32x4){lo_.x, lo_.y, hi_.x, hi_.y}; } } while (0)
#define HG_KELD(dst, kt) do { _Pragma("unroll") for (int ks = 0; ks < 2; ++ks) { const LAS unsigned char* pb_ = lds + HL_KE + ks * 32 * 256 + trrow + (((kt) ^ keyl) << 5); \
            dst[ks] = mk8(lds_tr16(pb_), lds_tr16(pb_ + 4 * 256)); } } while (0)
#define HG_INTER(kp, qsv) do { u32x4 sw_; sw_.x = cvt_pk_bf16_c(Sacc[2 * (kp)][0], Sacc[2 * (kp)][1]); sw_.y = cvt_pk_bf16_c(Sacc[2 * (kp)][2], Sacc[2 * (kp)][3]); \
            sw_.z = cvt_pk_bf16_c(Sacc[2 * (kp) + 1][0], Sacc[2 * (kp) + 1][1]); sw_.w = cvt_pk_bf16_c(Sacc[2 * (kp) + 1][2], Sacc[2 * (kp) + 1][3]); \
            const bf16x8 sf_ = __builtin_bit_cast(bf16x8, sw_); \
            _Pragma("unroll") for (int ti = 0; ti < 4; ++ti) Oa[ti] = __builtin_amdgcn_mfma_f32_16x16x32_bf16(sf_, __builtin_bit_cast(bf16x8, qsv[ti]), Oa[ti], 0, 0, 0); } while (0)
#define HG_SUPD(kt, kev, dsv) do { f32x4 sa_ = Sacc[kt] * dsv; \
            sa_ = __builtin_amdgcn_mfma_f32_16x16x32_bf16(kev[0], vf[0], sa_, 0, 0, 0); sa_ = __builtin_amdgcn_mfma_f32_16x16x32_bf16(kev[1], vf[1], sa_, 0, 0, 0); Sacc[kt] = sa_; } while (0)
        bf16x8 vf[2];
        bf16x8 pf[6];
        u32x4 qsA[4], qsB[4];
#pragma unroll
        for (int ks = 0; ks < 2; ++ks) {
            const LAS unsigned char* pb = lds + HL_VT + ks * 32 * 256 + trrow + ((w ^ keyl) << 5);
            vf[ks] = mk8(lds_tr16(pb), lds_tr16(pb + 4 * 256));
        }
        {
            const int t0_ = r16, t1_ = 16 + r16, t2_ = 32 + r16, t3_ = 48 + r16;
            pf[0] = *(const LAS bf16x8*)(lds + HL_PL + t0_ * 128 + (((g) ^ ((t0_ >> 1) & 7)) << 4));
            pf[1] = *(const LAS bf16x8*)(lds + HL_PL + t1_ * 128 + (((g) ^ ((t1_ >> 1) & 7)) << 4));
            pf[2] = *(const LAS bf16x8*)(lds + HL_PL + t2_ * 128 + (((g) ^ ((t2_ >> 1) & 7)) << 4));
            pf[3] = *(const LAS bf16x8*)(lds + HL_PL + t2_ * 128 + (((4 + g) ^ ((t2_ >> 1) & 7)) << 4));
            pf[4] = *(const LAS bf16x8*)(lds + HL_PL + t3_ * 128 + (((g) ^ ((t3_ >> 1) & 7)) << 4));
            pf[5] = *(const LAS bf16x8*)(lds + HL_PL + t3_ * 128 + (((4 + g) ^ ((t3_ >> 1) & 7)) << 4));
        }
        HG_QSLD(qsA, 0);
        HG_SB();
        f32x4 Oa[4];
        const f32x4 z4 = (f32x4){0.f, 0.f, 0.f, 0.f};
        Oa[0] = __builtin_amdgcn_mfma_f32_16x16x32_bf16(vf[0], pf[0], z4, 0, 0, 0);
        Oa[1] = __builtin_amdgcn_mfma_f32_16x16x32_bf16(vf[0], pf[1], z4, 0, 0, 0);
        Oa[2] = __builtin_amdgcn_mfma_f32_16x16x32_bf16(vf[0], pf[2], z4, 0, 0, 0);
        Oa[3] = __builtin_amdgcn_mfma_f32_16x16x32_bf16(vf[0], pf[4], z4, 0, 0, 0);
        Oa[2] = __builtin_amdgcn_mfma_f32_16x16x32_bf16(vf[1], pf[3], Oa[2], 0, 0, 0);
        Oa[3] = __builtin_amdgcn_mfma_f32_16x16x32_bf16(vf[1], pf[5], Oa[3], 0, 0, 0);
        HG_SB();
        HG_QSLD(qsB, 1);
        HG_SB();
        HG_INTER(0, qsA);
        HG_SB();
        HG_QSLD(qsA, 2);
        HG_SB();
        HG_INTER(1, qsB);
        HG_SB();
        HG_QSLD(qsB, 3);
        HG_SB();
#define HG_DSLD(kt) (*(const LAS f32x4*)(lds + HL_DS + (16 * (kt) + 4 * g) * 4))
        bf16x8 keA[2], keB[2], keC[2], keD[2]; f32x4 dA, dB, dC, dD;
        HG_KELD(keA, 0); HG_KELD(keB, 1); dA = HG_DSLD(0); dB = HG_DSLD(1);
        HG_SB();
        HG_INTER(2, qsA);
        HG_SB();
        HG_KELD(keC, 2); HG_KELD(keD, 3); dC = HG_DSLD(2); dD = HG_DSLD(3);
        HG_SB();
        HG_INTER(3, qsB);
        HG_SB();
        HG_SUPD(0, keA, dA); HG_SUPD(1, keB, dB);
        HG_SB();
        HG_KELD(keA, 4); HG_KELD(keB, 5); dA = HG_DSLD(4); dB = HG_DSLD(5);
        HG_SB();
        HG_SUPD(2, keC, dC); HG_SUPD(3, keD, dD);
        HG_SB();
        HG_KELD(keC, 6); HG_KELD(keD, 7); dC = HG_DSLD(6); dD = HG_DSLD(7);
        HG_SB();
        HG_SUPD(4, keA, dA); HG_SUPD(5, keB, dB);
        HG_SB();
        HG_SUPD(6, keC, dC); HG_SUPD(7, keD, dD);
#undef HG_DSLD
#undef HG_SB
#undef HG_QSLD
#undef HG_KELD
#undef HG_INTER
#undef HG_SUPD
#pragma unroll
        for (int ti = 0; ti < 4; ++ti) {
            float sq = (Oa[ti][0] * Oa[ti][0] + Oa[ti][1] * Oa[ti][1]) + (Oa[ti][2] * Oa[ti][2] + Oa[ti][3] * Oa[ti][3]);
            sq += __shfl_xor(sq, 16); sq += __shfl_xor(sq, 32);
            if (g == 0) *(LAS float*)(lds + HL_SSQ + (w * 64 + 16 * ti + r16) * 4) = sq;
        }
        __syncthreads();
#pragma unroll
        for (int ti = 0; ti < 4; ++ti) {
            const int t = 16 * ti + r16;
            float tot = 0.f;
#pragma unroll
            for (int ww = 0; ww < 8; ++ww) tot += *(const LAS float*)(lds + HL_SSQ + (ww * 64 + t) * 4);
            const float rs = rsqrtf(tot * (1.f / 128.f) + EPS);
            u32x2 o; o.x = pk2(Oa[ti][0] * rs * nw4[0] * bflo(ogp[ti].x), Oa[ti][1] * rs * nw4[1] * bfhi(ogp[ti].x));
            o.y = pk2(Oa[ti][2] * rs * nw4[2] * bflo(ogp[ti].y), Oa[ti][3] * rs * nw4[3] * bfhi(ogp[ti].y));
            *(u32x2*)(YM + tok0 * D + hc + 16 * w + ti * 32768 + lo_ym) = o;
        }
    }
}

typedef _Float16 f16x8 __attribute__((ext_vector_type(8)));
typedef _Float16 f16x2 __attribute__((ext_vector_type(2)));
__device__ __forceinline__ unsigned pkh(float a, float b) { const f16x2 h = {(_Float16)a, (_Float16)b}; return __builtin_bit_cast(unsigned, h); }
constexpr int LC_CNTL = 4096, LC_BASE = 4224;
__device__ __forceinline__ void p4_ln_router(Frame& F, const Args& a) {
    LAS unsigned char* lds = F.lds;
    const float* Z = (const float*)(F.ws + WS_Z); bf16_t* H1 = (bf16_t*)(F.ws + WS_H1);
    const float* w = a.in[11]; const float* b = a.in[12]; const float* br = a.in[14];
    int* cnt = (int*)(F.ws + WS_CTL) + CW_CNT; int* list = (int*)(F.ws + WS_LIST);
    int* tok_e = (int*)(F.ws + WS_TOKE); int* tok_p = (int*)(F.ws + WS_TOKP); float* tok_g = (float*)(F.ws + WS_TOKG);
    const int tid = F.tid, lane = F.lane, wv = F.wave, r16 = lane & 15, g = lane >> 4, nh = wv & 1, q = wv >> 1;
    LAS int* CNTL = (LAS int*)(lds + LDSCTL_OFF + LC_CNTL); LAS int* BASE = (LAS int*)(lds + LDSCTL_OFF + LC_BASE);
    if (tid < 32) CNTL[tid] = 0;
    const _Float16* ph = (const _Float16*)(F.ws + WS_WRH) + (size_t)(16 * nh + r16) * D + 512 * q + 8 * g;
    int se0 = 0, se1 = 0, se2 = 0, se3 = 0; float sg0 = 0.f, sg1 = 0.f, sg2 = 0.f, sg3 = 0.f;
    const int ntile = T / 32;
    const int nmy = (ntile - F.vcu + F.G - 1) / F.G;
    for (int it = 0; it < nmy; ++it) {
        const int tile = F.vcu + it * F.G;
        __syncthreads();
#define P4_LN(v, tlx) do { const int tl = (tlx); float s = 0.f; \
            _Pragma("unroll") for (int j = 0; j < 8; ++j) s += (v[j][0] + v[j][1]) + (v[j][2] + v[j][3]); \
            const float mean = wave_sum(s) * (1.f / D); float s2 = 0.f; \
            _Pragma("unroll") for (int j = 0; j < 8; ++j) { v[j] = v[j] - mean; s2 += (v[j][0] * v[j][0] + v[j][1] * v[j][1]) + (v[j][2] * v[j][2] + v[j][3] * v[j][3]); } \
            const float rstd = rsqrtf(wave_sum(s2) * (1.f / D) + EPS); \
            _Pragma("unroll") for (int j = 0; j < 8; ++j) { const f32x4 ww = *((const f32x4*)w + lane + 64 * j), bb = *((const f32x4*)b + lane + 64 * j); \
                f32x4 hv; hv[0] = v[j][0] * rstd * ww[0] + bb[0]; hv[1] = v[j][1] * rstd * ww[1] + bb[1]; hv[2] = v[j][2] * rstd * ww[2] + bb[2]; hv[3] = v[j][3] * rstd * ww[3] + bb[3]; \
                u32x2 hh; hh.x = pkh(hv[0], hv[1]); hh.y = pkh(hv[2], hv[3]); \
                *(LAS u32x2*)(lds + tl * 4096 + ((((lane >> 1) + 32 * j) ^ (tl & 15)) << 4) + (lane & 1) * 8) = hh; } } while (0)
#pragma unroll 1
        for (int ps = 0; ps < 2; ++ps) {
            f32x4 v0[8], v1[8];
            { const GAS f32x4* z0 = (const GAS f32x4*)(Z + (size_t)(tile * 32 + 4 * wv + 2 * ps) * D) + lane;
#pragma unroll
              for (int j = 0; j < 8; ++j) { v0[j] = z0[64 * j]; v1[j] = z0[64 * j + 512]; } }
            P4_LN(v0, 4 * wv + 2 * ps); P4_LN(v1, 4 * wv + 2 * ps + 1);
        }
#undef P4_LN
        __syncthreads();
#pragma unroll 2
        for (int r = 0; r < 16; ++r) {
            const int idx = r * 512 + tid, t = idx >> 8, c = idx & 255;
            const f16x8 hv8 = *(const LAS f16x8*)(lds + t * 4096 + ((c ^ (t & 15)) << 4));
            float f[8];
#pragma unroll
            for (int q8 = 0; q8 < 8; ++q8) f[q8] = (float)hv8[q8];
            const size_t go = (size_t)(tile * 32 + t) * D + 8 * c;
            u32x4 ob; ob.x = pk2(f[0], f[1]); ob.y = pk2(f[2], f[3]); ob.z = pk2(f[4], f[5]); ob.w = pk2(f[6], f[7]);
            *(GAS u32x4*)(H1 + go) = ob;
            u32x2 oq; oq.x = pk4_fp8(f[0] * SC_H1, f[1] * SC_H1, f[2] * SC_H1, f[3] * SC_H1); oq.y = pk4_fp8(f[4] * SC_H1, f[5] * SC_H1, f[6] * SC_H1, f[7] * SC_H1);
            *(GAS u32x2*)(F.ws + WS_H1Q + go) = oq;
        }
        f16x8 wf[16];
#pragma unroll
        for (int ks = 0; ks < 16; ++ks) wf[ks] = *(const f16x8*)(ph + 32 * ks);
        f32x4 acc0 = (f32x4){0.f, 0.f, 0.f, 0.f}, acc1 = (f32x4){0.f, 0.f, 0.f, 0.f};
#pragma unroll
        for (int ks = 0; ks < 16; ++ks) {
            const int off = r16 * 4096 + (((64 * q + 4 * ks + g) ^ r16) << 4);
            const f16x8 t0 = *(const LAS f16x8*)(lds + off), t1 = *(const LAS f16x8*)(lds + 65536 + off);
            acc0 = __builtin_amdgcn_mfma_f32_16x16x32_f16(wf[ks], t0, acc0, 0, 0, 0);
            acc1 = __builtin_amdgcn_mfma_f32_16x16x32_f16(wf[ks], t1, acc1, 0, 0, 0);
        }
        __syncthreads();
        *(LAS f32x4*)(lds + ((q * 32 + r16) * 32 + 16 * nh + 4 * g) * 4) = acc0;
        *(LAS f32x4*)(lds + ((q * 32 + 16 + r16) * 32 + 16 * nh + 4 * g) * 4) = acc1;
        __syncthreads();
#pragma unroll
        for (int ps = 0; ps < 2; ++ps) {
            const int e = lane & 31, tl = 4 * wv + 2 * ps + (lane >> 5);
            float sl = 0.f;
#pragma unroll
            for (int qq = 0; qq < 4; ++qq) sl += *(const LAS float*)(lds + ((qq * 32 + tl) * 32 + e) * 4);
            sl = sl * (1.f / 64.f) + br[e];
            float val = sl; int te[4]; float tv[4];
#pragma unroll
            for (int r = 0; r < 4; ++r) {
                float bv = val; int bi = e;
#pragma unroll
                for (int o = 1; o < 32; o <<= 1) { const float ov = __shfl_xor(bv, o); const int oi = __shfl_xor(bi, o); if (ov > bv || (ov == bv && oi < bi)) { bv = ov; bi = oi; } }
                te[r] = bi; tv[r] = bv; if (e == bi) val = -INFINITY;
            }
            float p[4], psum = 0.f;
#pragma unroll
            for (int r = 0; r < 4; ++r) { p[r] = __expf(tv[r] - tv[0]); psum += p[r]; }
            if (e < 4) {
                int ee = te[0]; float gg = p[0];
                if (e == 1) { ee = te[1]; gg = p[1]; } else if (e == 2) { ee = te[2]; gg = p[2]; } else if (e == 3) { ee = te[3]; gg = p[3]; }
                const float gn = gg / psum; const int idx = it * 2 + ps;
                if (idx == 0) { se0 = ee; sg0 = gn; } else if (idx == 1) { se1 = ee; sg1 = gn; } else if (idx == 2) { se2 = ee; sg2 = gn; } else { se3 = ee; sg3 = gn; }
            }
        }
    }
    __syncthreads();
    const bool own = (lane & 31) < 4;
    const int nent = nmy * 2;
    int rk0 = 0, rk1 = 0, rk2 = 0, rk3 = 0;
    if (own) {
        if (nent > 0) rk0 = __hip_atomic_fetch_add((LAS int*)&CNTL[se0], 1, __ATOMIC_RELAXED, __HIP_MEMORY_SCOPE_WORKGROUP);
        if (nent > 1) rk1 = __hip_atomic_fetch_add((LAS int*)&CNTL[se1], 1, __ATOMIC_RELAXED, __HIP_MEMORY_SCOPE_WORKGROUP);
        if (nent > 2) rk2 = __hip_atomic_fetch_add((LAS int*)&CNTL[se2], 1, __ATOMIC_RELAXED, __HIP_MEMORY_SCOPE_WORKGROUP);
        if (nent > 3) rk3 = __hip_atomic_fetch_add((LAS int*)&CNTL[se3], 1, __ATOMIC_RELAXED, __HIP_MEMORY_SCOPE_WORKGROUP);
    }
    __syncthreads();
    if (tid < 32) { const int c = CNTL[tid]; BASE[tid] = c > 0 ? atomicAdd(&cnt[tid], c) : 0; }
    __syncthreads();
    if (own) {
        const int k = lane & 31;
#define P4_EMIT(idx, sex, sgx, rkx) do { if (nent > (idx)) { const int m = (F.vcu + ((idx) >> 1) * F.G) * 32 + 4 * wv + 2 * ((idx) & 1) + (lane >> 5), pos = BASE[sex] + (rkx); \
            list[(size_t)(sex) * LISTCAP + pos] = m; tok_e[m * 4 + k] = (sex); tok_p[m * 4 + k] = pos; tok_g[m * 4 + k] = (sgx); } } while (0)
        P4_EMIT(0, se0, sg0, rk0); P4_EMIT(1, se1, sg1, rk1); P4_EMIT(2, se2, sg2, rk2); P4_EMIT(3, se3, sg3, rk3);
#undef P4_EMIT
    }
}
__device__ __forceinline__ int moe_tables(Frame& F) {
    LAS int* pts = (LAS int*)(F.lds + LDSCTL_OFF + LC_PTS); LAS int* cl = (LAS int*)(F.lds + LDSCTL_OFF + LC_CNT); LAS unsigned char* tileE = (LAS unsigned char*)(F.lds + LDSCTL_OFF + LC_TILEE);
    const int* cnt = (const int*)(F.ws + WS_CTL) + CW_CNT;
    __syncthreads();
    if (F.tid < 64) {
        const int e = F.tid & 31; const int c = __hip_atomic_load(cnt + e, RLX_AGENT); const int tl = (c + 255) >> 8;
        int incl = tl;
#pragma unroll
        for (int o = 1; o < 32; o <<= 1) { const int v = __shfl_up(incl, o, 32); if (e >= o) incl += v; }
        if (F.tid < 32) { cl[e] = c; pts[e] = incl - tl; if (e == 31) pts[32] = incl; }
    }
    __syncthreads();
    const int nmt = pts[32];
    for (int t = F.tid; t < nmt; t += NTHR) { int e = 0;
        for (int j = 0; j < 32; ++j) if (t >= pts[j + 1]) e = j + 1;
        tileE[t] = (unsigned char)e; }
    __syncthreads();
    return __builtin_amdgcn_readfirstlane(nmt);
}
__device__ __forceinline__ void p7_combine(Frame& F, const Args& a) {
    const LAS int* pts = (const LAS int*)(F.lds + LDSCTL_OFF + LC_PTS);
    const bf16_t* H1 = (const bf16_t*)(F.ws + WS_H1); const bf16_t* Y = (const bf16_t*)(F.ws + WS_Y);
    const int* tok_e = (const int*)(F.ws + WS_TOKE); const int* tok_p = (const int*)(F.ws + WS_TOKP); const float* tok_g = (const float*)(F.ws + WS_TOKG);
    const float* w = a.in[21]; const float* b = a.in[22]; float* out = a.out;
    const int gw = F.vcu * NWAVES + F.wave, NGW = F.G * NWAVES, lane = F.lane;
    LAS f32x4* WL = (LAS f32x4*)F.lds; LAS f32x4* BL = (LAS f32x4*)(F.lds + 8192);
    __syncthreads();
    WL[F.tid] = *((const f32x4*)w + F.tid); BL[F.tid] = *((const f32x4*)b + F.tid);
    __syncthreads();
    const int ntok = (T - gw + NGW - 1) / NGW;
    int rowv = 0; float gv = 0.f;
    { const int i = lane >> 2, k = lane & 3; if (i < ntok) { const int m = gw + i * NGW; const int e = tok_e[m * 4 + k]; rowv = pts[e] * 256 + tok_p[m * 4 + k]; gv = tok_g[m * 4 + k]; } }
#define P8_LOAD(hx, yx, i) do { const int m_ = gw + (i) * NGW; const GAS u32x2* hr_ = (const GAS u32x2*)(H1 + (size_t)m_ * D) + lane; \
        _Pragma("unroll") for (int j = 0; j < 8; ++j) hx[j] = hr_[64 * j]; \
        _Pragma("unroll") for (int k = 0; k < 4; ++k) { const int row_ = __builtin_amdgcn_readlane(rowv, 4 * (i) + k); const GAS u32x2* yr_ = (const GAS u32x2*)(Y + (size_t)row_ * D) + lane; \
            _Pragma("unroll") for (int j = 0; j < 8; ++j) yx[k][j] = yr_[64 * j]; } } while (0)
#define P8_DO(hx, yx, i) do { const int m_ = gw + (i) * NGW; f32x4 v[8]; asm volatile("" ::: "memory"); \
        _Pragma("unroll") for (int j = 0; j < 8; ++j) { v[j][0] = ALPHA * bflo(hx[j].x); v[j][1] = ALPHA * bfhi(hx[j].x); v[j][2] = ALPHA * bflo(hx[j].y); v[j][3] = ALPHA * bfhi(hx[j].y); } \
        _Pragma("unroll") for (int k = 0; k < 4; ++k) { const float g_ = __builtin_bit_cast(float, __builtin_amdgcn_readlane(__builtin_bit_cast(int, gv), 4 * (i) + k)); \
            _Pragma("unroll") for (int j = 0; j < 8; ++j) { v[j][0] += g_ * bflo(yx[k][j].x); v[j][1] += g_ * bfhi(yx[k][j].x); v[j][2] += g_ * bflo(yx[k][j].y); v[j][3] += g_ * bfhi(yx[k][j].y); } } \
        float s = 0.f; _Pragma("unroll") for (int j = 0; j < 8; ++j) s += (v[j][0] + v[j][1]) + (v[j][2] + v[j][3]); \
        const float mean = wave_sum(s) * (1.f / D); float s2 = 0.f; \
        _Pragma("unroll") for (int j = 0; j < 8; ++j) { v[j] = v[j] - mean; s2 += (v[j][0] * v[j][0] + v[j][1] * v[j][1]) + (v[j][2] * v[j][2] + v[j][3] * v[j][3]); } \
        const float rstd = rsqrtf(wave_sum(s2) * (1.f / D) + EPS); GAS f32x4* orow = (GAS f32x4*)(out + (size_t)m_ * D) + lane; \
        _Pragma("unroll") for (int j = 0; j < 8; ++j) { const f32x4 ww = WL[lane + 64 * j], bb = BL[lane + 64 * j]; \
            f32x4 o; o[0] = v[j][0] * rstd * ww[0] + bb[0]; o[1] = v[j][1] * rstd * ww[1] + bb[1]; o[2] = v[j][2] * rstd * ww[2] + bb[2]; o[3] = v[j][3] * rstd * ww[3] + bb[3]; orow[64 * j] = o; } } while (0)
    u32x2 hA[8], yA[4][8], hB[8], yB[4][8];
    if (ntok > 0) P8_LOAD(hA, yA, 0);
    for (int i = 0; i < ntok; i += 2) {
        if (i + 1 < ntok) P8_LOAD(hB, yB, i + 1);
        P8_DO(hA, yA, i);
        if (i + 1 < ntok) { if (i + 2 < ntok) P8_LOAD(hA, yA, i + 2); P8_DO(hB, yB, i + 1); }
    }
#undef P8_LOAD
#undef P8_DO
}

__global__ void __launch_bounds__(NTHR, 2) mk_fwd(Args args) {
    extern __shared__ __attribute__((aligned(16))) unsigned char lds_raw[];
    Frame F;
    F.lds = (LAS unsigned char*)lds_raw;
    F.tid = threadIdx.x; F.lane = F.tid & 63; F.wave = __builtin_amdgcn_readfirstlane(F.tid >> 6);
    F.G = gridDim.x; { const int bx = blockIdx.x; F.vcu = (F.G % 8 == 0) ? (bx % 8) * (F.G / 8) + bx / 8 : bx; }
    F.ws = args.ws;
    unsigned char* ws = args.ws;
    for (int u = F.tid; u < (LDS_BYTES - LDSCTL_OFF) / 4; u += NTHR) ((LAS unsigned*)(F.lds + LDSCTL_OFF))[u] = 0u;
    __syncthreads();
    XcdBarrier bar; bar.bar = (unsigned*)(ws + WS_CTL) + CW_BAR; bar.x = 0; bar.st = nullptr;
#if !MK_PER_PHASE
    bar = xcd_barrier_post((unsigned*)(ws + WS_CTL) + CW_BAR, (volatile LAS unsigned*)(F.lds + LDSCTL_OFF + LC_BAR));
#endif
    const int lo = args.ph_lo, hi = args.ph_hi;
#define IN(k) (lo <= (k) && (k) < hi)
#define REFRESH_IDS() do { int t_ = threadIdx.x; asm volatile("" : "+v"(t_)); F.tid = t_; F.lane = t_ & 63; F.wave = __builtin_amdgcn_readfirstlane(t_ >> 6); } while (0)
#define SEAM(k) do { if (IN(k) && IN((k) + 1)) xcd_barrier(bar); } while (0)

    if (IN(0)) { REFRESH_IDS(); for (int r = 0; r < REP0; ++r) { p0_prologue(F, args); if (r + 1 < REP0) xcd_barrier(bar); } } SEAM(0);

    if (IN(1)) { REFRESH_IDS();
        const int Gg = F.G;
        SchedDense S{(const bf16_t*)(ws + WS_H0), (const bf16_t*)(ws + WS_WIN), T / 256, INC / 256, Gg, (int)blockIdx.x};
        EpiInProj E{(bf16_t*)(ws + WS_QH), (bf16_t*)(ws + WS_KH), (bf16_t*)(ws + WS_VH), (bf16_t*)(ws + WS_OG), (bf16_t*)(ws + WS_AQ), (bf16_t*)(ws + WS_AK), (bf16_t*)(ws + WS_AV),
                    (float*)(ws + WS_GH), (const float*)(ws + WS_LB), args.in[4]};
        for (int r = 0; r < REP1; ++r) { gemm_phase<EpiInProj, SchedDense>(F.lds, S, E); if (r + 1 < REP1) xcd_barrier(bar); }
        {
            const int nwg = (T / 256) * (INC / 256), full = nwg / F.G, extra = nwg - full * F.G;
            const bool has_extra = (int)blockIdx.x < extra;
            if (has_extra) { if (threadIdx.x == 0) __hip_atomic_fetch_add((unsigned*)(ws + WS_CTL) + CW_P1DONE, 1u, RLX_AGENT); }
            else if (extra > 0) { __syncthreads(); cv_worker(F, args, (const unsigned*)(ws + WS_CTL) + CW_P1DONE, (unsigned)extra); }
        }
    } SEAM(1);

    if (IN(2)) { REFRESH_IDS();
        for (int r = 0; r < REP2; ++r) {
        const int nh = F.G > 64 ? 64 : F.G;
        const int a0 = F.G >= 192 ? 64 : 0, na = F.G >= 192 ? 64 : F.G;
        if ((int)blockIdx.x < nh) { for (int hu = blockIdx.x; hu < 64 * REP2H; hu += nh) hgrn_unit_mfma(F, args, (hu & 63) >> 3, hu & 7); }
        REFRESH_IDS();
        if ((int)blockIdx.x >= a0 && (int)blockIdx.x < a0 + na) {
            for (int v0 = (int)blockIdx.x - a0; v0 < NB * (L / AT_Q) * REP2A; v0 += na) { const int v = v0 % (NB * (L / AT_Q)); attn_unit_mfma(F, args, v / (L / AT_Q), v % (L / AT_Q)); }
        }
        __syncthreads();
        REFRESH_IDS();
        cv_worker(F, args, nullptr, 0u);
        if (r + 1 < REP2) xcd_barrier(bar); }
    } SEAM(2);

    if (IN(3)) { REFRESH_IDS();
        SchedDense S{(const bf16_t*)(ws + WS_YMIX), (const bf16_t*)(ws + WS_WOUT), T / 256, D / 256, F.G, (int)blockIdx.x};
        EpiOutProj E{(float*)(ws + WS_Z), args.in[0], (const float*)(ws + WS_STATS0), args.in[1], args.in[2], args.in[10]};
        for (int r = 0; r < REP3; ++r) { gemm_phase<EpiOutProj, SchedDense>(F.lds, S, E); if (r + 1 < REP3) xcd_barrier(bar); }
    } SEAM(3);

    if (IN(4)) { REFRESH_IDS(); p4_ln_router(F, args); }

    if (IN(5) && !IN(4)) { REFRESH_IDS(); __syncthreads(); cv_worker(F, args, nullptr, 0u); }
    if (IN(4) || IN(5)) { if (IN(6)) xcd_barrier(bar); }

    if (IN(6)) { REFRESH_IDS();
        const int nmt = moe_tables(F);
        SchedMoe<2048> S{(const void*)(ws + WS_H1Q), (const void*)(ws + WS_WGU), (size_t)4096 * KD, (const int*)(ws + WS_LIST),
                   (const LAS int*)(F.lds + LDSCTL_OFF + LC_PTS), (const LAS int*)(F.lds + LDSCTL_OFF + LC_CNT), (const LAS unsigned char*)(F.lds + LDSCTL_OFF + LC_TILEE), nmt, 16, F.G, (int)blockIdx.x, true};
        EpiMoe1F8 E{(unsigned char*)(ws + WS_HACT), args.in[16], args.in[18]};
        for (int r = 0; r < REP5; ++r) { gemm_phase<EpiMoe1F8, SchedMoe<2048>, true>(F.lds, S, E); if (r + 1 < REP5) xcd_barrier(bar); }
    } SEAM(6);

    if (IN(7)) { REFRESH_IDS();
        const int nmt = moe_tables(F);
        SchedMoe<2048> S{(const void*)(ws + WS_HACT), (const void*)(ws + WS_WD), (size_t)2048 * KD, (const int*)(ws + WS_LIST),
                   (const LAS int*)(F.lds + LDSCTL_OFF + LC_PTS), (const LAS int*)(F.lds + LDSCTL_OFF + LC_CNT), (const LAS unsigned char*)(F.lds + LDSCTL_OFF + LC_TILEE), nmt, 8, F.G, (int)blockIdx.x, false};
        EpiMoe2F8 E{(bf16_t*)(ws + WS_Y), args.in[20]};
        for (int r = 0; r < REP6; ++r) { gemm_phase<EpiMoe2F8, SchedMoe<2048>, true>(F.lds, S, E); if (r + 1 < REP6) xcd_barrier(bar); }
    } SEAM(7);

    if (IN(8)) { REFRESH_IDS(); (void)moe_tables(F); for (int r = 0; r < REP7; ++r) p7_combine(F, args); }
#undef IN
#undef SEAM
}
}

extern "C" void kernel_launch(void* const* d_in, const int* in_sizes, int n_in, void* d_out, int out_size, void* d_ws, size_t ws_size, hipStream_t stream) {
    static int grid = 0;
    if (grid == 0) {
        if (n_in != 23 || out_size != T * D || ws_size < WS_END) { fprintf(stderr, "kernel_launch: unexpected shapes (n_in %d out %d ws %zu need %zu)\n", n_in, out_size, ws_size, (size_t)WS_END); grid = -1; return; }
        int dev = 0, cus = 0, per_cu = 0;
        if (hipGetDevice(&dev) != hipSuccess || hipDeviceGetAttribute(&cus, hipDeviceAttributeMultiprocessorCount, dev) != hipSuccess) { grid = -1; return; }
        if (hipFuncSetAttribute((const void*)mk_fwd, hipFuncAttributeMaxDynamicSharedMemorySize, LDS_BYTES) != hipSuccess) { fprintf(stderr, "kernel_launch: hipFuncSetAttribute failed\n"); grid = -1; return; }
        if (hipOccupancyMaxActiveBlocksPerMultiprocessor(&per_cu, (const void*)mk_fwd, NTHR, LDS_BYTES) != hipSuccess || per_cu < 1) { fprintf(stderr, "kernel_launch: occupancy query says %d\n", per_cu); }
        (void)hipGetLastError();
        grid = cus;
    }
    if (grid < 0) return;
    if (hipMemsetAsync((char*)d_ws + WS_CTL, 0, CTL_ZERO_BYTES, stream) != hipSuccess) return;
    Args a{};
    for (int i = 0; i < 23; ++i) a.in[i] = (const float*)d_in[i];
    a.out = (float*)d_out; a.ws = (unsigned char*)d_ws;
#if MK_PER_PHASE
    for (int p = 0; p < NPHASE; ++p) { a.ph_lo = p; a.ph_hi = p + 1; hipLaunchKernelGGL(mk_fwd, dim3(grid), dim3(NTHR), LDS_BYTES, stream, a); }
#else
    a.ph_lo = 0; a.ph_hi = NPHASE; hipLaunchKernelGGL(mk_fwd, dim3(grid), dim3(NTHR), LDS_BYTES, stream, a);
#endif
}
```

```cpp
#include <hip/hip_runtime.h>
#include <cstdio>
#include <cstdint>

#ifndef MK_PER_PHASE
#define MK_PER_PHASE 0
#endif

#define LAS __attribute__((address_space(3)))
#define GAS __attribute__((address_space(1)))
typedef unsigned short bf16_t;
typedef short bf16x8 __attribute__((ext_vector_type(8)));
typedef float f32x4 __attribute__((ext_vector_type(4)));
typedef float f32x2 __attribute__((ext_vector_type(2)));
typedef unsigned u32x4 __attribute__((ext_vector_type(4)));
typedef unsigned u32x2 __attribute__((ext_vector_type(2)));
typedef GAS unsigned gu32;

namespace {
constexpr int D = 2048, NB = 8, L = 2048, T = NB * L;
constexpr int INC = 5376;
constexpr int NE = 32, FF = 2048, NA = T * 4;
constexpr int LISTCAP = T;
constexpr int MAXROWS = NA + NE * 256;
constexpr float ALPHA = 1.189207115002721f;
constexpr float EPS = 1e-5f;
constexpr int NWAVES = 8, NTHR = 512;
constexpr int NPHASE = 9;
constexpr int REP2H = 1, REP2A = 1;
constexpr int REP0 = 1, REP1 = 1, REP2 = 1, REP3 = 1, REP5 = 1, REP6 = 1, REP7 = 1;

constexpr size_t MiB = 1u << 20;
constexpr size_t WS_CTL = 0, CTL_ZERO_BYTES = 32768;
constexpr size_t WS_LB = 1 * MiB;
constexpr size_t WS_STATS0 = WS_LB + 4096;
constexpr size_t WS_LIST = 2 * MiB;
constexpr size_t WS_TOKE = 4 * MiB, WS_TOKP = WS_TOKE + (size_t)NA * 4, WS_TOKG = WS_TOKP + (size_t)NA * 4;
constexpr size_t WS_WRH = 5 * MiB;
constexpr size_t WS_WIN = 8 * MiB;
constexpr size_t WS_WOUT = 30 * MiB;
constexpr size_t WS_WGU = 40 * MiB;
constexpr size_t WS_WD = 552 * MiB;
constexpr size_t WS_H1 = 808 * MiB;
constexpr size_t WS_Z = 872 * MiB;
constexpr size_t WS_HACT = 1000 * MiB;
constexpr size_t WS_EARLY = 1288 * MiB;
constexpr size_t WS_H0 = WS_EARLY;
constexpr size_t WS_QH = WS_H0 + 64 * MiB, WS_KH = WS_QH + 32 * MiB, WS_VH = WS_KH + 32 * MiB, WS_OG = WS_VH + 32 * MiB, WS_AQ = WS_OG + 32 * MiB;
constexpr size_t WS_GH = WS_AQ + 32 * MiB;
constexpr size_t WS_AK = WS_GH + 64 * MiB, WS_AV = WS_AK + 4 * MiB;
constexpr size_t WS_YMIX = WS_AV + 4 * MiB;
constexpr size_t WS_H1Q = WS_KH;
constexpr size_t WS_Y = WS_EARLY;
constexpr size_t WS_END = WS_YMIX + 64 * MiB;
static_assert(WS_Y + (size_t)MAXROWS * 4096 <= WS_END + 0 * MiB || true, "");
static_assert(WS_END <= 2048 * MiB, "d_ws map");
constexpr int CW_CNT = 64;
constexpr int CW_CONV = 128, CW_P1DONE = 192, CW_HGDONE = 256;
constexpr int CW_BAR = 4096;

constexpr int RING_BYTES = 131072;
constexpr int CV_SCR = 17408;
constexpr int LDSCTL_OFF = 8 * CV_SCR;
constexpr int LDS_BYTES = 147456;
constexpr int LC_BAR = 0, LC_PTS = 64, LC_CNT = 256, LC_TILEE = 512, LC_MISC = 2048;

#define RLX_AGENT __ATOMIC_RELAXED, __HIP_MEMORY_SCOPE_AGENT
__device__ __forceinline__ unsigned f2bf(float f) { unsigned u = __builtin_bit_cast(unsigned, f); return (u + 0x7fffu + ((u >> 16) & 1u)) >> 16; }
__device__ __forceinline__ unsigned pk2(float lo, float hi) { return f2bf(lo) | (f2bf(hi) << 16); }
__device__ __forceinline__ float bf2f(unsigned short b) { return __builtin_bit_cast(float, (unsigned)b << 16); }
__device__ __forceinline__ float bflo(unsigned w) { return __builtin_bit_cast(float, w << 16); }
__device__ __forceinline__ float bfhi(unsigned w) { return __builtin_bit_cast(float, w & 0xffff0000u); }
typedef __bf16 bf16x2_t __attribute__((ext_vector_type(2)));
__device__ __forceinline__ unsigned cvt_pk_bf16_c(float lo, float hi) { f32x2 v = {lo, hi}; bf16x2_t b = __builtin_convertvector(v, bf16x2_t); return __builtin_bit_cast(unsigned, b); }
__device__ __forceinline__ unsigned cvt_pk_bf16(float lo, float hi) { unsigned r; asm volatile("v_cvt_pk_bf16_f32 %0, %1, %2" : "=v"(r) : "v"(lo), "v"(hi)); return r; }
__device__ __forceinline__ float wave_sum(float v) {
#pragma unroll
    for (int o = 1; o < 64; o <<= 1) v += __shfl_xor(v, o);
    return v;
}
__device__ __forceinline__ float sigm(float x) { return __builtin_amdgcn_rcpf(1.f + __expf(-x)); }

#define XB_TMO      128
#define XB_XCNT(j)  (256  + 64 * (j))
#define XB_XSUB(j)  (1280 + 64 * (j))
#define XB_XGEN(j)  (2304 + 64 * (j))
#define XB_TOP      3328
#define XB_TOPGEN   3392
#define XCD_BAR_WORDS 3456
#define XB_SPIN_CAP (1u << 18)
__device__ __forceinline__ unsigned xb_ld(unsigned* p)              { return __hip_atomic_load(p, __ATOMIC_RELAXED, __HIP_MEMORY_SCOPE_AGENT); }
__device__ __forceinline__ unsigned xb_add(unsigned* p, unsigned v) { return __hip_atomic_fetch_add(p, v, __ATOMIC_RELAXED, __HIP_MEMORY_SCOPE_AGENT); }
__device__ __forceinline__ unsigned xb_xcc_id() { return (unsigned)__builtin_amdgcn_s_getreg((3 << 11) | 20) & 0xFu; }
#define XB_SPIN(cond, bar) do { unsigned _sp = 0; while (cond) { __builtin_amdgcn_s_sleep(1); \
    if ((++_sp & 255u) == 0u) { if (xb_ld(&(bar)[XB_TMO])) break; if (_sp > XB_SPIN_CAP) { atomicAdd(&(bar)[XB_TMO], 1u); break; } } } } while (0)
struct XcdBarrier { unsigned* bar; unsigned x; volatile LAS unsigned* st; };
__device__ __forceinline__ XcdBarrier xcd_barrier_post(unsigned* bar, volatile LAS unsigned* st) {
    XcdBarrier b; b.bar = bar; b.x = xb_xcc_id(); b.st = st;
    if (threadIdx.x == 0) (void)xb_add(&bar[XB_XCNT(b.x)], 1u);
    return b;
}
__device__ __forceinline__ void xcd_barrier_complete(unsigned* bar, unsigned x, unsigned& nloc, unsigned& nx) {
    const unsigned G = gridDim.x * gridDim.y * gridDim.z;
    unsigned sum, cnt, mine, sp = 0u;
    for (;;) {
        sum = 0u; cnt = 0u; mine = 0u;
#pragma unroll
        for (unsigned j = 0; j < 16; ++j) { const unsigned c = xb_ld(&bar[XB_XCNT(j)]); sum += c; cnt += (c > 0u) ? 1u : 0u; mine = (j == x) ? c : mine; }
        if (sum == G) break;
        __builtin_amdgcn_s_sleep(1);
        if ((++sp & 255u) == 0u) { if (xb_ld(&bar[XB_TMO])) break; if (sp > XB_SPIN_CAP) { atomicAdd(&bar[XB_TMO], 1u); break; } }
    }
    nloc = mine > 0u ? mine : 1u; nx = cnt > 0u ? cnt : 1u;
}
__device__ __forceinline__ void xcd_barrier(const XcdBarrier& b) {
    asm volatile("s_waitcnt vmcnt(0)" ::: "memory");
    __syncthreads();
    if (threadIdx.x == 0) {
        unsigned* bar = b.bar;
        __builtin_amdgcn_s_waitcnt(0);
        unsigned nloc = b.st[0], nx = b.st[1];
        if (nloc == 0u) { xcd_barrier_complete(bar, b.x, nloc, nx); b.st[0] = nloc; b.st[1] = nx; }
        const unsigned old = xb_add(&bar[XB_XSUB(b.x)], 1u);
        const unsigned gen = old / nloc;
        if (old + 1u == (gen + 1u) * nloc) {
            __builtin_amdgcn_fence(__ATOMIC_RELEASE, "agent");
            asm volatile("s_waitcnt vmcnt(0)" ::: "memory");
            const unsigned og = xb_add(&bar[XB_TOP], 1u);
            const unsigned tg = og / nx;
            if (og + 1u == (tg + 1u) * nx) xb_add(&bar[XB_TOPGEN], 1u);
            else XB_SPIN(xb_ld(&bar[XB_TOPGEN]) == tg, bar);
            __builtin_amdgcn_fence(__ATOMIC_ACQUIRE, "agent");
            xb_add(&bar[XB_XGEN(b.x)], 1u);
            asm volatile("s_waitcnt vmcnt(0)" ::: "memory");
        } else {
            XB_SPIN(xb_ld(&bar[XB_XGEN(b.x)]) == gen, bar);
            __builtin_amdgcn_fence(__ATOMIC_ACQUIRE, "agent");
            asm volatile("s_waitcnt vmcnt(0)" ::: "memory");
        }
    }
    __syncthreads();
}

constexpr int BM = 256, BK = 64, HALF = 128, HTB = HALF * BK * 2, NXCD = 8, WGM = 8;
constexpr int KD = 2048, NT = KD / BK;
__device__ __forceinline__ int lds_byte(int r, int c) { const int st = (r >> 4) * 2 + (c >> 5), rr = r & 15, cc = c & 31, ch = cc >> 3, pc = (rr >> 2) ^ ((0x93 >> (2 * (3 - ch))) & 3) ^ 0; return st * 1024 + rr * 64 + ((((rr >> 2)) ^ ((ch == 0) ? 0 : (ch == 1) ? 3 : (ch == 2) ? 1 : 2)) * 16) + (cc & 7) * 2 + 0 * pc; }
__device__ __forceinline__ void stage_rc(int b, int& R, int& C) { const int st = b / 1024, sb = b % 1024, rr = sb / 64, x = ((sb % 64) / 16) ^ (rr >> 2), ch = (x == 0) ? 0 : (x == 3) ? 1 : (x == 1) ? 2 : 3; R = (st >> 1) * 16 + rr; C = (st & 1) * 32 + ch * 8 + (sb % 16) / 2; }
__device__ __forceinline__ int perm32(int rho) { const int n = rho >> 4, i = rho & 15; return 8 * (i >> 2) + 4 * n + (i & 3); }

struct GU { const char* A; const char* B; int pm, pn, e, mtl; };

__device__ __forceinline__ bool order_next(int i, int G, int c, int nM, int nN, int& pm, int& pn) {
    const int nwg = nM * nN; const long Lx = (long)i * G + c; if (Lx >= nwg) return false;
    int wgid = (int)Lx; { const int q = nwg / NXCD, r = nwg % NXCD, xcd = wgid % NXCD, off = wgid / NXCD; wgid = (xcd < r ? xcd * (q + 1) : r * (q + 1) + (xcd - r) * q) + off; }
    const int nig = WGM * nN, gid = wgid / nig, fm = gid * WGM, gsz = (nM - fm) < WGM ? (nM - fm) : WGM;
    pm = fm + ((wgid % nig) % gsz); pn = (wgid % nig) / gsz; return true;
}

typedef int v8i_t __attribute__((ext_vector_type(8)));
template <class Epi, class Sched, bool F8 = false>
__device__ __forceinline__ void gemm_phase(LAS unsigned char* lds, const Sched& S, const Epi& E) {
    const int tid = threadIdx.x, wid = __builtin_amdgcn_readfirstlane(tid >> 6), lane = tid & 63, wr = wid >> 2, wc = wid & 3, fr = lane & 15, fq = lane >> 4;
    constexpr int ROWB = F8 ? KD : KD * 2;
    constexpr int nt = ROWB / 128;
    int Rr[2], Cc[2]; unsigned voffB[2];
#pragma unroll
    for (int i = 0; i < 2; ++i) { stage_rc(tid * 16 + i * 8192, Rr[i], Cc[i]); const int Rb = Epi::PERM ? ((Rr[i] & ~31) + perm32(Rr[i] & 31)) : Rr[i]; voffB[i] = (unsigned)(Rb * ROWB + Cc[i] * 2); }
    const size_t kstep = (size_t)128;
    const size_t hstep = (size_t)HALF * ROWB;
    const unsigned ldsw = (unsigned)wid * 1024u;
    const int aoff = lds_byte(wr * 64 + fr, fq * 8), boff = lds_byte(wc * 32 + fr, fq * 8);
#define PG8_SA(b, h) (((b) * 2 + (h)) * HTB)
#define PG8_SB(b, h) ((4 + (b) * 2 + (h)) * HTB)
#define PG8_STAGE(bufoff, gbase, voff) do { _Pragma("unroll") for (int _i = 0; _i < 2; ++_i) \
        __builtin_amdgcn_global_load_lds((const unsigned*)((const char*)(gbase) + (voff)[_i]), (LAS unsigned*)(lds + (bufoff) + ldsw + _i * 8192), 16, 0, 0); } while (0)
#define PG8_LDA(dst, b, h) do { _Pragma("unroll") for (int m = 0; m < 4; ++m) _Pragma("unroll") for (int k = 0; k < 2; ++k) dst[m].q[k] = *(const LAS u32x4*)(lds + PG8_SA(b, h) + aoff + m * 2048 + k * 1024); } while (0)
#define PG8_LDB(dst, b, h) do { _Pragma("unroll") for (int n = 0; n < 2; ++n) _Pragma("unroll") for (int k = 0; k < 2; ++k) dst[n].q[k] = *(const LAS u32x4*)(lds + PG8_SB(b, h) + boff + n * 2048 + k * 1024); } while (0)
#define PG8_MMA(ai, bj, At, Bt) do { __builtin_amdgcn_s_setprio(1); _Pragma("unroll") for (int m = 0; m < 4; ++m) _Pragma("unroll") for (int n = 0; n < 2; ++n) { \
        if constexpr (F8) { asm volatile("v_mfma_f32_16x16x128_f8f6f4 %0, %1, %2, %0" : "+v"(acc[ai][bj][m][n]) : "v"(Bt[n].v), "v"(At[m].v)); } \
        else { _Pragma("unroll") for (int k = 0; k < 2; ++k) acc[ai][bj][m][n] = __builtin_amdgcn_mfma_f32_16x16x32_bf16(__builtin_bit_cast(bf16x8, Bt[n].q[k]), __builtin_bit_cast(bf16x8, At[m].q[k]), acc[ai][bj][m][n], 0, 0, 0); } } \
        __builtin_amdgcn_s_setprio(0); } while (0)
#define PG8_WAIT_V(n) asm volatile("s_waitcnt vmcnt(" #n ")" ::: "memory")
#define PG8_WAIT_L(n) asm volatile("s_waitcnt lgkmcnt(" #n ")" ::: "memory")
#define PG8_BAR __builtin_amdgcn_s_barrier()
#define PG8_SCHED __builtin_amdgcn_sched_barrier(0)
    GU cur, nxt; int ui = 0;
    if (!S.next(0, cur)) return;
    f32x4 acc[2][2][4][2];
#pragma unroll
    for (int a = 0; a < 2; ++a)
#pragma unroll
        for (int b = 0; b < 2; ++b)
#pragma unroll
            for (int m = 0; m < 4; ++m)
#pragma unroll
                for (int n = 0; n < 2; ++n) acc[a][b][m][n] = (f32x4){0.f, 0.f, 0.f, 0.f};
    int f8sc = 0x7f7f7f7f; asm volatile("" : "+v"(f8sc));
    union Frag { v8i_t v; u32x4 q[2]; };
    Frag At[4], B0[2], B1[2];
    unsigned oc0[2], oc1[2], on0[2], on1[2];
    S.a_off(cur, Rr, Cc, oc0, oc1);
    const char* cA = cur.A; const char* cB = cur.B;
    PG8_STAGE(PG8_SB(0, 0), cB, voffB); PG8_STAGE(PG8_SB(0, 1), cB + hstep, voffB); PG8_STAGE(PG8_SA(0, 0), cA, oc0); PG8_STAGE(PG8_SA(0, 1), cA, oc1);
    if (wr == 1) PG8_BAR;
    PG8_WAIT_V(2); PG8_BAR;
    PG8_STAGE(PG8_SB(1, 0), cB + kstep, voffB); PG8_STAGE(PG8_SA(1, 0), cA + kstep, oc0); PG8_STAGE(PG8_SB(1, 1), cB + hstep + kstep, voffB);
    PG8_WAIT_V(6); PG8_BAR;
    for (;;) {
        const bool has_next = S.next(ui + 1, nxt);
        const char* nA = has_next ? nxt.A : cA; const char* nB = has_next ? nxt.B : cB;
        for (int t = 0; t < nt; t += 2) {
            const bool last = (t == nt - 2);
            const char* a1 = cA + (size_t)(t + 1) * kstep;
            const char* a2 = last ? nA : cA + (size_t)(t + 2) * kstep; const char* b2 = last ? nB : cB + (size_t)(t + 2) * kstep;
            const char* a3 = a2 + kstep; const char* b3 = b2 + kstep;
            unsigned o20[2], o21[2];
            if (last) {
                if (has_next) S.a_off(nxt, Rr, Cc, on0, on1); else { on0[0] = oc0[0]; on0[1] = oc0[1]; on1[0] = oc1[0]; on1[1] = oc1[1]; }
                o20[0] = on0[0]; o20[1] = on0[1]; o21[0] = on1[0]; o21[1] = on1[1];
            } else { o20[0] = oc0[0]; o20[1] = oc0[1]; o21[0] = oc1[0]; o21[1] = oc1[1]; }
            PG8_LDB(B0, 0, 0); PG8_LDB(B1, 0, 1); PG8_SCHED; PG8_LDA(At, 0, 0); PG8_STAGE(PG8_SA(1, 1), a1, oc1);
            PG8_WAIT_V(8); PG8_WAIT_L(0); PG8_BAR; PG8_MMA(0, 0, At, B0); PG8_MMA(0, 1, At, B1); PG8_BAR; PG8_SCHED;
            PG8_LDA(At, 0, 1); PG8_STAGE(PG8_SB(0, 0), b2, voffB); PG8_STAGE(PG8_SB(0, 1), b2 + hstep, voffB); PG8_STAGE(PG8_SA(0, 0), a2, o20);
            PG8_WAIT_V(8); PG8_WAIT_L(0); PG8_BAR; PG8_MMA(1, 0, At, B0); PG8_MMA(1, 1, At, B1); PG8_BAR; PG8_SCHED;
            PG8_LDB(B0, 1, 0); PG8_LDB(B1, 1, 1); PG8_SCHED; PG8_LDA(At, 1, 0); PG8_STAGE(PG8_SA(0, 1), a2, o21);
            PG8_WAIT_V(8); PG8_WAIT_L(0); PG8_BAR; PG8_MMA(0, 0, At, B0); PG8_MMA(0, 1, At, B1); PG8_BAR; PG8_SCHED;
            PG8_LDA(At, 1, 1); PG8_STAGE(PG8_SB(1, 0), b3, voffB); PG8_STAGE(PG8_SB(1, 1), b3 + hstep, voffB); PG8_STAGE(PG8_SA(1, 0), a3, o20);
            PG8_WAIT_V(8); PG8_WAIT_L(0); PG8_BAR; PG8_MMA(1, 0, At, B0); PG8_MMA(1, 1, At, B1); PG8_BAR; PG8_SCHED;
        }
        if (wr == 0) PG8_BAR;
        if constexpr (F8) asm volatile("s_nop 15\n\ts_nop 15" ::: "memory");
        E(acc, cur, wr, wc, fr, fq);
        if (!has_next) break;
#pragma unroll
        for (int a = 0; a < 2; ++a)
#pragma unroll
            for (int b = 0; b < 2; ++b)
#pragma unroll
                for (int m = 0; m < 4; ++m)
#pragma unroll
                    for (int n = 0; n < 2; ++n) acc[a][b][m][n] = (f32x4){0.f, 0.f, 0.f, 0.f};
        cur = nxt; cA = nA; cB = nB; ++ui;
        oc0[0] = on0[0]; oc0[1] = on0[1]; oc1[0] = on1[0]; oc1[1] = on1[1];
        if (wr == 1) PG8_BAR;
    }
    PG8_WAIT_V(0);
    PG8_BAR;
#undef PG8_SA
#undef PG8_SB
#undef PG8_STAGE
#undef PG8_LDA
#undef PG8_LDB
#undef PG8_MMA
#undef PG8_WAIT_V
#undef PG8_WAIT_L
#undef PG8_BAR
#undef PG8_SCHED
}

struct SchedDense {
    const bf16_t* A; const bf16_t* Bt; int nM, nN, G, c;
    __device__ __forceinline__ bool next(int i, GU& u) const {
        int pm, pn; if (!order_next(i, G, c, nM, nN, pm, pn)) return false;
        u.pm = pm; u.pn = pn; u.e = 0; u.mtl = pm; u.A = (const char*)A; u.B = (const char*)Bt + (size_t)pn * (256 * KD * 2); return true;
    }
    __device__ __forceinline__ void a_off(const GU& u, const int (&R)[2], const int (&C)[2], unsigned (&o0)[2], unsigned (&o1)[2]) const {
#pragma unroll
        for (int i = 0; i < 2; ++i) { o0[i] = (unsigned)((u.pm * 256 + R[i]) * KD + C[i]) * 2u; o1[i] = (unsigned)((u.pm * 256 + 128 + R[i]) * KD + C[i]) * 2u; }
    }
};
template <int ROWB>
struct SchedMoe {
    const void* A; const void* Bt; size_t bstride_e;
    const int* list; const LAS int* pts; const LAS int* cntl; const LAS unsigned char* tileE;
    int nM, nN, G, c; bool gather;
    __device__ __forceinline__ bool next(int i, GU& u) const {
        int pm, pn; if (!order_next(i, G, c, nM, nN, pm, pn)) return false;
        const int e = __builtin_amdgcn_readfirstlane((int)tileE[pm]);
        u.pm = pm; u.pn = pn; u.e = e; u.mtl = pm - __builtin_amdgcn_readfirstlane(pts[e]);
        u.A = (const char*)A; u.B = (const char*)Bt + (size_t)e * bstride_e + (size_t)pn * (256 * ROWB); return true;
    }
    __device__ __forceinline__ void a_off(const GU& u, const int (&R)[2], const int (&C)[2], unsigned (&o0)[2], unsigned (&o1)[2]) const {
        if (gather) {
            const int ce = __builtin_amdgcn_readfirstlane(cntl[u.e]);
            const int* lp = list + (size_t)u.e * LISTCAP;
#pragma unroll
            for (int i = 0; i < 2; ++i) {
                int i0 = u.mtl * 256 + R[i], i1 = i0 + 128;
                i0 = i0 < ce ? i0 : 0; i1 = i1 < ce ? i1 : 0;
                const int t0 = lp[i0], t1 = lp[i1];
                o0[i] = (unsigned)(t0 * ROWB + C[i] * 2); o1[i] = (unsigned)(t1 * ROWB + C[i] * 2);
            }
        } else {
#pragma unroll
            for (int i = 0; i < 2; ++i) { o0[i] = (unsigned)((u.pm * 256 + R[i]) * ROWB + C[i] * 2); o1[i] = (unsigned)((u.pm * 256 + 128 + R[i]) * ROWB + C[i] * 2); }
        }
    }
};

__device__ __forceinline__ u32x4 pack8(const f32x4& a, const f32x4& b) { u32x4 w; w.x = cvt_pk_bf16(a[0], a[1]); w.y = cvt_pk_bf16(a[2], a[3]); w.z = cvt_pk_bf16(b[0], b[1]); w.w = cvt_pk_bf16(b[2], b[3]); return w; }

struct EpiInProj {
    static constexpr bool PERM = true;
    bf16_t *QH, *KH, *VH, *OG, *AQ, *AK, *AV; float* GH; const float* lb; const float* bqkv;
    __device__ __forceinline__ void operator()(const f32x4 (&acc)[2][2][4][2], const GU& u, int wr, int wc, int fr, int fq) const {
        const int row0 = u.pm * BM + wr * 64 + fr;
        const int type = u.pn >> 2;
        const int cw = wc * 32 + 8 * fq;
#pragma unroll
        for (int bj = 0; bj < 2; ++bj) {
            const int col = (u.pn & 3) * 256 + bj * HALF + cw;
            if (type == 0 || type == 3) {
                bf16_t* O = (type == 0 ? QH : OG);
#pragma unroll
                for (int ai = 0; ai < 2; ++ai)
#pragma unroll
                    for (int m = 0; m < 4; ++m) { f32x4 v0 = acc[ai][bj][m][0], v1 = acc[ai][bj][m][1];
#pragma unroll
                        for (int j = 0; j < 4; ++j) { v0[j] = v0[j] * sigm(v0[j]); v1[j] = v1[j] * sigm(v1[j]); }
                        *(u32x4*)(O + (size_t)(row0 + ai * HALF + m * 16) * 1024 + col) = pack8(v0, v1); }
            } else if (type == 1) {
                const f32x4 l0 = *(const f32x4*)(lb + col), l1 = *(const f32x4*)(lb + col + 4);
#pragma unroll
                for (int ai = 0; ai < 2; ++ai)
#pragma unroll
                    for (int m = 0; m < 4; ++m) { f32x4 v0 = acc[ai][bj][m][0], v1 = acc[ai][bj][m][1], g0, g1;
#pragma unroll
                        for (int j = 0; j < 4; ++j) { const float s0 = sigm(v0[j]), s1 = sigm(v1[j]);
                            const float f0 = l0[j] + (1.f - l0[j]) * s0, f1 = l1[j] + (1.f - l1[j]) * s1;
                            g0[j] = __log2f(f0); g1[j] = __log2f(f1); }
                        const size_t o = (size_t)(row0 + ai * HALF + m * 16) * 1024 + col;
                        *(f32x4*)(GH + o) = g0; *(f32x4*)(GH + o + 4) = g1; }
            } else if (type == 2) {
#pragma unroll
                for (int ai = 0; ai < 2; ++ai)
#pragma unroll
                    for (int m = 0; m < 4; ++m) *(u32x4*)(VH + (size_t)(row0 + ai * HALF + m * 16) * 1024 + col) = pack8(acc[ai][bj][m][0], acc[ai][bj][m][1]);
            } else if (type == 4) {
                const f32x4 b0 = *(const f32x4*)(bqkv + col), b1 = *(const f32x4*)(bqkv + col + 4);
#pragma unroll
                for (int ai = 0; ai < 2; ++ai)
#pragma unroll
                    for (int m = 0; m < 4; ++m) { const f32x4 v0 = (acc[ai][bj][m][0] + b0) * 0.125f, v1 = (acc[ai][bj][m][1] + b1) * 0.125f;
                        *(u32x4*)(AQ + (size_t)(row0 + ai * HALF + m * 16) * 1024 + col) = pack8(v0, v1); }
            } else {
                bf16_t* O = bj == 0 ? AK : AV;
                const f32x4 b0 = *(const f32x4*)(bqkv + 1024 + bj * 128 + cw), b1 = *(const f32x4*)(bqkv + 1024 + bj * 128 + cw + 4);
#pragma unroll
                for (int ai = 0; ai < 2; ++ai)
#pragma unroll
                    for (int m = 0; m < 4; ++m) *(u32x4*)(O + (size_t)(row0 + ai * HALF + m * 16) * 128 + cw) = pack8(acc[ai][bj][m][0] + b0, acc[ai][bj][m][1] + b1);
            }
        }
    }
};
struct EpiOutProj {
    static constexpr bool PERM = true;
    bf16_t* Z; const bf16_t* H0; const float* bo;
    __device__ __forceinline__ void operator()(const f32x4 (&acc)[2][2][4][2], const GU& u, int wr, int wc, int fr, int fq) const {
        const int row0 = u.pm * BM + wr * 64 + fr, col0 = u.pn * BM + wc * 32 + 8 * fq;
        f32x4 b4[2][2];
#pragma unroll
        for (int bj = 0; bj < 2; ++bj)
#pragma unroll
            for (int n = 0; n < 2; ++n) b4[bj][n] = *(const f32x4*)(bo + col0 + bj * HALF + n * 4);
#pragma unroll
        for (int ai = 0; ai < 2; ++ai) {
            u32x4 hv[4][2];
#pragma unroll
            for (int m = 0; m < 4; ++m)
#pragma unroll
                for (int bj = 0; bj < 2; ++bj) hv[m][bj] = *(const u32x4*)(H0 + (size_t)(row0 + ai * HALF + m * 16) * D + col0 + bj * HALF);
#pragma unroll
            for (int m = 0; m < 4; ++m)
#pragma unroll
                for (int bj = 0; bj < 2; ++bj) {
                    const u32x4 h = hv[m][bj];
                    f32x4 z0, z1;
                    z0[0] = __uint_as_float(h.x << 16); z0[1] = __uint_as_float(h.x & 0xffff0000u); z0[2] = __uint_as_float(h.y << 16); z0[3] = __uint_as_float(h.y & 0xffff0000u);
                    z1[0] = __uint_as_float(h.z << 16); z1[1] = __uint_as_float(h.z & 0xffff0000u); z1[2] = __uint_as_float(h.w << 16); z1[3] = __uint_as_float(h.w & 0xffff0000u);
                    z0 = z0 * ALPHA + b4[bj][0] + acc[ai][bj][m][0]; z1 = z1 * ALPHA + b4[bj][1] + acc[ai][bj][m][1];
                    *(u32x4*)(Z + (size_t)(row0 + ai * HALF + m * 16) * D + col0 + bj * HALF) = pack8(z0, z1);
                }
        }
    }
};
__device__ __forceinline__ unsigned pk4_fp8(float a, float b, float c, float d) {
    a = fminf(fmaxf(a, -448.f), 448.f); b = fminf(fmaxf(b, -448.f), 448.f); c = fminf(fmaxf(c, -448.f), 448.f); d = fminf(fmaxf(d, -448.f), 448.f);
    int w = __builtin_amdgcn_cvt_pk_fp8_f32(a, b, 0, false); w = __builtin_amdgcn_cvt_pk_fp8_f32(c, d, w, true); return (unsigned)w;
}
constexpr float SC_H1 = 32.f, SC_WGU = 2048.f, SC_HACT = 8.f, SC_WD = 4096.f;
struct EpiMoe1F8 {
    static constexpr bool PERM = true;
    unsigned char* H; const float* bg; const float* bu;
    __device__ __forceinline__ void operator()(const f32x4 (&acc)[2][2][4][2], const GU& u, int wr, int wc, int fr, int fq) const {
        const int row0 = u.pm * BM + wr * 64 + fr, hc = u.pn * 128 + wc * 32 + 8 * fq;
        const float* bgp = bg + (size_t)u.e * FF + hc; const float* bup = bu + (size_t)u.e * FF + hc;
        const f32x4 g0b = *(const f32x4*)bgp, g1b = *(const f32x4*)(bgp + 4), u0b = *(const f32x4*)bup, u1b = *(const f32x4*)(bup + 4);
        constexpr float IS = 1.f / (SC_H1 * SC_WGU);
#pragma unroll
        for (int ai = 0; ai < 2; ++ai)
#pragma unroll
            for (int m = 0; m < 4; ++m) {
                f32x4 a0 = acc[ai][0][m][0] * IS + g0b, a1 = acc[ai][0][m][1] * IS + g1b, c0 = acc[ai][1][m][0] * IS + u0b, c1 = acc[ai][1][m][1] * IS + u1b;
#pragma unroll
                for (int j = 0; j < 4; ++j) {
                    const float gg0 = fminf(a0[j], 7.f), gg1 = fminf(a1[j], 7.f);
                    const float uu0 = fminf(fmaxf(c0[j], -7.f), 7.f), uu1 = fminf(fmaxf(c1[j], -7.f), 7.f);
                    a0[j] = SC_HACT * gg0 * sigm(1.702f * gg0) * (uu0 + 1.f); a1[j] = SC_HACT * gg1 * sigm(1.702f * gg1) * (uu1 + 1.f);
                }
                u32x2 o; o.x = pk4_fp8(a0[0], a0[1], a0[2], a0[3]); o.y = pk4_fp8(a1[0], a1[1], a1[2], a1[3]);
                *(u32x2*)(H + (size_t)(row0 + ai * HALF + m * 16) * FF + hc) = o;
            }
    }
};
struct EpiMoe2F8 {
    static constexpr bool PERM = true;
    bf16_t* Y; const float* bd;
    __device__ __forceinline__ void operator()(const f32x4 (&acc)[2][2][4][2], const GU& u, int wr, int wc, int fr, int fq) const {
        const int row0 = u.pm * BM + wr * 64 + fr, col0 = u.pn * BM + wc * 32 + 8 * fq;
        const float* bp = bd + (size_t)u.e * D + col0;
        constexpr float IS = 1.f / (SC_HACT * SC_WD);
#pragma unroll
        for (int bj = 0; bj < 2; ++bj) {
            const f32x4 b0 = *(const f32x4*)(bp + bj * HALF), b1 = *(const f32x4*)(bp + bj * HALF + 4);
#pragma unroll
            for (int ai = 0; ai < 2; ++ai)
#pragma unroll
                for (int m = 0; m < 4; ++m) *(u32x4*)(Y + (size_t)(row0 + ai * HALF + m * 16) * D + col0 + bj * HALF) = pack8(acc[ai][bj][m][0] * IS + b0, acc[ai][bj][m][1] * IS + b1);
        }
    }
};
struct Args { const float* in[23]; float* out; unsigned char* ws; int ph_lo, ph_hi; };
struct Frame { LAS unsigned char* lds; int tid, lane, wave, G, vcu; unsigned char* ws; };

__device__ __forceinline__ void p0_transpose_item(const float* W, int N, int k0, int n0, bf16_t* WT_row0  , LAS float* scr, int lane) {
#pragma unroll 8
    for (int i = 0; i < 32; ++i) { const int kk = 2 * i + (lane >> 5); scr[kk * 33 + (lane & 31)] = W[(size_t)(k0 + kk) * N + n0 + (lane & 31)]; }
    asm volatile("s_waitcnt lgkmcnt(0)" ::: "memory");
    const int c = lane & 7;
#pragma unroll
    for (int j = 0; j < 4; ++j) { const int n = (lane >> 3) + 8 * j; const LAS float* s = scr + (8 * c) * 33 + n;
        u32x4 o; o.x = pk2(s[0 * 33], s[1 * 33]); o.y = pk2(s[2 * 33], s[3 * 33]); o.z = pk2(s[4 * 33], s[5 * 33]); o.w = pk2(s[6 * 33], s[7 * 33]);
        *(GAS u32x4*)(WT_row0 + (size_t)n * KD + k0 + 8 * c) = o; }
    asm volatile("s_waitcnt lgkmcnt(0)" ::: "memory");
}

__device__ __forceinline__ void p0_prologue(Frame& F, const Args& a) {
    LAS float* scr = (LAS float*)(F.lds + F.wave * 16384);
    const int gw = F.vcu * NWAVES + F.wave, NGW = F.G * NWAVES;
    unsigned char* ws = F.ws;
    for (int i = gw * 64 + F.lane; i < NE * D; i += NGW * 64) { const int e = i >> 11, k = i & 2047; ((_Float16*)(ws + WS_WRH))[i] = (_Float16)(a.in[13][(size_t)k * NE + e] * 64.f); }
    if (gw < 16) { const int i = gw * 64 + F.lane; const float* lbl = a.in[5]; const float l0 = lbl[i], l1 = lbl[1024 + i]; const float mx = fmaxf(l0, l1); const float e0 = __expf(l0 - mx), e1 = __expf(l1 - mx);
        ((float*)(ws + WS_LB))[i] = e0 / (e0 + e1); }
    {
        const float* x = a.in[0]; const float* w = a.in[1]; const float* b = a.in[2];
        bf16_t* H0 = (bf16_t*)(ws + WS_H0);
        f32x4 wwv[8], bbv[8];
#pragma unroll
        for (int j = 0; j < 8; ++j) { wwv[j] = *((const f32x4*)w + F.lane + 64 * j); bbv[j] = *((const f32x4*)b + F.lane + 64 * j); }
        for (int m = gw; m < T; m += NGW) {
            const GAS f32x4* xr = (const GAS f32x4*)(x + (size_t)m * D) + F.lane;
            f32x4 v[8]; float s = 0.f;
#pragma unroll
            for (int j = 0; j < 8; ++j) { v[j] = xr[64 * j]; s += (v[j][0] + v[j][1]) + (v[j][2] + v[j][3]); }
            const float mean = wave_sum(s) * (1.f / D); float s2 = 0.f;
#pragma unroll
            for (int j = 0; j < 8; ++j) { v[j] = v[j] - mean; s2 += (v[j][0] * v[j][0] + v[j][1] * v[j][1]) + (v[j][2] * v[j][2] + v[j][3] * v[j][3]); }
            const float rstd = rsqrtf(wave_sum(s2) * (1.f / D) + EPS);
            GAS u32x2* o8 = (GAS u32x2*)(H0 + (size_t)m * D) + F.lane;
#pragma unroll
            for (int j = 0; j < 8; ++j) { const f32x4 ww = wwv[j], bb = bbv[j];
                u32x2 o; o.x = pk2(v[j][0] * rstd * ww[0] + bb[0], v[j][1] * rstd * ww[1] + bb[1]); o.y = pk2(v[j][2] * rstd * ww[2] + bb[2], v[j][3] * rstd * ww[3] + bb[3]); o8[64 * j] = o; }
        }
    }
    constexpr int I_IN = 32 * (INC / 32), I_OUT = 32 * 64;
    constexpr int NITEMS = I_IN + I_OUT;
    for (int it = gw; it < NITEMS; it += NGW) {
        int r = it;
        if (r < I_IN) { const int nb = INC / 32, kb = r / nb, n0 = 32 * (r % nb); p0_transpose_item(a.in[3], INC, 64 * kb, n0, (bf16_t*)(ws + WS_WIN) + (size_t)n0 * KD, scr, F.lane); continue; } r -= I_IN;
        { const int kb = r / 64, n0 = 32 * (r % 64); p0_transpose_item(a.in[9], D, 64 * kb, n0, (bf16_t*)(ws + WS_WOUT) + (size_t)n0 * KD, scr, F.lane); }
    }
}

constexpr int CT_TILES = NE * 3 * 32 * 16, CT_RUN = 8;
constexpr int LC_CTB = 1024;
__device__ __forceinline__ void ct_src(const Args& a, unsigned char* ws, int id, const float*& W, unsigned char*& dst, float& sc, int& k0) {
    const int e = id / 1536, r = id - e * 1536, which = r >> 9, r2 = r & 511, kb = r2 >> 4, nb = r2 & 15;
    k0 = kb * 64;
    if (which < 2) { W = a.in[which == 0 ? 15 : 17] + (size_t)e * D * FF + nb * 128; dst = ws + WS_WGU + ((size_t)e * 4096 + (size_t)nb * 256 + which * 128) * KD; sc = SC_WGU; }
    else { W = a.in[19] + (size_t)e * FF * D + nb * 128; dst = ws + WS_WD + ((size_t)e * 2048 + (size_t)nb * 128) * KD; sc = SC_WD; }
}
__device__ __forceinline__ void cv_worker(Frame& F, const Args& a, const unsigned* stop_ctr, unsigned stop_at) {
    const int tid = F.tid, lane = F.lane, wv = F.wave;
    LAS unsigned char* ring = F.lds;
    volatile LAS int* ctb = (volatile LAS int*)(F.lds + LDSCTL_OFF + LC_CTB);
    unsigned* head = (unsigned*)(F.ws + WS_CTL) + CW_CONV;
    unsigned srcoff[4];
#pragma unroll
    for (int p = 0; p < 4; ++p) { const int row = 2 * (4 * wv + p) + (lane >> 5); srcoff[p] = (unsigned)(row * 2048 + 4 * ((lane & 31) ^ (2 * ((row >> 4) & 3)))); }
    const int on = tid >> 2, oc = tid & 3;
    const int rdoff = (16 * oc) * 128 * 4 + ((((on >> 2) ^ (2 * oc)) << 2) + (on & 3)) * 4;
#define CT_CLAIM(slotw) do { if (tid == 0) { int b_ = CT_TILES; if (!(stop_ctr && __hip_atomic_load(stop_ctr, RLX_AGENT) >= stop_at)) b_ = (int)__hip_atomic_fetch_add(head, (unsigned)CT_RUN, RLX_AGENT); ctb[slotw] = b_; } } while (0)
#define CT_DMA(id_, slot_) do { const float* W_; unsigned char* d_; float s_; int k_; ct_src(a, F.ws, (id_), W_, d_, s_, k_); const float* sp_ = W_ + (size_t)k_ * 2048; \
        _Pragma("unroll") for (int p = 0; p < 4; ++p) __builtin_amdgcn_global_load_lds((const unsigned*)(sp_ + srcoff[p]), (LAS unsigned*)(ring + (slot_) * 32768 + (4 * wv + p) * 1024), 16, 0, 0); } while (0)
    __syncthreads();
    CT_CLAIM(0);
    __syncthreads();
    int base = ctb[0];
    int issued = 0;
    bool more = base < CT_TILES;
#pragma unroll 1
    for (int i = 0; i < 3; ++i) { if (more) { CT_DMA(base + (issued & (CT_RUN - 1)), issued & 3); } ++issued; }
    int pbase = base;
    for (int k = 0; ; ++k) {
        if (((k + 3) & (CT_RUN - 1)) == 0) CT_CLAIM(((k + 3) / CT_RUN) & 1);
        if (pbase >= CT_TILES) break;
        asm volatile("s_waitcnt vmcnt(10)" ::: "memory");
        if (!more) asm volatile("s_waitcnt vmcnt(0)" ::: "memory");
        __syncthreads();
        {
            const float* W_; unsigned char* dst; float sc; int k0; ct_src(a, F.ws, pbase + (k & (CT_RUN - 1)), W_, dst, sc, k0);
            const LAS float* sp = (const LAS float*)(ring + (k & 3) * 32768 + rdoff);
            u32x4 o;
            o.x = pk4_fp8(sp[0 * 128] * sc, sp[1 * 128] * sc, sp[2 * 128] * sc, sp[3 * 128] * sc); o.y = pk4_fp8(sp[4 * 128] * sc, sp[5 * 128] * sc, sp[6 * 128] * sc, sp[7 * 128] * sc);
            o.z = pk4_fp8(sp[8 * 128] * sc, sp[9 * 128] * sc, sp[10 * 128] * sc, sp[11 * 128] * sc); o.w = pk4_fp8(sp[12 * 128] * sc, sp[13 * 128] * sc, sp[14 * 128] * sc, sp[15 * 128] * sc);
            *(GAS u32x4*)(dst + (size_t)on * KD + k0 + 16 * oc) = o;
            asm volatile("s_waitcnt lgkmcnt(0)" ::: "memory");
        }
        if (((k + 3) & (CT_RUN - 1)) == 0) { base = ctb[((k + 3) / CT_RUN) & 1]; more = base < CT_TILES; }
        if (more) { CT_DMA(base + ((k + 3) & (CT_RUN - 1)), (k + 3) & 3); }
        if (((k + 1) & (CT_RUN - 1)) == 0) pbase = ctb[((k + 1) / CT_RUN) & 1];
    }
    asm volatile("s_waitcnt vmcnt(0)" ::: "memory");
    __syncthreads();
#undef CT_CLAIM
#undef CT_DMA
}

constexpr int AT_Q = 32;
typedef float f32x16 __attribute__((ext_vector_type(16)));
typedef short s16x4 __attribute__((ext_vector_type(4)));
typedef short v4i16_t __attribute__((ext_vector_type(4)));
__device__ __forceinline__ s16x4 lds_tr16(const LAS unsigned char* p) { return __builtin_bit_cast(s16x4, __builtin_amdgcn_ds_read_tr16_b64_v4i16((LAS v4i16_t*)p)); }
__device__ __forceinline__ void attn_unit_mfma(Frame& F, const Args& a, int b, int qt) {
    LAS unsigned char* KS = F.lds;
    LAS unsigned char* VS = F.lds + 40960;
    LAS float* SSQ = (LAS float*)(F.lds + 81920);
    LAS float* NWL = (LAS float*)(F.lds + 83968);
    const bf16_t* AQ = (const bf16_t*)(F.ws + WS_AQ); const bf16_t* AK = (const bf16_t*)(F.ws + WS_AK); const bf16_t* AV = (const bf16_t*)(F.ws + WS_AV);
    bf16_t* YM = (bf16_t*)(F.ws + WS_YMIX);
    const int tid = F.tid, lane = F.lane, w = F.wave, r32 = lane & 31, hi = lane >> 5, t0 = qt * 32;
    __syncthreads();
#pragma unroll
    for (int p = 0; p < 5; ++p) {
        const int c = p * 512 + tid, row = c >> 4, ch = c & 15, kvh = ch >> 3, cr = ch & 7;
        const int pos = t0 - 128 + row;
        u32x4 kv = (u32x4){0u, 0u, 0u, 0u}, vv = (u32x4){0u, 0u, 0u, 0u};
        if (pos >= 0) { const size_t o = (size_t)(b * L + pos) * 128 + kvh * 64 + cr * 8; kv = *(const u32x4*)(AK + o); vv = *(const u32x4*)(AV + o); }
        *(LAS u32x4*)(KS + kvh * 20480 + row * 128 + ((cr ^ ((row >> 1) & 7)) << 4)) = kv;
        *(LAS u32x4*)(VS + kvh * 20480 + row * 128 + (((cr >> 2) ^ ((row >> 1) & 1)) << 6) + ((cr & 3) << 4)) = vv;
    }
    __syncthreads();
    if (tid < 256) *(LAS f32x4*)(NWL + 4 * tid) = *(const f32x4*)(a.in[8] + 4 * tid);
    const int kvh = w >> 2;
    const int ktmin = t0 < 128 ? (128 - t0) >> 5 : 0;
    const LAS unsigned char* Kb = KS + kvh * 20480;
    const LAS unsigned char* Vb = VS + kvh * 20480;
    unsigned OP[2][2][8];
    float ssq = 0.f;
#pragma unroll
    for (int hh = 0; hh < 2; ++hh) {
        const int head = 2 * w + hh;
        bf16x8 qf[4];
#pragma unroll
        for (int ks = 0; ks < 4; ++ks) qf[ks] = *(const bf16x8*)(AQ + (size_t)(b * L + t0 + r32) * 1024 + head * 64 + ks * 16 + hi * 8);
        f32x16 S[5];
#pragma unroll
        for (int kt = 0; kt < 5; ++kt) {
            const int row = kt * 32 + r32;
            f32x16 acc = (f32x16){0.f, 0.f, 0.f, 0.f, 0.f, 0.f, 0.f, 0.f, 0.f, 0.f, 0.f, 0.f, 0.f, 0.f, 0.f, 0.f};
#pragma unroll
            for (int ks = 0; ks < 4; ++ks) {
                const bf16x8 kf = *(const LAS bf16x8*)(Kb + row * 128 + (((2 * ks + hi) ^ ((row >> 1) & 7)) << 4));
                acc = __builtin_amdgcn_mfma_f32_32x32x16_bf16(kf, qf[ks], acc, 0, 0, 0);
            }
            S[kt] = acc;
        }
        const float sink = a.in[7][head];
        float m = sink;
#pragma unroll
        for (int kt = 0; kt < 5; ++kt)
#pragma unroll
            for (int r = 0; r < 16; ++r) {
                const int i = (r & 3) + 8 * (r >> 2) + 4 * hi;
                bool ok = kt >= ktmin;
                if (kt == 0) ok = ok && (i > r32);
                if (kt == 4) ok = ok && (i <= r32);
                const float v = ok ? S[kt][r] : -INFINITY;
                S[kt][r] = v; m = fmaxf(m, v);
            }
        m = fmaxf(m, __shfl_xor(m, 32));
        float l = 0.f;
#pragma unroll
        for (int kt = 0; kt < 5; ++kt)
#pragma unroll
            for (int r = 0; r < 16; ++r) { const float pv = __expf(S[kt][r] - m); S[kt][r] = pv; l += pv; }
        l += __shfl_xor(l, 32);
        l += __expf(sink - m);
        const float inv = 1.f / l;
#pragma unroll
        for (int dt = 0; dt < 2; ++dt) {
            f32x16 acc = (f32x16){0.f, 0.f, 0.f, 0.f, 0.f, 0.f, 0.f, 0.f, 0.f, 0.f, 0.f, 0.f, 0.f, 0.f, 0.f, 0.f};
            const int dcol = dt * 32 + 16 * ((lane >> 4) & 1) + 4 * (lane & 3);
            const int vlane = ((lane & 15) >> 2) * 128 + ((((dcol >> 5) ^ ((lane >> 3) & 1))) << 6) + (dcol & 31) * 2;
#pragma unroll
            for (int kt = 0; kt < 5; ++kt)
#pragma unroll
                for (int s2 = 0; s2 < 2; ++s2) {
                    const int rowb = kt * 32 + 16 * s2 + 4 * hi;
                    const s16x4 lo = lds_tr16(Vb + rowb * 128 + vlane), hi4 = lds_tr16(Vb + (rowb + 8) * 128 + vlane);
                    const bf16x8 vf = (bf16x8){lo[0], lo[1], lo[2], lo[3], hi4[0], hi4[1], hi4[2], hi4[3]};
                    u32x4 pw; pw.x = cvt_pk_bf16(S[kt][8 * s2 + 0], S[kt][8 * s2 + 1]); pw.y = cvt_pk_bf16(S[kt][8 * s2 + 2], S[kt][8 * s2 + 3]);
                    pw.z = cvt_pk_bf16(S[kt][8 * s2 + 4], S[kt][8 * s2 + 5]); pw.w = cvt_pk_bf16(S[kt][8 * s2 + 6], S[kt][8 * s2 + 7]);
                    acc = __builtin_amdgcn_mfma_f32_32x32x16_bf16(vf, __builtin_bit_cast(bf16x8, pw), acc, 0, 0, 0);
                }
#pragma unroll
            for (int r = 0; r < 16; ++r) { acc[r] *= inv; ssq += acc[r] * acc[r]; }
#pragma unroll
            for (int r = 0; r < 8; ++r) OP[hh][dt][r] = cvt_pk_bf16(acc[2 * r], acc[2 * r + 1]);
        }
    }
    ssq += __shfl_xor(ssq, 32);
    if (hi == 0) SSQ[w * 32 + r32] = ssq;
    __syncthreads();
    float tot = 0.f;
#pragma unroll
    for (int ww = 0; ww < 8; ++ww) tot += SSQ[ww * 32 + r32];
    const float rr = rsqrtf(tot * (1.f / 1024.f) + EPS);
#pragma unroll
    for (int hh = 0; hh < 2; ++hh)
#pragma unroll
        for (int dt = 0; dt < 2; ++dt)
#pragma unroll
            for (int g4 = 0; g4 < 4; ++g4) {
                const int d = (2 * w + hh) * 64 + dt * 32 + 8 * g4 + 4 * hi;
                const f32x4 nw4 = *(const LAS f32x4*)(NWL + d);
                const unsigned p0 = OP[hh][dt][2 * g4], p1 = OP[hh][dt][2 * g4 + 1];
                u32x2 o; o.x = pk2(bflo(p0) * rr * nw4[0], bfhi(p0) * rr * nw4[1]); o.y = pk2(bflo(p1) * rr * nw4[2], bfhi(p1) * rr * nw4[3]);
                *(u32x2*)(YM + (size_t)(b * L + t0 + r32) * D + 1024 + d) = o;
            }
}

constexpr int HL_QM = 0, HL_KM = 16384, HL_QS = 32768, HL_KE = 49152, HL_VT = 65536, HL_PL = 81920, HL_SEG = 90112, HL_DS = 94208, HL_SSQ = 94720;
__device__ __forceinline__ int trkey(int s) { return (s & 3) | (((s >> 3) & 1) << 2); }
__device__ __forceinline__ bf16x8 mk8(const s16x4& lo, const s16x4& hi) { return (bf16x8){lo[0], lo[1], lo[2], lo[3], hi[0], hi[1], hi[2], hi[3]}; }
__device__ __forceinline__ void hgrn_unit_mfma(Frame& F, const Args& a, int b, int h) {
    LAS unsigned char* lds = F.lds;
    const bf16_t* QH = (const bf16_t*)(F.ws + WS_QH); const bf16_t* VH = (const bf16_t*)(F.ws + WS_VH); const bf16_t* OG = (const bf16_t*)(F.ws + WS_OG);
    const float* GH = (const float*)(F.ws + WS_GH);
    bf16_t* YM = (bf16_t*)(F.ws + WS_YMIX);
    const int tid = F.tid, lane = F.lane, w = F.wave, r16 = lane & 15, g = lane >> 4, cp = lane;
    const size_t tokb = (size_t)b * L;
    const int hc = h * 128;
    f32x4 Sacc[8];
#pragma unroll
    for (int i = 0; i < 8; ++i) Sacc[i] = (f32x4){0.f, 0.f, 0.f, 0.f};
    f32x2 gpre[8]; unsigned qpre[8]; u32x4 vpre[2];
    const int vrow = tid >> 3, vc16 = tid & 7;
    const unsigned lo_g = 2u * (unsigned)cp, lo_v = (unsigned)(vrow * 1024 + vc16 * 8), lo_og = (unsigned)(r16 * 1024 + 4 * g), lo_ym = (unsigned)(r16 * 2048 + 4 * g);
    {
        const size_t rb = (tokb + 8 * w) * 1024 + hc;
        const float* gb = GH + rb; const bf16_t* qb = QH + rb; const bf16_t* vb = VH + tokb * 1024 + hc;
#pragma unroll
        for (int i = 0; i < 8; ++i) { gpre[i] = *(const f32x2*)(gb + i * 1024 + lo_g); qpre[i] = *(const unsigned*)(qb + i * 1024 + lo_g); }
        vpre[0] = *(const u32x4*)(vb + lo_v); vpre[1] = *(const u32x4*)(vb + 64 + lo_v);
    }
    const int keyl = ((lane & 15) >> 2) | ((g & 1) << 2);
    const int trrow = (8 * g + ((lane & 15) >> 2)) * 256 + 8 * (lane & 3);
    const unsigned wpar = (unsigned)(w & 1);
    const unsigned A1 = (((unsigned)cp >> 2) ^ (8u * wpar)) << 4, C1 = ((unsigned)cp & 3u) * 4u + (unsigned)w * 2048u;
    const unsigned A2 = (((unsigned)cp >> 1) ^ (16u * wpar)) << 3, C2 = ((unsigned)cp & 1u) * 4u + (unsigned)w * 2048u;
    const unsigned A3 = (((unsigned)cp >> 3) ^ (wpar << 2)) << 5, C3 = ((unsigned)cp & 7u) * 4u + (unsigned)w * 2048u;
    __syncthreads();
    for (int c = 0; c < L / 64; ++c) {
        int cc = c; asm volatile("" : "+s"(cc));
        const size_t tok0 = tokb + 64 * cc;
        { float run0 = 0.f, run1 = 0.f;
#pragma unroll
          for (int i = 0; i < 8; ++i) { run0 += gpre[i].x; run1 += gpre[i].y; }
          *(LAS f32x2*)(lds + HL_SEG + (w * 128 + 2 * cp) * 4) = (f32x2){run0, run1}; }
        { const int k0 = trkey(vrow);
          *(LAS u32x4*)(lds + HL_VT + vrow * 256 + ((((vc16 >> 1)) ^ k0) << 5) + (vc16 & 1) * 16) = vpre[0];
          *(LAS u32x4*)(lds + HL_VT + vrow * 256 + (((((vc16 + 8) >> 1)) ^ k0) << 5) + (vc16 & 1) * 16) = vpre[1]; }
        __syncthreads();
        f32x2 offc = (f32x2){0.f, 0.f}, rr = (f32x2){0.f, 0.f}, tot = (f32x2){0.f, 0.f};
#pragma unroll
        for (int sg = 0; sg < 8; ++sg) { const f32x2 sv = *(const LAS f32x2*)(lds + HL_SEG + (sg * 128 + 2 * cp) * 4);
            if (sg < w) offc += sv; if (sg < 4) rr += sv; tot += sv; }
        const f32x2 Rc = (f32x2){__builtin_amdgcn_exp2f(rr.x), __builtin_amdgcn_exp2f(rr.y)};
        const f32x2 C4 = (f32x2){__builtin_amdgcn_exp2f(tot.x - rr.x), __builtin_amdgcn_exp2f(tot.y - rr.y)};
        if (w == 0) *(LAS f32x2*)(lds + HL_DS + 2 * cp * 4) = (f32x2){__builtin_amdgcn_exp2f(tot.x), __builtin_amdgcn_exp2f(tot.y)};
#pragma unroll
        for (int i = 0; i < 8; ++i) {
            offc += gpre[i];
            const f32x2 d = offc - rr;
            const float E0 = __builtin_amdgcn_exp2f(fminf(fmaxf(d.x, -115.f), 115.f)), E1 = __builtin_amdgcn_exp2f(fminf(fmaxf(d.y, -115.f), 115.f));
            const float I0 = __builtin_amdgcn_rcpf(E0), I1 = __builtin_amdgcn_rcpf(E1);
            const float k0 = 1.f - __builtin_amdgcn_exp2f(gpre[i].x), k1 = 1.f - __builtin_amdgcn_exp2f(gpre[i].y);
            const f32x2 qm = (f32x2){bflo(qpre[i]) * E0, bfhi(qpre[i]) * E1}, km = (f32x2){k0 * I0, k1 * I1};
            const f32x2 qs = qm * Rc, ke = km * C4;
            LAS unsigned char* pq = lds + i * 256 + ((A1 ^ (unsigned)(i << 4)) + C1);
            *(LAS unsigned*)(pq + HL_QM) = cvt_pk_bf16_c(qm.x, qm.y);
            *(LAS unsigned*)(pq + HL_KM) = cvt_pk_bf16_c(km.x, km.y);
            *(LAS unsigned*)(lds + HL_QS + i * 256 + ((A2 ^ (unsigned)(i << 4)) + C2)) = cvt_pk_bf16_c(qs.x, qs.y);
            *(LAS unsigned*)(lds + HL_KE + i * 256 + ((A3 ^ (unsigned)((i & 3) << 5)) + C3)) = cvt_pk_bf16_c(ke.x, ke.y);
        }
        if (c + 1 < L / 64) {
            const size_t rb = (tok0 + 64 + 8 * w) * 1024 + hc;
            const float* gb = GH + rb; const bf16_t* qb = QH + rb; const bf16_t* vb = VH + (tok0 + 64) * 1024 + hc;
#pragma unroll
            for (int i = 0; i < 8; ++i) { gpre[i] = *(const f32x2*)(gb + i * 1024 + lo_g); qpre[i] = *(const unsigned*)(qb + i * 1024 + lo_g); }
            vpre[0] = *(const u32x4*)(vb + lo_v); vpre[1] = *(const u32x4*)(vb + 64 + lo_v);
        }
        __syncthreads();
#pragma unroll
        for (int rep = 0; rep < 2; ++rep) {
            if (rep == 1 && w >= 4) break;
            const int idx = rep == 0 ? w : 8 + w;
            const int si = (0xd940e4 >> (2 * idx)) & 3, ti = (0x8fb9e4 >> (2 * idx)) & 3;
            f32x4 pacc = (f32x4){0.f, 0.f, 0.f, 0.f};
            if (idx < 10) {
#pragma unroll
                for (int ks = 0; ks < 4; ++ks) {
                    const int ofs = r16 * 256 + (((4 * ks + g) ^ r16) << 4);
                    const bf16x8 af = *(const LAS bf16x8*)(lds + HL_KM + si * 4096 + ofs);
                    const bf16x8 bfr = *(const LAS bf16x8*)(lds + HL_QM + ti * 4096 + ofs);
                    pacc = __builtin_amdgcn_mfma_f32_16x16x32_bf16(af, bfr, pacc, 0, 0, 0);
                }
                const bool offd = si != ti;
#pragma unroll
                for (int r = 0; r < 4; ++r) pacc[r] = (offd || (4 * g + r <= r16)) ? pacc[r] : 0.f;
            }
            asm volatile("s_nop 7\n\ts_nop 7" ::: "memory");
            const int t = 16 * ti + r16;
            u32x2 pw; pw.x = cvt_pk_bf16_c(pacc[0], pacc[1]); pw.y = cvt_pk_bf16_c(pacc[2], pacc[3]);
            *(LAS u32x2*)(lds + HL_PL + t * 128 + (((2 * si + (g >> 1)) ^ ((t >> 1) & 7)) << 4) + (g & 1) * 8) = pw;
        }
        __syncthreads();
        const f32x4 nw4 = *(const f32x4*)(a.in[6] + 16 * w + 4 * g);
        u32x2 ogp[4];
        { const bf16_t* ob = OG + tok0 * 1024 + hc + 16 * w;
#pragma unroll
          for (int ti = 0; ti < 4; ++ti) ogp[ti] = *(const u32x2*)(ob + ti * 16384 + lo_og); }
#define HG_SB() __builtin_amdgcn_sched_barrier(0)
#define HG_QSLD(dst, kp) do { _Pragma("unroll") for (int ti = 0; ti < 4; ++ti) { const int t_ = 16 * ti + r16; \
            const u32x2 lo_ = *(const LAS u32x2*)(lds + HL_QS + t_ * 256 + (((8 * (kp) + g) ^ (r16 << 1)) << 3)); \
            const u32x2 hi_ = *(const LAS u32x2*)(lds + HL_QS + t_ * 256 + (((8 * (kp) + 4 + g) ^ (r16 << 1)) << 3)); \
            dst[ti] = (u32x4){lo_.x, lo_.y, hi_.x, hi_.y}; } } while (0)
#define HG_KELD(dst, kt) do { _Pragma("unroll") for (int ks = 0; ks < 2; ++ks) { const LAS unsigned char* pb_ = lds + HL_KE + ks * 32 * 256 + trrow + (((kt) ^ keyl) << 5); \
            dst[ks] = mk8(lds_tr16(pb_), lds_tr16(pb_ + 4 * 256)); } } while (0)
#define HG_INTER(kp, qsv) do { u32x4 sw_; sw_.x = cvt_pk_bf16_c(Sacc[2 * (kp)][0], Sacc[2 * (kp)][1]); sw_.y = cvt_pk_bf16_c(Sacc[2 * (kp)][2], Sacc[2 * (kp)][3]); \
            sw_.z = cvt_pk_bf16_c(Sacc[2 * (kp) + 1][0], Sacc[2 * (kp) + 1][1]); sw_.w = cvt_pk_bf16_c(Sacc[2 * (kp) + 1][2], Sacc[2 * (kp) + 1][3]); \
            const bf16x8 sf_ = __builtin_bit_cast(bf16x8, sw_); \
            _Pragma("unroll") for (int ti = 0; ti < 4; ++ti) Oa[ti] = __builtin_amdgcn_mfma_f32_16x16x32_bf16(sf_, __builtin_bit_cast(bf16x8, qsv[ti]), Oa[ti], 0, 0, 0); } while (0)
#define HG_SUPD(kt, kev, dsv) do { f32x4 sa_ = Sacc[kt] * dsv; \
            sa_ = __builtin_amdgcn_mfma_f32_16x16x32_bf16(kev[0], vf[0], sa_, 0, 0, 0); sa_ = __builtin_amdgcn_mfma_f32_16x16x32_bf16(kev[1], vf[1], sa_, 0, 0, 0); Sacc[kt] = sa_; } while (0)
        bf16x8 vf[2];
        bf16x8 pf[6];
        u32x4 qsA[4], qsB[4];
#pragma unroll
        for (int ks = 0; ks < 2; ++ks) {
            const LAS unsigned char* pb = lds + HL_VT + ks * 32 * 256 + trrow + ((w ^ keyl) << 5);
            vf[ks] = mk8(lds_tr16(pb), lds_tr16(pb + 4 * 256));
        }
        {
            const int t0_ = r16, t1_ = 16 + r16, t2_ = 32 + r16, t3_ = 48 + r16;
            pf[0] = *(const LAS bf16x8*)(lds + HL_PL + t0_ * 128 + (((g) ^ ((t0_ >> 1) & 7)) << 4));
            pf[1] = *(const LAS bf16x8*)(lds + HL_PL + t1_ * 128 + (((g) ^ ((t1_ >> 1) & 7)) << 4));
            pf[2] = *(const LAS bf16x8*)(lds + HL_PL + t2_ * 128 + (((g) ^ ((t2_ >> 1) & 7)) << 4));
            pf[3] = *(const LAS bf16x8*)(lds + HL_PL + t2_ * 128 + (((4 + g) ^ ((t2_ >> 1) & 7)) << 4));
            pf[4] = *(const LAS bf16x8*)(lds + HL_PL + t3_ * 128 + (((g) ^ ((t3_ >> 1) & 7)) << 4));
            pf[5] = *(const LAS bf16x8*)(lds + HL_PL + t3_ * 128 + (((4 + g) ^ ((t3_ >> 1) & 7)) << 4));
        }
        HG_QSLD(qsA, 0);
        HG_SB();
        f32x4 Oa[4];
        const f32x4 z4 = (f32x4){0.f, 0.f, 0.f, 0.f};
        Oa[0] = __builtin_amdgcn_mfma_f32_16x16x32_bf16(vf[0], pf[0], z4, 0, 0, 0);
        Oa[1] = __builtin_amdgcn_mfma_f32_16x16x32_bf16(vf[0], pf[1], z4, 0, 0, 0);
        Oa[2] = __builtin_amdgcn_mfma_f32_16x16x32_bf16(vf[0], pf[2], z4, 0, 0, 0);
        Oa[3] = __builtin_amdgcn_mfma_f32_16x16x32_bf16(vf[0], pf[4], z4, 0, 0, 0);
        Oa[2] = __builtin_amdgcn_mfma_f32_16x16x32_bf16(vf[1], pf[3], Oa[2], 0, 0, 0);
        Oa[3] = __builtin_amdgcn_mfma_f32_16x16x32_bf16(vf[1], pf[5], Oa[3], 0, 0, 0);
        HG_SB();
        HG_QSLD(qsB, 1);
        HG_SB();
        HG_INTER(0, qsA);
        HG_SB();
        HG_QSLD(qsA, 2);
        HG_SB();
        HG_INTER(1, qsB);
        HG_SB();
        HG_QSLD(qsB, 3);
        HG_SB();
#define HG_DSLD(kt) (*(const LAS f32x4*)(lds + HL_DS + (16 * (kt) + 4 * g) * 4))
        bf16x8 keA[2], keB[2], keC[2], keD[2]; f32x4 dA, dB, dC, dD;
        HG_KELD(keA, 0); HG_KELD(keB, 1); dA = HG_DSLD(0); dB = HG_DSLD(1);
        HG_SB();
        HG_INTER(2, qsA);
        HG_SB();
        HG_KELD(keC, 2); HG_KELD(keD, 3); dC = HG_DSLD(2); dD = HG_DSLD(3);
        HG_SB();
        HG_INTER(3, qsB);
        HG_SB();
        HG_SUPD(0, keA, dA); HG_SUPD(1, keB, dB);
        HG_SB();
        HG_KELD(keA, 4); HG_KELD(keB, 5); dA = HG_DSLD(4); dB = HG_DSLD(5);
        HG_SB();
        HG_SUPD(2, keC, dC); HG_SUPD(3, keD, dD);
        HG_SB();
        HG_KELD(keC, 6); HG_KELD(keD, 7); dC = HG_DSLD(6); dD = HG_DSLD(7);
        HG_SB();
        HG_SUPD(4, keA, dA); HG_SUPD(5, keB, dB);
        HG_SB();
        HG_SUPD(6, keC, dC); HG_SUPD(7, keD, dD);
#undef HG_DSLD
#undef HG_SB
#undef HG_QSLD
#undef HG_KELD
#undef HG_INTER
#undef HG_SUPD
#pragma unroll
        for (int ti = 0; ti < 4; ++ti) {
            float sq = (Oa[ti][0] * Oa[ti][0] + Oa[ti][1] * Oa[ti][1]) + (Oa[ti][2] * Oa[ti][2] + Oa[ti][3] * Oa[ti][3]);
            sq += __shfl_xor(sq, 16); sq += __shfl_xor(sq, 32);
            if (g == 0) *(LAS float*)(lds + HL_SSQ + (w * 64 + 16 * ti + r16) * 4) = sq;
        }
        __syncthreads();
#pragma unroll
        for (int ti = 0; ti < 4; ++ti) {
            const int t = 16 * ti + r16;
            float tot = 0.f;
#pragma unroll
            for (int ww = 0; ww < 8; ++ww) tot += *(const LAS float*)(lds + HL_SSQ + (ww * 64 + t) * 4);
            const float rs = rsqrtf(tot * (1.f / 128.f) + EPS);
            u32x2 o; o.x = pk2(Oa[ti][0] * rs * nw4[0] * bflo(ogp[ti].x), Oa[ti][1] * rs * nw4[1] * bfhi(ogp[ti].x));
            o.y = pk2(Oa[ti][2] * rs * nw4[2] * bflo(ogp[ti].y), Oa[ti][3] * rs * nw4[3] * bfhi(ogp[ti].y));
            *(u32x2*)(YM + tok0 * D + hc + 16 * w + ti * 32768 + lo_ym) = o;
        }
    }
}

typedef _Float16 f16x8 __attribute__((ext_vector_type(8)));
typedef _Float16 f16x2 __attribute__((ext_vector_type(2)));
__device__ __forceinline__ unsigned pkh(float a, float b) { const f16x2 h = {(_Float16)a, (_Float16)b}; return __builtin_bit_cast(unsigned, h); }
constexpr int LC_CNTL = 4096, LC_BASE = 4224;
__device__ __forceinline__ void p4_ln_router(Frame& F, const Args& a) {
    LAS unsigned char* lds = F.lds;
    const bf16_t* Z = (const bf16_t*)(F.ws + WS_Z); bf16_t* H1 = (bf16_t*)(F.ws + WS_H1);
    const float* w = a.in[11]; const float* b = a.in[12]; const float* br = a.in[14];
    int* cnt = (int*)(F.ws + WS_CTL) + CW_CNT; int* list = (int*)(F.ws + WS_LIST);
    int* tok_e = (int*)(F.ws + WS_TOKE); int* tok_p = (int*)(F.ws + WS_TOKP); float* tok_g = (float*)(F.ws + WS_TOKG);
    const int tid = F.tid, lane = F.lane, wv = F.wave, r16 = lane & 15, g = lane >> 4, nh = wv & 1, q = wv >> 1;
    LAS int* CNTL = (LAS int*)(lds + LDSCTL_OFF + LC_CNTL); LAS int* BASE = (LAS int*)(lds + LDSCTL_OFF + LC_BASE);
    if (tid < 32) CNTL[tid] = 0;
    const _Float16* ph = (const _Float16*)(F.ws + WS_WRH) + (size_t)(16 * nh + r16) * D + 512 * q + 8 * g;
    int se0 = 0, se1 = 0, se2 = 0, se3 = 0; float sg0 = 0.f, sg1 = 0.f, sg2 = 0.f, sg3 = 0.f;
    const int ntile = T / 32;
    const int nmy = (ntile - F.vcu + F.G - 1) / F.G;
    for (int it = 0; it < nmy; ++it) {
        const int tile = F.vcu + it * F.G;
        __syncthreads();
#define P4_LN(v, tlx) do { const int tl = (tlx); float s = 0.f; \
            _Pragma("unroll") for (int j = 0; j < 8; ++j) s += (v[j][0] + v[j][1]) + (v[j][2] + v[j][3]); \
            const float mean = wave_sum(s) * (1.f / D); float s2 = 0.f; \
            _Pragma("unroll") for (int j = 0; j < 8; ++j) { v[j] = v[j] - mean; s2 += (v[j][0] * v[j][0] + v[j][1] * v[j][1]) + (v[j][2] * v[j][2] + v[j][3] * v[j][3]); } \
            const float rstd = rsqrtf(wave_sum(s2) * (1.f / D) + EPS); \
            _Pragma("unroll") for (int j = 0; j < 8; ++j) { const f32x4 ww = *((const f32x4*)w + 2 * (lane + 64 * (j >> 1)) + (j & 1)), bb = *((const f32x4*)b + 2 * (lane + 64 * (j >> 1)) + (j & 1)); \
                f32x4 hv; hv[0] = v[j][0] * rstd * ww[0] + bb[0]; hv[1] = v[j][1] * rstd * ww[1] + bb[1]; hv[2] = v[j][2] * rstd * ww[2] + bb[2]; hv[3] = v[j][3] * rstd * ww[3] + bb[3]; \
                u32x2 hh; hh.x = pkh(hv[0], hv[1]); hh.y = pkh(hv[2], hv[3]); \
                *(LAS u32x2*)(lds + tl * 4096 + (((lane + 64 * (j >> 1)) ^ (tl & 15)) << 4) + (j & 1) * 8) = hh; } } while (0)
#pragma unroll 1
        for (int ps = 0; ps < 2; ++ps) {
            f32x4 v0[8], v1[8];
            { const GAS u32x4* z0 = (const GAS u32x4*)(Z + (size_t)(tile * 32 + 4 * wv + 2 * ps) * D) + lane;
              u32x4 r0[4], r1[4];
#pragma unroll
              for (int jj = 0; jj < 4; ++jj) { r0[jj] = z0[64 * jj]; r1[jj] = z0[64 * jj + 256]; }
#pragma unroll
              for (int jj = 0; jj < 4; ++jj) {
                  v0[2 * jj][0] = __uint_as_float(r0[jj].x << 16); v0[2 * jj][1] = __uint_as_float(r0[jj].x & 0xffff0000u); v0[2 * jj][2] = __uint_as_float(r0[jj].y << 16); v0[2 * jj][3] = __uint_as_float(r0[jj].y & 0xffff0000u);
                  v0[2 * jj + 1][0] = __uint_as_float(r0[jj].z << 16); v0[2 * jj + 1][1] = __uint_as_float(r0[jj].z & 0xffff0000u); v0[2 * jj + 1][2] = __uint_as_float(r0[jj].w << 16); v0[2 * jj + 1][3] = __uint_as_float(r0[jj].w & 0xffff0000u);
                  v1[2 * jj][0] = __uint_as_float(r1[jj].x << 16); v1[2 * jj][1] = __uint_as_float(r1[jj].x & 0xffff0000u); v1[2 * jj][2] = __uint_as_float(r1[jj].y << 16); v1[2 * jj][3] = __uint_as_float(r1[jj].y & 0xffff0000u);
                  v1[2 * jj + 1][0] = __uint_as_float(r1[jj].z << 16); v1[2 * jj + 1][1] = __uint_as_float(r1[jj].z & 0xffff0000u); v1[2 * jj + 1][2] = __uint_as_float(r1[jj].w << 16); v1[2 * jj + 1][3] = __uint_as_float(r1[jj].w & 0xffff0000u);
              } }
            P4_LN(v0, 4 * wv + 2 * ps); P4_LN(v1, 4 * wv + 2 * ps + 1);
        }
#undef P4_LN
        __syncthreads();
#pragma unroll 2
        for (int r = 0; r < 16; ++r) {
            const int idx = r * 512 + tid, t = idx >> 8, c = idx & 255;
            const f16x8 hv8 = *(const LAS f16x8*)(lds + t * 4096 + ((c ^ (t & 15)) << 4));
            float f[8];
#pragma unroll
            for (int q8 = 0; q8 < 8; ++q8) f[q8] = (float)hv8[q8];
            const size_t go = (size_t)(tile * 32 + t) * D + 8 * c;
            u32x4 ob; ob.x = pk2(f[0], f[1]); ob.y = pk2(f[2], f[3]); ob.z = pk2(f[4], f[5]); ob.w = pk2(f[6], f[7]);
            *(GAS u32x4*)(H1 + go) = ob;
            u32x2 oq; oq.x = pk4_fp8(f[0] * SC_H1, f[1] * SC_H1, f[2] * SC_H1, f[3] * SC_H1); oq.y = pk4_fp8(f[4] * SC_H1, f[5] * SC_H1, f[6] * SC_H1, f[7] * SC_H1);
            *(GAS u32x2*)(F.ws + WS_H1Q + go) = oq;
        }
        f16x8 wf[16];
#pragma unroll
        for (int ks = 0; ks < 16; ++ks) wf[ks] = *(const f16x8*)(ph + 32 * ks);
        f32x4 acc0 = (f32x4){0.f, 0.f, 0.f, 0.f}, acc1 = (f32x4){0.f, 0.f, 0.f, 0.f};
#pragma unroll
        for (int ks = 0; ks < 16; ++ks) {
            const int off = r16 * 4096 + (((64 * q + 4 * ks + g) ^ r16) << 4);
            const f16x8 t0 = *(const LAS f16x8*)(lds + off), t1 = *(const LAS f16x8*)(lds + 65536 + off);
            acc0 = __builtin_amdgcn_mfma_f32_16x16x32_f16(wf[ks], t0, acc0, 0, 0, 0);
            acc1 = __builtin_amdgcn_mfma_f32_16x16x32_f16(wf[ks], t1, acc1, 0, 0, 0);
        }
        __syncthreads();
        *(LAS f32x4*)(lds + ((q * 32 + r16) * 32 + 16 * nh + 4 * g) * 4) = acc0;
        *(LAS f32x4*)(lds + ((q * 32 + 16 + r16) * 32 + 16 * nh + 4 * g) * 4) = acc1;
        __syncthreads();
#pragma unroll
        for (int ps = 0; ps < 2; ++ps) {
            const int e = lane & 31, tl = 4 * wv + 2 * ps + (lane >> 5);
            float sl = 0.f;
#pragma unroll
            for (int qq = 0; qq < 4; ++qq) sl += *(const LAS float*)(lds + ((qq * 32 + tl) * 32 + e) * 4);
            sl = sl * (1.f / 64.f) + br[e];
            float val = sl; int te[4]; float tv[4];
#pragma unroll
            for (int r = 0; r < 4; ++r) {
                float bv = val; int bi = e;
#pragma unroll
                for (int o = 1; o < 32; o <<= 1) { const float ov = __shfl_xor(bv, o); const int oi = __shfl_xor(bi, o); if (ov > bv || (ov == bv && oi < bi)) { bv = ov; bi = oi; } }
                te[r] = bi; tv[r] = bv; if (e == bi) val = -INFINITY;
            }
            float p[4], psum = 0.f;
#pragma unroll
            for (int r = 0; r < 4; ++r) { p[r] = __expf(tv[r] - tv[0]); psum += p[r]; }
            if (e < 4) {
                int ee = te[0]; float gg = p[0];
                if (e == 1) { ee = te[1]; gg = p[1]; } else if (e == 2) { ee = te[2]; gg = p[2]; } else if (e == 3) { ee = te[3]; gg = p[3]; }
                const float gn = gg / psum; const int idx = it * 2 + ps;
                if (idx == 0) { se0 = ee; sg0 = gn; } else if (idx == 1) { se1 = ee; sg1 = gn; } else if (idx == 2) { se2 = ee; sg2 = gn; } else { se3 = ee; sg3 = gn; }
            }
        }
    }
    __syncthreads();
    const bool own = (lane & 31) < 4;
    const int nent = nmy * 2;
    int rk0 = 0, rk1 = 0, rk2 = 0, rk3 = 0;
    if (own) {
        if (nent > 0) rk0 = __hip_atomic_fetch_add((LAS int*)&CNTL[se0], 1, __ATOMIC_RELAXED, __HIP_MEMORY_SCOPE_WORKGROUP);
        if (nent > 1) rk1 = __hip_atomic_fetch_add((LAS int*)&CNTL[se1], 1, __ATOMIC_RELAXED, __HIP_MEMORY_SCOPE_WORKGROUP);
        if (nent > 2) rk2 = __hip_atomic_fetch_add((LAS int*)&CNTL[se2], 1, __ATOMIC_RELAXED, __HIP_MEMORY_SCOPE_WORKGROUP);
        if (nent > 3) rk3 = __hip_atomic_fetch_add((LAS int*)&CNTL[se3], 1, __ATOMIC_RELAXED, __HIP_MEMORY_SCOPE_WORKGROUP);
    }
    __syncthreads();
    if (tid < 32) { const int c = CNTL[tid]; BASE[tid] = c > 0 ? atomicAdd(&cnt[tid], c) : 0; }
    __syncthreads();
    if (own) {
        const int k = lane & 31;
#define P4_EMIT(idx, sex, sgx, rkx) do { if (nent > (idx)) { const int m = (F.vcu + ((idx) >> 1) * F.G) * 32 + 4 * wv + 2 * ((idx) & 1) + (lane >> 5), pos = BASE[sex] + (rkx); \
            list[(size_t)(sex) * LISTCAP + pos] = m; tok_e[m * 4 + k] = (sex); tok_p[m * 4 + k] = pos; tok_g[m * 4 + k] = (sgx); } } while (0)
        P4_EMIT(0, se0, sg0, rk0); P4_EMIT(1, se1, sg1, rk1); P4_EMIT(2, se2, sg2, rk2); P4_EMIT(3, se3, sg3, rk3);
#undef P4_EMIT
    }
}
__device__ __forceinline__ int moe_tables(Frame& F) {
    LAS int* pts = (LAS int*)(F.lds + LDSCTL_OFF + LC_PTS); LAS int* cl = (LAS int*)(F.lds + LDSCTL_OFF + LC_CNT); LAS unsigned char* tileE = (LAS unsigned char*)(F.lds + LDSCTL_OFF + LC_TILEE);
    const int* cnt = (const int*)(F.ws + WS_CTL) + CW_CNT;
    __syncthreads();
    if (F.tid < 64) {
        const int e = F.tid & 31; const int c = __hip_atomic_load(cnt + e, RLX_AGENT); const int tl = (c + 255) >> 8;
        int incl = tl;
#pragma unroll
        for (int o = 1; o < 32; o <<= 1) { const int v = __shfl_up(incl, o, 32); if (e >= o) incl += v; }
        if (F.tid < 32) { cl[e] = c; pts[e] = incl - tl; if (e == 31) pts[32] = incl; }
    }
    __syncthreads();
    const int nmt = pts[32];
    for (int t = F.tid; t < nmt; t += NTHR) { int e = 0;
        for (int j = 0; j < 32; ++j) if (t >= pts[j + 1]) e = j + 1;
        tileE[t] = (unsigned char)e; }
    __syncthreads();
    return __builtin_amdgcn_readfirstlane(nmt);
}
__device__ __forceinline__ void p7_combine(Frame& F, const Args& a) {
    const LAS int* pts = (const LAS int*)(F.lds + LDSCTL_OFF + LC_PTS);
    const bf16_t* H1 = (const bf16_t*)(F.ws + WS_H1); const bf16_t* Y = (const bf16_t*)(F.ws + WS_Y);
    const int* tok_e = (const int*)(F.ws + WS_TOKE); const int* tok_p = (const int*)(F.ws + WS_TOKP); const float* tok_g = (const float*)(F.ws + WS_TOKG);
    const float* w = a.in[21]; const float* b = a.in[22]; float* out = a.out;
    const int gw = F.vcu * NWAVES + F.wave, NGW = F.G * NWAVES, lane = F.lane;
    LAS f32x4* WL = (LAS f32x4*)F.lds; LAS f32x4* BL = (LAS f32x4*)(F.lds + 8192);
    __syncthreads();
    WL[F.tid] = *((const f32x4*)w + F.tid); BL[F.tid] = *((const f32x4*)b + F.tid);
    __syncthreads();
    const int ntok = (T - gw + NGW - 1) / NGW;
    int rowv = 0; float gv = 0.f;
    { const int i = lane >> 2, k = lane & 3; if (i < ntok) { const int m = gw + i * NGW; const int e = tok_e[m * 4 + k]; rowv = pts[e] * 256 + tok_p[m * 4 + k]; gv = tok_g[m * 4 + k]; } }
#define P8_LOAD(hx, yx, i) do { const int m_ = gw + (i) * NGW; const GAS u32x2* hr_ = (const GAS u32x2*)(H1 + (size_t)m_ * D) + lane; \
        _Pragma("unroll") for (int j = 0; j < 8; ++j) hx[j] = hr_[64 * j]; \
        _Pragma("unroll") for (int k = 0; k < 4; ++k) { const int row_ = __builtin_amdgcn_readlane(rowv, 4 * (i) + k); const GAS u32x2* yr_ = (const GAS u32x2*)(Y + (size_t)row_ * D) + lane; \
            _Pragma("unroll") for (int j = 0; j < 8; ++j) yx[k][j] = yr_[64 * j]; } } while (0)
#define P8_DO(hx, yx, i) do { const int m_ = gw + (i) * NGW; f32x4 v[8]; asm volatile("" ::: "memory"); \
        _Pragma("unroll") for (int j = 0; j < 8; ++j) { v[j][0] = ALPHA * bflo(hx[j].x); v[j][1] = ALPHA * bfhi(hx[j].x); v[j][2] = ALPHA * bflo(hx[j].y); v[j][3] = ALPHA * bfhi(hx[j].y); } \
        _Pragma("unroll") for (int k = 0; k < 4; ++k) { const float g_ = __builtin_bit_cast(float, __builtin_amdgcn_readlane(__builtin_bit_cast(int, gv), 4 * (i) + k)); \
            _Pragma("unroll") for (int j = 0; j < 8; ++j) { v[j][0] += g_ * bflo(yx[k][j].x); v[j][1] += g_ * bfhi(yx[k][j].x); v[j][2] += g_ * bflo(yx[k][j].y); v[j][3] += g_ * bfhi(yx[k][j].y); } } \
        float s = 0.f; _Pragma("unroll") for (int j = 0; j < 8; ++j) s += (v[j][0] + v[j][1]) + (v[j][2] + v[j][3]); \
        const float mean = wave_sum(s) * (1.f / D); float s2 = 0.f; \
        _Pragma("unroll") for (int j = 0; j < 8; ++j) { v[j] = v[j] - mean; s2 += (v[j][0] * v[j][0] + v[j][1] * v[j][1]) + (v[j][2] * v[j][2] + v[j][3] * v[j][3]); } \
        const float rstd = rsqrtf(wave_sum(s2) * (1.f / D) + EPS); GAS f32x4* orow = (GAS f32x4*)(out + (size_t)m_ * D) + lane; \
        _Pragma("unroll") for (int j = 0; j < 8; ++j) { const f32x4 ww = WL[lane + 64 * j], bb = BL[lane + 64 * j]; \
            f32x4 o; o[0] = v[j][0] * rstd * ww[0] + bb[0]; o[1] = v[j][1] * rstd * ww[1] + bb[1]; o[2] = v[j][2] * rstd * ww[2] + bb[2]; o[3] = v[j][3] * rstd * ww[3] + bb[3]; orow[64 * j] = o; } } while (0)
    u32x2 hA[8], yA[4][8], hB[8], yB[4][8];
    if (ntok > 0) P8_LOAD(hA, yA, 0);
    for (int i = 0; i < ntok; i += 2) {
        if (i + 1 < ntok) P8_LOAD(hB, yB, i + 1);
        P8_DO(hA, yA, i);
        if (i + 1 < ntok) { if (i + 2 < ntok) P8_LOAD(hA, yA, i + 2); P8_DO(hB, yB, i + 1); }
    }
#undef P8_LOAD
#undef P8_DO
}

__global__ void __launch_bounds__(NTHR, 2) mk_fwd(Args args) {
    extern __shared__ __attribute__((aligned(16))) unsigned char lds_raw[];
    Frame F;
    F.lds = (LAS unsigned char*)lds_raw;
    F.tid = threadIdx.x; F.lane = F.tid & 63; F.wave = __builtin_amdgcn_readfirstlane(F.tid >> 6);
    F.G = gridDim.x; { const int bx = blockIdx.x; F.vcu = (F.G % 8 == 0) ? (bx % 8) * (F.G / 8) + bx / 8 : bx; }
    F.ws = args.ws;
    unsigned char* ws = args.ws;
    for (int u = F.tid; u < (LDS_BYTES - LDSCTL_OFF) / 4; u += NTHR) ((LAS unsigned*)(F.lds + LDSCTL_OFF))[u] = 0u;
    __syncthreads();
    XcdBarrier bar; bar.bar = (unsigned*)(ws + WS_CTL) + CW_BAR; bar.x = 0; bar.st = nullptr;
#if !MK_PER_PHASE
    bar = xcd_barrier_post((unsigned*)(ws + WS_CTL) + CW_BAR, (volatile LAS unsigned*)(F.lds + LDSCTL_OFF + LC_BAR));
#endif
    const int lo = args.ph_lo, hi = args.ph_hi;
#define IN(k) (lo <= (k) && (k) < hi)
#define REFRESH_IDS() do { int t_ = threadIdx.x; asm volatile("" : "+v"(t_)); F.tid = t_; F.lane = t_ & 63; F.wave = __builtin_amdgcn_readfirstlane(t_ >> 6); } while (0)
#define SEAM(k) do { if (IN(k) && IN((k) + 1)) xcd_barrier(bar); } while (0)

    if (IN(0)) { REFRESH_IDS(); for (int r = 0; r < REP0; ++r) { p0_prologue(F, args); if (r + 1 < REP0) xcd_barrier(bar); } } SEAM(0);

    if (IN(1)) { REFRESH_IDS();
        const int Gg = F.G;
        SchedDense S{(const bf16_t*)(ws + WS_H0), (const bf16_t*)(ws + WS_WIN), T / 256, INC / 256, Gg, (int)blockIdx.x};
        EpiInProj E{(bf16_t*)(ws + WS_QH), (bf16_t*)(ws + WS_KH), (bf16_t*)(ws + WS_VH), (bf16_t*)(ws + WS_OG), (bf16_t*)(ws + WS_AQ), (bf16_t*)(ws + WS_AK), (bf16_t*)(ws + WS_AV),
                    (float*)(ws + WS_GH), (const float*)(ws + WS_LB), args.in[4]};
        for (int r = 0; r < REP1; ++r) { gemm_phase<EpiInProj, SchedDense>(F.lds, S, E); if (r + 1 < REP1) xcd_barrier(bar); }
        {
            const int nwg = (T / 256) * (INC / 256), full = nwg / F.G, extra = nwg - full * F.G;
            const bool has_extra = (int)blockIdx.x < extra;
            if (has_extra) { if (threadIdx.x == 0) __hip_atomic_fetch_add((unsigned*)(ws + WS_CTL) + CW_P1DONE, 1u, RLX_AGENT); }
            else if (extra > 0) { __syncthreads(); cv_worker(F, args, (const unsigned*)(ws + WS_CTL) + CW_P1DONE, (unsigned)extra); }
        }
    } SEAM(1);

    if (IN(2)) { REFRESH_IDS();
        for (int r = 0; r < REP2; ++r) {
        const int nh = F.G > 64 ? 64 : F.G;
        const int a0 = F.G >= 192 ? 64 : 0, na = F.G >= 192 ? 64 : F.G;
        if ((int)blockIdx.x < nh) { for (int hu = blockIdx.x; hu < 64 * REP2H; hu += nh) hgrn_unit_mfma(F, args, (hu & 63) >> 3, hu & 7); }
        REFRESH_IDS();
        if ((int)blockIdx.x >= a0 && (int)blockIdx.x < a0 + na) {
            for (int v0 = (int)blockIdx.x - a0; v0 < NB * (L / AT_Q) * REP2A; v0 += na) { const int v = v0 % (NB * (L / AT_Q)); attn_unit_mfma(F, args, v / (L / AT_Q), v % (L / AT_Q)); }
        }
        __syncthreads();
        REFRESH_IDS();
        cv_worker(F, args, nullptr, 0u);
        if (r + 1 < REP2) xcd_barrier(bar); }
    } SEAM(2);

    if (IN(3)) { REFRESH_IDS();
        SchedDense S{(const bf16_t*)(ws + WS_YMIX), (const bf16_t*)(ws + WS_WOUT), T / 256, D / 256, F.G, (int)blockIdx.x};
        EpiOutProj E{(bf16_t*)(ws + WS_Z), (const bf16_t*)(ws + WS_H0), args.in[10]};
        for (int r = 0; r < REP3; ++r) { gemm_phase<EpiOutProj, SchedDense>(F.lds, S, E); if (r + 1 < REP3) xcd_barrier(bar); }
    } SEAM(3);

    if (IN(4)) { REFRESH_IDS(); p4_ln_router(F, args); }

    if (IN(5) && !IN(4)) { REFRESH_IDS(); __syncthreads(); cv_worker(F, args, nullptr, 0u); }
    if (IN(4) || IN(5)) { if (IN(6)) xcd_barrier(bar); }

    if (IN(6)) { REFRESH_IDS();
        const int nmt = moe_tables(F);
        SchedMoe<2048> S{(const void*)(ws + WS_H1Q), (const void*)(ws + WS_WGU), (size_t)4096 * KD, (const int*)(ws + WS_LIST),
                   (const LAS int*)(F.lds + LDSCTL_OFF + LC_PTS), (const LAS int*)(F.lds + LDSCTL_OFF + LC_CNT), (const LAS unsigned char*)(F.lds + LDSCTL_OFF + LC_TILEE), nmt, 16, F.G, (int)blockIdx.x, true};
        EpiMoe1F8 E{(unsigned char*)(ws + WS_HACT), args.in[16], args.in[18]};
        for (int r = 0; r < REP5; ++r) { gemm_phase<EpiMoe1F8, SchedMoe<2048>, true>(F.lds, S, E); if (r + 1 < REP5) xcd_barrier(bar); }
    } SEAM(6);

    if (IN(7)) { REFRESH_IDS();
        const int nmt = moe_tables(F);
        SchedMoe<2048> S{(const void*)(ws + WS_HACT), (const void*)(ws + WS_WD), (size_t)2048 * KD, (const int*)(ws + WS_LIST),
                   (const LAS int*)(F.lds + LDSCTL_OFF + LC_PTS), (const LAS int*)(F.lds + LDSCTL_OFF + LC_CNT), (const LAS unsigned char*)(F.lds + LDSCTL_OFF + LC_TILEE), nmt, 8, F.G, (int)blockIdx.x, false};
        EpiMoe2F8 E{(bf16_t*)(ws + WS_Y), args.in[20]};
        for (int r = 0; r < REP6; ++r) { gemm_phase<EpiMoe2F8, SchedMoe<2048>, true>(F.lds, S, E); if (r + 1 < REP6) xcd_barrier(bar); }
    } SEAM(7);

    if (IN(8)) { REFRESH_IDS(); (void)moe_tables(F); for (int r = 0; r < REP7; ++r) p7_combine(F, args); }
#undef IN
#undef SEAM
}
}

extern "C" void kernel_launch(void* const* d_in, const int* in_sizes, int n_in, void* d_out, int out_size, void* d_ws, size_t ws_size, hipStream_t stream) {
    static int grid = 0;
    if (grid == 0) {
        if (n_in != 23 || out_size != T * D || ws_size < WS_END) { fprintf(stderr, "kernel_launch: unexpected shapes (n_in %d out %d ws %zu need %zu)\n", n_in, out_size, ws_size, (size_t)WS_END); grid = -1; return; }
        int dev = 0, cus = 0, per_cu = 0;
        if (hipGetDevice(&dev) != hipSuccess || hipDeviceGetAttribute(&cus, hipDeviceAttributeMultiprocessorCount, dev) != hipSuccess) { grid = -1; return; }
        if (hipFuncSetAttribute((const void*)mk_fwd, hipFuncAttributeMaxDynamicSharedMemorySize, LDS_BYTES) != hipSuccess) { fprintf(stderr, "kernel_launch: hipFuncSetAttribute failed\n"); grid = -1; return; }
        if (hipOccupancyMaxActiveBlocksPerMultiprocessor(&per_cu, (const void*)mk_fwd, NTHR, LDS_BYTES) != hipSuccess || per_cu < 1) { fprintf(stderr, "kernel_launch: occupancy query says %d\n", per_cu); }
        (void)hipGetLastError();
        grid = cus;
    }
    if (grid < 0) return;
    if (hipMemsetAsync((char*)d_ws + WS_CTL, 0, CTL_ZERO_BYTES, stream) != hipSuccess) return;
    Args a{};
    for (int i = 0; i < 23; ++i) a.in[i] = (const float*)d_in[i];
    a.out = (float*)d_out; a.ws = (unsigned char*)d_ws;
#if MK_PER_PHASE
    for (int p = 0; p < NPHASE; ++p) { a.ph_lo = p; a.ph_hi = p + 1; hipLaunchKernelGGL(mk_fwd, dim3(grid), dim3(NTHR), LDS_BYTES, stream, a); }
#else
    a.ph_lo = 0; a.ph_hi = NPHASE; hipLaunchKernelGGL(mk_fwd, dim3(grid), dim3(NTHR), LDS_BYTES, stream, a);
#endif
}
```

```cpp
#include <hip/hip_runtime.h>
#include <cstdio>
#include <cstdint>

#ifndef MK_PER_PHASE
#define MK_PER_PHASE 0
#endif

#define LAS __attribute__((address_space(3)))
#define GAS __attribute__((address_space(1)))
typedef unsigned short bf16_t;
typedef short bf16x8 __attribute__((ext_vector_type(8)));
typedef float f32x4 __attribute__((ext_vector_type(4)));
typedef float f32x2 __attribute__((ext_vector_type(2)));
typedef unsigned u32x4 __attribute__((ext_vector_type(4)));
typedef unsigned u32x2 __attribute__((ext_vector_type(2)));
typedef GAS unsigned gu32;

namespace {
constexpr int D = 2048, NB = 8, L = 2048, T = NB * L;
constexpr int INC = 5376;
constexpr int NE = 32, FF = 2048, NA = T * 4;
constexpr int LISTCAP = T;
constexpr int MAXROWS = NA + NE * 256;
constexpr float ALPHA = 1.189207115002721f;
constexpr float EPS = 1e-5f;
constexpr int NWAVES = 8, NTHR = 512;
constexpr int NPHASE = 9;
constexpr int REP2H = 1, REP2A = 1;
constexpr int REP0 = 1, REP1 = 1, REP2 = 1, REP3 = 1, REP5 = 1, REP6 = 1, REP7 = 1;

constexpr size_t MiB = 1u << 20;
constexpr size_t WS_CTL = 0, CTL_ZERO_BYTES = 32768;
constexpr size_t WS_LB = 1 * MiB;
constexpr size_t WS_STATS0 = WS_LB + 4096;
constexpr size_t WS_LIST = 2 * MiB;
constexpr size_t WS_TOKE = 4 * MiB, WS_TOKP = WS_TOKE + (size_t)NA * 4, WS_TOKG = WS_TOKP + (size_t)NA * 4;
constexpr size_t WS_WRH = 5 * MiB;
constexpr size_t WS_WIN = 8 * MiB;
constexpr size_t WS_WOUT = 30 * MiB;
constexpr size_t WS_WGU = 40 * MiB;
constexpr size_t WS_WD = 552 * MiB;
constexpr size_t WS_H1 = 808 * MiB;
constexpr size_t WS_Z = 872 * MiB;
constexpr size_t WS_HACT = 1000 * MiB;
constexpr size_t WS_EARLY = 1288 * MiB;
constexpr size_t WS_H0 = WS_EARLY;
constexpr size_t WS_QH = WS_H0 + 64 * MiB, WS_KH = WS_QH + 32 * MiB, WS_VH = WS_KH + 32 * MiB, WS_OG = WS_VH + 32 * MiB, WS_AQ = WS_OG + 32 * MiB;
constexpr size_t WS_GH = WS_AQ + 32 * MiB;
constexpr size_t WS_AK = WS_GH + 64 * MiB, WS_AV = WS_AK + 4 * MiB;
constexpr size_t WS_YMIX = WS_AV + 4 * MiB;
constexpr size_t WS_H1Q = WS_KH;
constexpr size_t WS_Y = WS_EARLY;
constexpr size_t WS_END = WS_YMIX + 64 * MiB;
static_assert(WS_Y + (size_t)MAXROWS * 4096 <= WS_END + 0 * MiB || true, "");
static_assert(WS_END <= 2048 * MiB, "d_ws map");
constexpr int CW_CNT = 64;
constexpr int CW_CONV = 128, CW_P1DONE = 192, CW_HGDONE = 256;
constexpr int CW_BAR = 4096;

constexpr int RING_BYTES = 131072;
constexpr int CV_SCR = 17408;
constexpr int LDSCTL_OFF = 8 * CV_SCR;
constexpr int LDS_BYTES = 147456;
constexpr int LC_BAR = 0, LC_PTS = 64, LC_CNT = 256, LC_TILEE = 512, LC_MISC = 2048;

#define RLX_AGENT __ATOMIC_RELAXED, __HIP_MEMORY_SCOPE_AGENT
__device__ __forceinline__ unsigned f2bf(float f) { unsigned u = __builtin_bit_cast(unsigned, f); return (u + 0x7fffu + ((u >> 16) & 1u)) >> 16; }
__device__ __forceinline__ unsigned pk2(float lo, float hi) { return f2bf(lo) | (f2bf(hi) << 16); }
__device__ __forceinline__ float bf2f(unsigned short b) { return __builtin_bit_cast(float, (unsigned)b << 16); }
__device__ __forceinline__ float bflo(unsigned w) { return __builtin_bit_cast(float, w << 16); }
__device__ __forceinline__ float bfhi(unsigned w) { return __builtin_bit_cast(float, w & 0xffff0000u); }
typedef __bf16 bf16x2_t __attribute__((ext_vector_type(2)));
__device__ __forceinline__ unsigned cvt_pk_bf16_c(float lo, float hi) { f32x2 v = {lo, hi}; bf16x2_t b = __builtin_convertvector(v, bf16x2_t); return __builtin_bit_cast(unsigned, b); }
__device__ __forceinline__ unsigned cvt_pk_bf16(float lo, float hi) { unsigned r; asm volatile("v_cvt_pk_bf16_f32 %0, %1, %2" : "=v"(r) : "v"(lo), "v"(hi)); return r; }
__device__ __forceinline__ float wave_sum(float v) {
#pragma unroll
    for (int o = 1; o < 64; o <<= 1) v += __shfl_xor(v, o);
    return v;
}
__device__ __forceinline__ float sigm(float x) { return __builtin_amdgcn_rcpf(1.f + __expf(-x)); }

#define XB_TMO      128
#define XB_XCNT(j)  (256  + 64 * (j))
#define XB_XSUB(j)  (1280 + 64 * (j))
#define XB_XGEN(j)  (2304 + 64 * (j))
#define XB_TOP      3328
#define XB_TOPGEN   3392
#define XCD_BAR_WORDS 3456
#define XB_SPIN_CAP (1u << 18)
__device__ __forceinline__ unsigned xb_ld(unsigned* p)              { return __hip_atomic_load(p, __ATOMIC_RELAXED, __HIP_MEMORY_SCOPE_AGENT); }
__device__ __forceinline__ unsigned xb_add(unsigned* p, unsigned v) { return __hip_atomic_fetch_add(p, v, __ATOMIC_RELAXED, __HIP_MEMORY_SCOPE_AGENT); }
__device__ __forceinline__ unsigned xb_xcc_id() { return (unsigned)__builtin_amdgcn_s_getreg((3 << 11) | 20) & 0xFu; }
#define XB_SPIN(cond, bar) do { unsigned _sp = 0; while (cond) { __builtin_amdgcn_s_sleep(1); \
    if ((++_sp & 255u) == 0u) { if (xb_ld(&(bar)[XB_TMO])) break; if (_sp > XB_SPIN_CAP) { atomicAdd(&(bar)[XB_TMO], 1u); break; } } } } while (0)
struct XcdBarrier { unsigned* bar; unsigned x; volatile LAS unsigned* st; };
__device__ __forceinline__ XcdBarrier xcd_barrier_post(unsigned* bar, volatile LAS unsigned* st) {
    XcdBarrier b; b.bar = bar; b.x = xb_xcc_id(); b.st = st;
    if (threadIdx.x == 0) (void)xb_add(&bar[XB_XCNT(b.x)], 1u);
    return b;
}
__device__ __forceinline__ void xcd_barrier_complete(unsigned* bar, unsigned x, unsigned& nloc, unsigned& nx) {
    const unsigned G = gridDim.x * gridDim.y * gridDim.z;
    unsigned sum, cnt, mine, sp = 0u;
    for (;;) {
        sum = 0u; cnt = 0u; mine = 0u;
#pragma unroll
        for (unsigned j = 0; j < 16; ++j) { const unsigned c = xb_ld(&bar[XB_XCNT(j)]); sum += c; cnt += (c > 0u) ? 1u : 0u; mine = (j == x) ? c : mine; }
        if (sum == G) break;
        __builtin_amdgcn_s_sleep(1);
        if ((++sp & 255u) == 0u) { if (xb_ld(&bar[XB_TMO])) break; if (sp > XB_SPIN_CAP) { atomicAdd(&bar[XB_TMO], 1u); break; } }
    }
    nloc = mine > 0u ? mine : 1u; nx = cnt > 0u ? cnt : 1u;
}
__device__ __forceinline__ void xcd_barrier(const XcdBarrier& b) {
    asm volatile("s_waitcnt vmcnt(0)" ::: "memory");
    __syncthreads();
    if (threadIdx.x == 0) {
        unsigned* bar = b.bar;
        __builtin_amdgcn_s_waitcnt(0);
        unsigned nloc = b.st[0], nx = b.st[1];
        if (nloc == 0u) { xcd_barrier_complete(bar, b.x, nloc, nx); b.st[0] = nloc; b.st[1] = nx; }
        const unsigned old = xb_add(&bar[XB_XSUB(b.x)], 1u);
        const unsigned gen = old / nloc;
        if (old + 1u == (gen + 1u) * nloc) {
            __builtin_amdgcn_fence(__ATOMIC_RELEASE, "agent");
            asm volatile("s_waitcnt vmcnt(0)" ::: "memory");
            const unsigned og = xb_add(&bar[XB_TOP], 1u);
            const unsigned tg = og / nx;
            if (og + 1u == (tg + 1u) * nx) xb_add(&bar[XB_TOPGEN], 1u);
            else XB_SPIN(xb_ld(&bar[XB_TOPGEN]) == tg, bar);
            __builtin_amdgcn_fence(__ATOMIC_ACQUIRE, "agent");
            xb_add(&bar[XB_XGEN(b.x)], 1u);
            asm volatile("s_waitcnt vmcnt(0)" ::: "memory");
        } else {
            XB_SPIN(xb_ld(&bar[XB_XGEN(b.x)]) == gen, bar);
            __builtin_amdgcn_fence(__ATOMIC_ACQUIRE, "agent");
            asm volatile("s_waitcnt vmcnt(0)" ::: "memory");
        }
    }
    __syncthreads();
}

constexpr int BM = 256, BK = 64, HALF = 128, HTB = HALF * BK * 2, NXCD = 8, WGM = 8;
constexpr int KD = 2048, NT = KD / BK;
__device__ __forceinline__ int lds_byte(int r, int c) { const int st = (r >> 4) * 2 + (c >> 5), rr = r & 15, cc = c & 31, ch = cc >> 3, pc = (rr >> 2) ^ ((0x93 >> (2 * (3 - ch))) & 3) ^ 0; return st * 1024 + rr * 64 + ((((rr >> 2)) ^ ((ch == 0) ? 0 : (ch == 1) ? 3 : (ch == 2) ? 1 : 2)) * 16) + (cc & 7) * 2 + 0 * pc; }
__device__ __forceinline__ void stage_rc(int b, int& R, int& C) { const int st = b / 1024, sb = b % 1024, rr = sb / 64, x = ((sb % 64) / 16) ^ (rr >> 2), ch = (x == 0) ? 0 : (x == 3) ? 1 : (x == 1) ? 2 : 3; R = (st >> 1) * 16 + rr; C = (st & 1) * 32 + ch * 8 + (sb % 16) / 2; }
__device__ __forceinline__ int perm32(int rho) { const int n = rho >> 4, i = rho & 15; return 8 * (i >> 2) + 4 * n + (i & 3); }

struct GU { const char* A; const char* B; int pm, pn, e, mtl; };

__device__ __forceinline__ bool order_next(int i, int G, int c, int nM, int nN, int& pm, int& pn) {
    const int nwg = nM * nN; const long Lx = (long)i * G + c; if (Lx >= nwg) return false;
    int wgid = (int)Lx; { const int q = nwg / NXCD, r = nwg % NXCD, xcd = wgid % NXCD, off = wgid / NXCD; wgid = (xcd < r ? xcd * (q + 1) : r * (q + 1) + (xcd - r) * q) + off; }
    const int nig = WGM * nN, gid = wgid / nig, fm = gid * WGM, gsz = (nM - fm) < WGM ? (nM - fm) : WGM;
    pm = fm + ((wgid % nig) % gsz); pn = (wgid % nig) / gsz; return true;
}

typedef int v8i_t __attribute__((ext_vector_type(8)));
template <class Epi, class Sched, bool F8 = false>
__device__ __forceinline__ void gemm_phase(LAS unsigned char* lds, const Sched& S, const Epi& E) {
    const int tid = threadIdx.x, wid = __builtin_amdgcn_readfirstlane(tid >> 6), lane = tid & 63, wr = wid >> 2, wc = wid & 3, fr = lane & 15, fq = lane >> 4;
    constexpr int ROWB = F8 ? KD : KD * 2;
    constexpr int nt = ROWB / 128;
    int Rr[2], Cc[2]; unsigned voffB[2];
#pragma unroll
    for (int i = 0; i < 2; ++i) { stage_rc(tid * 16 + i * 8192, Rr[i], Cc[i]); const int Rb = Epi::PERM ? ((Rr[i] & ~31) + perm32(Rr[i] & 31)) : Rr[i]; voffB[i] = (unsigned)(Rb * ROWB + Cc[i] * 2); }
    const size_t kstep = (size_t)128;
    const size_t hstep = (size_t)HALF * ROWB;
    const unsigned ldsw = (unsigned)wid * 1024u;
    const int aoff = lds_byte(wr * 64 + fr, fq * 8), boff = lds_byte(wc * 32 + fr, fq * 8);
#define PG8_SA(b, h) (((b) * 2 + (h)) * HTB)
#define PG8_SB(b, h) ((4 + (b) * 2 + (h)) * HTB)
#define PG8_STAGE(bufoff, gbase, voff) do { _Pragma("unroll") for (int _i = 0; _i < 2; ++_i) \
        __builtin_amdgcn_global_load_lds((const unsigned*)((const char*)(gbase) + (voff)[_i]), (LAS unsigned*)(lds + (bufoff) + ldsw + _i * 8192), 16, 0, 0); } while (0)
#define PG8_LDA(dst, b, h) do { _Pragma("unroll") for (int m = 0; m < 4; ++m) _Pragma("unroll") for (int k = 0; k < 2; ++k) dst[m].q[k] = *(const LAS u32x4*)(lds + PG8_SA(b, h) + aoff + m * 2048 + k * 1024); } while (0)
#define PG8_LDB(dst, b, h) do { _Pragma("unroll") for (int n = 0; n < 2; ++n) _Pragma("unroll") for (int k = 0; k < 2; ++k) dst[n].q[k] = *(const LAS u32x4*)(lds + PG8_SB(b, h) + boff + n * 2048 + k * 1024); } while (0)
#define PG8_MMA(ai, bj, At, Bt) do { __builtin_amdgcn_s_setprio(1); _Pragma("unroll") for (int m = 0; m < 4; ++m) _Pragma("unroll") for (int n = 0; n < 2; ++n) { \
        if constexpr (F8) { asm volatile("v_mfma_f32_16x16x128_f8f6f4 %0, %1, %2, %0" : "+v"(acc[ai][bj][m][n]) : "v"(Bt[n].v), "v"(At[m].v)); } \
        else { _Pragma("unroll") for (int k = 0; k < 2; ++k) acc[ai][bj][m][n] = __builtin_amdgcn_mfma_f32_16x16x32_bf16(__builtin_bit_cast(bf16x8, Bt[n].q[k]), __builtin_bit_cast(bf16x8, At[m].q[k]), acc[ai][bj][m][n], 0, 0, 0); } } \
        __builtin_amdgcn_s_setprio(0); } while (0)
#define PG8_WAIT_V(n) asm volatile("s_waitcnt vmcnt(" #n ")" ::: "memory")
#define PG8_WAIT_L(n) asm volatile("s_waitcnt lgkmcnt(" #n ")" ::: "memory")
#define PG8_BAR __builtin_amdgcn_s_barrier()
#define PG8_SCHED __builtin_amdgcn_sched_barrier(0)
    GU cur, nxt; int ui = 0;
    if (!S.next(0, cur)) return;
    f32x4 acc[2][2][4][2];
#pragma unroll
    for (int a = 0; a < 2; ++a)
#pragma unroll
        for (int b = 0; b < 2; ++b)
#pragma unroll
            for (int m = 0; m < 4; ++m)
#pragma unroll
                for (int n = 0; n < 2; ++n) acc[a][b][m][n] = (f32x4){0.f, 0.f, 0.f, 0.f};
    int f8sc = 0x7f7f7f7f; asm volatile("" : "+v"(f8sc));
    union Frag { v8i_t v; u32x4 q[2]; };
    Frag At[4], B0[2], B1[2];
    unsigned oc0[2], oc1[2], on0[2], on1[2];
    S.a_off(cur, Rr, Cc, oc0, oc1);
    const char* cA = cur.A; const char* cB = cur.B;
    PG8_STAGE(PG8_SB(0, 0), cB, voffB); PG8_STAGE(PG8_SB(0, 1), cB + hstep, voffB); PG8_STAGE(PG8_SA(0, 0), cA, oc0); PG8_STAGE(PG8_SA(0, 1), cA, oc1);
    PG8_STAGE(PG8_SB(1, 0), cB + kstep, voffB); PG8_STAGE(PG8_SB(1, 1), cB + hstep + kstep, voffB);
    PG8_WAIT_V(6); PG8_BAR;
    if (wr == 1) PG8_BAR;
    for (;;) {
        const bool has_next = S.next(ui + 1, nxt);
        const char* nA = has_next ? nxt.A : cA; const char* nB = has_next ? nxt.B : cB;
        for (int t = 0; t < nt; t += 2) {
            const bool last = (t == nt - 2);
            const char* a1 = cA + (size_t)(t + 1) * kstep;
            const char* a2 = last ? nA : cA + (size_t)(t + 2) * kstep; const char* b2 = last ? nB : cB + (size_t)(t + 2) * kstep;
            const char* b3 = b2 + kstep;
            unsigned o20[2], o21[2];
            if (last) {
                if (has_next) S.a_off(nxt, Rr, Cc, on0, on1); else { on0[0] = oc0[0]; on0[1] = oc0[1]; on1[0] = oc1[0]; on1[1] = oc1[1]; }
                o20[0] = on0[0]; o20[1] = on0[1]; o21[0] = on1[0]; o21[1] = on1[1];
            } else { o20[0] = oc0[0]; o20[1] = oc0[1]; o21[0] = oc1[0]; o21[1] = oc1[1]; }
            PG8_LDB(B0, 0, 0); PG8_LDB(B1, 0, 1); PG8_SCHED; PG8_LDA(At, 0, 0); PG8_STAGE(PG8_SA(1, 0), a1, oc0); PG8_STAGE(PG8_SA(1, 1), a1, oc1);
            PG8_WAIT_V(8); PG8_WAIT_L(0); PG8_BAR; PG8_MMA(0, 0, At, B0); PG8_MMA(0, 1, At, B1); PG8_BAR; PG8_SCHED;
            PG8_LDA(At, 0, 1); PG8_STAGE(PG8_SB(0, 0), b2, voffB); PG8_STAGE(PG8_SB(0, 1), b2 + hstep, voffB);
            PG8_WAIT_V(6); PG8_WAIT_L(0); PG8_BAR; PG8_MMA(1, 0, At, B0); PG8_MMA(1, 1, At, B1); PG8_BAR; PG8_SCHED;
            PG8_LDB(B0, 1, 0); PG8_LDB(B1, 1, 1); PG8_SCHED; PG8_LDA(At, 1, 0); PG8_STAGE(PG8_SA(0, 0), a2, o20); PG8_STAGE(PG8_SA(0, 1), a2, o21);
            PG8_WAIT_V(8); PG8_WAIT_L(0); PG8_BAR; PG8_MMA(0, 0, At, B0); PG8_MMA(0, 1, At, B1); PG8_BAR; PG8_SCHED;
            PG8_LDA(At, 1, 1); PG8_STAGE(PG8_SB(1, 0), b3, voffB); PG8_STAGE(PG8_SB(1, 1), b3 + hstep, voffB);
            PG8_WAIT_V(6); PG8_WAIT_L(0); PG8_BAR; PG8_MMA(1, 0, At, B0); PG8_MMA(1, 1, At, B1); PG8_BAR; PG8_SCHED;
        }
        if (wr == 0) PG8_BAR;
        if constexpr (F8) asm volatile("s_nop 15\n\ts_nop 15" ::: "memory");
        E(acc, cur, wr, wc, fr, fq);
        if (!has_next) break;
#pragma unroll
        for (int a = 0; a < 2; ++a)
#pragma unroll
            for (int b = 0; b < 2; ++b)
#pragma unroll
                for (int m = 0; m < 4; ++m)
#pragma unroll
                    for (int n = 0; n < 2; ++n) acc[a][b][m][n] = (f32x4){0.f, 0.f, 0.f, 0.f};
        cur = nxt; cA = nA; cB = nB; ++ui;
        oc0[0] = on0[0]; oc0[1] = on0[1]; oc1[0] = on1[0]; oc1[1] = on1[1];
        if (wr == 1) PG8_BAR;
    }
    PG8_WAIT_V(0);
    PG8_BAR;
#undef PG8_SA
#undef PG8_SB
#undef PG8_STAGE
#undef PG8_LDA
#undef PG8_LDB
#undef PG8_MMA
#undef PG8_WAIT_V
#undef PG8_WAIT_L
#undef PG8_BAR
#undef PG8_SCHED
}

struct SchedDense {
    const bf16_t* A; const bf16_t* Bt; int nM, nN, G, c;
    __device__ __forceinline__ bool next(int i, GU& u) const {
        int pm, pn; if (!order_next(i, G, c, nM, nN, pm, pn)) return false;
        u.pm = pm; u.pn = pn; u.e = 0; u.mtl = pm; u.A = (const char*)A; u.B = (const char*)Bt + (size_t)pn * (256 * KD * 2); return true;
    }
    __device__ __forceinline__ void a_off(const GU& u, const int (&R)[2], const int (&C)[2], unsigned (&o0)[2], unsigned (&o1)[2]) const {
#pragma unroll
        for (int i = 0; i < 2; ++i) { o0[i] = (unsigned)((u.pm * 256 + R[i]) * KD + C[i]) * 2u; o1[i] = (unsigned)((u.pm * 256 + 128 + R[i]) * KD + C[i]) * 2u; }
    }
};
template <int ROWB>
struct SchedMoe {
    const void* A; const void* Bt; size_t bstride_e;
    const int* list; const LAS int* pts; const LAS int* cntl; const LAS unsigned char* tileE;
    int nM, nN, G, c; bool gather;
    __device__ __forceinline__ bool next(int i, GU& u) const {
        int pm, pn; if (!order_next(i, G, c, nM, nN, pm, pn)) return false;
        const int e = __builtin_amdgcn_readfirstlane((int)tileE[pm]);
        u.pm = pm; u.pn = pn; u.e = e; u.mtl = pm - __builtin_amdgcn_readfirstlane(pts[e]);
        u.A = (const char*)A; u.B = (const char*)Bt + (size_t)e * bstride_e + (size_t)pn * (256 * ROWB); return true;
    }
    __device__ __forceinline__ void a_off(const GU& u, const int (&R)[2], const int (&C)[2], unsigned (&o0)[2], unsigned (&o1)[2]) const {
        if (gather) {
            const int ce = __builtin_amdgcn_readfirstlane(cntl[u.e]);
            const int* lp = list + (size_t)u.e * LISTCAP;
#pragma unroll
            for (int i = 0; i < 2; ++i) {
                int i0 = u.mtl * 256 + R[i], i1 = i0 + 128;
                i0 = i0 < ce ? i0 : 0; i1 = i1 < ce ? i1 : 0;
                const int t0 = lp[i0], t1 = lp[i1];
                o0[i] = (unsigned)(t0 * ROWB + C[i] * 2); o1[i] = (unsigned)(t1 * ROWB + C[i] * 2);
            }
        } else {
#pragma unroll
            for (int i = 0; i < 2; ++i) { o0[i] = (unsigned)((u.pm * 256 + R[i]) * ROWB + C[i] * 2); o1[i] = (unsigned)((u.pm * 256 + 128 + R[i]) * ROWB + C[i] * 2); }
        }
    }
};

__device__ __forceinline__ u32x4 pack8(const f32x4& a, const f32x4& b) { u32x4 w; w.x = cvt_pk_bf16(a[0], a[1]); w.y = cvt_pk_bf16(a[2], a[3]); w.z = cvt_pk_bf16(b[0], b[1]); w.w = cvt_pk_bf16(b[2], b[3]); return w; }

struct EpiInProj {
    static constexpr bool PERM = true;
    bf16_t *QH, *KH, *VH, *OG, *AQ, *AK, *AV; float* GH; const float* lb; const float* bqkv;
    __device__ __forceinline__ void operator()(const f32x4 (&acc)[2][2][4][2], const GU& u, int wr, int wc, int fr, int fq) const {
        const int row0 = u.pm * BM + wr * 64 + fr;
        const int type = u.pn >> 2;
        int cw = wc * 32 + 8 * fq; asm volatile("" : "+v"(cw));
#pragma unroll
        for (int bj = 0; bj < 2; ++bj) {
            const int col = (u.pn & 3) * 256 + bj * HALF + cw;
            if (type == 0 || type == 3) {
                bf16_t* O = (type == 0 ? QH : OG);
#pragma unroll
                for (int ai = 0; ai < 2; ++ai)
#pragma unroll
                    for (int m = 0; m < 4; ++m) { f32x4 v0 = acc[ai][bj][m][0], v1 = acc[ai][bj][m][1];
#pragma unroll
                        for (int j = 0; j < 4; ++j) { v0[j] = v0[j] * sigm(v0[j]); v1[j] = v1[j] * sigm(v1[j]); }
                        *(u32x4*)(O + (size_t)(row0 + ai * HALF + m * 16) * 1024 + col) = pack8(v0, v1); }
            } else if (type == 1) {
                const f32x4 l0 = *(const f32x4*)(lb + col), l1 = *(const f32x4*)(lb + col + 4);
#pragma unroll
                for (int ai = 0; ai < 2; ++ai)
#pragma unroll
                    for (int m = 0; m < 4; ++m) { f32x4 v0 = acc[ai][bj][m][0], v1 = acc[ai][bj][m][1], g0, g1;
#pragma unroll
                        for (int j = 0; j < 4; ++j) { const float s0 = sigm(v0[j]), s1 = sigm(v1[j]);
                            const float f0 = l0[j] + (1.f - l0[j]) * s0, f1 = l1[j] + (1.f - l1[j]) * s1;
                            g0[j] = __log2f(f0); g1[j] = __log2f(f1); }
                        const size_t o = (size_t)(row0 + ai * HALF + m * 16) * 1024 + col;
                        *(f32x4*)(GH + o) = g0; *(f32x4*)(GH + o + 4) = g1; }
            } else if (type == 2) {
#pragma unroll
                for (int ai = 0; ai < 2; ++ai)
#pragma unroll
                    for (int m = 0; m < 4; ++m) *(u32x4*)(VH + (size_t)(row0 + ai * HALF + m * 16) * 1024 + col) = pack8(acc[ai][bj][m][0], acc[ai][bj][m][1]);
            } else if (type == 4) {
                const f32x4 b0 = *(const f32x4*)(bqkv + col), b1 = *(const f32x4*)(bqkv + col + 4);
#pragma unroll
                for (int ai = 0; ai < 2; ++ai)
#pragma unroll
                    for (int m = 0; m < 4; ++m) { const f32x4 v0 = (acc[ai][bj][m][0] + b0) * 0.125f, v1 = (acc[ai][bj][m][1] + b1) * 0.125f;
                        *(u32x4*)(AQ + (size_t)(row0 + ai * HALF + m * 16) * 1024 + col) = pack8(v0, v1); }
            } else {
                bf16_t* O = bj == 0 ? AK : AV;
                const f32x4 b0 = *(const f32x4*)(bqkv + 1024 + bj * 128 + cw), b1 = *(const f32x4*)(bqkv + 1024 + bj * 128 + cw + 4);
#pragma unroll
                for (int ai = 0; ai < 2; ++ai)
#pragma unroll
                    for (int m = 0; m < 4; ++m) *(u32x4*)(O + (size_t)(row0 + ai * HALF + m * 16) * 128 + cw) = pack8(acc[ai][bj][m][0] + b0, acc[ai][bj][m][1] + b1);
            }
        }
    }
};
struct EpiOutProj {
    static constexpr bool PERM = true;
    bf16_t* Z; const bf16_t* H0; const float* bo;
    __device__ __forceinline__ void operator()(const f32x4 (&acc)[2][2][4][2], const GU& u, int wr, int wc, int fr, int fq) const {
        const int row0 = u.pm * BM + wr * 64 + fr, col0 = u.pn * BM + wc * 32 + 8 * fq;
        f32x4 b4[2][2];
#pragma unroll
        for (int bj = 0; bj < 2; ++bj)
#pragma unroll
            for (int n = 0; n < 2; ++n) b4[bj][n] = *(const f32x4*)(bo + col0 + bj * HALF + n * 4);
#pragma unroll
        for (int ai = 0; ai < 2; ++ai) {
            u32x4 hv[4][2];
#pragma unroll
            for (int m = 0; m < 4; ++m)
#pragma unroll
                for (int bj = 0; bj < 2; ++bj) hv[m][bj] = *(const u32x4*)(H0 + (size_t)(row0 + ai * HALF + m * 16) * D + col0 + bj * HALF);
#pragma unroll
            for (int m = 0; m < 4; ++m)
#pragma unroll
                for (int bj = 0; bj < 2; ++bj) {
                    const u32x4 h = hv[m][bj];
                    f32x4 z0, z1;
                    z0[0] = __uint_as_float(h.x << 16); z0[1] = __uint_as_float(h.x & 0xffff0000u); z0[2] = __uint_as_float(h.y << 16); z0[3] = __uint_as_float(h.y & 0xffff0000u);
                    z1[0] = __uint_as_float(h.z << 16); z1[1] = __uint_as_float(h.z & 0xffff0000u); z1[2] = __uint_as_float(h.w << 16); z1[3] = __uint_as_float(h.w & 0xffff0000u);
                    z0 = z0 * ALPHA + b4[bj][0] + acc[ai][bj][m][0]; z1 = z1 * ALPHA + b4[bj][1] + acc[ai][bj][m][1];
                    *(u32x4*)(Z + (size_t)(row0 + ai * HALF + m * 16) * D + col0 + bj * HALF) = pack8(z0, z1);
                }
        }
    }
};
__device__ __forceinline__ unsigned pk4_fp8(float a, float b, float c, float d) {
    a = fminf(fmaxf(a, -448.f), 448.f); b = fminf(fmaxf(b, -448.f), 448.f); c = fminf(fmaxf(c, -448.f), 448.f); d = fminf(fmaxf(d, -448.f), 448.f);
    int w = __builtin_amdgcn_cvt_pk_fp8_f32(a, b, 0, false); w = __builtin_amdgcn_cvt_pk_fp8_f32(c, d, w, true); return (unsigned)w;
}
constexpr float SC_H1 = 32.f, SC_WGU = 2048.f, SC_HACT = 8.f, SC_WD = 4096.f;
struct EpiMoe1F8 {
    static constexpr bool PERM = true;
    unsigned char* H; const float* bg; const float* bu;
    __device__ __forceinline__ void operator()(const f32x4 (&acc)[2][2][4][2], const GU& u, int wr, int wc, int fr, int fq) const {
        const int row0 = u.pm * BM + wr * 64 + fr, hc = u.pn * 128 + wc * 32 + 8 * fq;
        const float* bgp = bg + (size_t)u.e * FF + hc; const float* bup = bu + (size_t)u.e * FF + hc;
        const f32x4 g0b = *(const f32x4*)bgp, g1b = *(const f32x4*)(bgp + 4), u0b = *(const f32x4*)bup, u1b = *(const f32x4*)(bup + 4);
        constexpr float IS = 1.f / (SC_H1 * SC_WGU);
#pragma unroll
        for (int ai = 0; ai < 2; ++ai)
#pragma unroll
            for (int m = 0; m < 4; ++m) {
                f32x4 a0 = acc[ai][0][m][0] * IS + g0b, a1 = acc[ai][0][m][1] * IS + g1b, c0 = acc[ai][1][m][0] * IS + u0b, c1 = acc[ai][1][m][1] * IS + u1b;
#pragma unroll
                for (int j = 0; j < 4; ++j) {
                    const float gg0 = fminf(a0[j], 7.f), gg1 = fminf(a1[j], 7.f);
                    const float uu0 = fminf(fmaxf(c0[j], -7.f), 7.f), uu1 = fminf(fmaxf(c1[j], -7.f), 7.f);
                    a0[j] = SC_HACT * gg0 * sigm(1.702f * gg0) * (uu0 + 1.f); a1[j] = SC_HACT * gg1 * sigm(1.702f * gg1) * (uu1 + 1.f);
                }
                u32x2 o; o.x = pk4_fp8(a0[0], a0[1], a0[2], a0[3]); o.y = pk4_fp8(a1[0], a1[1], a1[2], a1[3]);
                *(u32x2*)(H + (size_t)(row0 + ai * HALF + m * 16) * FF + hc) = o;
            }
    }
};
struct EpiMoe2F8 {
    static constexpr bool PERM = true;
    bf16_t* Y; const float* bd;
    __device__ __forceinline__ void operator()(const f32x4 (&acc)[2][2][4][2], const GU& u, int wr, int wc, int fr, int fq) const {
        const int row0 = u.pm * BM + wr * 64 + fr, col0 = u.pn * BM + wc * 32 + 8 * fq;
        const float* bp = bd + (size_t)u.e * D + col0;
        constexpr float IS = 1.f / (SC_HACT * SC_WD);
#pragma unroll
        for (int bj = 0; bj < 2; ++bj) {
            const f32x4 b0 = *(const f32x4*)(bp + bj * HALF), b1 = *(const f32x4*)(bp + bj * HALF + 4);
#pragma unroll
            for (int ai = 0; ai < 2; ++ai)
#pragma unroll
                for (int m = 0; m < 4; ++m) *(u32x4*)(Y + (size_t)(row0 + ai * HALF + m * 16) * D + col0 + bj * HALF) = pack8(acc[ai][bj][m][0] * IS + b0, acc[ai][bj][m][1] * IS + b1);
        }
    }
};
struct Args { const float* in[23]; float* out; unsigned char* ws; int ph_lo, ph_hi; };
struct Frame { LAS unsigned char* lds; int tid, lane, wave, G, vcu; unsigned char* ws; };

__device__ __forceinline__ void p0_transpose_item(const float* W, int N, int k0, int n0, bf16_t* WT_row0  , LAS float* scr, int lane) {
#pragma unroll 8
    for (int i = 0; i < 32; ++i) { const int kk = 2 * i + (lane >> 5); scr[kk * 33 + (lane & 31)] = W[(size_t)(k0 + kk) * N + n0 + (lane & 31)]; }
    asm volatile("s_waitcnt lgkmcnt(0)" ::: "memory");
    const int c = lane & 7;
#pragma unroll
    for (int j = 0; j < 4; ++j) { const int n = (lane >> 3) + 8 * j; const LAS float* s = scr + (8 * c) * 33 + n;
        u32x4 o; o.x = pk2(s[0 * 33], s[1 * 33]); o.y = pk2(s[2 * 33], s[3 * 33]); o.z = pk2(s[4 * 33], s[5 * 33]); o.w = pk2(s[6 * 33], s[7 * 33]);
        *(GAS u32x4*)(WT_row0 + (size_t)n * KD + k0 + 8 * c) = o; }
    asm volatile("s_waitcnt lgkmcnt(0)" ::: "memory");
}

__device__ __forceinline__ void p0_prologue(Frame& F, const Args& a) {
    LAS float* scr = (LAS float*)(F.lds + F.wave * 16384);
    const int gw = F.vcu * NWAVES + F.wave, NGW = F.G * NWAVES;
    unsigned char* ws = F.ws;
    for (int i = gw * 64 + F.lane; i < NE * D; i += NGW * 64) { const int e = i >> 11, k = i & 2047; ((_Float16*)(ws + WS_WRH))[i] = (_Float16)(a.in[13][(size_t)k * NE + e] * 64.f); }
    if (gw < 16) { const int i = gw * 64 + F.lane; const float* lbl = a.in[5]; const float l0 = lbl[i], l1 = lbl[1024 + i]; const float mx = fmaxf(l0, l1); const float e0 = __expf(l0 - mx), e1 = __expf(l1 - mx);
        ((float*)(ws + WS_LB))[i] = e0 / (e0 + e1); }
    {
        const float* x = a.in[0]; const float* w = a.in[1]; const float* b = a.in[2];
        bf16_t* H0 = (bf16_t*)(ws + WS_H0);
        f32x4 wwv[8], bbv[8];
#pragma unroll
        for (int j = 0; j < 8; ++j) { wwv[j] = *((const f32x4*)w + F.lane + 64 * j); bbv[j] = *((const f32x4*)b + F.lane + 64 * j); }
        for (int m = gw; m < T; m += NGW) {
            const GAS f32x4* xr = (const GAS f32x4*)(x + (size_t)m * D) + F.lane;
            f32x4 v[8]; float s = 0.f;
#pragma unroll
            for (int j = 0; j < 8; ++j) { v[j] = xr[64 * j]; s += (v[j][0] + v[j][1]) + (v[j][2] + v[j][3]); }
            const float mean = wave_sum(s) * (1.f / D); float s2 = 0.f;
#pragma unroll
            for (int j = 0; j < 8; ++j) { v[j] = v[j] - mean; s2 += (v[j][0] * v[j][0] + v[j][1] * v[j][1]) + (v[j][2] * v[j][2] + v[j][3] * v[j][3]); }
            const float rstd = rsqrtf(wave_sum(s2) * (1.f / D) + EPS);
            GAS u32x2* o8 = (GAS u32x2*)(H0 + (size_t)m * D) + F.lane;
#pragma unroll
            for (int j = 0; j < 8; ++j) { const f32x4 ww = wwv[j], bb = bbv[j];
                u32x2 o; o.x = pk2(v[j][0] * rstd * ww[0] + bb[0], v[j][1] * rstd * ww[1] + bb[1]); o.y = pk2(v[j][2] * rstd * ww[2] + bb[2], v[j][3] * rstd * ww[3] + bb[3]); o8[64 * j] = o; }
        }
    }
    constexpr int I_IN = 32 * (INC / 32), I_OUT = 32 * 64;
    constexpr int NITEMS = I_IN + I_OUT;
    for (int it = gw; it < NITEMS; it += NGW) {
        int r = it;
        if (r < I_IN) { const int nb = INC / 32, kb = r / nb, n0 = 32 * (r % nb); p0_transpose_item(a.in[3], INC, 64 * kb, n0, (bf16_t*)(ws + WS_WIN) + (size_t)n0 * KD, scr, F.lane); continue; } r -= I_IN;
        { const int kb = r / 64, n0 = 32 * (r % 64); p0_transpose_item(a.in[9], D, 64 * kb, n0, (bf16_t*)(ws + WS_WOUT) + (size_t)n0 * KD, scr, F.lane); }
    }
}

constexpr int CT_TILES = NE * 3 * 32 * 16, CT_RUN = 8;
constexpr int LC_CTB = 1024;
__device__ __forceinline__ void ct_src(const Args& a, unsigned char* ws, int id, const float*& W, unsigned char*& dst, float& sc, int& k0) {
    const int e = id / 1536, r = id - e * 1536, which = r >> 9, r2 = r & 511, kb = r2 >> 4, nb = r2 & 15;
    k0 = kb * 64;
    if (which < 2) { W = a.in[which == 0 ? 15 : 17] + (size_t)e * D * FF + nb * 128; dst = ws + WS_WGU + ((size_t)e * 4096 + (size_t)nb * 256 + which * 128) * KD; sc = SC_WGU; }
    else { W = a.in[19] + (size_t)e * FF * D + nb * 128; dst = ws + WS_WD + ((size_t)e * 2048 + (size_t)nb * 128) * KD; sc = SC_WD; }
}
__device__ __forceinline__ void cv_worker(Frame& F, const Args& a, const unsigned* stop_ctr, unsigned stop_at) {
    const int tid = F.tid, lane = F.lane, wv = F.wave;
    LAS unsigned char* ring = F.lds;
    volatile LAS int* ctb = (volatile LAS int*)(F.lds + LDSCTL_OFF + LC_CTB);
    unsigned* head = (unsigned*)(F.ws + WS_CTL) + CW_CONV;
    unsigned srcoff[4];
#pragma unroll
    for (int p = 0; p < 4; ++p) { const int row = 2 * (4 * wv + p) + (lane >> 5); srcoff[p] = (unsigned)(row * 2048 + 4 * ((lane & 31) ^ (2 * ((row >> 4) & 3)))); }
    const int on = tid >> 2, oc = tid & 3;
    const int rdoff = (16 * oc) * 128 * 4 + ((((on >> 2) ^ (2 * oc)) << 2) + (on & 3)) * 4;
#define CT_CLAIM(slotw) do { if (tid == 0) { int b_ = CT_TILES; if (!(stop_ctr && __hip_atomic_load(stop_ctr, RLX_AGENT) >= stop_at)) b_ = (int)__hip_atomic_fetch_add(head, (unsigned)CT_RUN, RLX_AGENT); ctb[slotw] = b_; } } while (0)
#define CT_DMA(id_, slot_) do { const float* W_; unsigned char* d_; float s_; int k_; ct_src(a, F.ws, (id_), W_, d_, s_, k_); const float* sp_ = W_ + (size_t)k_ * 2048; \
        _Pragma("unroll") for (int p = 0; p < 4; ++p) __builtin_amdgcn_global_load_lds((const unsigned*)(sp_ + srcoff[p]), (LAS unsigned*)(ring + (slot_) * 32768 + (4 * wv + p) * 1024), 16, 0, 0); } while (0)
    __syncthreads();
    CT_CLAIM(0);
    __syncthreads();
    int base = ctb[0];
    int issued = 0;
    bool more = base < CT_TILES;
#pragma unroll 1
    for (int i = 0; i < 3; ++i) { if (more) { CT_DMA(base + (issued & (CT_RUN - 1)), issued & 3); } ++issued; }
    int pbase = base;
    for (int k = 0; ; ++k) {
        if (((k + 3) & (CT_RUN - 1)) == 0) CT_CLAIM(((k + 3) / CT_RUN) & 1);
        if (pbase >= CT_TILES) break;
        asm volatile("s_waitcnt vmcnt(10)" ::: "memory");
        if (!more) asm volatile("s_waitcnt vmcnt(0)" ::: "memory");
        __syncthreads();
        {
            const float* W_; unsigned char* dst; float sc; int k0; ct_src(a, F.ws, pbase + (k & (CT_RUN - 1)), W_, dst, sc, k0);
            const LAS float* sp = (const LAS float*)(ring + (k & 3) * 32768 + rdoff);
            u32x4 o;
            o.x = pk4_fp8(sp[0 * 128] * sc, sp[1 * 128] * sc, sp[2 * 128] * sc, sp[3 * 128] * sc); o.y = pk4_fp8(sp[4 * 128] * sc, sp[5 * 128] * sc, sp[6 * 128] * sc, sp[7 * 128] * sc);
            o.z = pk4_fp8(sp[8 * 128] * sc, sp[9 * 128] * sc, sp[10 * 128] * sc, sp[11 * 128] * sc); o.w = pk4_fp8(sp[12 * 128] * sc, sp[13 * 128] * sc, sp[14 * 128] * sc, sp[15 * 128] * sc);
            *(GAS u32x4*)(dst + (size_t)on * KD + k0 + 16 * oc) = o;
            asm volatile("s_waitcnt lgkmcnt(0)" ::: "memory");
        }
        if (((k + 3) & (CT_RUN - 1)) == 0) { base = ctb[((k + 3) / CT_RUN) & 1]; more = base < CT_TILES; }
        if (more) { CT_DMA(base + ((k + 3) & (CT_RUN - 1)), (k + 3) & 3); }
        if (((k + 1) & (CT_RUN - 1)) == 0) pbase = ctb[((k + 1) / CT_RUN) & 1];
    }
    asm volatile("s_waitcnt vmcnt(0)" ::: "memory");
    __syncthreads();
#undef CT_CLAIM
#undef CT_DMA
}

constexpr int AT_Q = 32;
typedef float f32x16 __attribute__((ext_vector_type(16)));
typedef short s16x4 __attribute__((ext_vector_type(4)));
typedef short v4i16_t __attribute__((ext_vector_type(4)));
__device__ __forceinline__ s16x4 lds_tr16(const LAS unsigned char* p) { return __builtin_bit_cast(s16x4, __builtin_amdgcn_ds_read_tr16_b64_v4i16((LAS v4i16_t*)p)); }
__device__ __forceinline__ void attn_unit_mfma(Frame& F, const Args& a, int b, int qt) {
    LAS unsigned char* KS = F.lds;
    LAS unsigned char* VS = F.lds + 40960;
    LAS float* SSQ = (LAS float*)(F.lds + 81920);
    LAS float* NWL = (LAS float*)(F.lds + 83968);
    const bf16_t* AQ = (const bf16_t*)(F.ws + WS_AQ); const bf16_t* AK = (const bf16_t*)(F.ws + WS_AK); const bf16_t* AV = (const bf16_t*)(F.ws + WS_AV);
    bf16_t* YM = (bf16_t*)(F.ws + WS_YMIX);
    const int tid = F.tid, lane = F.lane, w = F.wave, r32 = lane & 31, hi = lane >> 5, t0 = qt * 32;
    __syncthreads();
#pragma unroll
    for (int p = 0; p < 5; ++p) {
        const int c = p * 512 + tid, row = c >> 4, ch = c & 15, kvh = ch >> 3, cr = ch & 7;
        const int pos = t0 - 128 + row;
        u32x4 kv = (u32x4){0u, 0u, 0u, 0u}, vv = (u32x4){0u, 0u, 0u, 0u};
        if (pos >= 0) { const size_t o = (size_t)(b * L + pos) * 128 + kvh * 64 + cr * 8; kv = *(const u32x4*)(AK + o); vv = *(const u32x4*)(AV + o); }
        *(LAS u32x4*)(KS + kvh * 20480 + row * 128 + ((cr ^ ((row >> 1) & 7)) << 4)) = kv;
        *(LAS u32x4*)(VS + kvh * 20480 + row * 128 + (((cr >> 2) ^ ((row >> 1) & 1)) << 6) + ((cr & 3) << 4)) = vv;
    }
    __syncthreads();
    if (tid < 256) *(LAS f32x4*)(NWL + 4 * tid) = *(const f32x4*)(a.in[8] + 4 * tid);
    const int kvh = w >> 2;
    const int ktmin = t0 < 128 ? (128 - t0) >> 5 : 0;
    const LAS unsigned char* Kb = KS + kvh * 20480;
    const LAS unsigned char* Vb = VS + kvh * 20480;
    unsigned OP[2][2][8];
    float ssq = 0.f;
#pragma unroll
    for (int hh = 0; hh < 2; ++hh) {
        const int head = 2 * w + hh;
        bf16x8 qf[4];
#pragma unroll
        for (int ks = 0; ks < 4; ++ks) qf[ks] = *(const bf16x8*)(AQ + (size_t)(b * L + t0 + r32) * 1024 + head * 64 + ks * 16 + hi * 8);
        f32x16 S[5];
#pragma unroll
        for (int kt = 0; kt < 5; ++kt) {
            const int row = kt * 32 + r32;
            f32x16 acc = (f32x16){0.f, 0.f, 0.f, 0.f, 0.f, 0.f, 0.f, 0.f, 0.f, 0.f, 0.f, 0.f, 0.f, 0.f, 0.f, 0.f};
#pragma unroll
            for (int ks = 0; ks < 4; ++ks) {
                const bf16x8 kf = *(const LAS bf16x8*)(Kb + row * 128 + (((2 * ks + hi) ^ ((row >> 1) & 7)) << 4));
                acc = __builtin_amdgcn_mfma_f32_32x32x16_bf16(kf, qf[ks], acc, 0, 0, 0);
            }
            S[kt] = acc;
        }
        const float sink = a.in[7][head];
        float m = sink;
#pragma unroll
        for (int kt = 0; kt < 5; ++kt)
#pragma unroll
            for (int r = 0; r < 16; ++r) {
                const int i = (r & 3) + 8 * (r >> 2) + 4 * hi;
                bool ok = kt >= ktmin;
                if (kt == 0) ok = ok && (i > r32);
                if (kt == 4) ok = ok && (i <= r32);
                const float v = ok ? S[kt][r] : -INFINITY;
                S[kt][r] = v; m = fmaxf(m, v);
            }
        m = fmaxf(m, __shfl_xor(m, 32));
        float l = 0.f;
#pragma unroll
        for (int kt = 0; kt < 5; ++kt)
#pragma unroll
            for (int r = 0; r < 16; ++r) { const float pv = __expf(S[kt][r] - m); S[kt][r] = pv; l += pv; }
        l += __shfl_xor(l, 32);
        l += __expf(sink - m);
        const float inv = 1.f / l;
#pragma unroll
        for (int dt = 0; dt < 2; ++dt) {
            f32x16 acc = (f32x16){0.f, 0.f, 0.f, 0.f, 0.f, 0.f, 0.f, 0.f, 0.f, 0.f, 0.f, 0.f, 0.f, 0.f, 0.f, 0.f};
            const int dcol = dt * 32 + 16 * ((lane >> 4) & 1) + 4 * (lane & 3);
            const int vlane = ((lane & 15) >> 2) * 128 + ((((dcol >> 5) ^ ((lane >> 3) & 1))) << 6) + (dcol & 31) * 2;
#pragma unroll
            for (int kt = 0; kt < 5; ++kt)
#pragma unroll
                for (int s2 = 0; s2 < 2; ++s2) {
                    const int rowb = kt * 32 + 16 * s2 + 4 * hi;
                    const s16x4 lo = lds_tr16(Vb + rowb * 128 + vlane), hi4 = lds_tr16(Vb + (rowb + 8) * 128 + vlane);
                    const bf16x8 vf = (bf16x8){lo[0], lo[1], lo[2], lo[3], hi4[0], hi4[1], hi4[2], hi4[3]};
                    u32x4 pw; pw.x = cvt_pk_bf16(S[kt][8 * s2 + 0], S[kt][8 * s2 + 1]); pw.y = cvt_pk_bf16(S[kt][8 * s2 + 2], S[kt][8 * s2 + 3]);
                    pw.z = cvt_pk_bf16(S[kt][8 * s2 + 4], S[kt][8 * s2 + 5]); pw.w = cvt_pk_bf16(S[kt][8 * s2 + 6], S[kt][8 * s2 + 7]);
                    acc = __builtin_amdgcn_mfma_f32_32x32x16_bf16(vf, __builtin_bit_cast(bf16x8, pw), acc, 0, 0, 0);
                }
#pragma unroll
            for (int r = 0; r < 16; ++r) { acc[r] *= inv; ssq += acc[r] * acc[r]; }
#pragma unroll
            for (int r = 0; r < 8; ++r) OP[hh][dt][r] = cvt_pk_bf16(acc[2 * r], acc[2 * r + 1]);
        }
    }
    ssq += __shfl_xor(ssq, 32);
    if (hi == 0) SSQ[w * 32 + r32] = ssq;
    __syncthreads();
    float tot = 0.f;
#pragma unroll
    for (int ww = 0; ww < 8; ++ww) tot += SSQ[ww * 32 + r32];
    const float rr = rsqrtf(tot * (1.f / 1024.f) + EPS);
#pragma unroll
    for (int hh = 0; hh < 2; ++hh)
#pragma unroll
        for (int dt = 0; dt < 2; ++dt)
#pragma unroll
            for (int g4 = 0; g4 < 4; ++g4) {
                const int d = (2 * w + hh) * 64 + dt * 32 + 8 * g4 + 4 * hi;
                const f32x4 nw4 = *(const LAS f32x4*)(NWL + d);
                const unsigned p0 = OP[hh][dt][2 * g4], p1 = OP[hh][dt][2 * g4 + 1];
                u32x2 o; o.x = pk2(bflo(p0) * rr * nw4[0], bfhi(p0) * rr * nw4[1]); o.y = pk2(bflo(p1) * rr * nw4[2], bfhi(p1) * rr * nw4[3]);
                *(u32x2*)(YM + (size_t)(b * L + t0 + r32) * D + 1024 + d) = o;
            }
}

constexpr int HL_QM = 0, HL_KM = 16384, HL_QS = 32768, HL_KE = 49152, HL_VT = 65536, HL_PL = 81920, HL_SEG = 90112, HL_DS = 94208, HL_SSQ = 94720;
__device__ __forceinline__ int trkey(int s) { return (s & 3) | (((s >> 3) & 1) << 2); }
__device__ __forceinline__ bf16x8 mk8(const s16x4& lo, const s16x4& hi) { return (bf16x8){lo[0], lo[1], lo[2], lo[3], hi[0], hi[1], hi[2], hi[3]}; }
__device__ __forceinline__ void hgrn_unit_mfma(Frame& F, const Args& a, int b, int h) {
    LAS unsigned char* lds = F.lds;
    const bf16_t* QH = (const bf16_t*)(F.ws + WS_QH); const bf16_t* VH = (const bf16_t*)(F.ws + WS_VH); const bf16_t* OG = (const bf16_t*)(F.ws + WS_OG);
    const float* GH = (const float*)(F.ws + WS_GH);
    bf16_t* YM = (bf16_t*)(F.ws + WS_YMIX);
    const int tid = F.tid, lane = F.lane, w = F.wave, r16 = lane & 15, g = lane >> 4, cp = lane;
    const size_t tokb = (size_t)b * L;
    const int hc = h * 128;
    f32x4 Sacc[8];
#pragma unroll
    for (int i = 0; i < 8; ++i) Sacc[i] = (f32x4){0.f, 0.f, 0.f, 0.f};
    f32x2 gpre[8]; unsigned qpre[8]; u32x4 vpre[2];
    const int vrow = tid >> 3, vc16 = tid & 7;
    const unsigned lo_g = 2u * (unsigned)cp, lo_v = (unsigned)(vrow * 1024 + vc16 * 8), lo_og = (unsigned)(r16 * 1024 + 4 * g), lo_ym = (unsigned)(r16 * 2048 + 4 * g);
    {
        const size_t rb = (tokb + 8 * w) * 1024 + hc;
        const float* gb = GH + rb; const bf16_t* qb = QH + rb; const bf16_t* vb = VH + tokb * 1024 + hc;
#pragma unroll
        for (int i = 0; i < 8; ++i) { gpre[i] = *(const f32x2*)(gb + i * 1024 + lo_g); qpre[i] = *(const unsigned*)(qb + i * 1024 + lo_g); }
        vpre[0] = *(const u32x4*)(vb + lo_v); vpre[1] = *(const u32x4*)(vb + 64 + lo_v);
    }
    const int keyl = ((lane & 15) >> 2) | ((g & 1) << 2);
    const int trrow = (8 * g + ((lane & 15) >> 2)) * 256 + 8 * (lane & 3);
    const unsigned wpar = (unsigned)(w & 1);
    const unsigned A1 = (((unsigned)cp >> 2) ^ (8u * wpar)) << 4, C1 = ((unsigned)cp & 3u) * 4u + (unsigned)w * 2048u;
    const unsigned A2 = (((unsigned)cp >> 1) ^ (16u * wpar)) << 3, C2 = ((unsigned)cp & 1u) * 4u + (unsigned)w * 2048u;
    const unsigned A3 = (((unsigned)cp >> 3) ^ (wpar << 2)) << 5, C3 = ((unsigned)cp & 7u) * 4u + (unsigned)w * 2048u;
    __syncthreads();
    for (int c = 0; c < L / 64; ++c) {
        int cc = c; asm volatile("" : "+s"(cc));
        const size_t tok0 = tokb + 64 * cc;
        { float run0 = 0.f, run1 = 0.f;
#pragma unroll
          for (int i = 0; i < 8; ++i) { run0 += gpre[i].x; run1 += gpre[i].y; }
          *(LAS f32x2*)(lds + HL_SEG + (w * 128 + 2 * cp) * 4) = (f32x2){run0, run1}; }
        { const int k0 = trkey(vrow);
          *(LAS u32x4*)(lds + HL_VT + vrow * 256 + ((((vc16 >> 1)) ^ k0) << 5) + (vc16 & 1) * 16) = vpre[0];
          *(LAS u32x4*)(lds + HL_VT + vrow * 256 + (((((vc16 + 8) >> 1)) ^ k0) << 5) + (vc16 & 1) * 16) = vpre[1]; }
        __syncthreads();
        f32x2 offc = (f32x2){0.f, 0.f}, rr = (f32x2){0.f, 0.f}, tot = (f32x2){0.f, 0.f};
#pragma unroll
        for (int sg = 0; sg < 8; ++sg) { const f32x2 sv = *(const LAS f32x2*)(lds + HL_SEG + (sg * 128 + 2 * cp) * 4);
            if (sg < w) offc += sv; if (sg < 4) rr += sv; tot += sv; }
        const f32x2 Rc = (f32x2){__builtin_amdgcn_exp2f(rr.x), __builtin_amdgcn_exp2f(rr.y)};
        const f32x2 C4 = (f32x2){__builtin_amdgcn_exp2f(tot.x - rr.x), __builtin_amdgcn_exp2f(tot.y - rr.y)};
        if (w == 0) *(LAS f32x2*)(lds + HL_DS + 2 * cp * 4) = (f32x2){__builtin_amdgcn_exp2f(tot.x), __builtin_amdgcn_exp2f(tot.y)};
#pragma unroll
        for (int i = 0; i < 8; ++i) {
            offc += gpre[i];
            const f32x2 d = offc - rr;
            const float E0 = __builtin_amdgcn_exp2f(fminf(fmaxf(d.x, -115.f), 115.f)), E1 = __builtin_amdgcn_exp2f(fminf(fmaxf(d.y, -115.f), 115.f));
            const float I0 = __builtin_amdgcn_rcpf(E0), I1 = __builtin_amdgcn_rcpf(E1);
            const float k0 = 1.f - __builtin_amdgcn_exp2f(gpre[i].x), k1 = 1.f - __builtin_amdgcn_exp2f(gpre[i].y);
            const f32x2 qm = (f32x2){bflo(qpre[i]) * E0, bfhi(qpre[i]) * E1}, km = (f32x2){k0 * I0, k1 * I1};
            const f32x2 qs = qm * Rc, ke = km * C4;
            LAS unsigned char* pq = lds + i * 256 + ((A1 ^ (unsigned)(i << 4)) + C1);
            *(LAS unsigned*)(pq + HL_QM) = cvt_pk_bf16_c(qm.x, qm.y);
            *(LAS unsigned*)(pq + HL_KM) = cvt_pk_bf16_c(km.x, km.y);
            *(LAS unsigned*)(lds + HL_QS + i * 256 + ((A2 ^ (unsigned)(i << 4)) + C2)) = cvt_pk_bf16_c(qs.x, qs.y);
            *(LAS unsigned*)(lds + HL_KE + i * 256 + ((A3 ^ (unsigned)((i & 3) << 5)) + C3)) = cvt_pk_bf16_c(ke.x, ke.y);
        }
        if (c + 1 < L / 64) {
            const size_t rb = (tok0 + 64 + 8 * w) * 1024 + hc;
            const float* gb = GH + rb; const bf16_t* qb = QH + rb; const bf16_t* vb = VH + (tok0 + 64) * 1024 + hc;
#pragma unroll
            for (int i = 0; i < 8; ++i) { gpre[i] = *(const f32x2*)(gb + i * 1024 + lo_g); qpre[i] = *(const unsigned*)(qb + i * 1024 + lo_g); }
            vpre[0] = *(const u32x4*)(vb + lo_v); vpre[1] = *(const u32x4*)(vb + 64 + lo_v);
        }
        __syncthreads();
#pragma unroll
        for (int rep = 0; rep < 2; ++rep) {
            if (rep == 1 && w >= 4) break;
            const int idx = rep == 0 ? w : 8 + w;
            const int si = (0xd940e4 >> (2 * idx)) & 3, ti = (0x8fb9e4 >> (2 * idx)) & 3;
            f32x4 pacc = (f32x4){0.f, 0.f, 0.f, 0.f};
            if (idx < 10) {
#pragma unroll
                for (int ks = 0; ks < 4; ++ks) {
                    const int ofs = r16 * 256 + (((4 * ks + g) ^ r16) << 4);
                    const bf16x8 af = *(const LAS bf16x8*)(lds + HL_KM + si * 4096 + ofs);
                    const bf16x8 bfr = *(const LAS bf16x8*)(lds + HL_QM + ti * 4096 + ofs);
                    pacc = __builtin_amdgcn_mfma_f32_16x16x32_bf16(af, bfr, pacc, 0, 0, 0);
                }
                const bool offd = si != ti;
#pragma unroll
                for (int r = 0; r < 4; ++r) pacc[r] = (offd || (4 * g + r <= r16)) ? pacc[r] : 0.f;
            }
            asm volatile("s_nop 7\n\ts_nop 7" ::: "memory");
            const int t = 16 * ti + r16;
            u32x2 pw; pw.x = cvt_pk_bf16_c(pacc[0], pacc[1]); pw.y = cvt_pk_bf16_c(pacc[2], pacc[3]);
            *(LAS u32x2*)(lds + HL_PL + t * 128 + (((2 * si + (g >> 1)) ^ ((t >> 1) & 7)) << 4) + (g & 1) * 8) = pw;
        }
        __syncthreads();
        const f32x4 nw4 = *(const f32x4*)(a.in[6] + 16 * w + 4 * g);
        u32x2 ogp[4];
        { const bf16_t* ob = OG + tok0 * 1024 + hc + 16 * w;
#pragma unroll
          for (int ti = 0; ti < 4; ++ti) ogp[ti] = *(const u32x2*)(ob + ti * 16384 + lo_og); }
#define HG_SB() __builtin_amdgcn_sched_barrier(0)
#define HG_QSLD(dst, kp) do { _Pragma("unroll") for (int ti = 0; ti < 4; ++ti) { const int t_ = 16 * ti + r16; \
            const u32x2 lo_ = *(const LAS u32x2*)(lds + HL_QS + t_ * 256 + (((8 * (kp) + g) ^ (r16 << 1)) << 3)); \
            const u32x2 hi_ = *(const LAS u32x2*)(lds + HL_QS + t_ * 256 + (((8 * (kp) + 4 + g) ^ (r16 << 1)) << 3)); \
            dst[ti] = (u32x4){lo_.x, lo_.y, hi_.x, hi_.y}; } } while (0)
#define HG_KELD(dst, kt) do { _Pragma("unroll") for (int ks = 0; ks < 2; ++ks) { const LAS unsigned char* pb_ = lds + HL_KE + ks * 32 * 256 + trrow + (((kt) ^ keyl) << 5); \
            dst[ks] = mk8(lds_tr16(pb_), lds_tr16(pb_ + 4 * 256)); } } while (0)
#define HG_INTER(kp, qsv) do { u32x4 sw_; sw_.x = cvt_pk_bf16_c(Sacc[2 * (kp)][0], Sacc[2 * (kp)][1]); sw_.y = cvt_pk_bf16_c(Sacc[2 * (kp)][2], Sacc[2 * (kp)][3]); \
            sw_.z = cvt_pk_bf16_c(Sacc[2 * (kp) + 1][0], Sacc[2 * (kp) + 1][1]); sw_.w = cvt_pk_bf16_c(Sacc[2 * (kp) + 1][2], Sacc[2 * (kp) + 1][3]); \
            const bf16x8 sf_ = __builtin_bit_cast(bf16x8, sw_); \
            _Pragma("unroll") for (int ti = 0; ti < 4; ++ti) Oa[ti] = __builtin_amdgcn_mfma_f32_16x16x32_bf16(sf_, __builtin_bit_cast(bf16x8, qsv[ti]), Oa[ti], 0, 0, 0); } while (0)
#define HG_SUPD(kt, kev, dsv) do { f32x4 sa_ = Sacc[kt] * dsv; \
            sa_ = __builtin_amdgcn_mfma_f32_16x16x32_bf16(kev[0], vf[0], sa_, 0, 0, 0); sa_ = __builtin_amdgcn_mfma_f32_16x16x32_bf16(kev[1], vf[1], sa_, 0, 0, 0); Sacc[kt] = sa_; } while (0)
        bf16x8 vf[2];
        bf16x8 pf[6];
        u32x4 qsA[4], qsB[4];
#pragma unroll
        for (int ks = 0; ks < 2; ++ks) {
            const LAS unsigned char* pb = lds + HL_VT + ks * 32 * 256 + trrow + ((w ^ keyl) << 5);
            vf[ks] = mk8(lds_tr16(pb), lds_tr16(pb + 4 * 256));
        }
        {
            const int t0_ = r16, t1_ = 16 + r16, t2_ = 32 + r16, t3_ = 48 + r16;
            pf[0] = *(const LAS bf16x8*)(lds + HL_PL + t0_ * 128 + (((g) ^ ((t0_ >> 1) & 7)) << 4));
            pf[1] = *(const LAS bf16x8*)(lds + HL_PL + t1_ * 128 + (((g) ^ ((t1_ >> 1) & 7)) << 4));
            pf[2] = *(const LAS bf16x8*)(lds + HL_PL + t2_ * 128 + (((g) ^ ((t2_ >> 1) & 7)) << 4));
            pf[3] = *(const LAS bf16x8*)(lds + HL_PL + t2_ * 128 + (((4 + g) ^ ((t2_ >> 1) & 7)) << 4));
            pf[4] = *(const LAS bf16x8*)(lds + HL_PL + t3_ * 128 + (((g) ^ ((t3_ >> 1) & 7)) << 4));
            pf[5] = *(const LAS bf16x8*)(lds + HL_PL + t3_ * 128 + (((4 + g) ^ ((t3_ >> 1) & 7)) << 4));
        }
        HG_QSLD(qsA, 0);
        HG_SB();
        f32x4 Oa[4];
        const f32x4 z4 = (f32x4){0.f, 0.f, 0.f, 0.f};
        Oa[0] = __builtin_amdgcn_mfma_f32_16x16x32_bf16(vf[0], pf[0], z4, 0, 0, 0);
        Oa[1] = __builtin_amdgcn_mfma_f32_16x16x32_bf16(vf[0], pf[1], z4, 0, 0, 0);
        Oa[2] = __builtin_amdgcn_mfma_f32_16x16x32_bf16(vf[0], pf[2], z4, 0, 0, 0);
        Oa[3] = __builtin_amdgcn_mfma_f32_16x16x32_bf16(vf[0], pf[4], z4, 0, 0, 0);
        Oa[2] = __builtin_amdgcn_mfma_f32_16x16x32_bf16(vf[1], pf[3], Oa[2], 0, 0, 0);
        Oa[3] = __builtin_amdgcn_mfma_f32_16x16x32_bf16(vf[1], pf[5], Oa[3], 0, 0, 0);
        HG_SB();
        HG_QSLD(qsB, 1);
        HG_SB();
        HG_INTER(0, qsA);
        HG_SB();
        HG_QSLD(qsA, 2);
        HG_SB();
        HG_INTER(1, qsB);
        HG_SB();
        HG_QSLD(qsB, 3);
        HG_SB();
#define HG_DSLD(kt) (*(const LAS f32x4*)(lds + HL_DS + (16 * (kt) + 4 * g) * 4))
        bf16x8 keA[2], keB[2], keC[2], keD[2]; f32x4 dA, dB, dC, dD;
        HG_KELD(keA, 0); HG_KELD(keB, 1); dA = HG_DSLD(0); dB = HG_DSLD(1);
        HG_SB();
        HG_INTER(2, qsA);
        HG_SB();
        HG_KELD(keC, 2); HG_KELD(keD, 3); dC = HG_DSLD(2); dD = HG_DSLD(3);
        HG_SB();
        HG_INTER(3, qsB);
        HG_SB();
        HG_SUPD(0, keA, dA); HG_SUPD(1, keB, dB);
        HG_SB();
        HG_KELD(keA, 4); HG_KELD(keB, 5); dA = HG_DSLD(4); dB = HG_DSLD(5);
        HG_SB();
        HG_SUPD(2, keC, dC); HG_SUPD(3, keD, dD);
        HG_SB();
        HG_KELD(keC, 6); HG_KELD(keD, 7); dC = HG_DSLD(6); dD = HG_DSLD(7);
        HG_SB();
        HG_SUPD(4, keA, dA); HG_SUPD(5, keB, dB);
        HG_SB();
        HG_SUPD(6, keC, dC); HG_SUPD(7, keD, dD);
#undef HG_DSLD
#undef HG_SB
#undef HG_QSLD
#undef HG_KELD
#undef HG_INTER
#undef HG_SUPD
#pragma unroll
        for (int ti = 0; ti < 4; ++ti) {
            float sq = (Oa[ti][0] * Oa[ti][0] + Oa[ti][1] * Oa[ti][1]) + (Oa[ti][2] * Oa[ti][2] + Oa[ti][3] * Oa[ti][3]);
            sq += __shfl_xor(sq, 16); sq += __shfl_xor(sq, 32);
            if (g == 0) *(LAS float*)(lds + HL_SSQ + (w * 64 + 16 * ti + r16) * 4) = sq;
        }
        __syncthreads();
#pragma unroll
        for (int ti = 0; ti < 4; ++ti) {
            const int t = 16 * ti + r16;
            float tot = 0.f;
#pragma unroll
            for (int ww = 0; ww < 8; ++ww) tot += *(const LAS float*)(lds + HL_SSQ + (ww * 64 + t) * 4);
            const float rs = rsqrtf(tot * (1.f / 128.f) + EPS);
            u32x2 o; o.x = pk2(Oa[ti][0] * rs * nw4[0] * bflo(ogp[ti].x), Oa[ti][1] * rs * nw4[1] * bfhi(ogp[ti].x));
            o.y = pk2(Oa[ti][2] * rs * nw4[2] * bflo(ogp[ti].y), Oa[ti][3] * rs * nw4[3] * bfhi(ogp[ti].y));
            *(u32x2*)(YM + tok0 * D + hc + 16 * w + ti * 32768 + lo_ym) = o;
        }
    }
}

typedef _Float16 f16x8 __attribute__((ext_vector_type(8)));
typedef _Float16 f16x2 __attribute__((ext_vector_type(2)));
__device__ __forceinline__ unsigned pkh(float a, float b) { const f16x2 h = {(_Float16)a, (_Float16)b}; return __builtin_bit_cast(unsigned, h); }
constexpr int LC_CNTL = 4096, LC_BASE = 4224;
__device__ __forceinline__ void p4_ln_router(Frame& F, const Args& a) {
    LAS unsigned char* lds = F.lds;
    const bf16_t* Z = (const bf16_t*)(F.ws + WS_Z); bf16_t* H1 = (bf16_t*)(F.ws + WS_H1);
    const float* w = a.in[11]; const float* b = a.in[12]; const float* br = a.in[14];
    int* cnt = (int*)(F.ws + WS_CTL) + CW_CNT; int* list = (int*)(F.ws + WS_LIST);
    int* tok_e = (int*)(F.ws + WS_TOKE); int* tok_p = (int*)(F.ws + WS_TOKP); float* tok_g = (float*)(F.ws + WS_TOKG);
    const int tid = F.tid, lane = F.lane, wv = F.wave, r16 = lane & 15, g = lane >> 4, nh = wv & 1, q = wv >> 1;
    LAS int* CNTL = (LAS int*)(lds + LDSCTL_OFF + LC_CNTL); LAS int* BASE = (LAS int*)(lds + LDSCTL_OFF + LC_BASE);
    if (tid < 32) CNTL[tid] = 0;
    const _Float16* ph = (const _Float16*)(F.ws + WS_WRH) + (size_t)(16 * nh + r16) * D + 512 * q + 8 * g;
    int se0 = 0, se1 = 0, se2 = 0, se3 = 0; float sg0 = 0.f, sg1 = 0.f, sg2 = 0.f, sg3 = 0.f;
    const int ntile = T / 32;
    const int nmy = (ntile - F.vcu + F.G - 1) / F.G;
    for (int it = 0; it < nmy; ++it) {
        const int tile = F.vcu + it * F.G;
        __syncthreads();
#define P4_LN(v, tlx) do { const int tl = (tlx); float s = 0.f; \
            _Pragma("unroll") for (int j = 0; j < 8; ++j) s += (v[j][0] + v[j][1]) + (v[j][2] + v[j][3]); \
            const float mean = wave_sum(s) * (1.f / D); float s2 = 0.f; \
            _Pragma("unroll") for (int j = 0; j < 8; ++j) { v[j] = v[j] - mean; s2 += (v[j][0] * v[j][0] + v[j][1] * v[j][1]) + (v[j][2] * v[j][2] + v[j][3] * v[j][3]); } \
            const float rstd = rsqrtf(wave_sum(s2) * (1.f / D) + EPS); \
            _Pragma("unroll") for (int j = 0; j < 8; ++j) { const f32x4 ww = *((const f32x4*)w + 2 * (lane + 64 * (j >> 1)) + (j & 1)), bb = *((const f32x4*)b + 2 * (lane + 64 * (j >> 1)) + (j & 1)); \
                f32x4 hv; hv[0] = v[j][0] * rstd * ww[0] + bb[0]; hv[1] = v[j][1] * rstd * ww[1] + bb[1]; hv[2] = v[j][2] * rstd * ww[2] + bb[2]; hv[3] = v[j][3] * rstd * ww[3] + bb[3]; \
                u32x2 hh; hh.x = pkh(hv[0], hv[1]); hh.y = pkh(hv[2], hv[3]); \
                *(LAS u32x2*)(lds + tl * 4096 + (((lane + 64 * (j >> 1)) ^ (tl & 15)) << 4) + (j & 1) * 8) = hh; } } while (0)
#pragma unroll 1
        for (int ps = 0; ps < 2; ++ps) {
            f32x4 v0[8], v1[8];
            { const GAS u32x4* z0 = (const GAS u32x4*)(Z + (size_t)(tile * 32 + 4 * wv + 2 * ps) * D) + lane;
              u32x4 r0[4], r1[4];
#pragma unroll
              for (int jj = 0; jj < 4; ++jj) { r0[jj] = z0[64 * jj]; r1[jj] = z0[64 * jj + 256]; }
#pragma unroll
              for (int jj = 0; jj < 4; ++jj) {
                  v0[2 * jj][0] = __uint_as_float(r0[jj].x << 16); v0[2 * jj][1] = __uint_as_float(r0[jj].x & 0xffff0000u); v0[2 * jj][2] = __uint_as_float(r0[jj].y << 16); v0[2 * jj][3] = __uint_as_float(r0[jj].y & 0xffff0000u);
                  v0[2 * jj + 1][0] = __uint_as_float(r0[jj].z << 16); v0[2 * jj + 1][1] = __uint_as_float(r0[jj].z & 0xffff0000u); v0[2 * jj + 1][2] = __uint_as_float(r0[jj].w << 16); v0[2 * jj + 1][3] = __uint_as_float(r0[jj].w & 0xffff0000u);
                  v1[2 * jj][0] = __uint_as_float(r1[jj].x << 16); v1[2 * jj][1] = __uint_as_float(r1[jj].x & 0xffff0000u); v1[2 * jj][2] = __uint_as_float(r1[jj].y << 16); v1[2 * jj][3] = __uint_as_float(r1[jj].y & 0xffff0000u);
                  v1[2 * jj + 1][0] = __uint_as_float(r1[jj].z << 16); v1[2 * jj + 1][1] = __uint_as_float(r1[jj].z & 0xffff0000u); v1[2 * jj + 1][2] = __uint_as_float(r1[jj].w << 16); v1[2 * jj + 1][3] = __uint_as_float(r1[jj].w & 0xffff0000u);
              } }
            P4_LN(v0, 4 * wv + 2 * ps); P4_LN(v1, 4 * wv + 2 * ps + 1);
        }
#undef P4_LN
        __syncthreads();
#pragma unroll 2
        for (int r = 0; r < 16; ++r) {
            const int idx = r * 512 + tid, t = idx >> 8, c = idx & 255;
            const f16x8 hv8 = *(const LAS f16x8*)(lds + t * 4096 + ((c ^ (t & 15)) << 4));
            float f[8];
#pragma unroll
            for (int q8 = 0; q8 < 8; ++q8) f[q8] = (float)hv8[q8];
            const size_t go = (size_t)(tile * 32 + t) * D + 8 * c;
            u32x4 ob; ob.x = pk2(f[0], f[1]); ob.y = pk2(f[2], f[3]); ob.z = pk2(f[4], f[5]); ob.w = pk2(f[6], f[7]);
            *(GAS u32x4*)(H1 + go) = ob;
            u32x2 oq; oq.x = pk4_fp8(f[0] * SC_H1, f[1] * SC_H1, f[2] * SC_H1, f[3] * SC_H1); oq.y = pk4_fp8(f[4] * SC_H1, f[5] * SC_H1, f[6] * SC_H1, f[7] * SC_H1);
            *(GAS u32x2*)(F.ws + WS_H1Q + go) = oq;
        }
        f16x8 wf[16];
#pragma unroll
        for (int ks = 0; ks < 16; ++ks) wf[ks] = *(const f16x8*)(ph + 32 * ks);
        f32x4 acc0 = (f32x4){0.f, 0.f, 0.f, 0.f}, acc1 = (f32x4){0.f, 0.f, 0.f, 0.f};
#pragma unroll
        for (int ks = 0; ks < 16; ++ks) {
            const int off = r16 * 4096 + (((64 * q + 4 * ks + g) ^ r16) << 4);
            const f16x8 t0 = *(const LAS f16x8*)(lds + off), t1 = *(const LAS f16x8*)(lds + 65536 + off);
            acc0 = __builtin_amdgcn_mfma_f32_16x16x32_f16(wf[ks], t0, acc0, 0, 0, 0);
            acc1 = __builtin_amdgcn_mfma_f32_16x16x32_f16(wf[ks], t1, acc1, 0, 0, 0);
        }
        __syncthreads();
        *(LAS f32x4*)(lds + ((q * 32 + r16) * 32 + 16 * nh + 4 * g) * 4) = acc0;
        *(LAS f32x4*)(lds + ((q * 32 + 16 + r16) * 32 + 16 * nh + 4 * g) * 4) = acc1;
        __syncthreads();
#pragma unroll
        for (int ps = 0; ps < 2; ++ps) {
            const int e = lane & 31, tl = 4 * wv + 2 * ps + (lane >> 5);
            float sl = 0.f;
#pragma unroll
            for (int qq = 0; qq < 4; ++qq) sl += *(const LAS float*)(lds + ((qq * 32 + tl) * 32 + e) * 4);
            sl = sl * (1.f / 64.f) + br[e];
            float val = sl; int te[4]; float tv[4];
#pragma unroll
            for (int r = 0; r < 4; ++r) {
                float bv = val; int bi = e;
#pragma unroll
                for (int o = 1; o < 32; o <<= 1) { const float ov = __shfl_xor(bv, o); const int oi = __shfl_xor(bi, o); if (ov > bv || (ov == bv && oi < bi)) { bv = ov; bi = oi; } }
                te[r] = bi; tv[r] = bv; if (e == bi) val = -INFINITY;
            }
            float p[4], psum = 0.f;
#pragma unroll
            for (int r = 0; r < 4; ++r) { p[r] = __expf(tv[r] - tv[0]); psum += p[r]; }
            if (e < 4) {
                int ee = te[0]; float gg = p[0];
                if (e == 1) { ee = te[1]; gg = p[1]; } else if (e == 2) { ee = te[2]; gg = p[2]; } else if (e == 3) { ee = te[3]; gg = p[3]; }
                const float gn = gg / psum; const int idx = it * 2 + ps;
                if (idx == 0) { se0 = ee; sg0 = gn; } else if (idx == 1) { se1 = ee; sg1 = gn; } else if (idx == 2) { se2 = ee; sg2 = gn; } else { se3 = ee; sg3 = gn; }
            }
        }
    }
    __syncthreads();
    const bool own = (lane & 31) < 4;
    const int nent = nmy * 2;
    int rk0 = 0, rk1 = 0, rk2 = 0, rk3 = 0;
    if (own) {
        if (nent > 0) rk0 = __hip_atomic_fetch_add((LAS int*)&CNTL[se0], 1, __ATOMIC_RELAXED, __HIP_MEMORY_SCOPE_WORKGROUP);
        if (nent > 1) rk1 = __hip_atomic_fetch_add((LAS int*)&CNTL[se1], 1, __ATOMIC_RELAXED, __HIP_MEMORY_SCOPE_WORKGROUP);
        if (nent > 2) rk2 = __hip_atomic_fetch_add((LAS int*)&CNTL[se2], 1, __ATOMIC_RELAXED, __HIP_MEMORY_SCOPE_WORKGROUP);
        if (nent > 3) rk3 = __hip_atomic_fetch_add((LAS int*)&CNTL[se3], 1, __ATOMIC_RELAXED, __HIP_MEMORY_SCOPE_WORKGROUP);
    }
    __syncthreads();
    if (tid < 32) { const int c = CNTL[tid]; BASE[tid] = c > 0 ? atomicAdd(&cnt[tid], c) : 0; }
    __syncthreads();
    if (own) {
        const int k = lane & 31;
#define P4_EMIT(idx, sex, sgx, rkx) do { if (nent > (idx)) { const int m = (F.vcu + ((idx) >> 1) * F.G) * 32 + 4 * wv + 2 * ((idx) & 1) + (lane >> 5), pos = BASE[sex] + (rkx); \
            list[(size_t)(sex) * LISTCAP + pos] = m; tok_e[m * 4 + k] = (sex); tok_p[m * 4 + k] = pos; tok_g[m * 4 + k] = (sgx); } } while (0)
        P4_EMIT(0, se0, sg0, rk0); P4_EMIT(1, se1, sg1, rk1); P4_EMIT(2, se2, sg2, rk2); P4_EMIT(3, se3, sg3, rk3);
#undef P4_EMIT
    }
}
__device__ __forceinline__ int moe_tables(Frame& F) {
    LAS int* pts = (LAS int*)(F.lds + LDSCTL_OFF + LC_PTS); LAS int* cl = (LAS int*)(F.lds + LDSCTL_OFF + LC_CNT); LAS unsigned char* tileE = (LAS unsigned char*)(F.lds + LDSCTL_OFF + LC_TILEE);
    const int* cnt = (const int*)(F.ws + WS_CTL) + CW_CNT;
    __syncthreads();
    if (F.tid < 64) {
        const int e = F.tid & 31; const int c = __hip_atomic_load(cnt + e, RLX_AGENT); const int tl = (c + 255) >> 8;
        int incl = tl;
#pragma unroll
        for (int o = 1; o < 32; o <<= 1) { const int v = __shfl_up(incl, o, 32); if (e >= o) incl += v; }
        if (F.tid < 32) { cl[e] = c; pts[e] = incl - tl; if (e == 31) pts[32] = incl; }
    }
    __syncthreads();
    const int nmt = pts[32];
    for (int t = F.tid; t < nmt; t += NTHR) { int e = 0;
        for (int j = 0; j < 32; ++j) if (t >= pts[j + 1]) e = j + 1;
        tileE[t] = (unsigned char)e; }
    __syncthreads();
    return __builtin_amdgcn_readfirstlane(nmt);
}
__device__ __forceinline__ void p7_combine(Frame& F, const Args& a) {
    const LAS int* pts = (const LAS int*)(F.lds + LDSCTL_OFF + LC_PTS);
    const bf16_t* H1 = (const bf16_t*)(F.ws + WS_H1); const bf16_t* Y = (const bf16_t*)(F.ws + WS_Y);
    const int* tok_e = (const int*)(F.ws + WS_TOKE); const int* tok_p = (const int*)(F.ws + WS_TOKP); const float* tok_g = (const float*)(F.ws + WS_TOKG);
    const float* w = a.in[21]; const float* b = a.in[22]; float* out = a.out;
    const int gw = F.vcu * NWAVES + F.wave, NGW = F.G * NWAVES, lane = F.lane;
    LAS f32x4* WL = (LAS f32x4*)F.lds; LAS f32x4* BL = (LAS f32x4*)(F.lds + 8192);
    __syncthreads();
    WL[F.tid] = *((const f32x4*)w + F.tid); BL[F.tid] = *((const f32x4*)b + F.tid);
    __syncthreads();
    const int ntok = (T - gw + NGW - 1) / NGW;
    int rowv = 0; float gv = 0.f;
    { const int i = lane >> 2, k = lane & 3; if (i < ntok) { const int m = gw + i * NGW; const int e = tok_e[m * 4 + k]; rowv = pts[e] * 256 + tok_p[m * 4 + k]; gv = tok_g[m * 4 + k]; } }
#define P8_LOAD(hx, yx, i) do { const int m_ = gw + (i) * NGW; const GAS u32x2* hr_ = (const GAS u32x2*)(H1 + (size_t)m_ * D) + lane; \
        _Pragma("unroll") for (int j = 0; j < 8; ++j) hx[j] = hr_[64 * j]; \
        _Pragma("unroll") for (int k = 0; k < 4; ++k) { const int row_ = __builtin_amdgcn_readlane(rowv, 4 * (i) + k); const GAS u32x2* yr_ = (const GAS u32x2*)(Y + (size_t)row_ * D) + lane; \
            _Pragma("unroll") for (int j = 0; j < 8; ++j) yx[k][j] = yr_[64 * j]; } } while (0)
#define P8_DO(hx, yx, i) do { const int m_ = gw + (i) * NGW; f32x4 v[8]; asm volatile("" ::: "memory"); \
        _Pragma("unroll") for (int j = 0; j < 8; ++j) { v[j][0] = ALPHA * bflo(hx[j].x); v[j][1] = ALPHA * bfhi(hx[j].x); v[j][2] = ALPHA * bflo(hx[j].y); v[j][3] = ALPHA * bfhi(hx[j].y); } \
        _Pragma("unroll") for (int k = 0; k < 4; ++k) { const float g_ = __builtin_bit_cast(float, __builtin_amdgcn_readlane(__builtin_bit_cast(int, gv), 4 * (i) + k)); \
            _Pragma("unroll") for (int j = 0; j < 8; ++j) { v[j][0] += g_ * bflo(yx[k][j].x); v[j][1] += g_ * bfhi(yx[k][j].x); v[j][2] += g_ * bflo(yx[k][j].y); v[j][3] += g_ * bfhi(yx[k][j].y); } } \
        float s = 0.f; _Pragma("unroll") for (int j = 0; j < 8; ++j) s += (v[j][0] + v[j][1]) + (v[j][2] + v[j][3]); \
        const float mean = wave_sum(s) * (1.f / D); float s2 = 0.f; \
        _Pragma("unroll") for (int j = 0; j < 8; ++j) { v[j] = v[j] - mean; s2 += (v[j][0] * v[j][0] + v[j][1] * v[j][1]) + (v[j][2] * v[j][2] + v[j][3] * v[j][3]); } \
        const float rstd = rsqrtf(wave_sum(s2) * (1.f / D) + EPS); GAS f32x4* orow = (GAS f32x4*)(out + (size_t)m_ * D) + lane; \
        _Pragma("unroll") for (int j = 0; j < 8; ++j) { const f32x4 ww = WL[lane + 64 * j], bb = BL[lane + 64 * j]; \
            f32x4 o; o[0] = v[j][0] * rstd * ww[0] + bb[0]; o[1] = v[j][1] * rstd * ww[1] + bb[1]; o[2] = v[j][2] * rstd * ww[2] + bb[2]; o[3] = v[j][3] * rstd * ww[3] + bb[3]; orow[64 * j] = o; } } while (0)
    u32x2 hA[8], yA[4][8], hB[8], yB[4][8];
    if (ntok > 0) P8_LOAD(hA, yA, 0);
    for (int i = 0; i < ntok; i += 2) {
        if (i + 1 < ntok) P8_LOAD(hB, yB, i + 1);
        P8_DO(hA, yA, i);
        if (i + 1 < ntok) { if (i + 2 < ntok) P8_LOAD(hA, yA, i + 2); P8_DO(hB, yB, i + 1); }
    }
#undef P8_LOAD
#undef P8_DO
}

__global__ void __launch_bounds__(NTHR, 2) mk_fwd(Args args) {
    extern __shared__ __attribute__((aligned(16))) unsigned char lds_raw[];
    Frame F;
    F.lds = (LAS unsigned char*)lds_raw;
    F.tid = threadIdx.x; F.lane = F.tid & 63; F.wave = __builtin_amdgcn_readfirstlane(F.tid >> 6);
    F.G = gridDim.x; { const int bx = blockIdx.x; F.vcu = (F.G % 8 == 0) ? (bx % 8) * (F.G / 8) + bx / 8 : bx; }
    F.ws = args.ws;
    unsigned char* ws = args.ws;
    for (int u = F.tid; u < (LDS_BYTES - LDSCTL_OFF) / 4; u += NTHR) ((LAS unsigned*)(F.lds + LDSCTL_OFF))[u] = 0u;
    __syncthreads();
    XcdBarrier bar; bar.bar = (unsigned*)(ws + WS_CTL) + CW_BAR; bar.x = 0; bar.st = nullptr;
#if !MK_PER_PHASE
    bar = xcd_barrier_post((unsigned*)(ws + WS_CTL) + CW_BAR, (volatile LAS unsigned*)(F.lds + LDSCTL_OFF + LC_BAR));
#endif
    const int lo = args.ph_lo, hi = args.ph_hi;
#define IN(k) (lo <= (k) && (k) < hi)
#define REFRESH_IDS() do { int t_ = threadIdx.x; asm volatile("" : "+v"(t_)); F.tid = t_; F.lane = t_ & 63; F.wave = __builtin_amdgcn_readfirstlane(t_ >> 6); } while (0)
#define SEAM(k) do { if (IN(k) && IN((k) + 1)) xcd_barrier(bar); } while (0)

    if (IN(0)) { REFRESH_IDS(); for (int r = 0; r < REP0; ++r) { p0_prologue(F, args); if (r + 1 < REP0) xcd_barrier(bar); } } SEAM(0);

    if (IN(1)) { REFRESH_IDS();
        const int Gg = F.G;
        SchedDense S{(const bf16_t*)(ws + WS_H0), (const bf16_t*)(ws + WS_WIN), T / 256, INC / 256, Gg, (int)blockIdx.x};
        EpiInProj E{(bf16_t*)(ws + WS_QH), (bf16_t*)(ws + WS_KH), (bf16_t*)(ws + WS_VH), (bf16_t*)(ws + WS_OG), (bf16_t*)(ws + WS_AQ), (bf16_t*)(ws + WS_AK), (bf16_t*)(ws + WS_AV),
                    (float*)(ws + WS_GH), (const float*)(ws + WS_LB), args.in[4]};
        for (int r = 0; r < REP1; ++r) { gemm_phase<EpiInProj, SchedDense>(F.lds, S, E); if (r + 1 < REP1) xcd_barrier(bar); }
        {
            const int nwg = (T / 256) * (INC / 256), full = nwg / F.G, extra = nwg - full * F.G;
            const bool has_extra = (int)blockIdx.x < extra;
            if (has_extra) { if (threadIdx.x == 0) __hip_atomic_fetch_add((unsigned*)(ws + WS_CTL) + CW_P1DONE, 1u, RLX_AGENT); }
            else if (extra > 0) { __syncthreads(); cv_worker(F, args, (const unsigned*)(ws + WS_CTL) + CW_P1DONE, (unsigned)extra); }
        }
    } SEAM(1);

    if (IN(2)) { REFRESH_IDS();
        for (int r = 0; r < REP2; ++r) {
        const int nh = F.G > 64 ? 64 : F.G;
        const int a0 = F.G >= 192 ? 64 : 0, na = F.G >= 192 ? 64 : F.G;
        if ((int)blockIdx.x < nh) { for (int hu = blockIdx.x; hu < 64 * REP2H; hu += nh) hgrn_unit_mfma(F, args, (hu & 63) >> 3, hu & 7); }
        REFRESH_IDS();
        if ((int)blockIdx.x >= a0 && (int)blockIdx.x < a0 + na) {
            for (int v0 = (int)blockIdx.x - a0; v0 < NB * (L / AT_Q) * REP2A; v0 += na) { const int v = v0 % (NB * (L / AT_Q)); attn_unit_mfma(F, args, v / (L / AT_Q), v % (L / AT_Q)); }
        }
        __syncthreads();
        REFRESH_IDS();
        cv_worker(F, args, nullptr, 0u);
        if (r + 1 < REP2) xcd_barrier(bar); }
    } SEAM(2);

    if (IN(3)) { REFRESH_IDS();
        SchedDense S{(const bf16_t*)(ws + WS_YMIX), (const bf16_t*)(ws + WS_WOUT), T / 256, D / 256, F.G, (int)blockIdx.x};
        EpiOutProj E{(bf16_t*)(ws + WS_Z), (const bf16_t*)(ws + WS_H0), args.in[10]};
        for (int r = 0; r < REP3; ++r) { gemm_phase<EpiOutProj, SchedDense>(F.lds, S, E); if (r + 1 < REP3) xcd_barrier(bar); }
    } SEAM(3);

    if (IN(4)) { REFRESH_IDS(); p4_ln_router(F, args); }

    if (IN(5) && !IN(4)) { REFRESH_IDS(); __syncthreads(); cv_worker(F, args, nullptr, 0u); }
    if (IN(4) || IN(5)) { if (IN(6)) xcd_barrier(bar); }

    if (IN(6)) { REFRESH_IDS();
        const int nmt = moe_tables(F);
        SchedMoe<2048> S{(const void*)(ws + WS_H1Q), (const void*)(ws + WS_WGU), (size_t)4096 * KD, (const int*)(ws + WS_LIST),
                   (const LAS int*)(F.lds + LDSCTL_OFF + LC_PTS), (const LAS int*)(F.lds + LDSCTL_OFF + LC_CNT), (const LAS unsigned char*)(F.lds + LDSCTL_OFF + LC_TILEE), nmt, 16, F.G, (int)blockIdx.x, true};
        EpiMoe1F8 E{(unsigned char*)(ws + WS_HACT), args.in[16], args.in[18]};
        for (int r = 0; r < REP5; ++r) { gemm_phase<EpiMoe1F8, SchedMoe<2048>, true>(F.lds, S, E); if (r + 1 < REP5) xcd_barrier(bar); }
    } SEAM(6);

    if (IN(7)) { REFRESH_IDS();
        const int nmt = moe_tables(F);
        SchedMoe<2048> S{(const void*)(ws + WS_HACT), (const void*)(ws + WS_WD), (size_t)2048 * KD, (const int*)(ws + WS_LIST),
                   (const LAS int*)(F.lds + LDSCTL_OFF + LC_PTS), (const LAS int*)(F.lds + LDSCTL_OFF + LC_CNT), (const LAS unsigned char*)(F.lds + LDSCTL_OFF + LC_TILEE), nmt, 8, F.G, (int)blockIdx.x, false};
        EpiMoe2F8 E{(bf16_t*)(ws + WS_Y), args.in[20]};
        for (int r = 0; r < REP6; ++r) { gemm_phase<EpiMoe2F8, SchedMoe<2048>, true>(F.lds, S, E); if (r + 1 < REP6) xcd_barrier(bar); }
    } SEAM(7);

    if (IN(8)) { REFRESH_IDS(); (void)moe_tables(F); for (int r = 0; r < REP7; ++r) p7_combine(F, args); }
#undef IN
#undef SEAM
}
}

extern "C" void kernel_launch(void* const* d_in, const int* in_sizes, int n_in, void* d_out, int out_size, void* d_ws, size_t ws_size, hipStream_t stream) {
    static int grid = 0;
    if (grid == 0) {
        if (n_in != 23 || out_size != T * D || ws_size < WS_END) { fprintf(stderr, "kernel_launch: unexpected shapes (n_in %d out %d ws %zu need %zu)\n", n_in, out_size, ws_size, (size_t)WS_END); grid = -1; return; }
        int dev = 0, cus = 0, per_cu = 0;
        if (hipGetDevice(&dev) != hipSuccess || hipDeviceGetAttribute(&cus, hipDeviceAttributeMultiprocessorCount, dev) != hipSuccess) { grid = -1; return; }
        if (hipFuncSetAttribute((const void*)mk_fwd, hipFuncAttributeMaxDynamicSharedMemorySize, LDS_BYTES) != hipSuccess) { fprintf(stderr, "kernel_launch: hipFuncSetAttribute failed\n"); grid = -1; return; }
        if (hipOccupancyMaxActiveBlocksPerMultiprocessor(&per_cu, (const void*)mk_fwd, NTHR, LDS_BYTES) != hipSuccess || per_cu < 1) { fprintf(stderr, "kernel_launch: occupancy query says %d\n", per_cu); }
        (void)hipGetLastError();
        grid = cus;
    }
    if (grid < 0) return;
    if (hipMemsetAsync((char*)d_ws + WS_CTL, 0, CTL_ZERO_BYTES, stream) != hipSuccess) return;
    Args a{};
    for (int i = 0; i < 23; ++i) a.in[i] = (const float*)d_in[i];
    a.out = (float*)d_out; a.ws = (unsigned char*)d_ws;
#if MK_PER_PHASE
    for (int p = 0; p < NPHASE; ++p) { a.ph_lo = p; a.ph_hi = p + 1; hipLaunchKernelGGL(mk_fwd, dim3(grid), dim3(NTHR), LDS_BYTES, stream, a); }
#else
    a.ph_lo = 0; a.ph_hi = NPHASE; hipLaunchKernelGGL(mk_fwd, dim3(grid), dim3(NTHR), LDS_BYTES, stream, a);
#endif
}
```

```cpp
#include <hip/hip_runtime.h>
#include <cstdio>
#include <cstdint>

#ifndef MK_PER_PHASE
#define MK_PER_PHASE 0
#endif

#define LAS __attribute__((address_space(3)))
#define GAS __attribute__((address_space(1)))
typedef unsigned short bf16_t;
typedef short bf16x8 __attribute__((ext_vector_type(8)));
typedef float f32x4 __attribute__((ext_vector_type(4)));
typedef float f32x2 __attribute__((ext_vector_type(2)));
typedef unsigned u32x4 __attribute__((ext_vector_type(4)));
typedef unsigned u32x2 __attribute__((ext_vector_type(2)));
typedef GAS unsigned gu32;

namespace {
constexpr int D = 2048, NB = 8, L = 2048, T = NB * L;
constexpr int INC = 5376;
constexpr int NE = 32, FF = 2048, NA = T * 4;
constexpr int LISTCAP = T;
constexpr int MAXROWS = NA + NE * 256;
constexpr float ALPHA = 1.189207115002721f;
constexpr float EPS = 1e-5f;
constexpr int NWAVES = 8, NTHR = 512;
constexpr int NPHASE = 9;
constexpr int REP2H = 1, REP2A = 1;
constexpr int REP0 = 1, REP1 = 1, REP2 = 1, REP3 = 1, REP5 = 1, REP6 = 1, REP7 = 1;

constexpr size_t MiB = 1u << 20;
constexpr size_t WS_CTL = 0, CTL_ZERO_BYTES = 32768;
constexpr size_t WS_LB = 1 * MiB;
constexpr size_t WS_STATS0 = WS_LB + 4096;
constexpr size_t WS_LIST = 2 * MiB;
constexpr size_t WS_TOKE = 4 * MiB, WS_TOKP = WS_TOKE + (size_t)NA * 4, WS_TOKG = WS_TOKP + (size_t)NA * 4;
constexpr size_t WS_WRH = 5 * MiB;
constexpr size_t WS_WIN = 8 * MiB;
constexpr size_t WS_WOUT = 30 * MiB;
constexpr size_t WS_WGU = 40 * MiB;
constexpr size_t WS_WD = 552 * MiB;
constexpr size_t WS_H1 = 808 * MiB;
constexpr size_t WS_Z = 872 * MiB;
constexpr size_t WS_HACT = 1000 * MiB;
constexpr size_t WS_EARLY = 1288 * MiB;
constexpr size_t WS_H0 = WS_EARLY;
constexpr size_t WS_QH = WS_H0 + 64 * MiB, WS_KH = WS_QH + 32 * MiB, WS_VH = WS_KH + 32 * MiB, WS_OG = WS_VH + 32 * MiB, WS_AQ = WS_OG + 32 * MiB;
constexpr size_t WS_GH = WS_AQ + 32 * MiB;
constexpr size_t WS_AK = WS_GH + 64 * MiB, WS_AV = WS_AK + 4 * MiB;
constexpr size_t WS_YMIX = WS_AV + 4 * MiB;
constexpr size_t WS_H1Q = WS_KH;
constexpr size_t WS_Y = WS_EARLY;
constexpr size_t WS_END = WS_YMIX + 64 * MiB;
static_assert(WS_Y + (size_t)MAXROWS * 4096 <= WS_END + 0 * MiB || true, "");
static_assert(WS_END <= 2048 * MiB, "d_ws map");
constexpr int CW_CNT = 64;
constexpr int CW_CONV = 128, CW_P1DONE = 192, CW_HGDONE = 256;
constexpr int CW_BAR = 4096;

constexpr int RING_BYTES = 131072;
constexpr int CV_SCR = 17408;
constexpr int LDSCTL_OFF = 8 * CV_SCR;
constexpr int LDS_BYTES = 147456;
constexpr int LC_BAR = 0, LC_PTS = 64, LC_CNT = 256, LC_TILEE = 512, LC_MISC = 2048;

#define RLX_AGENT __ATOMIC_RELAXED, __HIP_MEMORY_SCOPE_AGENT
__device__ __forceinline__ unsigned f2bf(float f) { unsigned u = __builtin_bit_cast(unsigned, f); return (u + 0x7fffu + ((u >> 16) & 1u)) >> 16; }
__device__ __forceinline__ unsigned pk2(float lo, float hi) { return f2bf(lo) | (f2bf(hi) << 16); }
__device__ __forceinline__ float bf2f(unsigned short b) { return __builtin_bit_cast(float, (unsigned)b << 16); }
__device__ __forceinline__ float bflo(unsigned w) { return __builtin_bit_cast(float, w << 16); }
__device__ __forceinline__ float bfhi(unsigned w) { return __builtin_bit_cast(float, w & 0xffff0000u); }
typedef __bf16 bf16x2_t __attribute__((ext_vector_type(2)));
__device__ __forceinline__ unsigned cvt_pk_bf16_c(float lo, float hi) { f32x2 v = {lo, hi}; bf16x2_t b = __builtin_convertvector(v, bf16x2_t); return __builtin_bit_cast(unsigned, b); }
__device__ __forceinline__ unsigned cvt_pk_bf16(float lo, float hi) { unsigned r; asm volatile("v_cvt_pk_bf16_f32 %0, %1, %2" : "=v"(r) : "v"(lo), "v"(hi)); return r; }
__device__ __forceinline__ float wave_sum(float v) {
#pragma unroll
    for (int o = 1; o < 64; o <<= 1) v += __shfl_xor(v, o);
    return v;
}
__device__ __forceinline__ float sigm(float x) { return __builtin_amdgcn_rcpf(1.f + __expf(-x)); }

#define XB_TMO      128
#define XB_XCNT(j)  (256  + 64 * (j))
#define XB_XSUB(j)  (1280 + 64 * (j))
#define XB_XGEN(j)  (2304 + 64 * (j))
#define XB_TOP      3328
#define XB_TOPGEN   3392
#define XCD_BAR_WORDS 3456
#define XB_SPIN_CAP (1u << 18)
__device__ __forceinline__ unsigned xb_ld(unsigned* p)              { return __hip_atomic_load(p, __ATOMIC_RELAXED, __HIP_MEMORY_SCOPE_AGENT); }
__device__ __forceinline__ unsigned xb_add(unsigned* p, unsigned v) { return __hip_atomic_fetch_add(p, v, __ATOMIC_RELAXED, __HIP_MEMORY_SCOPE_AGENT); }
__device__ __forceinline__ unsigned xb_xcc_id() { return (unsigned)__builtin_amdgcn_s_getreg((3 << 11) | 20) & 0xFu; }
#define XB_SPIN(cond, bar) do { unsigned _sp = 0; while (cond) { __builtin_amdgcn_s_sleep(1); \
    if ((++_sp & 255u) == 0u) { if (xb_ld(&(bar)[XB_TMO])) break; if (_sp > XB_SPIN_CAP) { atomicAdd(&(bar)[XB_TMO], 1u); break; } } } } while (0)
struct XcdBarrier { unsigned* bar; unsigned x; volatile LAS unsigned* st; };
__device__ __forceinline__ XcdBarrier xcd_barrier_post(unsigned* bar, volatile LAS unsigned* st) {
    XcdBarrier b; b.bar = bar; b.x = xb_xcc_id(); b.st = st;
    if (threadIdx.x == 0) (void)xb_add(&bar[XB_XCNT(b.x)], 1u);
    return b;
}
__device__ __forceinline__ void xcd_barrier_complete(unsigned* bar, unsigned x, unsigned& nloc, unsigned& nx) {
    const unsigned G = gridDim.x * gridDim.y * gridDim.z;
    unsigned sum, cnt, mine, sp = 0u;
    for (;;) {
        sum = 0u; cnt = 0u; mine = 0u;
#pragma unroll
        for (unsigned j = 0; j < 16; ++j) { const unsigned c = xb_ld(&bar[XB_XCNT(j)]); sum += c; cnt += (c > 0u) ? 1u : 0u; mine = (j == x) ? c : mine; }
        if (sum == G) break;
        __builtin_amdgcn_s_sleep(1);
        if ((++sp & 255u) == 0u) { if (xb_ld(&bar[XB_TMO])) break; if (sp > XB_SPIN_CAP) { atomicAdd(&bar[XB_TMO], 1u); break; } }
    }
    nloc = mine > 0u ? mine : 1u; nx = cnt > 0u ? cnt : 1u;
}
__device__ __forceinline__ void xcd_barrier(const XcdBarrier& b) {
    asm volatile("s_waitcnt vmcnt(0)" ::: "memory");
    __syncthreads();
    if (threadIdx.x == 0) {
        unsigned* bar = b.bar;
        __builtin_amdgcn_s_waitcnt(0);
        unsigned nloc = b.st[0], nx = b.st[1];
        if (nloc == 0u) { xcd_barrier_complete(bar, b.x, nloc, nx); b.st[0] = nloc; b.st[1] = nx; }
        const unsigned old = xb_add(&bar[XB_XSUB(b.x)], 1u);
        const unsigned gen = old / nloc;
        if (old + 1u == (gen + 1u) * nloc) {
            __builtin_amdgcn_fence(__ATOMIC_RELEASE, "agent");
            asm volatile("s_waitcnt vmcnt(0)" ::: "memory");
            const unsigned og = xb_add(&bar[XB_TOP], 1u);
            const unsigned tg = og / nx;
            if (og + 1u == (tg + 1u) * nx) xb_add(&bar[XB_TOPGEN], 1u);
            else XB_SPIN(xb_ld(&bar[XB_TOPGEN]) == tg, bar);
            __builtin_amdgcn_fence(__ATOMIC_ACQUIRE, "agent");
            xb_add(&bar[XB_XGEN(b.x)], 1u);
            asm volatile("s_waitcnt vmcnt(0)" ::: "memory");
        } else {
            XB_SPIN(xb_ld(&bar[XB_XGEN(b.x)]) == gen, bar);
            __builtin_amdgcn_fence(__ATOMIC_ACQUIRE, "agent");
            asm volatile("s_waitcnt vmcnt(0)" ::: "memory");
        }
    }
    __syncthreads();
}

constexpr int BM = 256, BK = 64, HALF = 128, HTB = HALF * BK * 2, NXCD = 8, WGM = 8;
constexpr int STAG1 = 1, STAG3 = 1, STAG6 = 1, STAG7 = 1;
constexpr int KD = 2048, NT = KD / BK;
__device__ __forceinline__ int lds_byte(int r, int c) { const int st = (r >> 4) * 2 + (c >> 5), rr = r & 15, cc = c & 31, ch = cc >> 3, pc = (rr >> 2) ^ ((0x93 >> (2 * (3 - ch))) & 3) ^ 0; return st * 1024 + rr * 64 + ((((rr >> 2)) ^ ((ch == 0) ? 0 : (ch == 1) ? 3 : (ch == 2) ? 1 : 2)) * 16) + (cc & 7) * 2 + 0 * pc; }
__device__ __forceinline__ void stage_rc(int b, int& R, int& C) { const int st = b / 1024, sb = b % 1024, rr = sb / 64, x = ((sb % 64) / 16) ^ (rr >> 2), ch = (x == 0) ? 0 : (x == 3) ? 1 : (x == 1) ? 2 : 3; R = (st >> 1) * 16 + rr; C = (st & 1) * 32 + ch * 8 + (sb % 16) / 2; }
__device__ __forceinline__ int perm32(int rho) { const int n = rho >> 4, i = rho & 15; return 8 * (i >> 2) + 4 * n + (i & 3); }

struct GU { const char* A; const char* B; int pm, pn, e, mtl; };

__device__ __forceinline__ bool order_next(int i, int G, int c, int nM, int nN, int& pm, int& pn) {
    const int nwg = nM * nN; const long Lx = (long)i * G + c; if (Lx >= nwg) return false;
    int wgid = (int)Lx; { const int q = nwg / NXCD, r = nwg % NXCD, xcd = wgid % NXCD, off = wgid / NXCD; wgid = (xcd < r ? xcd * (q + 1) : r * (q + 1) + (xcd - r) * q) + off; }
    const int nig = WGM * nN, gid = wgid / nig, fm = gid * WGM, gsz = (nM - fm) < WGM ? (nM - fm) : WGM;
    pm = fm + ((wgid % nig) % gsz); pn = (wgid % nig) / gsz; return true;
}

typedef int v8i_t __attribute__((ext_vector_type(8)));
template <class Epi, class Sched, bool F8 = false>
__device__ __forceinline__ void gemm_phase(LAS unsigned char* lds, const Sched& S, const Epi& E) {
    const int tid = threadIdx.x, wid = __builtin_amdgcn_readfirstlane(tid >> 6), lane = tid & 63, wr = wid >> 2, wc = wid & 3, fr = lane & 15, fq = lane >> 4;
    constexpr int ROWB = F8 ? KD : KD * 2;
    constexpr int nt = ROWB / 128;
    int Rr[2], Cc[2]; unsigned voffB[2];
#pragma unroll
    for (int i = 0; i < 2; ++i) { stage_rc(tid * 16 + i * 8192, Rr[i], Cc[i]); const int Rb = Epi::PERM ? ((Rr[i] & ~31) + perm32(Rr[i] & 31)) : Rr[i]; voffB[i] = (unsigned)(Rb * ROWB + Cc[i] * 2); }
    const size_t kstep = (size_t)128;
    const size_t hstep = (size_t)HALF * ROWB;
    const unsigned ldsw = (unsigned)wid * 1024u;
    const int aoff = lds_byte(wr * 64 + fr, fq * 8), boff = lds_byte(wc * 32 + fr, fq * 8);
#define PG8_SA(b, h) (((b) * 2 + (h)) * HTB)
#define PG8_SB(b, h) ((4 + (b) * 2 + (h)) * HTB)
#define PG8_STAGE(bufoff, gbase, voff) do { _Pragma("unroll") for (int _i = 0; _i < 2; ++_i) \
        __builtin_amdgcn_global_load_lds((const unsigned*)((const char*)(gbase) + (voff)[_i]), (LAS unsigned*)(lds + (bufoff) + ldsw + _i * 8192), 16, 0, 0); } while (0)
#define PG8_LDA(dst, b, h) do { _Pragma("unroll") for (int m = 0; m < 4; ++m) _Pragma("unroll") for (int k = 0; k < 2; ++k) dst[m].q[k] = *(const LAS u32x4*)(lds + PG8_SA(b, h) + aoff + m * 2048 + k * 1024); } while (0)
#define PG8_LDB(dst, b, h) do { _Pragma("unroll") for (int n = 0; n < 2; ++n) _Pragma("unroll") for (int k = 0; k < 2; ++k) dst[n].q[k] = *(const LAS u32x4*)(lds + PG8_SB(b, h) + boff + n * 2048 + k * 1024); } while (0)
#define PG8_MMA(ai, bj, At, Bt) do { __builtin_amdgcn_s_setprio(1); _Pragma("unroll") for (int m = 0; m < 4; ++m) _Pragma("unroll") for (int n = 0; n < 2; ++n) { \
        if constexpr (F8) { asm volatile("v_mfma_f32_16x16x128_f8f6f4 %0, %1, %2, %0" : "+v"(acc[ai][bj][m][n]) : "v"(Bt[n].v), "v"(At[m].v)); } \
        else { _Pragma("unroll") for (int k = 0; k < 2; ++k) acc[ai][bj][m][n] = __builtin_amdgcn_mfma_f32_16x16x32_bf16(__builtin_bit_cast(bf16x8, Bt[n].q[k]), __builtin_bit_cast(bf16x8, At[m].q[k]), acc[ai][bj][m][n], 0, 0, 0); } } \
        __builtin_amdgcn_s_setprio(0); } while (0)
#define PG8_WAIT_V(n) asm volatile("s_waitcnt vmcnt(" #n ")" ::: "memory")
#define PG8_WAIT_L(n) asm volatile("s_waitcnt lgkmcnt(" #n ")" ::: "memory")
#define PG8_BAR __builtin_amdgcn_s_barrier()
#define PG8_SCHED __builtin_amdgcn_sched_barrier(0)
    GU cur, nxt; int ui = 0;
    if (!S.next(0, cur)) return;
    f32x4 acc[2][2][4][2];
#pragma unroll
    for (int a = 0; a < 2; ++a)
#pragma unroll
        for (int b = 0; b < 2; ++b)
#pragma unroll
            for (int m = 0; m < 4; ++m)
#pragma unroll
                for (int n = 0; n < 2; ++n) acc[a][b][m][n] = (f32x4){0.f, 0.f, 0.f, 0.f};
    int f8sc = 0x7f7f7f7f; asm volatile("" : "+v"(f8sc));
    union Frag { v8i_t v; u32x4 q[2]; };
    Frag At[4], B0[2], B1[2];
    unsigned oc0[2], oc1[2], on0[2], on1[2];
    S.a_off(cur, Rr, Cc, oc0, oc1);
    const char* cA = cur.A; const char* cB = cur.B;
    PG8_STAGE(PG8_SB(0, 0), cB, voffB); PG8_STAGE(PG8_SB(0, 1), cB + hstep, voffB); PG8_STAGE(PG8_SA(0, 0), cA, oc0); PG8_STAGE(PG8_SA(0, 1), cA, oc1);
    PG8_STAGE(PG8_SB(1, 0), cB + kstep, voffB); PG8_STAGE(PG8_SB(1, 1), cB + hstep + kstep, voffB);
    PG8_WAIT_V(6); PG8_BAR;
    if (wr == 1) PG8_BAR;
    for (;;) {
        const bool has_next = S.next(ui + 1, nxt);
        const char* nA = has_next ? nxt.A : cA; const char* nB = has_next ? nxt.B : cB;
        for (int t = 0; t < nt; t += 2) {
            const bool last = (t == nt - 2);
            const char* a1 = cA + (size_t)(t + 1) * kstep;
            const char* a2 = last ? nA : cA + (size_t)(t + 2) * kstep; const char* b2 = last ? nB : cB + (size_t)(t + 2) * kstep;
            const char* b3 = b2 + kstep;
            unsigned o20[2], o21[2];
            if (last) {
                if (has_next) S.a_off(nxt, Rr, Cc, on0, on1); else { on0[0] = oc0[0]; on0[1] = oc0[1]; on1[0] = oc1[0]; on1[1] = oc1[1]; }
                o20[0] = on0[0]; o20[1] = on0[1]; o21[0] = on1[0]; o21[1] = on1[1];
            } else { o20[0] = oc0[0]; o20[1] = oc0[1]; o21[0] = oc1[0]; o21[1] = oc1[1]; }
            PG8_LDB(B0, 0, 0); PG8_LDB(B1, 0, 1); PG8_SCHED; PG8_LDA(At, 0, 0); PG8_STAGE(PG8_SA(1, 0), a1, oc0); PG8_STAGE(PG8_SA(1, 1), a1, oc1);
            PG8_WAIT_V(8); PG8_WAIT_L(0); PG8_BAR; PG8_MMA(0, 0, At, B0); PG8_MMA(0, 1, At, B1); PG8_BAR; PG8_SCHED;
            PG8_LDA(At, 0, 1); PG8_STAGE(PG8_SB(0, 0), b2, voffB); PG8_STAGE(PG8_SB(0, 1), b2 + hstep, voffB);
            PG8_WAIT_V(6); PG8_WAIT_L(0); PG8_BAR; PG8_MMA(1, 0, At, B0); PG8_MMA(1, 1, At, B1); PG8_BAR; PG8_SCHED;
            PG8_LDB(B0, 1, 0); PG8_LDB(B1, 1, 1); PG8_SCHED; PG8_LDA(At, 1, 0); PG8_STAGE(PG8_SA(0, 0), a2, o20); PG8_STAGE(PG8_SA(0, 1), a2, o21);
            PG8_WAIT_V(8); PG8_WAIT_L(0); PG8_BAR; PG8_MMA(0, 0, At, B0); PG8_MMA(0, 1, At, B1); PG8_BAR; PG8_SCHED;
            PG8_LDA(At, 1, 1); PG8_STAGE(PG8_SB(1, 0), b3, voffB); PG8_STAGE(PG8_SB(1, 1), b3 + hstep, voffB);
            PG8_WAIT_V(6); PG8_WAIT_L(0); PG8_BAR; PG8_MMA(1, 0, At, B0); PG8_MMA(1, 1, At, B1); PG8_BAR; PG8_SCHED;
        }
        if (wr == 0) PG8_BAR;
        if constexpr (F8) asm volatile("s_nop 15\n\ts_nop 15" ::: "memory");
        E(acc, cur, wr, wc, fr, fq);
        if (!has_next) break;
#pragma unroll
        for (int a = 0; a < 2; ++a)
#pragma unroll
            for (int b = 0; b < 2; ++b)
#pragma unroll
                for (int m = 0; m < 4; ++m)
#pragma unroll
                    for (int n = 0; n < 2; ++n) acc[a][b][m][n] = (f32x4){0.f, 0.f, 0.f, 0.f};
        cur = nxt; cA = nA; cB = nB; ++ui;
        oc0[0] = on0[0]; oc0[1] = on0[1]; oc1[0] = on1[0]; oc1[1] = on1[1];
        if (wr == 1) PG8_BAR;
    }
    PG8_WAIT_V(0);
    PG8_BAR;
#undef PG8_SA
#undef PG8_SB
#undef PG8_STAGE
#undef PG8_LDA
#undef PG8_LDB
#undef PG8_MMA
#undef PG8_WAIT_V
#undef PG8_WAIT_L
#undef PG8_BAR
#undef PG8_SCHED
}

struct SchedDense {
    const bf16_t* A; const bf16_t* Bt; int nM, nN, G, c;
    __device__ __forceinline__ bool next(int i, GU& u) const {
        int pm, pn; if (!order_next(i, G, c, nM, nN, pm, pn)) return false;
        u.pm = pm; u.pn = pn; u.e = 0; u.mtl = pm; u.A = (const char*)A; u.B = (const char*)Bt + (size_t)pn * (256 * KD * 2); return true;
    }
    __device__ __forceinline__ void a_off(const GU& u, const int (&R)[2], const int (&C)[2], unsigned (&o0)[2], unsigned (&o1)[2]) const {
#pragma unroll
        for (int i = 0; i < 2; ++i) { o0[i] = (unsigned)((u.pm * 256 + R[i]) * KD + C[i]) * 2u; o1[i] = (unsigned)((u.pm * 256 + 128 + R[i]) * KD + C[i]) * 2u; }
    }
};
template <int ROWB>
struct SchedMoe {
    const void* A; const void* Bt; size_t bstride_e;
    const int* list; const LAS int* pts; const LAS int* cntl; const LAS unsigned char* tileE;
    int nM, nN, G, c; bool gather;
    __device__ __forceinline__ bool next(int i, GU& u) const {
        int pm, pn; if (!order_next(i, G, c, nM, nN, pm, pn)) return false;
        const int e = __builtin_amdgcn_readfirstlane((int)tileE[pm]);
        u.pm = pm; u.pn = pn; u.e = e; u.mtl = pm - __builtin_amdgcn_readfirstlane(pts[e]);
        u.A = (const char*)A; u.B = (const char*)Bt + (size_t)e * bstride_e + (size_t)pn * (256 * ROWB); return true;
    }
    __device__ __forceinline__ void a_off(const GU& u, const int (&R)[2], const int (&C)[2], unsigned (&o0)[2], unsigned (&o1)[2]) const {
        if (gather) {
            const int ce = __builtin_amdgcn_readfirstlane(cntl[u.e]);
            const int* lp = list + (size_t)u.e * LISTCAP;
#pragma unroll
            for (int i = 0; i < 2; ++i) {
                int i0 = u.mtl * 256 + R[i], i1 = i0 + 128;
                i0 = i0 < ce ? i0 : 0; i1 = i1 < ce ? i1 : 0;
                const int t0 = lp[i0], t1 = lp[i1];
                o0[i] = (unsigned)(t0 * ROWB + C[i] * 2); o1[i] = (unsigned)(t1 * ROWB + C[i] * 2);
            }
        } else {
#pragma unroll
            for (int i = 0; i < 2; ++i) { o0[i] = (unsigned)((u.pm * 256 + R[i]) * ROWB + C[i] * 2); o1[i] = (unsigned)((u.pm * 256 + 128 + R[i]) * ROWB + C[i] * 2); }
        }
    }
};

__device__ __forceinline__ u32x4 pack8(const f32x4& a, const f32x4& b) { u32x4 w; w.x = cvt_pk_bf16(a[0], a[1]); w.y = cvt_pk_bf16(a[2], a[3]); w.z = cvt_pk_bf16(b[0], b[1]); w.w = cvt_pk_bf16(b[2], b[3]); return w; }

struct EpiInProj {
    static constexpr bool PERM = true;
    bf16_t *QH, *KH, *VH, *OG, *AQ, *AK, *AV; float* GH; const float* lb; const float* bqkv;
    __device__ __forceinline__ void operator()(const f32x4 (&acc)[2][2][4][2], const GU& u, int wr, int wc, int fr, int fq) const {
        const int row0 = u.pm * BM + wr * 64 + fr;
        const int type = u.pn >> 2;
        int cw = wc * 32 + 8 * fq; asm volatile("" : "+v"(cw));
#pragma unroll
        for (int bj = 0; bj < 2; ++bj) {
            const int col = (u.pn & 3) * 256 + bj * HALF + cw;
            if (type == 0 || type == 3) {
                bf16_t* O = (type == 0 ? QH : OG);
#pragma unroll
                for (int ai = 0; ai < 2; ++ai)
#pragma unroll
                    for (int m = 0; m < 4; ++m) { f32x4 v0 = acc[ai][bj][m][0], v1 = acc[ai][bj][m][1];
#pragma unroll
                        for (int j = 0; j < 4; ++j) { v0[j] = v0[j] * sigm(v0[j]); v1[j] = v1[j] * sigm(v1[j]); }
                        *(u32x4*)(O + (size_t)(row0 + ai * HALF + m * 16) * 1024 + col) = pack8(v0, v1); }
            } else if (type == 1) {
                const f32x4 l0 = *(const f32x4*)(lb + col), l1 = *(const f32x4*)(lb + col + 4);
#pragma unroll
                for (int ai = 0; ai < 2; ++ai)
#pragma unroll
                    for (int m = 0; m < 4; ++m) { f32x4 v0 = acc[ai][bj][m][0], v1 = acc[ai][bj][m][1], g0, g1;
#pragma unroll
                        for (int j = 0; j < 4; ++j) { const float s0 = sigm(v0[j]), s1 = sigm(v1[j]);
                            const float f0 = l0[j] + (1.f - l0[j]) * s0, f1 = l1[j] + (1.f - l1[j]) * s1;
                            g0[j] = __log2f(f0); g1[j] = __log2f(f1); }
                        const size_t o = (size_t)(row0 + ai * HALF + m * 16) * 1024 + col;
                        *(f32x4*)(GH + o) = g0; *(f32x4*)(GH + o + 4) = g1; }
            } else if (type == 2) {
#pragma unroll
                for (int ai = 0; ai < 2; ++ai)
#pragma unroll
                    for (int m = 0; m < 4; ++m) *(u32x4*)(VH + (size_t)(row0 + ai * HALF + m * 16) * 1024 + col) = pack8(acc[ai][bj][m][0], acc[ai][bj][m][1]);
            } else if (type == 4) {
                const f32x4 b0 = *(const f32x4*)(bqkv + col), b1 = *(const f32x4*)(bqkv + col + 4);
#pragma unroll
                for (int ai = 0; ai < 2; ++ai)
#pragma unroll
                    for (int m = 0; m < 4; ++m) { const f32x4 v0 = (acc[ai][bj][m][0] + b0) * 0.125f, v1 = (acc[ai][bj][m][1] + b1) * 0.125f;
                        *(u32x4*)(AQ + (size_t)(row0 + ai * HALF + m * 16) * 1024 + col) = pack8(v0, v1); }
            } else {
                bf16_t* O = bj == 0 ? AK : AV;
                const f32x4 b0 = *(const f32x4*)(bqkv + 1024 + bj * 128 + cw), b1 = *(const f32x4*)(bqkv + 1024 + bj * 128 + cw + 4);
#pragma unroll
                for (int ai = 0; ai < 2; ++ai)
#pragma unroll
                    for (int m = 0; m < 4; ++m) *(u32x4*)(O + (size_t)(row0 + ai * HALF + m * 16) * 128 + cw) = pack8(acc[ai][bj][m][0] + b0, acc[ai][bj][m][1] + b1);
            }
        }
    }
};
struct EpiOutProj {
    static constexpr bool PERM = true;
    bf16_t* Z; const bf16_t* H0; const float* bo;
    __device__ __forceinline__ void operator()(const f32x4 (&acc)[2][2][4][2], const GU& u, int wr, int wc, int fr, int fq) const {
        const int row0 = u.pm * BM + wr * 64 + fr, col0 = u.pn * BM + wc * 32 + 8 * fq;
        f32x4 b4[2][2];
#pragma unroll
        for (int bj = 0; bj < 2; ++bj)
#pragma unroll
            for (int n = 0; n < 2; ++n) b4[bj][n] = *(const f32x4*)(bo + col0 + bj * HALF + n * 4);
#pragma unroll
        for (int ai = 0; ai < 2; ++ai) {
            u32x4 hv[4][2];
#pragma unroll
            for (int m = 0; m < 4; ++m)
#pragma unroll
                for (int bj = 0; bj < 2; ++bj) hv[m][bj] = *(const u32x4*)(H0 + (size_t)(row0 + ai * HALF + m * 16) * D + col0 + bj * HALF);
#pragma unroll
            for (int m = 0; m < 4; ++m)
#pragma unroll
                for (int bj = 0; bj < 2; ++bj) {
                    const u32x4 h = hv[m][bj];
                    f32x4 z0, z1;
                    z0[0] = __uint_as_float(h.x << 16); z0[1] = __uint_as_float(h.x & 0xffff0000u); z0[2] = __uint_as_float(h.y << 16); z0[3] = __uint_as_float(h.y & 0xffff0000u);
                    z1[0] = __uint_as_float(h.z << 16); z1[1] = __uint_as_float(h.z & 0xffff0000u); z1[2] = __uint_as_float(h.w << 16); z1[3] = __uint_as_float(h.w & 0xffff0000u);
                    z0 = z0 * ALPHA + b4[bj][0] + acc[ai][bj][m][0]; z1 = z1 * ALPHA + b4[bj][1] + acc[ai][bj][m][1];
                    *(u32x4*)(Z + (size_t)(row0 + ai * HALF + m * 16) * D + col0 + bj * HALF) = pack8(z0, z1);
                }
        }
    }
};
__device__ __forceinline__ unsigned pk4_fp8(float a, float b, float c, float d) {
    a = fminf(fmaxf(a, -448.f), 448.f); b = fminf(fmaxf(b, -448.f), 448.f); c = fminf(fmaxf(c, -448.f), 448.f); d = fminf(fmaxf(d, -448.f), 448.f);
    int w = __builtin_amdgcn_cvt_pk_fp8_f32(a, b, 0, false); w = __builtin_amdgcn_cvt_pk_fp8_f32(c, d, w, true); return (unsigned)w;
}
constexpr float SC_H1 = 32.f, SC_WGU = 2048.f, SC_HACT = 8.f, SC_WD = 4096.f, SC_Y = 64.f;
struct EpiMoe1F8 {
    static constexpr bool PERM = true;
    unsigned char* H; const float* bg; const float* bu;
    __device__ __forceinline__ void operator()(const f32x4 (&acc)[2][2][4][2], const GU& u, int wr, int wc, int fr, int fq) const {
        const int row0 = u.pm * BM + wr * 64 + fr, hc = u.pn * 128 + wc * 32 + 8 * fq;
        const float* bgp = bg + (size_t)u.e * FF + hc; const float* bup = bu + (size_t)u.e * FF + hc;
        const f32x4 g0b = *(const f32x4*)bgp, g1b = *(const f32x4*)(bgp + 4), u0b = *(const f32x4*)bup, u1b = *(const f32x4*)(bup + 4);
        constexpr float IS = 1.f / (SC_H1 * SC_WGU);
#pragma unroll
        for (int ai = 0; ai < 2; ++ai)
#pragma unroll
            for (int m = 0; m < 4; ++m) {
                f32x4 a0 = acc[ai][0][m][0] * IS + g0b, a1 = acc[ai][0][m][1] * IS + g1b, c0 = acc[ai][1][m][0] * IS + u0b, c1 = acc[ai][1][m][1] * IS + u1b;
#pragma unroll
                for (int j = 0; j < 4; ++j) {
                    const float gg0 = fminf(a0[j], 7.f), gg1 = fminf(a1[j], 7.f);
                    const float uu0 = fminf(fmaxf(c0[j], -7.f), 7.f), uu1 = fminf(fmaxf(c1[j], -7.f), 7.f);
                    a0[j] = SC_HACT * gg0 * sigm(1.702f * gg0) * (uu0 + 1.f); a1[j] = SC_HACT * gg1 * sigm(1.702f * gg1) * (uu1 + 1.f);
                }
                u32x2 o; o.x = pk4_fp8(a0[0], a0[1], a0[2], a0[3]); o.y = pk4_fp8(a1[0], a1[1], a1[2], a1[3]);
                *(u32x2*)(H + (size_t)(row0 + ai * HALF + m * 16) * FF + hc) = o;
            }
    }
};
struct EpiMoe2F8 {
    static constexpr bool PERM = true;
    unsigned char* Y; const float* bd;
    __device__ __forceinline__ void operator()(const f32x4 (&acc)[2][2][4][2], const GU& u, int wr, int wc, int fr, int fq) const {
        const int row0 = u.pm * BM + wr * 64 + fr, col0 = u.pn * BM + wc * 32 + 8 * fq;
        const float* bp = bd + (size_t)u.e * D + col0;
        constexpr float IS = SC_Y / (SC_HACT * SC_WD);
#pragma unroll
        for (int bj = 0; bj < 2; ++bj) {
            const f32x4 b0 = *(const f32x4*)(bp + bj * HALF) * SC_Y, b1 = *(const f32x4*)(bp + bj * HALF + 4) * SC_Y;
#pragma unroll
            for (int ai = 0; ai < 2; ++ai)
#pragma unroll
                for (int m = 0; m < 4; ++m) { const f32x4 y0 = acc[ai][bj][m][0] * IS + b0, y1 = acc[ai][bj][m][1] * IS + b1;
                    u32x2 o; o.x = pk4_fp8(y0[0], y0[1], y0[2], y0[3]); o.y = pk4_fp8(y1[0], y1[1], y1[2], y1[3]);
                    *(u32x2*)(Y + (size_t)(row0 + ai * HALF + m * 16) * D + col0 + bj * HALF) = o; }
        }
    }
};

struct Args { const float* in[23]; float* out; unsigned char* ws; int ph_lo, ph_hi; };
struct Frame { LAS unsigned char* lds; int tid, lane, wave, G, vcu; unsigned char* ws; };

__device__ __forceinline__ void p0_transpose_item(const float* W, int N, int k0, int n0, bf16_t* WT_row0  , LAS float* scr, int lane) {
#pragma unroll 8
    for (int i = 0; i < 32; ++i) { const int kk = 2 * i + (lane >> 5); scr[kk * 33 + (lane & 31)] = W[(size_t)(k0 + kk) * N + n0 + (lane & 31)]; }
    asm volatile("s_waitcnt lgkmcnt(0)" ::: "memory");
    const int c = lane & 7;
#pragma unroll
    for (int j = 0; j < 4; ++j) { const int n = (lane >> 3) + 8 * j; const LAS float* s = scr + (8 * c) * 33 + n;
        u32x4 o; o.x = pk2(s[0 * 33], s[1 * 33]); o.y = pk2(s[2 * 33], s[3 * 33]); o.z = pk2(s[4 * 33], s[5 * 33]); o.w = pk2(s[6 * 33], s[7 * 33]);
        *(GAS u32x4*)(WT_row0 + (size_t)n * KD + k0 + 8 * c) = o; }
    asm volatile("s_waitcnt lgkmcnt(0)" ::: "memory");
}

__device__ __forceinline__ void p0_prologue(Frame& F, const Args& a) {
    LAS float* scr = (LAS float*)(F.lds + F.wave * 16384);
    const int gw = F.vcu * NWAVES + F.wave, NGW = F.G * NWAVES;
    unsigned char* ws = F.ws;
    for (int i = gw * 64 + F.lane; i < NE * D; i += NGW * 64) { const int e = i >> 11, k = i & 2047; ((_Float16*)(ws + WS_WRH))[i] = (_Float16)(a.in[13][(size_t)k * NE + e] * 64.f); }
    if (gw < 16) { const int i = gw * 64 + F.lane; const float* lbl = a.in[5]; const float l0 = lbl[i], l1 = lbl[1024 + i]; const float mx = fmaxf(l0, l1); const float e0 = __expf(l0 - mx), e1 = __expf(l1 - mx);
        ((float*)(ws + WS_LB))[i] = e0 / (e0 + e1); }
    {
        const float* x = a.in[0]; const float* w = a.in[1]; const float* b = a.in[2];
        bf16_t* H0 = (bf16_t*)(ws + WS_H0);
        f32x4 wwv[8], bbv[8];
#pragma unroll
        for (int j = 0; j < 8; ++j) { wwv[j] = *((const f32x4*)w + F.lane + 64 * j); bbv[j] = *((const f32x4*)b + F.lane + 64 * j); }
        for (int m = gw; m < T; m += NGW) {
            const GAS f32x4* xr = (const GAS f32x4*)(x + (size_t)m * D) + F.lane;
            f32x4 v[8]; float s = 0.f;
#pragma unroll
            for (int j = 0; j < 8; ++j) { v[j] = xr[64 * j]; s += (v[j][0] + v[j][1]) + (v[j][2] + v[j][3]); }
            const float mean = wave_sum(s) * (1.f / D); float s2 = 0.f;
#pragma unroll
            for (int j = 0; j < 8; ++j) { v[j] = v[j] - mean; s2 += (v[j][0] * v[j][0] + v[j][1] * v[j][1]) + (v[j][2] * v[j][2] + v[j][3] * v[j][3]); }
            const float rstd = rsqrtf(wave_sum(s2) * (1.f / D) + EPS);
            GAS u32x2* o8 = (GAS u32x2*)(H0 + (size_t)m * D) + F.lane;
#pragma unroll
            for (int j = 0; j < 8; ++j) { const f32x4 ww = wwv[j], bb = bbv[j];
                u32x2 o; o.x = pk2(v[j][0] * rstd * ww[0] + bb[0], v[j][1] * rstd * ww[1] + bb[1]); o.y = pk2(v[j][2] * rstd * ww[2] + bb[2], v[j][3] * rstd * ww[3] + bb[3]); o8[64 * j] = o; }
        }
    }
    constexpr int I_IN = 32 * (INC / 32), I_OUT = 32 * 64;
    constexpr int NITEMS = I_IN + I_OUT;
    for (int it = gw; it < NITEMS; it += NGW) {
        int r = it;
        if (r < I_IN) { const int nb = INC / 32, kb = r / nb, n0 = 32 * (r % nb); p0_transpose_item(a.in[3], INC, 64 * kb, n0, (bf16_t*)(ws + WS_WIN) + (size_t)n0 * KD, scr, F.lane); continue; } r -= I_IN;
        { const int kb = r / 64, n0 = 32 * (r % 64); p0_transpose_item(a.in[9], D, 64 * kb, n0, (bf16_t*)(ws + WS_WOUT) + (size_t)n0 * KD, scr, F.lane); }
    }
}

constexpr int CT_TILES = NE * 3 * 32 * 16, CT_RUN = 8;
constexpr int LC_CTB = 1024;
__device__ __forceinline__ void ct_src(const Args& a, unsigned char* ws, int id, const float*& W, unsigned char*& dst, float& sc, int& k0) {
    const int e = id / 1536, r = id - e * 1536, which = r >> 9, r2 = r & 511, kb = r2 >> 4, nb = r2 & 15;
    k0 = kb * 64;
    if (which < 2) { W = a.in[which == 0 ? 15 : 17] + (size_t)e * D * FF + nb * 128; dst = ws + WS_WGU + ((size_t)e * 4096 + (size_t)nb * 256 + which * 128) * KD; sc = SC_WGU; }
    else { W = a.in[19] + (size_t)e * FF * D + nb * 128; dst = ws + WS_WD + ((size_t)e * 2048 + (size_t)nb * 128) * KD; sc = SC_WD; }
}
__device__ __forceinline__ void cv_worker(Frame& F, const Args& a, const unsigned* stop_ctr, unsigned stop_at) {
    const int tid = F.tid, lane = F.lane, wv = F.wave;
    LAS unsigned char* ring = F.lds;
    volatile LAS int* ctb = (volatile LAS int*)(F.lds + LDSCTL_OFF + LC_CTB);
    unsigned* head = (unsigned*)(F.ws + WS_CTL) + CW_CONV;
    unsigned srcoff[4];
#pragma unroll
    for (int p = 0; p < 4; ++p) { const int row = 2 * (4 * wv + p) + (lane >> 5); srcoff[p] = (unsigned)(row * 2048 + 4 * ((lane & 31) ^ (2 * ((row >> 4) & 3)))); }
    const int on = tid >> 2, oc = tid & 3;
    const int rdoff = (16 * oc) * 128 * 4 + ((((on >> 2) ^ (2 * oc)) << 2) + (on & 3)) * 4;
#define CT_CLAIM(slotw) do { if (tid == 0) { int b_ = CT_TILES; if (!(stop_ctr && __hip_atomic_load(stop_ctr, RLX_AGENT) >= stop_at)) b_ = (int)__hip_atomic_fetch_add(head, (unsigned)CT_RUN, RLX_AGENT); ctb[slotw] = b_; } } while (0)
#define CT_DMA(id_, slot_) do { const float* W_; unsigned char* d_; float s_; int k_; ct_src(a, F.ws, (id_), W_, d_, s_, k_); const float* sp_ = W_ + (size_t)k_ * 2048; \
        _Pragma("unroll") for (int p = 0; p < 4; ++p) __builtin_amdgcn_global_load_lds((const unsigned*)(sp_ + srcoff[p]), (LAS unsigned*)(ring + (slot_) * 32768 + (4 * wv + p) * 1024), 16, 0, 0); } while (0)
    __syncthreads();
    CT_CLAIM(0);
    __syncthreads();
    int base = ctb[0];
    int issued = 0;
    bool more = base < CT_TILES;
#pragma unroll 1
    for (int i = 0; i < 3; ++i) { if (more) { CT_DMA(base + (issued & (CT_RUN - 1)), issued & 3); } ++issued; }
    int pbase = base;
    for (int k = 0; ; ++k) {
        if (((k + 3) & (CT_RUN - 1)) == 0) CT_CLAIM(((k + 3) / CT_RUN) & 1);
        if (pbase >= CT_TILES) break;
        asm volatile("s_waitcnt vmcnt(10)" ::: "memory");
        if (!more) asm volatile("s_waitcnt vmcnt(0)" ::: "memory");
        __syncthreads();
        {
            const float* W_; unsigned char* dst; float sc; int k0; ct_src(a, F.ws, pbase + (k & (CT_RUN - 1)), W_, dst, sc, k0);
            const LAS float* sp = (const LAS float*)(ring + (k & 3) * 32768 + rdoff);
            u32x4 o;
            o.x = pk4_fp8(sp[0 * 128] * sc, sp[1 * 128] * sc, sp[2 * 128] * sc, sp[3 * 128] * sc); o.y = pk4_fp8(sp[4 * 128] * sc, sp[5 * 128] * sc, sp[6 * 128] * sc, sp[7 * 128] * sc);
            o.z = pk4_fp8(sp[8 * 128] * sc, sp[9 * 128] * sc, sp[10 * 128] * sc, sp[11 * 128] * sc); o.w = pk4_fp8(sp[12 * 128] * sc, sp[13 * 128] * sc, sp[14 * 128] * sc, sp[15 * 128] * sc);
            *(GAS u32x4*)(dst + (size_t)on * KD + k0 + 16 * oc) = o;
            asm volatile("s_waitcnt lgkmcnt(0)" ::: "memory");
        }
        if (((k + 3) & (CT_RUN - 1)) == 0) { base = ctb[((k + 3) / CT_RUN) & 1]; more = base < CT_TILES; }
        if (more) { CT_DMA(base + ((k + 3) & (CT_RUN - 1)), (k + 3) & 3); }
        if (((k + 1) & (CT_RUN - 1)) == 0) pbase = ctb[((k + 1) / CT_RUN) & 1];
    }
    asm volatile("s_waitcnt vmcnt(0)" ::: "memory");
    __syncthreads();
#undef CT_CLAIM
#undef CT_DMA
}

constexpr int AT_Q = 32;
typedef float f32x16 __attribute__((ext_vector_type(16)));
typedef short s16x4 __attribute__((ext_vector_type(4)));
typedef short v4i16_t __attribute__((ext_vector_type(4)));
__device__ __forceinline__ s16x4 lds_tr16(const LAS unsigned char* p) { return __builtin_bit_cast(s16x4, __builtin_amdgcn_ds_read_tr16_b64_v4i16((LAS v4i16_t*)p)); }
__device__ __forceinline__ void attn_unit_mfma(Frame& F, const Args& a, int b, int qt) {
    LAS unsigned char* KS = F.lds;
    LAS unsigned char* VS = F.lds + 40960;
    LAS float* SSQ = (LAS float*)(F.lds + 81920);
    LAS float* NWL = (LAS float*)(F.lds + 83968);
    const bf16_t* AQ = (const bf16_t*)(F.ws + WS_AQ); const bf16_t* AK = (const bf16_t*)(F.ws + WS_AK); const bf16_t* AV = (const bf16_t*)(F.ws + WS_AV);
    bf16_t* YM = (bf16_t*)(F.ws + WS_YMIX);
    const int tid = F.tid, lane = F.lane, w = F.wave, r32 = lane & 31, hi = lane >> 5, t0 = qt * 32;
    __syncthreads();
#pragma unroll
    for (int p = 0; p < 5; ++p) {
        const int c = p * 512 + tid, row = c >> 4, ch = c & 15, kvh = ch >> 3, cr = ch & 7;
        const int pos = t0 - 128 + row;
        u32x4 kv = (u32x4){0u, 0u, 0u, 0u}, vv = (u32x4){0u, 0u, 0u, 0u};
        if (pos >= 0) { const size_t o = (size_t)(b * L + pos) * 128 + kvh * 64 + cr * 8; kv = *(const u32x4*)(AK + o); vv = *(const u32x4*)(AV + o); }
        *(LAS u32x4*)(KS + kvh * 20480 + row * 128 + ((cr ^ ((row >> 1) & 7)) << 4)) = kv;
        *(LAS u32x4*)(VS + kvh * 20480 + row * 128 + (((cr >> 2) ^ ((row >> 1) & 1)) << 6) + ((cr & 3) << 4)) = vv;
    }
    __syncthreads();
    if (tid < 256) *(LAS f32x4*)(NWL + 4 * tid) = *(const f32x4*)(a.in[8] + 4 * tid);
    const int kvh = w >> 2;
    const int ktmin = t0 < 128 ? (128 - t0) >> 5 : 0;
    const LAS unsigned char* Kb = KS + kvh * 20480;
    const LAS unsigned char* Vb = VS + kvh * 20480;
    unsigned OP[2][2][8];
    float ssq = 0.f;
#pragma unroll
    for (int hh = 0; hh < 2; ++hh) {
        const int head = 2 * w + hh;
        bf16x8 qf[4];
#pragma unroll
        for (int ks = 0; ks < 4; ++ks) qf[ks] = *(const bf16x8*)(AQ + (size_t)(b * L + t0 + r32) * 1024 + head * 64 + ks * 16 + hi * 8);
        f32x16 S[5];
#pragma unroll
        for (int kt = 0; kt < 5; ++kt) {
            const int row = kt * 32 + r32;
            f32x16 acc = (f32x16){0.f, 0.f, 0.f, 0.f, 0.f, 0.f, 0.f, 0.f, 0.f, 0.f, 0.f, 0.f, 0.f, 0.f, 0.f, 0.f};
#pragma unroll
            for (int ks = 0; ks < 4; ++ks) {
                const bf16x8 kf = *(const LAS bf16x8*)(Kb + row * 128 + (((2 * ks + hi) ^ ((row >> 1) & 7)) << 4));
                acc = __builtin_amdgcn_mfma_f32_32x32x16_bf16(kf, qf[ks], acc, 0, 0, 0);
            }
            S[kt] = acc;
        }
        const float sink = a.in[7][head];
        float m = sink;
#pragma unroll
        for (int kt = 0; kt < 5; ++kt)
#pragma unroll
            for (int r = 0; r < 16; ++r) {
                const int i = (r & 3) + 8 * (r >> 2) + 4 * hi;
                bool ok = kt >= ktmin;
                if (kt == 0) ok = ok && (i > r32);
                if (kt == 4) ok = ok && (i <= r32);
                const float v = ok ? S[kt][r] : -INFINITY;
                S[kt][r] = v; m = fmaxf(m, v);
            }
        m = fmaxf(m, __shfl_xor(m, 32));
        float l = 0.f;
#pragma unroll
        for (int kt = 0; kt < 5; ++kt)
#pragma unroll
            for (int r = 0; r < 16; ++r) { const float pv = __expf(S[kt][r] - m); S[kt][r] = pv; l += pv; }
        l += __shfl_xor(l, 32);
        l += __expf(sink - m);
        const float inv = 1.f / l;
#pragma unroll
        for (int dt = 0; dt < 2; ++dt) {
            f32x16 acc = (f32x16){0.f, 0.f, 0.f, 0.f, 0.f, 0.f, 0.f, 0.f, 0.f, 0.f, 0.f, 0.f, 0.f, 0.f, 0.f, 0.f};
            const int dcol = dt * 32 + 16 * ((lane >> 4) & 1) + 4 * (lane & 3);
            const int vlane = ((lane & 15) >> 2) * 128 + ((((dcol >> 5) ^ ((lane >> 3) & 1))) << 6) + (dcol & 31) * 2;
#pragma unroll
            for (int kt = 0; kt < 5; ++kt)
#pragma unroll
                for (int s2 = 0; s2 < 2; ++s2) {
                    const int rowb = kt * 32 + 16 * s2 + 4 * hi;
                    const s16x4 lo = lds_tr16(Vb + rowb * 128 + vlane), hi4 = lds_tr16(Vb + (rowb + 8) * 128 + vlane);
                    const bf16x8 vf = (bf16x8){lo[0], lo[1], lo[2], lo[3], hi4[0], hi4[1], hi4[2], hi4[3]};
                    u32x4 pw; pw.x = cvt_pk_bf16(S[kt][8 * s2 + 0], S[kt][8 * s2 + 1]); pw.y = cvt_pk_bf16(S[kt][8 * s2 + 2], S[kt][8 * s2 + 3]);
                    pw.z = cvt_pk_bf16(S[kt][8 * s2 + 4], S[kt][8 * s2 + 5]); pw.w = cvt_pk_bf16(S[kt][8 * s2 + 6], S[kt][8 * s2 + 7]);
                    acc = __builtin_amdgcn_mfma_f32_32x32x16_bf16(vf, __builtin_bit_cast(bf16x8, pw), acc, 0, 0, 0);
                }
#pragma unroll
            for (int r = 0; r < 16; ++r) { acc[r] *= inv; ssq += acc[r] * acc[r]; }
#pragma unroll
            for (int r = 0; r < 8; ++r) OP[hh][dt][r] = cvt_pk_bf16(acc[2 * r], acc[2 * r + 1]);
        }
    }
    ssq += __shfl_xor(ssq, 32);
    if (hi == 0) SSQ[w * 32 + r32] = ssq;
    __syncthreads();
    float tot = 0.f;
#pragma unroll
    for (int ww = 0; ww < 8; ++ww) tot += SSQ[ww * 32 + r32];
    const float rr = rsqrtf(tot * (1.f / 1024.f) + EPS);
#pragma unroll
    for (int hh = 0; hh < 2; ++hh)
#pragma unroll
        for (int dt = 0; dt < 2; ++dt)
#pragma unroll
            for (int g4 = 0; g4 < 4; ++g4) {
                const int d = (2 * w + hh) * 64 + dt * 32 + 8 * g4 + 4 * hi;
                const f32x4 nw4 = *(const LAS f32x4*)(NWL + d);
                const unsigned p0 = OP[hh][dt][2 * g4], p1 = OP[hh][dt][2 * g4 + 1];
                u32x2 o; o.x = pk2(bflo(p0) * rr * nw4[0], bfhi(p0) * rr * nw4[1]); o.y = pk2(bflo(p1) * rr * nw4[2], bfhi(p1) * rr * nw4[3]);
                *(u32x2*)(YM + (size_t)(b * L + t0 + r32) * D + 1024 + d) = o;
            }
}

constexpr int HL_QM = 0, HL_KM = 16384, HL_QS = 32768, HL_KE = 49152, HL_VT = 65536, HL_PL = 81920, HL_SEG = 90112, HL_DS = 94208, HL_SSQ = 94720;
__device__ __forceinline__ int trkey(int s) { return (s & 3) | (((s >> 3) & 1) << 2); }
__device__ __forceinline__ bf16x8 mk8(const s16x4& lo, const s16x4& hi) { return (bf16x8){lo[0], lo[1], lo[2], lo[3], hi[0], hi[1], hi[2], hi[3]}; }
__device__ __forceinline__ void hgrn_unit_mfma(Frame& F, const Args& a, int b, int h) {
    LAS unsigned char* lds = F.lds;
    const bf16_t* QH = (const bf16_t*)(F.ws + WS_QH); const bf16_t* VH = (const bf16_t*)(F.ws + WS_VH); const bf16_t* OG = (const bf16_t*)(F.ws + WS_OG);
    const float* GH = (const float*)(F.ws + WS_GH);
    bf16_t* YM = (bf16_t*)(F.ws + WS_YMIX);
    const int tid = F.tid, lane = F.lane, w = F.wave, r16 = lane & 15, g = lane >> 4, cp = lane;
    const size_t tokb = (size_t)b * L;
    const int hc = h * 128;
    f32x4 Sacc[8];
#pragma unroll
    for (int i = 0; i < 8; ++i) Sacc[i] = (f32x4){0.f, 0.f, 0.f, 0.f};
    f32x2 gpre[8]; unsigned qpre[8]; u32x4 vpre[2];
    const int vrow = tid >> 3, vc16 = tid & 7;
    const unsigned lo_g = 2u * (unsigned)cp, lo_v = (unsigned)(vrow * 1024 + vc16 * 8), lo_og = (unsigned)(r16 * 1024 + 4 * g), lo_ym = (unsigned)(r16 * 2048 + 4 * g);
    {
        const size_t rb = (tokb + 8 * w) * 1024 + hc;
        const float* gb = GH + rb; const bf16_t* qb = QH + rb; const bf16_t* vb = VH + tokb * 1024 + hc;
#pragma unroll
        for (int i = 0; i < 8; ++i) { gpre[i] = *(const f32x2*)(gb + i * 1024 + lo_g); qpre[i] = *(const unsigned*)(qb + i * 1024 + lo_g); }
        vpre[0] = *(const u32x4*)(vb + lo_v); vpre[1] = *(const u32x4*)(vb + 64 + lo_v);
    }
    const int keyl = ((lane & 15) >> 2) | ((g & 1) << 2);
    const int trrow = (8 * g + ((lane & 15) >> 2)) * 256 + 8 * (lane & 3);
    const unsigned wpar = (unsigned)(w & 1);
    const unsigned A1 = (((unsigned)cp >> 2) ^ (8u * wpar)) << 4, C1 = ((unsigned)cp & 3u) * 4u + (unsigned)w * 2048u;
    const unsigned A2 = (((unsigned)cp >> 1) ^ (16u * wpar)) << 3, C2 = ((unsigned)cp & 1u) * 4u + (unsigned)w * 2048u;
    const unsigned A3 = (((unsigned)cp >> 3) ^ (wpar << 2)) << 5, C3 = ((unsigned)cp & 7u) * 4u + (unsigned)w * 2048u;
    __syncthreads();
    for (int c = 0; c < L / 64; ++c) {
        int cc = c; asm volatile("" : "+s"(cc));
        const size_t tok0 = tokb + 64 * cc;
        { float run0 = 0.f, run1 = 0.f;
#pragma unroll
          for (int i = 0; i < 8; ++i) { run0 += gpre[i].x; run1 += gpre[i].y; }
          *(LAS f32x2*)(lds + HL_SEG + (w * 128 + 2 * cp) * 4) = (f32x2){run0, run1}; }
        { const int k0 = trkey(vrow);
          *(LAS u32x4*)(lds + HL_VT + vrow * 256 + ((((vc16 >> 1)) ^ k0) << 5) + (vc16 & 1) * 16) = vpre[0];
          *(LAS u32x4*)(lds + HL_VT + vrow * 256 + (((((vc16 + 8) >> 1)) ^ k0) << 5) + (vc16 & 1) * 16) = vpre[1]; }
        __syncthreads();
        f32x2 offc = (f32x2){0.f, 0.f}, rr = (f32x2){0.f, 0.f}, tot = (f32x2){0.f, 0.f};
#pragma unroll
        for (int sg = 0; sg < 8; ++sg) { const f32x2 sv = *(const LAS f32x2*)(lds + HL_SEG + (sg * 128 + 2 * cp) * 4);
            if (sg < w) offc += sv; if (sg < 4) rr += sv; tot += sv; }
        const f32x2 Rc = (f32x2){__builtin_amdgcn_exp2f(rr.x), __builtin_amdgcn_exp2f(rr.y)};
        const f32x2 C4 = (f32x2){__builtin_amdgcn_exp2f(tot.x - rr.x), __builtin_amdgcn_exp2f(tot.y - rr.y)};
        if (w == 0) *(LAS f32x2*)(lds + HL_DS + 2 * cp * 4) = (f32x2){__builtin_amdgcn_exp2f(tot.x), __builtin_amdgcn_exp2f(tot.y)};
#pragma unroll
        for (int i = 0; i < 8; ++i) {
            offc += gpre[i];
            const f32x2 d = offc - rr;
            const float E0 = __builtin_amdgcn_exp2f(fminf(fmaxf(d.x, -115.f), 115.f)), E1 = __builtin_amdgcn_exp2f(fminf(fmaxf(d.y, -115.f), 115.f));
            const float I0 = __builtin_amdgcn_rcpf(E0), I1 = __builtin_amdgcn_rcpf(E1);
            const float k0 = 1.f - __builtin_amdgcn_exp2f(gpre[i].x), k1 = 1.f - __builtin_amdgcn_exp2f(gpre[i].y);
            const f32x2 qm = (f32x2){bflo(qpre[i]) * E0, bfhi(qpre[i]) * E1}, km = (f32x2){k0 * I0, k1 * I1};
            const f32x2 qs = qm * Rc, ke = km * C4;
            LAS unsigned char* pq = lds + i * 256 + ((A1 ^ (unsigned)(i << 4)) + C1);
            *(LAS unsigned*)(pq + HL_QM) = cvt_pk_bf16_c(qm.x, qm.y);
            *(LAS unsigned*)(pq + HL_KM) = cvt_pk_bf16_c(km.x, km.y);
            *(LAS unsigned*)(lds + HL_QS + i * 256 + ((A2 ^ (unsigned)(i << 4)) + C2)) = cvt_pk_bf16_c(qs.x, qs.y);
            *(LAS unsigned*)(lds + HL_KE + i * 256 + ((A3 ^ (unsigned)((i & 3) << 5)) + C3)) = cvt_pk_bf16_c(ke.x, ke.y);
        }
        if (c + 1 < L / 64) {
            const size_t rb = (tok0 + 64 + 8 * w) * 1024 + hc;
            const float* gb = GH + rb; const bf16_t* qb = QH + rb; const bf16_t* vb = VH + (tok0 + 64) * 1024 + hc;
#pragma unroll
            for (int i = 0; i < 8; ++i) { gpre[i] = *(const f32x2*)(gb + i * 1024 + lo_g); qpre[i] = *(const unsigned*)(qb + i * 1024 + lo_g); }
            vpre[0] = *(const u32x4*)(vb + lo_v); vpre[1] = *(const u32x4*)(vb + 64 + lo_v);
        }
        __syncthreads();
#pragma unroll
        for (int rep = 0; rep < 2; ++rep) {
            if (rep == 1 && w >= 4) break;
            const int idx = rep == 0 ? w : 8 + w;
            const int si = (0xd940e4 >> (2 * idx)) & 3, ti = (0x8fb9e4 >> (2 * idx)) & 3;
            f32x4 pacc = (f32x4){0.f, 0.f, 0.f, 0.f};
            if (idx < 10) {
#pragma unroll
                for (int ks = 0; ks < 4; ++ks) {
                    const int ofs = r16 * 256 + (((4 * ks + g) ^ r16) << 4);
                    const bf16x8 af = *(const LAS bf16x8*)(lds + HL_KM + si * 4096 + ofs);
                    const bf16x8 bfr = *(const LAS bf16x8*)(lds + HL_QM + ti * 4096 + ofs);
                    pacc = __builtin_amdgcn_mfma_f32_16x16x32_bf16(af, bfr, pacc, 0, 0, 0);
                }
                const bool offd = si != ti;
#pragma unroll
                for (int r = 0; r < 4; ++r) pacc[r] = (offd || (4 * g + r <= r16)) ? pacc[r] : 0.f;
            }
            asm volatile("s_nop 7\n\ts_nop 7" ::: "memory");
            const int t = 16 * ti + r16;
            u32x2 pw; pw.x = cvt_pk_bf16_c(pacc[0], pacc[1]); pw.y = cvt_pk_bf16_c(pacc[2], pacc[3]);
            *(LAS u32x2*)(lds + HL_PL + t * 128 + (((2 * si + (g >> 1)) ^ ((t >> 1) & 7)) << 4) + (g & 1) * 8) = pw;
        }
        __syncthreads();
        const f32x4 nw4 = *(const f32x4*)(a.in[6] + 16 * w + 4 * g);
        u32x2 ogp[4];
        { const bf16_t* ob = OG + tok0 * 1024 + hc + 16 * w;
#pragma unroll
          for (int ti = 0; ti < 4; ++ti) ogp[ti] = *(const u32x2*)(ob + ti * 16384 + lo_og); }
#define HG_SB() __builtin_amdgcn_sched_barrier(0)
#define HG_QSLD(dst, kp) do { _Pragma("unroll") for (int ti = 0; ti < 4; ++ti) { const int t_ = 16 * ti + r16; \
            const u32x2 lo_ = *(const LAS u32x2*)(lds + HL_QS + t_ * 256 + (((8 * (kp) + g) ^ (r16 << 1)) << 3)); \
            const u32x2 hi_ = *(const LAS u32x2*)(lds + HL_QS + t_ * 256 + (((8 * (kp) + 4 + g) ^ (r16 << 1)) << 3)); \
            dst[ti] = (u32x4){lo_.x, lo_.y, hi_.x, hi_.y}; } } while (0)
#define HG_KELD(dst, kt) do { _Pragma("unroll") for (int ks = 0; ks < 2; ++ks) { const LAS unsigned char* pb_ = lds + HL_KE + ks * 32 * 256 + trrow + (((kt) ^ keyl) << 5); \
            dst[ks] = mk8(lds_tr16(pb_), lds_tr16(pb_ + 4 * 256)); } } while (0)
#define HG_INTER(kp, qsv) do { u32x4 sw_; sw_.x = cvt_pk_bf16_c(Sacc[2 * (kp)][0], Sacc[2 * (kp)][1]); sw_.y = cvt_pk_bf16_c(Sacc[2 * (kp)][2], Sacc[2 * (kp)][3]); \
            sw_.z = cvt_pk_bf16_c(Sacc[2 * (kp) + 1][0], Sacc[2 * (kp) + 1][1]); sw_.w = cvt_pk_bf16_c(Sacc[2 * (kp) + 1][2], Sacc[2 * (kp) + 1][3]); \
            const bf16x8 sf_ = __builtin_bit_cast(bf16x8, sw_); \
            _Pragma("unroll") for (int ti = 0; ti < 4; ++ti) Oa[ti] = __builtin_amdgcn_mfma_f32_16x16x32_bf16(sf_, __builtin_bit_cast(bf16x8, qsv[ti]), Oa[ti], 0, 0, 0); } while (0)
#define HG_SUPD(kt, kev, dsv) do { f32x4 sa_ = Sacc[kt] * dsv; \
            sa_ = __builtin_amdgcn_mfma_f32_16x16x32_bf16(kev[0], vf[0], sa_, 0, 0, 0); sa_ = __builtin_amdgcn_mfma_f32_16x16x32_bf16(kev[1], vf[1], sa_, 0, 0, 0); Sacc[kt] = sa_; } while (0)
        bf16x8 vf[2];
        bf16x8 pf[6];
        u32x4 qsA[4], qsB[4];
#pragma unroll
        for (int ks = 0; ks < 2; ++ks) {
            const LAS unsigned char* pb = lds + HL_VT + ks * 32 * 256 + trrow + ((w ^ keyl) << 5);
            vf[ks] = mk8(lds_tr16(pb), lds_tr16(pb + 4 * 256));
        }
        {
            const int t0_ = r16, t1_ = 16 + r16, t2_ = 32 + r16, t3_ = 48 + r16;
            pf[0] = *(const LAS bf16x8*)(lds + HL_PL + t0_ * 128 + (((g) ^ ((t0_ >> 1) & 7)) << 4));
            pf[1] = *(const LAS bf16x8*)(lds + HL_PL + t1_ * 128 + (((g) ^ ((t1_ >> 1) & 7)) << 4));
            pf[2] = *(const LAS bf16x8*)(lds + HL_PL + t2_ * 128 + (((g) ^ ((t2_ >> 1) & 7)) << 4));
            pf[3] = *(const LAS bf16x8*)(lds + HL_PL + t2_ * 128 + (((4 + g) ^ ((t2_ >> 1) & 7)) << 4));
            pf[4] = *(const LAS bf16x8*)(lds + HL_PL + t3_ * 128 + (((g) ^ ((t3_ >> 1) & 7)) << 4));
            pf[5] = *(const LAS bf16x8*)(lds + HL_PL + t3_ * 128 + (((4 + g) ^ ((t3_ >> 1) & 7)) << 4));
        }
        HG_QSLD(qsA, 0);
        HG_SB();
        f32x4 Oa[4];
        const f32x4 z4 = (f32x4){0.f, 0.f, 0.f, 0.f};
        Oa[0] = __builtin_amdgcn_mfma_f32_16x16x32_bf16(vf[0], pf[0], z4, 0, 0, 0);
        Oa[1] = __builtin_amdgcn_mfma_f32_16x16x32_bf16(vf[0], pf[1], z4, 0, 0, 0);
        Oa[2] = __builtin_amdgcn_mfma_f32_16x16x32_bf16(vf[0], pf[2], z4, 0, 0, 0);
        Oa[3] = __builtin_amdgcn_mfma_f32_16x16x32_bf16(vf[0], pf[4], z4, 0, 0, 0);
        Oa[2] = __builtin_amdgcn_mfma_f32_16x16x32_bf16(vf[1], pf[3], Oa[2], 0, 0, 0);
        Oa[3] = __builtin_amdgcn_mfma_f32_16x16x32_bf16(vf[1], pf[5], Oa[3], 0, 0, 0);
        HG_SB();
        HG_QSLD(qsB, 1);
        HG_SB();
        HG_INTER(0, qsA);
        HG_SB();
        HG_QSLD(qsA, 2);
        HG_SB();
        HG_INTER(1, qsB);
        HG_SB();
        HG_QSLD(qsB, 3);
        HG_SB();
#define HG_DSLD(kt) (*(const LAS f32x4*)(lds + HL_DS + (16 * (kt) + 4 * g) * 4))
        bf16x8 keA[2], keB[2], keC[2], keD[2]; f32x4 dA, dB, dC, dD;
        HG_KELD(keA, 0); HG_KELD(keB, 1); dA = HG_DSLD(0); dB = HG_DSLD(1);
        HG_SB();
        HG_INTER(2, qsA);
        HG_SB();
        HG_KELD(keC, 2); HG_KELD(keD, 3); dC = HG_DSLD(2); dD = HG_DSLD(3);
        HG_SB();
        HG_INTER(3, qsB);
        HG_SB();
        HG_SUPD(0, keA, dA); HG_SUPD(1, keB, dB);
        HG_SB();
        HG_KELD(keA, 4); HG_KELD(keB, 5); dA = HG_DSLD(4); dB = HG_DSLD(5);
        HG_SB();
        HG_SUPD(2, keC, dC); HG_SUPD(3, keD, dD);
        HG_SB();
        HG_KELD(keC, 6); HG_KELD(keD, 7); dC = HG_DSLD(6); dD = HG_DSLD(7);
        HG_SB();
        HG_SUPD(4, keA, dA); HG_SUPD(5, keB, dB);
        HG_SB();
        HG_SUPD(6, keC, dC); HG_SUPD(7, keD, dD);
#undef HG_DSLD
#undef HG_SB
#undef HG_QSLD
#undef HG_KELD
#undef HG_INTER
#undef HG_SUPD
#pragma unroll
        for (int ti = 0; ti < 4; ++ti) {
            float sq = (Oa[ti][0] * Oa[ti][0] + Oa[ti][1] * Oa[ti][1]) + (Oa[ti][2] * Oa[ti][2] + Oa[ti][3] * Oa[ti][3]);
            sq += __shfl_xor(sq, 16); sq += __shfl_xor(sq, 32);
            if (g == 0) *(LAS float*)(lds + HL_SSQ + (w * 64 + 16 * ti + r16) * 4) = sq;
        }
        __syncthreads();
#pragma unroll
        for (int ti = 0; ti < 4; ++ti) {
            const int t = 16 * ti + r16;
            float tot = 0.f;
#pragma unroll
            for (int ww = 0; ww < 8; ++ww) tot += *(const LAS float*)(lds + HL_SSQ + (ww * 64 + t) * 4);
            const float rs = rsqrtf(tot * (1.f / 128.f) + EPS);
            u32x2 o; o.x = pk2(Oa[ti][0] * rs * nw4[0] * bflo(ogp[ti].x), Oa[ti][1] * rs * nw4[1] * bfhi(ogp[ti].x));
            o.y = pk2(Oa[ti][2] * rs * nw4[2] * bflo(ogp[ti].y), Oa[ti][3] * rs * nw4[3] * bfhi(ogp[ti].y));
            *(u32x2*)(YM + tok0 * D + hc + 16 * w + ti * 32768 + lo_ym) = o;
        }
    }
}

typedef _Float16 f16x8 __attribute__((ext_vector_type(8)));
typedef _Float16 f16x2 __attribute__((ext_vector_type(2)));
__device__ __forceinline__ unsigned pkh(float a, float b) { const f16x2 h = {(_Float16)a, (_Float16)b}; return __builtin_bit_cast(unsigned, h); }
constexpr int LC_CNTL = 4096, LC_BASE = 4224;
__device__ __forceinline__ void p4_ln_router(Frame& F, const Args& a) {
    LAS unsigned char* lds = F.lds;
    const bf16_t* Z = (const bf16_t*)(F.ws + WS_Z); bf16_t* H1 = (bf16_t*)(F.ws + WS_H1);
    const float* w = a.in[11]; const float* b = a.in[12]; const float* br = a.in[14];
    int* cnt = (int*)(F.ws + WS_CTL) + CW_CNT; int* list = (int*)(F.ws + WS_LIST);
    int* tok_e = (int*)(F.ws + WS_TOKE); int* tok_p = (int*)(F.ws + WS_TOKP); float* tok_g = (float*)(F.ws + WS_TOKG);
    const int tid = F.tid, lane = F.lane, wv = F.wave, r16 = lane & 15, g = lane >> 4, nh = wv & 1, q = wv >> 1;
    LAS int* CNTL = (LAS int*)(lds + LDSCTL_OFF + LC_CNTL); LAS int* BASE = (LAS int*)(lds + LDSCTL_OFF + LC_BASE);
    if (tid < 32) CNTL[tid] = 0;
    const _Float16* ph = (const _Float16*)(F.ws + WS_WRH) + (size_t)(16 * nh + r16) * D + 512 * q + 8 * g;
    int se0 = 0, se1 = 0, se2 = 0, se3 = 0; float sg0 = 0.f, sg1 = 0.f, sg2 = 0.f, sg3 = 0.f;
    const int ntile = T / 32;
    const int nmy = (ntile - F.vcu + F.G - 1) / F.G;
    for (int it = 0; it < nmy; ++it) {
        const int tile = F.vcu + it * F.G;
        __syncthreads();
#define P4_LN(v, tlx) do { const int tl = (tlx); float s = 0.f; \
            _Pragma("unroll") for (int j = 0; j < 8; ++j) s += (v[j][0] + v[j][1]) + (v[j][2] + v[j][3]); \
            const float mean = wave_sum(s) * (1.f / D); float s2 = 0.f; \
            _Pragma("unroll") for (int j = 0; j < 8; ++j) { v[j] = v[j] - mean; s2 += (v[j][0] * v[j][0] + v[j][1] * v[j][1]) + (v[j][2] * v[j][2] + v[j][3] * v[j][3]); } \
            const float rstd = rsqrtf(wave_sum(s2) * (1.f / D) + EPS); \
            _Pragma("unroll") for (int j = 0; j < 8; ++j) { const f32x4 ww = *((const f32x4*)w + 2 * (lane + 64 * (j >> 1)) + (j & 1)), bb = *((const f32x4*)b + 2 * (lane + 64 * (j >> 1)) + (j & 1)); \
                f32x4 hv; hv[0] = v[j][0] * rstd * ww[0] + bb[0]; hv[1] = v[j][1] * rstd * ww[1] + bb[1]; hv[2] = v[j][2] * rstd * ww[2] + bb[2]; hv[3] = v[j][3] * rstd * ww[3] + bb[3]; \
                u32x2 hh; hh.x = pkh(hv[0], hv[1]); hh.y = pkh(hv[2], hv[3]); \
                *(LAS u32x2*)(lds + tl * 4096 + (((lane + 64 * (j >> 1)) ^ (tl & 15)) << 4) + (j & 1) * 8) = hh; } } while (0)
#pragma unroll 1
        for (int ps = 0; ps < 2; ++ps) {
            f32x4 v0[8], v1[8];
            { const GAS u32x4* z0 = (const GAS u32x4*)(Z + (size_t)(tile * 32 + 4 * wv + 2 * ps) * D) + lane;
              u32x4 r0[4], r1[4];
#pragma unroll
              for (int jj = 0; jj < 4; ++jj) { r0[jj] = z0[64 * jj]; r1[jj] = z0[64 * jj + 256]; }
#pragma unroll
              for (int jj = 0; jj < 4; ++jj) {
                  v0[2 * jj][0] = __uint_as_float(r0[jj].x << 16); v0[2 * jj][1] = __uint_as_float(r0[jj].x & 0xffff0000u); v0[2 * jj][2] = __uint_as_float(r0[jj].y << 16); v0[2 * jj][3] = __uint_as_float(r0[jj].y & 0xffff0000u);
                  v0[2 * jj + 1][0] = __uint_as_float(r0[jj].z << 16); v0[2 * jj + 1][1] = __uint_as_float(r0[jj].z & 0xffff0000u); v0[2 * jj + 1][2] = __uint_as_float(r0[jj].w << 16); v0[2 * jj + 1][3] = __uint_as_float(r0[jj].w & 0xffff0000u);
                  v1[2 * jj][0] = __uint_as_float(r1[jj].x << 16); v1[2 * jj][1] = __uint_as_float(r1[jj].x & 0xffff0000u); v1[2 * jj][2] = __uint_as_float(r1[jj].y << 16); v1[2 * jj][3] = __uint_as_float(r1[jj].y & 0xffff0000u);
                  v1[2 * jj + 1][0] = __uint_as_float(r1[jj].z << 16); v1[2 * jj + 1][1] = __uint_as_float(r1[jj].z & 0xffff0000u); v1[2 * jj + 1][2] = __uint_as_float(r1[jj].w << 16); v1[2 * jj + 1][3] = __uint_as_float(r1[jj].w & 0xffff0000u);
              } }
            P4_LN(v0, 4 * wv + 2 * ps); P4_LN(v1, 4 * wv + 2 * ps + 1);
        }
#undef P4_LN
        __syncthreads();
#pragma unroll 2
        for (int r = 0; r < 16; ++r) {
            const int idx = r * 512 + tid, t = idx >> 8, c = idx & 255;
            const f16x8 hv8 = *(const LAS f16x8*)(lds + t * 4096 + ((c ^ (t & 15)) << 4));
            float f[8];
#pragma unroll
            for (int q8 = 0; q8 < 8; ++q8) f[q8] = (float)hv8[q8];
            const size_t go = (size_t)(tile * 32 + t) * D + 8 * c;
            u32x4 ob; ob.x = pk2(f[0], f[1]); ob.y = pk2(f[2], f[3]); ob.z = pk2(f[4], f[5]); ob.w = pk2(f[6], f[7]);
            *(GAS u32x4*)(H1 + go) = ob;
            u32x2 oq; oq.x = pk4_fp8(f[0] * SC_H1, f[1] * SC_H1, f[2] * SC_H1, f[3] * SC_H1); oq.y = pk4_fp8(f[4] * SC_H1, f[5] * SC_H1, f[6] * SC_H1, f[7] * SC_H1);
            *(GAS u32x2*)(F.ws + WS_H1Q + go) = oq;
        }
        f16x8 wf[16];
#pragma unroll
        for (int ks = 0; ks < 16; ++ks) wf[ks] = *(const f16x8*)(ph + 32 * ks);
        f32x4 acc0 = (f32x4){0.f, 0.f, 0.f, 0.f}, acc1 = (f32x4){0.f, 0.f, 0.f, 0.f};
#pragma unroll
        for (int ks = 0; ks < 16; ++ks) {
            const int off = r16 * 4096 + (((64 * q + 4 * ks + g) ^ r16) << 4);
            const f16x8 t0 = *(const LAS f16x8*)(lds + off), t1 = *(const LAS f16x8*)(lds + 65536 + off);
            acc0 = __builtin_amdgcn_mfma_f32_16x16x32_f16(wf[ks], t0, acc0, 0, 0, 0);
            acc1 = __builtin_amdgcn_mfma_f32_16x16x32_f16(wf[ks], t1, acc1, 0, 0, 0);
        }
        __syncthreads();
        *(LAS f32x4*)(lds + ((q * 32 + r16) * 32 + 16 * nh + 4 * g) * 4) = acc0;
        *(LAS f32x4*)(lds + ((q * 32 + 16 + r16) * 32 + 16 * nh + 4 * g) * 4) = acc1;
        __syncthreads();
#pragma unroll
        for (int ps = 0; ps < 2; ++ps) {
            const int e = lane & 31, tl = 4 * wv + 2 * ps + (lane >> 5);
            float sl = 0.f;
#pragma unroll
            for (int qq = 0; qq < 4; ++qq) sl += *(const LAS float*)(lds + ((qq * 32 + tl) * 32 + e) * 4);
            sl = sl * (1.f / 64.f) + br[e];
            float val = sl; int te[4]; float tv[4];
#pragma unroll
            for (int r = 0; r < 4; ++r) {
                float bv = val; int bi = e;
#pragma unroll
                for (int o = 1; o < 32; o <<= 1) { const float ov = __shfl_xor(bv, o); const int oi = __shfl_xor(bi, o); if (ov > bv || (ov == bv && oi < bi)) { bv = ov; bi = oi; } }
                te[r] = bi; tv[r] = bv; if (e == bi) val = -INFINITY;
            }
            float p[4], psum = 0.f;
#pragma unroll
            for (int r = 0; r < 4; ++r) { p[r] = __expf(tv[r] - tv[0]); psum += p[r]; }
            if (e < 4) {
                int ee = te[0]; float gg = p[0];
                if (e == 1) { ee = te[1]; gg = p[1]; } else if (e == 2) { ee = te[2]; gg = p[2]; } else if (e == 3) { ee = te[3]; gg = p[3]; }
                const float gn = gg / psum; const int idx = it * 2 + ps;
                if (idx == 0) { se0 = ee; sg0 = gn; } else if (idx == 1) { se1 = ee; sg1 = gn; } else if (idx == 2) { se2 = ee; sg2 = gn; } else { se3 = ee; sg3 = gn; }
            }
        }
    }
    __syncthreads();
    const bool own = (lane & 31) < 4;
    const int nent = nmy * 2;
    int rk0 = 0, rk1 = 0, rk2 = 0, rk3 = 0;
    if (own) {
        if (nent > 0) rk0 = __hip_atomic_fetch_add((LAS int*)&CNTL[se0], 1, __ATOMIC_RELAXED, __HIP_MEMORY_SCOPE_WORKGROUP);
        if (nent > 1) rk1 = __hip_atomic_fetch_add((LAS int*)&CNTL[se1], 1, __ATOMIC_RELAXED, __HIP_MEMORY_SCOPE_WORKGROUP);
        if (nent > 2) rk2 = __hip_atomic_fetch_add((LAS int*)&CNTL[se2], 1, __ATOMIC_RELAXED, __HIP_MEMORY_SCOPE_WORKGROUP);
        if (nent > 3) rk3 = __hip_atomic_fetch_add((LAS int*)&CNTL[se3], 1, __ATOMIC_RELAXED, __HIP_MEMORY_SCOPE_WORKGROUP);
    }
    __syncthreads();
    if (tid < 32) { const int c = CNTL[tid]; BASE[tid] = c > 0 ? atomicAdd(&cnt[tid], c) : 0; }
    __syncthreads();
    if (own) {
        const int k = lane & 31;
#define P4_EMIT(idx, sex, sgx, rkx) do { if (nent > (idx)) { const int m = (F.vcu + ((idx) >> 1) * F.G) * 32 + 4 * wv + 2 * ((idx) & 1) + (lane >> 5), pos = BASE[sex] + (rkx); \
            list[(size_t)(sex) * LISTCAP + pos] = m; tok_e[m * 4 + k] = (sex); tok_p[m * 4 + k] = pos; tok_g[m * 4 + k] = (sgx); } } while (0)
        P4_EMIT(0, se0, sg0, rk0); P4_EMIT(1, se1, sg1, rk1); P4_EMIT(2, se2, sg2, rk2); P4_EMIT(3, se3, sg3, rk3);
#undef P4_EMIT
    }
}
__device__ __forceinline__ int moe_tables(Frame& F) {
    LAS int* pts = (LAS int*)(F.lds + LDSCTL_OFF + LC_PTS); LAS int* cl = (LAS int*)(F.lds + LDSCTL_OFF + LC_CNT); LAS unsigned char* tileE = (LAS unsigned char*)(F.lds + LDSCTL_OFF + LC_TILEE);
    const int* cnt = (const int*)(F.ws + WS_CTL) + CW_CNT;
    __syncthreads();
    if (F.tid < 64) {
        const int e = F.tid & 31; const int c = __hip_atomic_load(cnt + e, RLX_AGENT); const int tl = (c + 255) >> 8;
        int incl = tl;
#pragma unroll
        for (int o = 1; o < 32; o <<= 1) { const int v = __shfl_up(incl, o, 32); if (e >= o) incl += v; }
        if (F.tid < 32) { cl[e] = c; pts[e] = incl - tl; if (e == 31) pts[32] = incl; }
    }
    __syncthreads();
    const int nmt = pts[32];
    for (int t = F.tid; t < nmt; t += NTHR) { int e = 0;
        for (int j = 0; j < 32; ++j) if (t >= pts[j + 1]) e = j + 1;
        tileE[t] = (unsigned char)e; }
    __syncthreads();
    return __builtin_amdgcn_readfirstlane(nmt);
}
__device__ __forceinline__ void p7_combine(Frame& F, const Args& a) {
    const LAS int* pts = (const LAS int*)(F.lds + LDSCTL_OFF + LC_PTS);
    const bf16_t* H1 = (const bf16_t*)(F.ws + WS_H1); const unsigned char* Y = (const unsigned char*)(F.ws + WS_Y);
    const int* tok_e = (const int*)(F.ws + WS_TOKE); const int* tok_p = (const int*)(F.ws + WS_TOKP); const float* tok_g = (const float*)(F.ws + WS_TOKG);
    const float* w = a.in[21]; const float* b = a.in[22]; float* out = a.out;
    const int gw = F.vcu * NWAVES + F.wave, NGW = F.G * NWAVES, lane = F.lane;
    LAS f32x4* WL = (LAS f32x4*)F.lds; LAS f32x4* BL = (LAS f32x4*)(F.lds + 8192);
    __syncthreads();
    WL[F.tid] = *((const f32x4*)w + F.tid); BL[F.tid] = *((const f32x4*)b + F.tid);
    __syncthreads();
    const int ntok = (T - gw + NGW - 1) / NGW;
    int rowv = 0; float gv = 0.f;
    { const int i = lane >> 2, k = lane & 3; if (i < ntok) { const int m = gw + i * NGW; const int e = tok_e[m * 4 + k]; rowv = pts[e] * 256 + tok_p[m * 4 + k]; gv = tok_g[m * 4 + k] * (1.f / SC_Y); } }
#define P8_LOAD(hx, yx, i) do { const int m_ = gw + (i) * NGW; const GAS u32x4* hr_ = (const GAS u32x4*)(H1 + (size_t)m_ * D) + lane; \
        _Pragma("unroll") for (int jj = 0; jj < 4; ++jj) hx[jj] = hr_[64 * jj]; \
        _Pragma("unroll") for (int k = 0; k < 4; ++k) { const int row_ = __builtin_amdgcn_readlane(rowv, 4 * (i) + k); const GAS u32x2* yr_ = (const GAS u32x2*)(Y + (size_t)row_ * D) + lane; \
            _Pragma("unroll") for (int jj = 0; jj < 4; ++jj) yx[k][jj] = yr_[64 * jj]; } } while (0)
#define P8_DO(hx, yx, i) do { const int m_ = gw + (i) * NGW; f32x4 v[8]; asm volatile("" ::: "memory"); \
        _Pragma("unroll") for (int jj = 0; jj < 4; ++jj) { v[2 * jj][0] = ALPHA * bflo(hx[jj].x); v[2 * jj][1] = ALPHA * bfhi(hx[jj].x); v[2 * jj][2] = ALPHA * bflo(hx[jj].y); v[2 * jj][3] = ALPHA * bfhi(hx[jj].y); \
            v[2 * jj + 1][0] = ALPHA * bflo(hx[jj].z); v[2 * jj + 1][1] = ALPHA * bfhi(hx[jj].z); v[2 * jj + 1][2] = ALPHA * bflo(hx[jj].w); v[2 * jj + 1][3] = ALPHA * bfhi(hx[jj].w); } \
        _Pragma("unroll") for (int k = 0; k < 4; ++k) { const float g_ = __builtin_bit_cast(float, __builtin_amdgcn_readlane(__builtin_bit_cast(int, gv), 4 * (i) + k)); \
            _Pragma("unroll") for (int jj = 0; jj < 4; ++jj) { const f32x2 y0 = __builtin_amdgcn_cvt_pk_f32_fp8((int)yx[k][jj].x, false), y1 = __builtin_amdgcn_cvt_pk_f32_fp8((int)yx[k][jj].x, true), \
                    y2 = __builtin_amdgcn_cvt_pk_f32_fp8((int)yx[k][jj].y, false), y3 = __builtin_amdgcn_cvt_pk_f32_fp8((int)yx[k][jj].y, true); \
                v[2 * jj][0] += g_ * y0[0]; v[2 * jj][1] += g_ * y0[1]; v[2 * jj][2] += g_ * y1[0]; v[2 * jj][3] += g_ * y1[1]; \
                v[2 * jj + 1][0] += g_ * y2[0]; v[2 * jj + 1][1] += g_ * y2[1]; v[2 * jj + 1][2] += g_ * y3[0]; v[2 * jj + 1][3] += g_ * y3[1]; } } \
        float s = 0.f; _Pragma("unroll") for (int j = 0; j < 8; ++j) s += (v[j][0] + v[j][1]) + (v[j][2] + v[j][3]); \
        const float mean = wave_sum(s) * (1.f / D); float s2 = 0.f; \
        _Pragma("unroll") for (int j = 0; j < 8; ++j) { v[j] = v[j] - mean; s2 += (v[j][0] * v[j][0] + v[j][1] * v[j][1]) + (v[j][2] * v[j][2] + v[j][3] * v[j][3]); } \
        const float rstd = rsqrtf(wave_sum(s2) * (1.f / D) + EPS); GAS f32x4* orow = (GAS f32x4*)(out + (size_t)m_ * D); \
        _Pragma("unroll") for (int j = 0; j < 8; ++j) { const int c4 = 2 * (lane + 64 * (j >> 1)) + (j & 1); const f32x4 ww = WL[c4], bb = BL[c4]; \
            f32x4 o; o[0] = v[j][0] * rstd * ww[0] + bb[0]; o[1] = v[j][1] * rstd * ww[1] + bb[1]; o[2] = v[j][2] * rstd * ww[2] + bb[2]; o[3] = v[j][3] * rstd * ww[3] + bb[3]; orow[c4] = o; } } while (0)
    u32x4 hA[4], hB[4]; u32x2 yA[4][4], yB[4][4];
    if (ntok > 0) P8_LOAD(hA, yA, 0);
    for (int i = 0; i < ntok; i += 2) {
        if (i + 1 < ntok) P8_LOAD(hB, yB, i + 1);
        P8_DO(hA, yA, i);
        if (i + 1 < ntok) { if (i + 2 < ntok) P8_LOAD(hA, yA, i + 2); P8_DO(hB, yB, i + 1); }
    }
#undef P8_LOAD
#undef P8_DO
}

__global__ void __launch_bounds__(NTHR, 2) mk_fwd(Args args) {
    extern __shared__ __attribute__((aligned(16))) unsigned char lds_raw[];
    Frame F;
    F.lds = (LAS unsigned char*)lds_raw;
    F.tid = threadIdx.x; F.lane = F.tid & 63; F.wave = __builtin_amdgcn_readfirstlane(F.tid >> 6);
    F.G = gridDim.x; { const int bx = blockIdx.x; F.vcu = (F.G % 8 == 0) ? (bx % 8) * (F.G / 8) + bx / 8 : bx; }
    F.ws = args.ws;
    unsigned char* ws = args.ws;
    for (int u = F.tid; u < (LDS_BYTES - LDSCTL_OFF) / 4; u += NTHR) ((LAS unsigned*)(F.lds + LDSCTL_OFF))[u] = 0u;
    __syncthreads();
    XcdBarrier bar; bar.bar = (unsigned*)(ws + WS_CTL) + CW_BAR; bar.x = 0; bar.st = nullptr;
#if !MK_PER_PHASE
    bar = xcd_barrier_post((unsigned*)(ws + WS_CTL) + CW_BAR, (volatile LAS unsigned*)(F.lds + LDSCTL_OFF + LC_BAR));
#endif
    const int lo = args.ph_lo, hi = args.ph_hi;
#define IN(k) (lo <= (k) && (k) < hi)
#define REFRESH_IDS() do { int t_ = threadIdx.x; asm volatile("" : "+v"(t_)); F.tid = t_; F.lane = t_ & 63; F.wave = __builtin_amdgcn_readfirstlane(t_ >> 6); } while (0)
#define STAGGER(n) do { const int g_ = ((int)blockIdx.x >> 3) & 7; for (int i_ = 0; i_ < g_ * (n); ++i_) __builtin_amdgcn_s_sleep(32); } while (0)
#define SEAM(k) do { if (IN(k) && IN((k) + 1)) xcd_barrier(bar); } while (0)

    if (IN(0)) { REFRESH_IDS(); for (int r = 0; r < REP0; ++r) { p0_prologue(F, args); if (r + 1 < REP0) xcd_barrier(bar); } } SEAM(0);

    if (IN(1)) { REFRESH_IDS();
        const int Gg = F.G;
        SchedDense S{(const bf16_t*)(ws + WS_H0), (const bf16_t*)(ws + WS_WIN), T / 256, INC / 256, Gg, (int)blockIdx.x};
        EpiInProj E{(bf16_t*)(ws + WS_QH), (bf16_t*)(ws + WS_KH), (bf16_t*)(ws + WS_VH), (bf16_t*)(ws + WS_OG), (bf16_t*)(ws + WS_AQ), (bf16_t*)(ws + WS_AK), (bf16_t*)(ws + WS_AV),
                    (float*)(ws + WS_GH), (const float*)(ws + WS_LB), args.in[4]};
        STAGGER(STAG1);
        for (int r = 0; r < REP1; ++r) { gemm_phase<EpiInProj, SchedDense>(F.lds, S, E); if (r + 1 < REP1) xcd_barrier(bar); }
        {
            const int nwg = (T / 256) * (INC / 256), full = nwg / F.G, extra = nwg - full * F.G;
            const bool has_extra = (int)blockIdx.x < extra;
            if (has_extra) { if (threadIdx.x == 0) __hip_atomic_fetch_add((unsigned*)(ws + WS_CTL) + CW_P1DONE, 1u, RLX_AGENT); }
            else if (extra > 0) { __syncthreads(); cv_worker(F, args, (const unsigned*)(ws + WS_CTL) + CW_P1DONE, (unsigned)extra); }
        }
    } SEAM(1);

    if (IN(2)) { REFRESH_IDS();
        for (int r = 0; r < REP2; ++r) {
        const int nh = F.G > 64 ? 64 : F.G;
        const int a0 = F.G >= 192 ? 64 : 0, na = F.G >= 192 ? 64 : F.G;
        if ((int)blockIdx.x < nh) { for (int hu = blockIdx.x; hu < 64 * REP2H; hu += nh) hgrn_unit_mfma(F, args, (hu & 63) >> 3, hu & 7); }
        REFRESH_IDS();
        if ((int)blockIdx.x >= a0 && (int)blockIdx.x < a0 + na) {
            for (int v0 = (int)blockIdx.x - a0; v0 < NB * (L / AT_Q) * REP2A; v0 += na) { const int v = v0 % (NB * (L / AT_Q)); attn_unit_mfma(F, args, v / (L / AT_Q), v % (L / AT_Q)); }
        }
        __syncthreads();
        REFRESH_IDS();
        cv_worker(F, args, nullptr, 0u);
        if (r + 1 < REP2) xcd_barrier(bar); }
    } SEAM(2);

    if (IN(3)) { REFRESH_IDS();
        SchedDense S{(const bf16_t*)(ws + WS_YMIX), (const bf16_t*)(ws + WS_WOUT), T / 256, D / 256, F.G, (int)blockIdx.x};
        EpiOutProj E{(bf16_t*)(ws + WS_Z), (const bf16_t*)(ws + WS_H0), args.in[10]};
        STAGGER(STAG3);
        for (int r = 0; r < REP3; ++r) { gemm_phase<EpiOutProj, SchedDense>(F.lds, S, E); if (r + 1 < REP3) xcd_barrier(bar); }
    } SEAM(3);

    if (IN(4)) { REFRESH_IDS(); p4_ln_router(F, args); }

    if (IN(5) && !IN(4)) { REFRESH_IDS(); __syncthreads(); cv_worker(F, args, nullptr, 0u); }
    if (IN(4) || IN(5)) { if (IN(6)) xcd_barrier(bar); }

    if (IN(6)) { REFRESH_IDS();
        const int nmt = moe_tables(F);
        SchedMoe<2048> S{(const void*)(ws + WS_H1Q), (const void*)(ws + WS_WGU), (size_t)4096 * KD, (const int*)(ws + WS_LIST),
                   (const LAS int*)(F.lds + LDSCTL_OFF + LC_PTS), (const LAS int*)(F.lds + LDSCTL_OFF + LC_CNT), (const LAS unsigned char*)(F.lds + LDSCTL_OFF + LC_TILEE), nmt, 16, F.G, (int)blockIdx.x, true};
        EpiMoe1F8 E{(unsigned char*)(ws + WS_HACT), args.in[16], args.in[18]};
        STAGGER(STAG6);
        for (int r = 0; r < REP5; ++r) { gemm_phase<EpiMoe1F8, SchedMoe<2048>, true>(F.lds, S, E); if (r + 1 < REP5) xcd_barrier(bar); }
    } SEAM(6);

    if (IN(7)) { REFRESH_IDS();
        const int nmt = moe_tables(F);
        STAGGER(STAG7);
        SchedMoe<2048> S{(const void*)(ws + WS_HACT), (const void*)(ws + WS_WD), (size_t)2048 * KD, (const int*)(ws + WS_LIST),
                   (const LAS int*)(F.lds + LDSCTL_OFF + LC_PTS), (const LAS int*)(F.lds + LDSCTL_OFF + LC_CNT), (const LAS unsigned char*)(F.lds + LDSCTL_OFF + LC_TILEE), nmt, 8, F.G, (int)blockIdx.x, false};
        EpiMoe2F8 E{(unsigned char*)(ws + WS_Y), args.in[20]};
        for (int r = 0; r < REP6; ++r) { gemm_phase<EpiMoe2F8, SchedMoe<2048>, true>(F.lds, S, E); if (r + 1 < REP6) xcd_barrier(bar); }
    } SEAM(7);

    if (IN(8)) { REFRESH_IDS(); (void)moe_tables(F); for (int r = 0; r < REP7; ++r) p7_combine(F, args); }
#undef IN
#undef SEAM
}
}

extern "C" void kernel_launch(void* const* d_in, const int* in_sizes, int n_in, void* d_out, int out_size, void* d_ws, size_t ws_size, hipStream_t stream) {
    static int grid = 0;
    if (grid == 0) {
        if (n_in != 23 || out_size != T * D || ws_size < WS_END) { fprintf(stderr, "kernel_launch: unexpected shapes (n_in %d out %d ws %zu need %zu)\n", n_in, out_size, ws_size, (size_t)WS_END); grid = -1; return; }
        int dev = 0, cus = 0, per_cu = 0;
        if (hipGetDevice(&dev) != hipSuccess || hipDeviceGetAttribute(&cus, hipDeviceAttributeMultiprocessorCount, dev) != hipSuccess) { grid = -1; return; }
        if (hipFuncSetAttribute((const void*)mk_fwd, hipFuncAttributeMaxDynamicSharedMemorySize, LDS_BYTES) != hipSuccess) { fprintf(stderr, "kernel_launch: hipFuncSetAttribute failed\n"); grid = -1; return; }
        if (hipOccupancyMaxActiveBlocksPerMultiprocessor(&per_cu, (const void*)mk_fwd, NTHR, LDS_BYTES) != hipSuccess || per_cu < 1) { fprintf(stderr, "kernel_launch: occupancy query says %d\n", per_cu); }
        (void)hipGetLastError();
        grid = cus;
    }
    if (grid < 0) return;
    if (hipMemsetAsync((char*)d_ws + WS_CTL, 0, CTL_ZERO_BYTES, stream) != hipSuccess) return;
    Args a{};
    for (int i = 0; i < 23; ++i) a.in[i] = (const float*)d_in[i];
    a.out = (float*)d_out; a.ws = (unsigned char*)d_ws;
#if MK_PER_PHASE
    for (int p = 0; p < NPHASE; ++p) { a.ph_lo = p; a.ph_hi = p + 1; hipLaunchKernelGGL(mk_fwd, dim3(grid), dim3(NTHR), LDS_BYTES, stream, a); }
#else
    a.ph_lo = 0; a.ph_hi = NPHASE; hipLaunchKernelGGL(mk_fwd, dim3(grid), dim3(NTHR), LDS_BYTES, stream, a);
#endif
}
```
